# Optimizing an MI355X kernel written in HIP

```python
import math
import jax
import jax.numpy as jnp
from jax import lax
import numpy as np

D_MODEL = 1024
BATCH = 8
SEQ = 4096
DEPTH = 2

HEAD_DIM = 64
ROT_DIM = HEAD_DIM // 4
ROPE_THETA = 500000.0
NORM_EPS = 1e-6
NEG_INF = -1e30
ATTN_SCALE = HEAD_DIM ** -0.5
Q_CHUNK = 32

N_BRANCH = 3
BRANCH_HEADS = 8
BRANCH_WIDTH = BRANCH_HEADS * HEAD_DIM

DIL_PATTERNS = ((128, 1), (512, 4), (2048, 16))
N_GROUPS_A = len(DIL_PATTERNS)

IDX_HEADS = 8
IDX_DIM = 64
IDX_ROT = IDX_DIM // 4
IDX_TOPK_MAX = 256

MOBA_BLOCK = 256
MOBA_TOPK = 3

A_QKV_COLS = 3 * N_GROUPS_A * BRANCH_WIDTH
B_QKV_COLS = 3 * BRANCH_WIDTH
IDX_Q_COLS = IDX_HEADS * IDX_DIM
IDX_K_COLS = IDX_DIM
IDX_W_COLS = IDX_HEADS
C_QKV_COLS = 3 * BRANCH_WIDTH
SILU_GATE_COLS = N_BRANCH * BRANCH_WIDTH
MERGE_GATE_COLS = N_BRANCH * D_MODEL
IN_COLS = (A_QKV_COLS, B_QKV_COLS, IDX_Q_COLS, IDX_K_COLS, IDX_W_COLS,
           C_QKV_COLS, SILU_GATE_COLS, MERGE_GATE_COLS)
N_IN = sum(IN_COLS)
SPLIT_POINTS = tuple(int(c) for c in np.cumsum(IN_COLS)[:-1])

kernel_name = 'hybrid_dilated_dsa_moba_block'


def rms_norm(x, g):
    xf = x.astype(jnp.float32)
    y = xf * lax.rsqrt(jnp.mean(xf * xf, axis=-1, keepdims=True) + NORM_EPS)
    return (y * g.astype(jnp.float32)).astype(x.dtype)


def rope_tables(positions, rot_dim):
    inv = ROPE_THETA ** (-jnp.arange(0, rot_dim, 2, dtype=jnp.float32) / rot_dim)
    ang = positions.astype(jnp.float32)[..., None] * inv
    return jnp.cos(ang)[:, :, None, :], jnp.sin(ang)[:, :, None, :]


def partial_rope(x, cos, sin):
    half = cos.shape[-1]
    xf = x.astype(jnp.float32)
    x1, x2, rest = xf[..., :half], xf[..., half:2 * half], xf[..., 2 * half:]
    out = jnp.concatenate([x1 * cos - x2 * sin, x2 * cos + x1 * sin, rest], axis=-1)
    return out.astype(x.dtype)


def banded_attention(q, k, v, band):
    N, n, dh = q.shape
    nb = -(-n // band)
    pad = nb * band - n
    qb = jnp.pad(q, ((0, 0), (0, pad), (0, 0))).reshape(N, nb, band, dh)
    kp = jnp.pad(k, ((0, 0), (band, pad), (0, 0)))
    vp = jnp.pad(v, ((0, 0), (band, pad), (0, 0)))

    def windows(t):
        return jnp.concatenate([t[:, :-band].reshape(N, nb, band, dh),
                                t[:, band:].reshape(N, nb, band, dh)], axis=2)

    kw, vw = windows(kp), windows(vp)
    s = jnp.einsum('nbqd,nbkd->nbqk', qb, kw, preferred_element_type=jnp.float32) * ATTN_SCALE
    i = jnp.arange(band)[:, None]
    j = jnp.arange(2 * band)[None, :]
    dist = i + band - j
    blk = jnp.arange(nb)[:, None, None]
    valid = (dist >= 0) & (dist <= band) & ((blk > 0) | (j >= band))
    s = jnp.where(valid, s, NEG_INF)
    m = jnp.max(s, axis=-1, keepdims=True)
    p = jnp.exp(s - m)
    den = jnp.sum(p, axis=-1, keepdims=True)
    o = jnp.einsum('nbqk,nbkd->nbqd', (p / den).astype(v.dtype), vw)
    lse = (m + jnp.log(den))[..., 0]
    return o.reshape(N, nb * band, dh)[:, :n], lse.reshape(N, nb * band)[:, :n]


def dilated_attention(q, k, v):
    B, S, _, dh = q.shape
    H = BRANCH_HEADS
    q = q.reshape(B, S, N_GROUPS_A, H, dh)
    k = k.reshape(B, S, N_GROUPS_A, H, dh)
    v = v.reshape(B, S, N_GROUPS_A, H, dh)
    outs, lses = [], []
    for g, (window, dil) in enumerate(DIL_PATTERNS):
        n = S // dil

        def fold(t):
            return t[:, :, g].reshape(B, n, dil, H, dh).transpose(0, 2, 3, 1, 4).reshape(B * dil * H, n, dh)

        o, lse = banded_attention(fold(q), fold(k), fold(v), window // dil)
        outs.append(o.reshape(B, dil, H, n, dh).transpose(0, 3, 1, 2, 4).reshape(B, S, H, dh))
        lses.append(lse.reshape(B, dil, H, n).transpose(0, 3, 1, 2).reshape(B, S, H))
    o = jnp.stack(outs, axis=2)
    wts = jax.nn.softmax(jnp.stack(lses, axis=2), axis=2)
    return jnp.einsum('bsgh,bsghd->bshd', wts.astype(o.dtype), o)


def dsa_attention(q, k, v, q_idx, k_idx, w_idx):
    B, S, H, dh = q.shape
    topk = min(IDX_TOPK_MAX, S // 4)
    b_i = jnp.arange(B)[:, None, None]
    s_pos = jnp.arange(S)
    k_idx32 = k_idx.astype(jnp.float32)

    def chunk(c):
        t0 = c * Q_CHUNK
        qc = lax.dynamic_slice_in_dim(q, t0, Q_CHUNK, axis=1)
        qi = lax.dynamic_slice_in_dim(q_idx, t0, Q_CHUNK, axis=1).astype(jnp.float32)
        wi = lax.dynamic_slice_in_dim(w_idx, t0, Q_CHUNK, axis=1).astype(jnp.float32)
        t = t0 + jnp.arange(Q_CHUNK)
        logits = jnp.einsum('bqhd,bsd->bqhs', qi, k_idx32) * (IDX_DIM ** -0.5)
        score = jnp.einsum('bqh,bqhs->bqs', wi * (IDX_HEADS ** -0.5), jax.nn.relu(logits))
        score = jnp.where(s_pos[None, None, :] <= t[None, :, None], score, NEG_INF)
        _, idx = lax.top_k(score, topk)
        ok = idx <= t[None, :, None]
        ks = k[b_i, idx]
        vs = v[b_i, idx]
        s = jnp.einsum('bqhd,bqkhd->bqhk', qc, ks, preferred_element_type=jnp.float32) * ATTN_SCALE
        s = jnp.where(ok[:, :, None, :], s, NEG_INF)
        p = jax.nn.softmax(s, axis=-1)
        return jnp.einsum('bqhk,bqkhd->bqhd', p.astype(v.dtype), vs)

    out = lax.map(chunk, jnp.arange(S // Q_CHUNK))
    return out.transpose(1, 0, 2, 3, 4).reshape(B, S, H, dh)


def moba_attention(q, k, v):
    B, S, H, dh = q.shape
    nblk = -(-S // MOBA_BLOCK)
    pad = nblk * MOBA_BLOCK - S
    kp = jnp.pad(k, ((0, 0), (0, pad), (0, 0), (0, 0)))
    vp = jnp.pad(v, ((0, 0), (0, pad), (0, 0), (0, 0)))
    kb = kp.reshape(B, nblk, MOBA_BLOCK, H, dh).transpose(0, 3, 1, 2, 4)
    vb = vp.reshape(B, nblk, MOBA_BLOCK, H, dh).transpose(0, 3, 1, 2, 4)
    kmean = jnp.mean(kb.astype(jnp.float32), axis=3)
    topb = min(MOBA_TOPK, nblk - 1)
    b_i = jnp.arange(B)[:, None, None, None]
    h_i = jnp.arange(H)[None, :, None, None]
    blk_ids = jnp.arange(nblk)
    in_blk = jnp.arange(MOBA_BLOCK)

    def chunk(c):
        t0 = c * Q_CHUNK
        qc = lax.dynamic_slice_in_dim(q, t0, Q_CHUNK, axis=1).transpose(0, 2, 1, 3)
        t = t0 + jnp.arange(Q_CHUNK)
        own = t0 // MOBA_BLOCK
        k_own = lax.dynamic_index_in_dim(kb, own, axis=2, keepdims=False)
        v_own = lax.dynamic_index_in_dim(vb, own, axis=2, keepdims=False)
        s_own = jnp.einsum('bhqd,bhkd->bhqk', qc, k_own, preferred_element_type=jnp.float32) * ATTN_SCALE
        causal = (own * MOBA_BLOCK + in_blk)[None, :] <= t[:, None]
        s_own = jnp.where(causal, s_own, NEG_INF)
        if topb > 0:
            gate = jnp.einsum('bhqd,bhnd->bhqn', qc.astype(jnp.float32), kmean)
            gate = jnp.where(blk_ids < own, gate, NEG_INF)
            _, bidx = lax.top_k(gate, topb)
            okb = bidx < own
            ks = kb[b_i, h_i, bidx]
            vs = vb[b_i, h_i, bidx]
            s_sel = jnp.einsum('bhqd,bhqnkd->bhqnk', qc, ks, preferred_element_type=jnp.float32) * ATTN_SCALE
            s_sel = jnp.where(okb[..., None], s_sel, NEG_INF).reshape(B, H, Q_CHUNK, topb * MOBA_BLOCK)
            p = jax.nn.softmax(jnp.concatenate([s_sel, s_own], axis=-1), axis=-1).astype(v.dtype)
            p_sel = p[..., :topb * MOBA_BLOCK].reshape(B, H, Q_CHUNK, topb, MOBA_BLOCK)
            p_own = p[..., topb * MOBA_BLOCK:]
            o = (jnp.einsum('bhqnk,bhqnkd->bhqd', p_sel, vs)
                 + jnp.einsum('bhqk,bhkd->bhqd', p_own, v_own))
        else:
            p_own = jax.nn.softmax(s_own, axis=-1).astype(v.dtype)
            o = jnp.einsum('bhqk,bhkd->bhqd', p_own, v_own)
        return o.transpose(0, 2, 1, 3)

    out = lax.map(chunk, jnp.arange(S // Q_CHUNK))
    return out.transpose(1, 0, 2, 3, 4).reshape(B, S, H, dh)


def hybrid_layer(x, cos, sin, cos_i, sin_i, norm_g, w_in, qk_g, w_br, w_out):
    B, S, _ = x.shape
    h = rms_norm(x, norm_g)
    proj = jnp.einsum('bsd,dc->bsc', h, w_in)
    a_qkv, b_qkv, q_idx, k_idx, w_idx, c_qkv, z, g = jnp.split(proj, SPLIT_POINTS, axis=-1)

    def heads(t, n_heads):
        t = t.reshape(B, S, 3, n_heads, HEAD_DIM)
        return t[:, :, 0], t[:, :, 1], t[:, :, 2]

    def prep_qk(q, k, mixer):
        q = partial_rope(rms_norm(q, qk_g[mixer, 0]), cos, sin)
        k = partial_rope(rms_norm(k, qk_g[mixer, 1]), cos, sin)
        return q, k

    qa, ka, va = heads(a_qkv, N_GROUPS_A * BRANCH_HEADS)
    qa, ka = prep_qk(qa, ka, 0)
    o_a = dilated_attention(qa, ka, va)

    qb, kb, vb = heads(b_qkv, BRANCH_HEADS)
    qb, kb = prep_qk(qb, kb, 1)
    q_idx = partial_rope(q_idx.reshape(B, S, IDX_HEADS, IDX_DIM), cos_i, sin_i)
    k_idx = partial_rope(k_idx[:, :, None, :], cos_i, sin_i)[:, :, 0]
    o_b = dsa_attention(qb, kb, vb, q_idx, k_idx, w_idx)

    qc, kc, vc = heads(c_qkv, BRANCH_HEADS)
    qc, kc = prep_qk(qc, kc, 2)
    o_c = moba_attention(qc, kc, vc)

    o = jnp.stack([o_a, o_b, o_c], axis=2).reshape(B, S, N_BRANCH, BRANCH_WIDTH)
    o = o * jax.nn.silu(z.reshape(B, S, N_BRANCH, BRANCH_WIDTH))
    y = jnp.einsum('bsnc,ncd->bsnd', o, w_br)
    gate = jax.nn.sigmoid(g.reshape(B, S, N_BRANCH, D_MODEL))
    merged = jnp.sum(gate * y, axis=2)
    return x + jnp.einsum('bsd,de->bse', merged, w_out)


def setup_inputs(seed: int = 0) -> dict:
    key = jax.random.key(seed)
    ks = jax.random.split(key, 7)
    x = jax.random.normal(ks[0], (BATCH, SEQ, D_MODEL), jnp.float32)
    offsets = jax.random.randint(ks[1], (BATCH, 1), 0, 2048, dtype=jnp.int32)
    positions = (offsets + jnp.arange(SEQ, dtype=jnp.int32)[None, :]).astype(jnp.int32)
    norm_g = 1.0 + 0.1 * jax.random.normal(ks[2], (DEPTH, D_MODEL), jnp.float32)
    w_in = jax.random.normal(ks[3], (DEPTH, D_MODEL, N_IN), jnp.float32) * (D_MODEL ** -0.5)
    qk_g = 1.0 + 0.1 * jax.random.normal(ks[4], (DEPTH, N_BRANCH, 2, HEAD_DIM), jnp.float32)
    w_br = jax.random.normal(ks[5], (DEPTH, N_BRANCH, BRANCH_WIDTH, D_MODEL), jnp.float32) * (BRANCH_WIDTH ** -0.5)
    w_out = jax.random.normal(ks[6], (DEPTH, D_MODEL, D_MODEL), jnp.float32) * (D_MODEL ** -0.5)
    return {'x': x, 'positions': positions, 'norm_g': norm_g, 'w_in': w_in,
            'qk_g': qk_g, 'w_br': w_br, 'w_out': w_out}


def reference(x, positions, norm_g, w_in, qk_g, w_br, w_out):
    cos, sin = rope_tables(positions, ROT_DIM)
    cos_i, sin_i = rope_tables(positions, IDX_ROT)
    for layer in range(DEPTH):
        x = hybrid_layer(x, cos, sin, cos_i, sin_i, norm_g[layer], w_in[layer],
                         qk_g[layer], w_br[layer], w_out[layer])
    return x
```

```cpp
#include <hip/hip_runtime.h>
#include <hip/hip_cooperative_groups.h>
#include <cstdio>
#include <cstdint>
namespace cg = cooperative_groups;

typedef unsigned short bf16_t;
typedef short bf16x8 __attribute__((ext_vector_type(8)));
typedef short s16x4 __attribute__((ext_vector_type(4)));
typedef float f32x4 __attribute__((ext_vector_type(4)));
typedef float f32x16 __attribute__((ext_vector_type(16)));
typedef unsigned u32x4 __attribute__((ext_vector_type(4)));
typedef unsigned u32x2 __attribute__((ext_vector_type(2)));
#define DI __device__ __forceinline__

constexpr int S = 4096, DM = 1024, NB = 8, DEPTH = 2;
constexpr int NIN = 12872, NPAD = 13056;
constexpr int BG = 2, TG = BG * S, NGRP = NB / BG;
constexpr int NTHREADS = 512;
constexpr int SHM_BYTES = 131072;
constexpr float QSCALE = 0.125f * 1.4426950408889634f;
constexpr float LN2F = 0.6931471805599453f;
constexpr int SEL_CAP = 768;

constexpr size_t al256(size_t x) { return (x + 255) & ~(size_t)255; }
constexpr size_t OFF_WTIN = 0;
constexpr size_t OFF_WTBR = OFF_WTIN + al256((size_t)DEPTH * NPAD * DM * 2);
constexpr size_t OFF_WTOUT = OFF_WTBR + al256((size_t)DEPTH * 3 * DM * 512 * 2);
constexpr size_t OFF_CS = OFF_WTOUT + al256((size_t)DEPTH * DM * DM * 2);
constexpr size_t OFF_XB = OFF_CS + al256((size_t)NB * S * 8 * 8);
constexpr size_t OFF_SS = OFF_XB + al256((size_t)TG * DM * 2);
constexpr size_t OFF_QA = OFF_SS + al256((size_t)TG * 8 * 4);
constexpr size_t OFF_KA = OFF_QA + al256((size_t)TG * 1536 * 2);
constexpr size_t OFF_VA = OFF_KA + al256((size_t)TG * 1536 * 2);
constexpr size_t OFF_QB = OFF_VA + al256((size_t)TG * 1536 * 2);
constexpr size_t OFF_KB = OFF_QB + al256((size_t)TG * 512 * 2);
constexpr size_t OFF_VB = OFF_KB + al256((size_t)TG * 512 * 2);
constexpr size_t OFF_QC = OFF_VB + al256((size_t)TG * 512 * 2);
constexpr size_t OFF_KC = OFF_QC + al256((size_t)TG * 512 * 2);
constexpr size_t OFF_VC = OFF_KC + al256((size_t)TG * 512 * 2);
constexpr size_t OFF_IQ = OFF_VC + al256((size_t)TG * 512 * 2);
constexpr size_t OFF_IK = OFF_IQ + al256((size_t)TG * 512 * 2);
constexpr size_t OFF_IW = OFF_IK + al256((size_t)TG * 64 * 2);
constexpr size_t OFF_SZ = OFF_IW + al256((size_t)TG * 8 * 4);
constexpr size_t OFF_SG = OFF_SZ + al256((size_t)TG * 1536 * 2);
constexpr size_t OFF_OA = OFF_SG + al256((size_t)TG * 3072 * 2);
constexpr size_t OFF_LSE = OFF_OA + al256((size_t)3 * TG * 512 * 2);
constexpr size_t OFF_MASK = OFF_LSE + al256((size_t)3 * TG * 8 * 4);
constexpr size_t OFF_KM = OFF_MASK + al256((size_t)BG * S * (S / 8));
constexpr size_t OFF_MF = OFF_KM + al256((size_t)BG * 8 * 16 * 64 * 2 * 2);
constexpr size_t OFF_MB = OFF_MF + al256((size_t)TG * DM * 4);
constexpr size_t WS_NEED = OFF_MB + al256((size_t)TG * DM * 2);

struct Params {
    const float* x; const int* pos; const float* norm_g; const float* w_in; const float* qk_g; const float* w_br; const float* w_out;
    float* out; char* ws;
};

DI int ltid() { int t = threadIdx.x; asm volatile("" : "+v"(t)); return t; }
DI unsigned cvt_pk_bf16(float lo, float hi) { unsigned r; asm volatile("v_cvt_pk_bf16_f32 %0, %1, %2" : "=v"(r) : "v"(lo), "v"(hi)); return r; }
DI bf16_t f2bf(float x) { return (bf16_t)(cvt_pk_bf16(x, 0.f) & 0xffffu); }
DI float bf2f(bf16_t v) { return __uint_as_float(((unsigned)v) << 16); }
DI float fexp2(float x) { return __builtin_amdgcn_exp2f(x); }
DI float shx(float v, int mask) { const int l = ltid() & 63; return __int_as_float(__builtin_amdgcn_ds_bpermute((l ^ mask) << 2, __float_as_int(v))); }
DI float wave_sum(float v) { for (int o = 32; o > 0; o >>= 1) v += shx(v, o); return v; }
DI int f2sort(float f) { int i = __float_as_int(f); return i ^ ((i >> 31) & 0x7fffffff); }
DI float sort2f(int i) { return __int_as_float(i ^ ((i >> 31) & 0x7fffffff)); }
#define MFMA32(a, b, c) __builtin_amdgcn_mfma_f32_32x32x16_bf16((a), (b), (c), 0, 0, 0)
#define MFMA16(a, b, c) __builtin_amdgcn_mfma_f32_16x16x32_bf16((a), (b), (c), 0, 0, 0)

DI int src_col_of_group(int hg) { return hg <= 104 ? hg * 64 : (hg <= 200 ? 6728 + (hg - 105) * 64 : 6720); }

DI void convert_tile(const float* src, int ld_src, int k0, int n_src0, int n_valid, const float* kscale, bf16_t* dst, int ld_dst, int n_dst0, float* tl  ) {
    const int tid = ltid();
    __syncthreads();
#pragma unroll
    for (int i = 0; i < 8; ++i) {
        int e = tid + i * 512, kk = e >> 6, nn = e & 63;
        float v = 0.f;
        if (nn < n_valid) { v = src[(size_t)(k0 + kk) * ld_src + n_src0 + nn]; if (kscale) v *= kscale[k0 + kk]; }
        tl[kk * 65 + nn] = v;
    }
    __syncthreads();
#pragma unroll
    for (int i = 0; i < 4; ++i) {
        int e = tid + i * 512, nn = e >> 5, kp = (e & 31) * 2;
        unsigned w = cvt_pk_bf16(tl[kp * 65 + nn], tl[(kp + 1) * 65 + nn]);
        *(unsigned*)(dst + (size_t)(n_dst0 + nn) * ld_dst + k0 + kp) = w;
    }
}

DI void xprep_tokens(const float* xsrc  , bf16_t* xb, float* ss, int tok_begin, int tok_end) {
    const int lane = ltid() & 63, wid = ltid() >> 6;
    for (int t = tok_begin + wid; t < tok_end; t += 8) {
        const float* xr = xsrc + (size_t)t * DM;
        float sum = 0.f;
#pragma unroll
        for (int i = 0; i < 4; ++i) {
            f32x4 v = *(const f32x4*)(xr + i * 256 + lane * 4);
            sum += v[0] * v[0] + v[1] * v[1] + v[2] * v[2] + v[3] * v[3];
            u32x2 w; w[0] = cvt_pk_bf16(v[0], v[1]); w[1] = cvt_pk_bf16(v[2], v[3]);
            *(u32x2*)(xb + (size_t)t * DM + i * 256 + lane * 4) = w;
        }
        sum = wave_sum(sum);
        if (lane < 8) ss[(size_t)t * 8 + lane] = lane == 0 ? sum : 0.f;
    }
}

DI void phase_prep(const Params& p, char* shm) {
    char* ws = p.ws;
    const int G = gridDim.x, bid = blockIdx.x, tid = ltid();
    float2* cs = (float2*)(ws + OFF_CS);
    for (int e = bid * NTHREADS + tid; e < NB * S * 8; e += G * NTHREADS) {
        int i = e & 7, t = e >> 3;
        float inv = powf(500000.0f, -(float)(2 * i) / 16.0f);
        float ang = (float)p.pos[t] * inv;
        double rev = (double)ang * 0.15915494309189535;
        rev -= floor(rev);
        float rf = (float)rev;
        cs[e] = make_float2(__builtin_amdgcn_cosf(rf), __builtin_amdgcn_sinf(rf));
    }
    float* tl = (float*)shm;
    const int n_in_tiles = DEPTH * 16 * 204, n_br_tiles = DEPTH * 3 * 8 * 16, n_out_tiles = DEPTH * 16 * 16;
    for (int it = bid; it < n_in_tiles + n_br_tiles + n_out_tiles; it += G) {
        if (it < n_in_tiles) {
            int l = it / (16 * 204), r = it % (16 * 204), hg = r / 16, kt = r % 16;
            int nvalid = hg <= 200 ? 64 : (hg == 201 ? 8 : 0);
            convert_tile(p.w_in + (size_t)l * DM * NIN, NIN, kt * 64, src_col_of_group(hg), nvalid, p.norm_g + l * DM,
                         (bf16_t*)(ws + OFF_WTIN) + (size_t)l * NPAD * DM, DM, hg * 64, tl);
        } else if (it < n_in_tiles + n_br_tiles) {
            int r = it - n_in_tiles; int ln = r / 128, q = r % 128, kt = q / 16, nt = q % 16;
            convert_tile(p.w_br + (size_t)ln * 512 * DM, DM, kt * 64, nt * 64, 64, nullptr, (bf16_t*)(ws + OFF_WTBR) + (size_t)ln * DM * 512, 512, nt * 64, tl);
        } else {
            int r = it - n_in_tiles - n_br_tiles; int l = r / 256, q = r % 256, kt = q / 16, nt = q % 16;
            convert_tile(p.w_out + (size_t)l * DM * DM, DM, kt * 64, nt * 64, 64, nullptr, (bf16_t*)(ws + OFF_WTOUT) + (size_t)l * DM * DM, DM, nt * 64, tl);
        }
    }
    int per = (TG + G - 1) / G;
    int tb = bid * per, te = tb + per < TG ? tb + per : TG;
    xprep_tokens(p.x, (bf16_t*)(ws + OFF_XB), (float*)(ws + OFF_SS), tb, te);
}

constexpr int BM = 256, BK = 64, HALF = 128, NXCD = 8, WGM = 8, HT = HALF * BK;
DI int lds_byte(int r, int c) { int st = (r >> 4) * 2 + (c >> 5), rr = r & 15, cc = c & 31, ob = rr * 64 + cc * 2; return st * 1024 + (ob ^ (((ob >> 9) & 1) << 5)); }
DI void stage_rc(int b, int& R, int& C) { int st = b / 1024, sb = b % 1024, swz = sb ^ (((sb >> 9) & 1) << 5); R = (st >> 1) * 16 + swz / 64; C = (st & 1) * 32 + (swz % 64) / 2; }

#define SA(b, h) (shm + ((b) * 2 + (h)) * HT)
#define SB(b, h) (shm + (4 + (b) * 2 + (h)) * HT)
DI void glds16(const void* sbase, unsigned voff, unsigned lds_dst) {
    unsigned keep;
    asm volatile("s_mov_b32 %0, m0\n\ts_mov_b32 m0, %3\n\ts_nop 0\n\tglobal_load_lds_dwordx4 %1, %2\n\ts_mov_b32 m0, %0"
                 : "=&s"(keep) : "v"(voff), "s"(sbase), "s"(lds_dst) : "memory");
}
#define STAGE(P, BASE, LD, br, kt, VOFF) do { const bf16_t* _gp = (BASE) + (size_t)(br) * (LD) + (size_t)(kt) * BK; \
    const unsigned _l0 = (unsigned)(size_t)(P) + wbase16; \
    glds16(_gp, VOFF[0], _l0); glds16(_gp, VOFF[1], _l0 + 8192u); } while (0)
#define LDA(dst, b, h) _Pragma("unroll") for (int m = 0; m < 4; ++m) _Pragma("unroll") for (int k = 0; k < 2; ++k) \
    dst[m][k] = *reinterpret_cast<const bf16x8*>((char*)SA(b, h) + lds_byte(wr * 64 + m * 16 + fr, k * 32 + fq * 8))
#define LDB(dst, b, h) _Pragma("unroll") for (int n = 0; n < 2; ++n) _Pragma("unroll") for (int k = 0; k < 2; ++k) \
    dst[n][k] = *reinterpret_cast<const bf16x8*>((char*)SB(b, h) + lds_byte(wc * 32 + n * 16 + fr, k * 32 + fq * 8))
#define MMA(ai, bj, At, Bt_) do { __builtin_amdgcn_s_setprio(1); \
    _Pragma("unroll") for (int m = 0; m < 4; ++m) _Pragma("unroll") for (int n = 0; n < 2; ++n) _Pragma("unroll") for (int k = 0; k < 2; ++k) \
      acc[ai][bj][m][n] = MFMA16(At[m][k], Bt_[n][k], acc[ai][bj][m][n]); \
    __builtin_amdgcn_s_setprio(0); } while (0)
#define WAIT_V(n) asm volatile("s_waitcnt vmcnt(" #n ")" ::: "memory")
#define WAIT_L(n) asm volatile("s_waitcnt lgkmcnt(" #n ")" ::: "memory")
#define BAR __builtin_amdgcn_s_barrier()
#define SCHED __builtin_amdgcn_sched_barrier(0)

template <class Epi>
DI void gemm_phase(const bf16_t* __restrict__ Abase, int lda, size_t a_sub, int M, const bf16_t* __restrict__ Bbase, int ldb, size_t b_sub, int N, int K, int nsub,
                   Epi& epi, __attribute__((address_space(3))) bf16_t* shm) {
    const int nM = M / BM, nN = N / BM, nwg = nM * nN;
    const int wid = ltid() >> 6, lane = ltid() & 63, wr = wid >> 2, wc = wid & 3, fr = lane & 15, fq = lane >> 4;
    const int nt = K / BK;
    unsigned voffA[2], voffB[2];
    const unsigned wbase16 = __builtin_amdgcn_readfirstlane((ltid() & ~63u) * 16u);
#pragma unroll
    for (int i = 0; i < 2; ++i) { int r_, c_; stage_rc(ltid() * 16 + i * 8192, r_, c_); voffA[i] = (unsigned)(r_ * lda + c_) * 2u; voffB[i] = (unsigned)(r_ * ldb + c_) * 2u; }
    for (int L = blockIdx.x; L < nwg; L += gridDim.x) {
        int wgid = L;
        { int q = nwg / NXCD, r = nwg % NXCD, xcd = wgid % NXCD, off = wgid / NXCD; wgid = (xcd < r ? xcd * (q + 1) : r * (q + 1) + (xcd - r) * q) + off; }
        const int nig = WGM * nN, gid = wgid / nig, fm = gid * WGM, gsz = min(nM - fm, WGM);
        const int pm = fm + ((wgid % nig) % gsz), pn = (wgid % nig) / gsz, brow = pm * BM, bcol = pn * BM;
        for (int sub = 0; sub < nsub; ++sub) {
            const bf16_t* A = Abase + (size_t)sub * a_sub;
            const bf16_t* Bt = Bbase + (size_t)sub * b_sub;
            f32x4 acc[2][2][4][2] = {};
            bf16x8 At[4][2], B0[2][2], B1[2][2];
            STAGE(SB(0, 0), Bt, ldb, bcol, 0, voffB); STAGE(SA(0, 0), A, lda, brow, 0, voffA);
            STAGE(SB(0, 1), Bt, ldb, bcol + HALF, 0, voffB); STAGE(SA(0, 1), A, lda, brow + HALF, 0, voffA);
            if (wr == 1) BAR;
            WAIT_V(4); BAR;
            STAGE(SB(1, 0), Bt, ldb, bcol, 1, voffB); STAGE(SA(1, 0), A, lda, brow, 1, voffA); STAGE(SB(1, 1), Bt, ldb, bcol + HALF, 1, voffB);
            WAIT_V(6); BAR;
            for (int t = 0; t < nt - 2; t += 2) {
                LDB(B0, 0, 0); SCHED; LDA(At, 0, 0); STAGE(SA(1, 1), A, lda, brow + HALF, t + 1, voffA);
                WAIT_L(8); BAR; WAIT_L(0); MMA(0, 0, At, B0); BAR; SCHED;
                LDB(B1, 0, 1); STAGE(SB(0, 0), Bt, ldb, bcol, t + 2, voffB);
                BAR; WAIT_L(0); MMA(0, 1, At, B1); BAR;
                LDA(At, 0, 1); STAGE(SA(0, 0), A, lda, brow, t + 2, voffA);
                BAR; WAIT_L(0); MMA(1, 0, At, B0); BAR; SCHED;
                STAGE(SB(0, 1), Bt, ldb, bcol + HALF, t + 2, voffB);
                WAIT_V(6); BAR; MMA(1, 1, At, B1); BAR;
                LDB(B0, 1, 0); SCHED; LDA(At, 1, 0); STAGE(SA(0, 1), A, lda, brow + HALF, t + 2, voffA);
                WAIT_L(8); BAR; WAIT_L(0); MMA(0, 0, At, B0); BAR; SCHED;
                LDB(B1, 1, 1); STAGE(SB(1, 0), Bt, ldb, bcol, t + 3, voffB);
                BAR; WAIT_L(0); MMA(0, 1, At, B1); BAR;
                LDA(At, 1, 1); STAGE(SA(1, 0), A, lda, brow, t + 3, voffA);
                BAR; WAIT_L(0); MMA(1, 0, At, B0); BAR; SCHED;
                STAGE(SB(1, 1), Bt, ldb, bcol + HALF, t + 3, voffB);
                WAIT_V(6); BAR; MMA(1, 1, At, B1); BAR;
            }
            { LDB(B0, 0, 0); LDA(At, 0, 0); STAGE(SA(1, 1), A, lda, brow + HALF, nt - 1, voffA);
              BAR; WAIT_L(0); MMA(0, 0, At, B0); BAR;
              LDB(B1, 0, 1); BAR; WAIT_L(0); MMA(0, 1, At, B1); BAR;
              LDA(At, 0, 1); WAIT_V(4); BAR; WAIT_L(0); MMA(1, 0, At, B0); MMA(1, 1, At, B1); BAR; }
            { LDB(B0, 1, 0); LDA(At, 1, 0); WAIT_V(2); BAR; WAIT_L(0); MMA(0, 0, At, B0); BAR;
              LDB(B1, 1, 1); WAIT_V(0); BAR; WAIT_L(0); MMA(0, 1, At, B1); BAR;
              LDA(At, 1, 1); BAR; WAIT_L(0); MMA(1, 0, At, B0); MMA(1, 1, At, B1); BAR; }
            if (wr == 0) BAR;
            { int t2 = ltid();
              const int wid2 = t2 >> 6, lane2 = t2 & 63;
              epi(acc, brow, bcol, sub, wid2 >> 2, wid2 & 3, lane2 & 15, lane2 >> 4); }
        }
    }
}

struct EpiIn {
    const Params* p; int layer; int gtok0;
    DI void operator()(const f32x4 (&acc)[2][2][4][2], int brow, int bcol, int sub, int wr, int wc, int fr, int fq) const {
        char* ws = p->ws;
        const float* ss = (const float*)(ws + OFF_SS);
        const float2* cs = (const float2*)(ws + OFF_CS);
        const int lane = ltid() & 63;
#pragma unroll
        for (int bj = 0; bj < 2; ++bj)
#pragma unroll
            for (int n = 0; n < 2; ++n) {
                const int tl = bcol + bj * 128 + wc * 32 + n * 16 + fr;
                const f32x4 s0 = *(const f32x4*)(ss + (size_t)tl * 8), s1 = *(const f32x4*)(ss + (size_t)tl * 8 + 4);
                const float rstd = rsqrtf((s0[0] + s0[1] + s0[2] + s0[3] + s1[0] + s1[1] + s1[2] + s1[3]) * (1.0f / DM) + 1e-6f);
                const int bl = tl >> 12, s = tl & (S - 1);
                const int tg = gtok0 + tl;
#pragma unroll
                for (int ai = 0; ai < 2; ++ai) {
                    const int hg = (brow + ai * 128 + wr * 64) >> 6;
                    float v[16];
#pragma unroll
                    for (int m = 0; m < 4; ++m)
#pragma unroll
                        for (int j = 0; j < 4; ++j) v[m * 4 + j] = acc[ai][bj][m][n][j] * rstd;
                    int kind;
                    int mixer = 0, isk = 0, hh = 0, H = 8; size_t qoff = 0, koff = 0, voff = 0;
                    if (hg < 72) { mixer = 0; H = 24; qoff = OFF_QA; koff = OFF_KA; voff = OFF_VA; kind = hg < 48 ? 0 : 1; isk = hg >= 24; hh = hg % 24; }
                    else if (hg < 96) { mixer = 1; qoff = OFF_QB; koff = OFF_KB; voff = OFF_VB; kind = hg < 88 ? 0 : 1; isk = hg >= 80; hh = (hg - 72) & 7; }
                    else if (hg < 105) { kind = 2; isk = hg == 104; hh = hg - 96; }
                    else if (hg < 129) { mixer = 2; qoff = OFF_QC; koff = OFF_KC; voff = OFF_VC; kind = hg < 121 ? 0 : 1; isk = hg >= 113; hh = (hg - 105) & 7; }
                    else if (hg < 153) kind = 3;
                    else if (hg < 201) kind = 4;
                    else kind = hg == 201 ? 5 : 6;

                    if (kind == 0 || kind == 2) {
                        if (kind == 0) {
                            float sq = 0.f;
#pragma unroll
                            for (int i = 0; i < 16; ++i) sq += v[i] * v[i];
                            sq += shx(sq, 16); sq += shx(sq, 32);
                            const float rn = rsqrtf(sq * (1.0f / 64) + 1e-6f);
                            const float* gq = p->qk_g + ((size_t)(layer * 3 + mixer) * 2 + isk) * 64;
#pragma unroll
                            for (int m = 0; m < 4; ++m) {
                                const f32x4 g4 = *(const f32x4*)(gq + m * 16 + fq * 4);
#pragma unroll
                                for (int j = 0; j < 4; ++j) v[m * 4 + j] *= rn * g4[j];
                            }
                        }
                        {
                            const int ib = (fq & 1) * 4;
                            const f32x4 c01 = *(const f32x4*)(cs + (size_t)tg * 8 + ib), c23 = *(const f32x4*)(cs + (size_t)tg * 8 + ib + 2);
                            const float cj[4] = {c01[0], c01[2], c23[0], c23[2]}, sj[4] = {c01[1], c01[3], c23[1], c23[3]};
#pragma unroll
                            for (int j = 0; j < 4; ++j) {
                                const float mine = v[j], other = shx(mine, 32);
                                v[j] = fq < 2 ? mine * cj[j] - other * sj[j] : mine * cj[j] + other * sj[j];
                            }
                        }
                        bf16_t* dst;
                        if (kind == 0) {
                            const float sc = isk ? 1.0f : QSCALE;
#pragma unroll
                            for (int i = 0; i < 16; ++i) v[i] *= sc;
                            int row = s;
                            if (mixer == 0) { const int g = hh >> 3; const int sh = 2 * g; row = ((s & ((1 << sh) - 1)) << (12 - sh)) + (s >> sh); }
                            dst = (bf16_t*)(ws + (isk ? koff : qoff)) + ((size_t)(bl * H + hh) * S + row) * 64;
                        } else {
                            dst = isk ? (bf16_t*)(ws + OFF_IK) + (size_t)tl * 64 : (bf16_t*)(ws + OFF_IQ) + ((size_t)(bl * 8 + hh) * S + s) * 64;
                        }
#pragma unroll
                        for (int m = 0; m < 4; ++m) {
                            u32x2 w; w[0] = cvt_pk_bf16(v[m * 4], v[m * 4 + 1]); w[1] = cvt_pk_bf16(v[m * 4 + 2], v[m * 4 + 3]);
                            *(u32x2*)(dst + m * 16 + fq * 4) = w;
                        }
                    } else if (kind == 1) {
                        int row = s;
                        if (mixer == 0) { const int g = hh >> 3; const int sh = 2 * g; row = ((s & ((1 << sh) - 1)) << (12 - sh)) + (s >> sh); }
                        bf16_t* dst = (bf16_t*)(ws + voff) + (size_t)(bl * H + hh) * 64 * S + row;
#pragma unroll
                        for (int m = 0; m < 4; ++m)
#pragma unroll
                            for (int j = 0; j < 4; ++j) dst[(size_t)(m * 16 + fq * 4 + j) * S] = f2bf(v[m * 4 + j]);
                    } else if (kind == 3 || kind == 4) {
                        bf16_t* dst = kind == 3 ? (bf16_t*)(ws + OFF_SZ) + (size_t)tl * 1536 + (hg - 129) * 64 : (bf16_t*)(ws + OFF_SG) + (size_t)tl * 3072 + (hg - 153) * 64;
#pragma unroll
                        for (int i = 0; i < 16; ++i) { const float sg = 1.0f / (1.0f + __expf(-v[i])); v[i] = kind == 3 ? v[i] * sg : sg; }
#pragma unroll
                        for (int m = 0; m < 4; ++m) {
                            u32x2 w; w[0] = cvt_pk_bf16(v[m * 4], v[m * 4 + 1]); w[1] = cvt_pk_bf16(v[m * 4 + 2], v[m * 4 + 3]);
                            *(u32x2*)(dst + m * 16 + fq * 4) = w;
                        }
                    } else if (kind == 5) {
                        if (fq < 2) { f32x4 o = {v[0], v[1], v[2], v[3]}; *(f32x4*)((float*)(ws + OFF_IW) + (size_t)tl * 8 + fq * 4) = o; }
                    }
                }
            }
        (void)lane; (void)sub;
    }
};

struct EpiBr {
    const Params* p;
    DI void operator()(const f32x4 (&acc)[2][2][4][2], int brow, int bcol, int sub, int wr, int wc, int fr, int fq) const {
        char* ws = p->ws;
        const bf16_t* sg = (const bf16_t*)(ws + OFF_SG);
        float* mf = (float*)(ws + OFF_MF);
        bf16_t* mb = (bf16_t*)(ws + OFF_MB);
#pragma unroll
        for (int bj = 0; bj < 2; ++bj)
#pragma unroll
            for (int n = 0; n < 2; ++n) {
                const int tl = bcol + bj * 128 + wc * 32 + n * 16 + fr;
#pragma unroll
                for (int ai = 0; ai < 2; ++ai)
#pragma unroll
                    for (int m = 0; m < 4; ++m) {
                        const int e = brow + ai * 128 + wr * 64 + m * 16 + fq * 4;
                        const u32x2 gw = *(const u32x2*)(sg + (size_t)tl * 3072 + sub * 1024 + e);
                        f32x4 g4 = {__uint_as_float(gw[0] << 16), __uint_as_float(gw[0] & 0xffff0000u), __uint_as_float(gw[1] << 16), __uint_as_float(gw[1] & 0xffff0000u)};
                        f32x4 r = acc[ai][bj][m][n] * g4;
                        float* mp = mf + (size_t)tl * DM + e;
                        if (sub > 0) r += *(const f32x4*)mp;
                        if (sub < 2) *(f32x4*)mp = r;
                        else { u32x2 w; w[0] = cvt_pk_bf16(r[0], r[1]); w[1] = cvt_pk_bf16(r[2], r[3]); *(u32x2*)(mb + (size_t)tl * DM + e) = w; }
                    }
                asm volatile("" ::: "memory");
            }
    }
};

struct EpiOut {
    const Params* p; int layer; int gtok0;
    DI void operator()(const f32x4 (&acc)[2][2][4][2], int brow, int bcol, int sub, int wr, int wc, int fr, int fq) const {
        char* ws = p->ws;
        const float* xin = layer == 0 ? p->x : p->out;
        bf16_t* xb = (bf16_t*)(ws + OFF_XB);
        float* ss = (float*)(ws + OFF_SS);
#pragma unroll
        for (int bj = 0; bj < 2; ++bj)
#pragma unroll
            for (int n = 0; n < 2; ++n) {
                const int tl = bcol + bj * 128 + wc * 32 + n * 16 + fr;
                const size_t tg = (size_t)gtok0 + tl;
                float sq = 0.f;
#pragma unroll
                for (int ai = 0; ai < 2; ++ai)
#pragma unroll
                    for (int m = 0; m < 4; ++m) {
                        const int e = brow + ai * 128 + wr * 64 + m * 16 + fq * 4;
                        f32x4 r = *(const f32x4*)(xin + tg * DM + e) + acc[ai][bj][m][n];
                        *(f32x4*)(p->out + tg * DM + e) = r;
                        if (layer == 0) {
                            sq += r[0] * r[0] + r[1] * r[1] + r[2] * r[2] + r[3] * r[3];
                            u32x2 w; w[0] = cvt_pk_bf16(r[0], r[1]); w[1] = cvt_pk_bf16(r[2], r[3]);
                            *(u32x2*)(xb + (size_t)tl * DM + e) = w;
                        }
                    }
                if (layer == 0) {
                    sq += shx(sq, 16); sq += shx(sq, 32);
                    if (fq == 0) ss[(size_t)tl * 8 + (brow >> 8) * 2 + wr] = sq;
                }
            }
        (void)sub;
    }
};

DI void select_chunk(const Params& p, int bl, int c, char* shm) {
    char* ws = p.ws;
    const bf16_t* IQ = (const bf16_t*)(ws + OFF_IQ);
    const bf16_t* IK = (const bf16_t*)(ws + OFF_IK);
    const float* IW = (const float*)(ws + OFF_IW);
    unsigned* hist = (unsigned*)shm; unsigned* bits = (unsigned*)(shm + 16384);
    int* ctl = (int*)(shm + 24576); int* cnt = ctl, *mn = ctl + 16, *mx = ctl + 32, *bsel = ctl + 48, *needp = ctl + 64;
    u32x2* list = (u32x2*)(shm + 32768);
    const int tid = ltid(), lane = tid & 63, w = tid >> 6, q = lane & 15, g = lane >> 4;
    const int t0 = c * 16, tq = t0 + q;
    __syncthreads();
    for (int i = tid; i < 16 * 256 + 16 * 128; i += NTHREADS) hist[i] = 0;
    if (tid < 16) { cnt[tid] = 0; mn[tid] = 0x7fffffff; mx[tid] = (int)0x80000000; }
    bf16x8 qf[8][2]; float wq[8];
#pragma unroll
    for (int hd = 0; hd < 8; ++hd) {
        const bf16_t* qp = IQ + ((size_t)(bl * 8 + hd) * S + tq) * 64 + g * 8;
        qf[hd][0] = *(const bf16x8*)qp; qf[hd][1] = *(const bf16x8*)(qp + 32);
        wq[hd] = IW[(size_t)(bl * S + tq) * 8 + hd];
    }
    auto score = [&](int kt) -> f32x4 {
        const bf16_t* kp = IK + ((size_t)bl * S + kt * 16 + q) * 64 + g * 8;
        const bf16x8 k0 = *(const bf16x8*)kp, k1 = *(const bf16x8*)(kp + 32);
        f32x4 sc = {0.f, 0.f, 0.f, 0.f};
#pragma unroll
        for (int hd = 0; hd < 8; ++hd) {
            f32x4 a = {0.f, 0.f, 0.f, 0.f};
            a = MFMA16(k0, qf[hd][0], a); a = MFMA16(k1, qf[hd][1], a);
#pragma unroll
            for (int j = 0; j < 4; ++j) sc[j] += wq[hd] * fmaxf(a[j], 0.f);
        }
        return sc;
    };
    __syncthreads();
    {
        float lo = 3.0e38f, hi = -3.0e38f;
        for (int kt = w; kt <= c; kt += 8) {
            const f32x4 sc = score(kt);
#pragma unroll
            for (int j = 0; j < 4; ++j) if (kt * 16 + 4 * g + j <= tq) { lo = fminf(lo, sc[j]); hi = fmaxf(hi, sc[j]); }
        }
        lo = fminf(lo, shx(lo, 16)); lo = fminf(lo, shx(lo, 32));
        hi = fmaxf(hi, shx(hi, 16)); hi = fmaxf(hi, shx(hi, 32));
        if (g == 0) { atomicMin(&mn[q], f2sort(lo)); atomicMax(&mx[q], f2sort(hi)); }
    }
    __syncthreads();
    const float rlo = sort2f(mn[q]), rhi = sort2f(mx[q]);
    const float rscale = rhi > rlo ? 256.0f / (rhi - rlo) : 0.f;
    for (int kt = w; kt <= c; kt += 8) {
        const f32x4 sc = score(kt);
#pragma unroll
        for (int j = 0; j < 4; ++j) if (kt * 16 + 4 * g + j <= tq) {
            int b = (int)((sc[j] - rlo) * rscale); b = b > 255 ? 255 : (b < 0 ? 0 : b);
            atomicAdd(&hist[q * 256 + b], 1u);
        }
    }
    __syncthreads();
    {
        const int row = tid >> 5, i = tid & 31;
        unsigned c8[8]; unsigned tot = 0;
#pragma unroll
        for (int k = 0; k < 8; ++k) { c8[k] = hist[row * 256 + i * 8 + k]; tot += c8[k]; }
        unsigned above = 0;
        {
            unsigned run = tot;
#pragma unroll
            for (int o = 1; o < 32; o <<= 1) { const int l_ = tid & 63; unsigned v = (unsigned)__builtin_amdgcn_ds_bpermute(((l_ + o) & 63) << 2, (int)run); if (i + o < 32) run += v; }
            above = run - tot;
        }
        const int trow = t0 + row; const unsigned need = trow + 1 < 256 ? trow + 1 : 256;
        if (above < need && above + tot >= need) {
            unsigned a = above;
#pragma unroll
            for (int k = 7; k >= 0; --k) { if (a < need && a + c8[k] >= need) { bsel[row] = i * 8 + k; needp[row] = (int)(need - a); } a += c8[k]; }
        }
    }
    __syncthreads();
    const int bstar = bsel[q];
    for (int kt = w; kt <= c; kt += 8) {
        const f32x4 sc = score(kt);
        unsigned nib = 0;
#pragma unroll
        for (int j = 0; j < 4; ++j) if (kt * 16 + 4 * g + j <= tq) {
            int b = (int)((sc[j] - rlo) * rscale); b = b > 255 ? 255 : (b < 0 ? 0 : b);
            if (b > bstar) nib |= 1u << j;
            else if (b == bstar) { int pos = atomicAdd(&cnt[q], 1); if (pos < SEL_CAP) { u32x2 e; e[0] = (unsigned)f2sort(sc[j]) ^ 0x80000000u; e[1] = kt * 16 + 4 * g + j; list[q * SEL_CAP + pos] = e; } }
        }
        if (nib) atomicOr(&bits[q * 128 + (kt >> 1)], nib << ((kt & 1) * 16 + 4 * g));
    }
    __syncthreads();
    {
        const int row = tid >> 5, i = tid & 31;
        int n = cnt[row]; n = n < SEL_CAP ? n : SEL_CAP;
        const int need = needp[row];
        for (int a = i; a < n; a += 32) {
            const u32x2 ea = list[row * SEL_CAP + a];
            int rank = 0;
            for (int b = 0; b < n; ++b) { const u32x2 eb = list[row * SEL_CAP + b]; rank += (eb[0] > ea[0]) || (eb[0] == ea[0] && eb[1] < ea[1]); }
            if (rank < need) atomicOr(&bits[row * 128 + (ea[1] >> 5)], 1u << (ea[1] & 31));
        }
    }
    __syncthreads();
    unsigned* mask = (unsigned*)(ws + OFF_MASK) + ((size_t)bl * S + t0) * 128;
    for (int i = tid; i < 16 * 128; i += NTHREADS) mask[i] = bits[i];
}

DI void kmean_item(const Params& p, int bl, int h, int n, char* shm) {
    char* ws = p.ws;
    const bf16_t* K = (const bf16_t*)(ws + OFF_KC) + ((size_t)(bl * 8 + h) * S + n * 256) * 64;
    float* red = (float*)shm;
    const int tid = ltid(), d = tid & 63, part = tid >> 6;
    float s = 0.f;
    for (int k = 0; k < 32; ++k) s += bf2f(K[(size_t)(part * 32 + k) * 64 + d]);
    __syncthreads();
    red[part * 64 + d] = s;
    __syncthreads();
    if (tid < 64) {
        float t = 0.f;
        for (int k = 0; k < 8; ++k) t += red[k * 64 + tid];
        t *= (1.0f / 256);
        bf16_t hi = f2bf(t); bf16_t lo = f2bf(t - bf2f(hi));
        bf16_t* km = (bf16_t*)(ws + OFF_KM) + (((size_t)(bl * 8 + h) * 16 + n) * 2) * 64;
        km[tid] = hi; km[64 + tid] = lo;
    }
}

struct AttnAcc { f32x16 o0, o1; float m, l; };
DI void attn_init(AttnAcc& a) {
#pragma unroll
    for (int i = 0; i < 16; ++i) { a.o0[i] = 0.f; a.o1[i] = 0.f; }
    a.m = -1.0e30f; a.l = 0.f;
}
struct KVFrag { bf16x8 k[4]; s16x4 v[2][2][2]; };
DI void kv_load(KVFrag& f, const bf16_t* Kt, const bf16_t* Vt, int r, int h) {
#pragma unroll
    for (int kk = 0; kk < 4; ++kk) f.k[kk] = *(const bf16x8*)(Kt + (size_t)r * 64 + kk * 16 + h * 8);
#pragma unroll
    for (int db = 0; db < 2; ++db)
#pragma unroll
        for (int u = 0; u < 2; ++u)
#pragma unroll
            for (int hf = 0; hf < 2; ++hf) f.v[db][u][hf] = *(const s16x4*)(Vt + (size_t)(db * 32 + r) * S + 16 * u + 8 * hf + 4 * h);
}
DI void attn_step(AttnAcc& a, const KVFrag& f, const bf16x8 (&qf)[4], unsigned vm) {
    f32x16 st;
#pragma unroll
    for (int i = 0; i < 16; ++i) st[i] = 0.f;
#pragma unroll
    for (int kk = 0; kk < 4; ++kk) st = MFMA32(f.k[kk], qf[kk], st);
    float mx = st[0];
#pragma unroll
    for (int i = 1; i < 16; ++i) mx = fmaxf(mx, st[i]);
    mx = fmaxf(mx, shx(mx, 32));
    const float mn = fmaxf(a.m, mx);
    const float alpha = fexp2(a.m - mn);
    a.m = mn;
    float pv[16]; float ps = 0.f;
#pragma unroll
    for (int i = 0; i < 16; ++i) { float e = fexp2(st[i] - mn); e = (vm >> i) & 1u ? e : 0.f; pv[i] = e; ps += e; }
    a.l = a.l * alpha + ps;
#pragma unroll
    for (int i = 0; i < 16; ++i) { a.o0[i] *= alpha; a.o1[i] *= alpha; }
    u32x4 p0, p1;
#pragma unroll
    for (int i = 0; i < 4; ++i) { p0[i] = cvt_pk_bf16(pv[2 * i], pv[2 * i + 1]); p1[i] = cvt_pk_bf16(pv[8 + 2 * i], pv[8 + 2 * i + 1]); }
    const bf16x8 pf0 = __builtin_bit_cast(bf16x8, p0), pf1 = __builtin_bit_cast(bf16x8, p1);
    bf16x8 v00, v01, v10, v11;
#pragma unroll
    for (int i = 0; i < 4; ++i) {
        v00[i] = f.v[0][0][0][i]; v00[4 + i] = f.v[0][0][1][i]; v01[i] = f.v[0][1][0][i]; v01[4 + i] = f.v[0][1][1][i];
        v10[i] = f.v[1][0][0][i]; v10[4 + i] = f.v[1][0][1][i]; v11[i] = f.v[1][1][0][i]; v11[4 + i] = f.v[1][1][1][i];
    }
    a.o0 = MFMA32(v00, pf0, a.o0); a.o0 = MFMA32(v01, pf1, a.o0);
    a.o1 = MFMA32(v10, pf0, a.o1); a.o1 = MFMA32(v11, pf1, a.o1);
}
DI void load_q(bf16x8 (&qf)[4], const bf16_t* Qrow, int h) {
#pragma unroll
    for (int kk = 0; kk < 4; ++kk) qf[kk] = *(const bf16x8*)(Qrow + kk * 16 + h * 8);
}
DI int koff(int i, int h) { return 8 * (i >> 2) + 4 * h + (i & 3); }

DI void attn_a_item(const Params& p, int bl, int hh, int rb) {
    char* ws = p.ws;
    const int lane = ltid() & 63, w = ltid() >> 6, r = lane & 31, h = lane >> 5;
    const int g = hh >> 3, sh = 2 * g, n = S >> sh;
    const int row0 = rb * 256 + w * 32;
    const int rr = row0 / n, m0 = row0 % n;
    const bf16_t* Q = (const bf16_t*)(ws + OFF_QA) + (size_t)(bl * 24 + hh) * S * 64;
    const bf16_t* K = (const bf16_t*)(ws + OFF_KA) + (size_t)(bl * 24 + hh) * S * 64;
    const bf16_t* Vt = (const bf16_t*)(ws + OFF_VA) + (size_t)(bl * 24 + hh) * 64 * S;
    bf16x8 qf[4]; load_q(qf, Q + (size_t)(row0 + r) * 64, h);
    AttnAcc a; attn_init(a);
    for (int k = 0; k < 5; ++k) {
        const int mk0 = m0 - 128 + 32 * k;
        if (mk0 < 0) continue;
        KVFrag f; kv_load(f, K + (size_t)(rr * n + mk0) * 64, Vt + rr * n + mk0, r, h);
        unsigned vm = 0xffffu;
        if (k == 0 || k == 4) {
            vm = 0;
#pragma unroll
            for (int i = 0; i < 16; ++i) { const int d = (m0 + r) - (mk0 + koff(i, h)); if (d >= 0 && d <= 128) vm |= 1u << i; }
        }
        attn_step(a, f, qf, vm);
    }
    const float l = a.l + shx(a.l, 32);
    const float inv = 1.0f / l;
    const int s = ((m0 + r) << sh) + rr;
    const size_t tl = (size_t)bl * S + s;
    bf16_t* o = (bf16_t*)(ws + OFF_OA) + ((size_t)g * TG + tl) * 512 + (hh & 7) * 64;
#pragma unroll
    for (int q4 = 0; q4 < 4; ++q4) {
        u32x2 w0, w1;
        w0[0] = cvt_pk_bf16(a.o0[q4 * 4] * inv, a.o0[q4 * 4 + 1] * inv); w0[1] = cvt_pk_bf16(a.o0[q4 * 4 + 2] * inv, a.o0[q4 * 4 + 3] * inv);
        w1[0] = cvt_pk_bf16(a.o1[q4 * 4] * inv, a.o1[q4 * 4 + 1] * inv); w1[1] = cvt_pk_bf16(a.o1[q4 * 4 + 2] * inv, a.o1[q4 * 4 + 3] * inv);
        *(u32x2*)(o + 8 * q4 + 4 * h) = w0; *(u32x2*)(o + 32 + 8 * q4 + 4 * h) = w1;
    }
    if (h == 0) ((float*)(ws + OFF_LSE))[((size_t)g * TG + tl) * 8 + (hh & 7)] = (a.m + __log2f(l)) * LN2F;
}

DI void attn_store_gated(const Params& p, const AttnAcc& a, size_t tl, int col0, int h) {
    const float l = a.l + shx(a.l, 32);
    const float inv = 1.0f / l;
    bf16_t* z = (bf16_t*)(p.ws + OFF_SZ) + tl * 1536 + col0;
#pragma unroll
    for (int q4 = 0; q4 < 4; ++q4) {
#pragma unroll
        for (int db = 0; db < 2; ++db) {
            bf16_t* zp = z + db * 32 + 8 * q4 + 4 * h;
            const u32x2 zw = *(const u32x2*)zp;
            const float z0 = __uint_as_float(zw[0] << 16), z1 = __uint_as_float(zw[0] & 0xffff0000u), z2 = __uint_as_float(zw[1] << 16), z3 = __uint_as_float(zw[1] & 0xffff0000u);
            const f32x16& o = db ? a.o1 : a.o0;
            u32x2 wv; wv[0] = cvt_pk_bf16(o[q4 * 4] * inv * z0, o[q4 * 4 + 1] * inv * z1); wv[1] = cvt_pk_bf16(o[q4 * 4 + 2] * inv * z2, o[q4 * 4 + 3] * inv * z3);
            *(u32x2*)zp = wv;
        }
    }
}

DI void attn_b_item(const Params& p, int bl, int hd, int qb) {
    char* ws = p.ws;
    const int lane = ltid() & 63, w = ltid() >> 6, r = lane & 31, h = lane >> 5;
    const int q0 = qb * 256 + w * 32;
    const bf16_t* Q = (const bf16_t*)(ws + OFF_QB) + (size_t)(bl * 8 + hd) * S * 64;
    const bf16_t* K = (const bf16_t*)(ws + OFF_KB) + (size_t)(bl * 8 + hd) * S * 64;
    const bf16_t* Vt = (const bf16_t*)(ws + OFF_VB) + (size_t)(bl * 8 + hd) * 64 * S;
    const unsigned* mrow = (const unsigned*)(ws + OFF_MASK) + ((size_t)bl * S + q0 + r) * 128;
    bf16x8 qf[4]; load_q(qf, Q + (size_t)(q0 + r) * 64, h);
    AttnAcc a; attn_init(a);
    const int nkt = q0 / 32 + 1;
    KVFrag f; kv_load(f, K, Vt, r, h);
    unsigned mw = mrow[0];
    for (int kt = 0; kt < nkt; ++kt) {
        KVFrag fn; unsigned mwn = 0;
        const int ktn = kt + 1 < nkt ? kt + 1 : kt;
        kv_load(fn, K + (size_t)ktn * 32 * 64, Vt + ktn * 32, r, h); mwn = mrow[ktn];
        const unsigned ws4 = mw >> (4 * h);
        const unsigned vm = (ws4 & 0xfu) | ((ws4 >> 4) & 0xf0u) | ((ws4 >> 8) & 0xf00u) | ((ws4 >> 12) & 0xf000u);
        attn_step(a, f, qf, vm);
        f = fn; mw = mwn;
    }
    attn_store_gated(p, a, (size_t)bl * S + q0 + r, 512 + hd * 64, h);
}

DI void attn_c_item(const Params& p, int bl, int hd, int qb) {
    char* ws = p.ws;
    const int lane = ltid() & 63, w = ltid() >> 6, r = lane & 31, h = lane >> 5;
    const int q0 = qb * 256 + w * 32, own = qb;
    const bf16_t* Q = (const bf16_t*)(ws + OFF_QC) + (size_t)(bl * 8 + hd) * S * 64;
    const bf16_t* K = (const bf16_t*)(ws + OFF_KC) + (size_t)(bl * 8 + hd) * S * 64;
    const bf16_t* Vt = (const bf16_t*)(ws + OFF_VC) + (size_t)(bl * 8 + hd) * 64 * S;
    bf16x8 qf[4]; load_q(qf, Q + (size_t)(q0 + r) * 64, h);
    unsigned sel = 0;
    if (own > 0) {
        const bf16_t* km = (const bf16_t*)(ws + OFF_KM) + (((size_t)(bl * 8 + hd) * 16 + (r & 15)) * 2) * 64;
        f32x16 gt;
#pragma unroll
        for (int i = 0; i < 16; ++i) gt[i] = 0.f;
#pragma unroll
        for (int kk = 0; kk < 4; ++kk) {
            bf16x8 ahi = *(const bf16x8*)(km + kk * 16 + h * 8), alo = *(const bf16x8*)(km + 64 + kk * 16 + h * 8);
            if (r >= 16) { ahi = (bf16x8){0, 0, 0, 0, 0, 0, 0, 0}; alo = ahi; }
            gt = MFMA32(ahi, qf[kk], gt); gt = MFMA32(alo, qf[kk], gt);
        }
        float gl[16];
#pragma unroll
        for (int i = 0; i < 8; ++i) {
            const float mine = gt[i], oth = shx(mine, 32);
            const int blk_mine = 8 * (i >> 2) + 4 * h + (i & 3), blk_oth = 8 * (i >> 2) + 4 * (1 - h) + (i & 3);
            (void)blk_mine; (void)blk_oth;
            gl[8 * (i >> 2) + (i & 3)] = h == 0 ? mine : oth;
            gl[8 * (i >> 2) + 4 + (i & 3)] = h == 0 ? oth : mine;
        }
#pragma unroll
        for (int pick = 0; pick < 3; ++pick) {
            float best = -3.0e38f; int bi = -1;
#pragma unroll
            for (int nb = 0; nb < 16; ++nb) { const bool ok = nb < own && !((sel >> nb) & 1u); if (ok && gl[nb] > best) { best = gl[nb]; bi = nb; } }
            if (bi >= 0) sel |= 1u << bi;
        }
    }
    AttnAcc a; attn_init(a);
    for (int nb = 0; nb < own; ++nb) {
        const bool mine = (sel >> nb) & 1u;
        if (__ballot(mine) == 0ull) continue;
        const unsigned vm = mine ? 0xffffu : 0u;
        for (int kt = 0; kt < 8; ++kt) {
            KVFrag f; kv_load(f, K + (size_t)(nb * 256 + kt * 32) * 64, Vt + nb * 256 + kt * 32, r, h);
            attn_step(a, f, qf, vm);
        }
    }
    for (int kt = own * 8; kt <= q0 / 32; ++kt) {
        KVFrag f; kv_load(f, K + (size_t)kt * 32 * 64, Vt + kt * 32, r, h);
        unsigned vm = 0xffffu;
        if (kt == q0 / 32) {
            vm = 0;
#pragma unroll
            for (int i = 0; i < 16; ++i) if (koff(i, h) <= r) vm |= 1u << i;
        }
        attn_step(a, f, qf, vm);
    }
    attn_store_gated(p, a, (size_t)bl * S + q0 + r, 1024 + hd * 64, h);
}

DI void merge_a_item(const Params& p, int item) {
    char* ws = p.ws;
    const int tid = ltid();
    const bf16_t* oa = (const bf16_t*)(ws + OFF_OA);
    const float* lse = (const float*)(ws + OFF_LSE);
    bf16_t* sz = (bf16_t*)(ws + OFF_SZ);
    for (int it = 0; it < 8; ++it) {
        const size_t tl = (size_t)item * 64 + it * 8 + (tid >> 6);
        const int c8 = (tid & 63) * 8, hd = c8 >> 6;
        const float l0 = lse[(0 * (size_t)TG + tl) * 8 + hd], l1 = lse[(1 * (size_t)TG + tl) * 8 + hd], l2 = lse[(2 * (size_t)TG + tl) * 8 + hd];
        const float mx = fmaxf(l0, fmaxf(l1, l2));
        float w0 = __expf(l0 - mx), w1 = __expf(l1 - mx), w2 = __expf(l2 - mx);
        const float inv = 1.0f / (w0 + w1 + w2); w0 *= inv; w1 *= inv; w2 *= inv;
        const u32x4 a0 = *(const u32x4*)(oa + (0 * (size_t)TG + tl) * 512 + c8), a1 = *(const u32x4*)(oa + (1 * (size_t)TG + tl) * 512 + c8), a2 = *(const u32x4*)(oa + (2 * (size_t)TG + tl) * 512 + c8);
        const u32x4 zz = *(const u32x4*)(sz + tl * 1536 + c8);
        u32x4 res;
#pragma unroll
        for (int k = 0; k < 4; ++k) {
            const float lo = (w0 * __uint_as_float(a0[k] << 16) + w1 * __uint_as_float(a1[k] << 16) + w2 * __uint_as_float(a2[k] << 16)) * __uint_as_float(zz[k] << 16);
            const float hi = (w0 * __uint_as_float(a0[k] & 0xffff0000u) + w1 * __uint_as_float(a1[k] & 0xffff0000u) + w2 * __uint_as_float(a2[k] & 0xffff0000u)) * __uint_as_float(zz[k] & 0xffff0000u);
            res[k] = cvt_pk_bf16(lo, hi);
        }
        *(u32x4*)(sz + tl * 1536 + c8) = res;
    }
}

DI int snake_item(int round, int G, int bid) { return (round & 1) ? round * G + (G - 1 - bid) : round * G + bid; }

__global__ void __launch_bounds__(NTHREADS) fwd_megakernel(Params p) {
    __shared__ __attribute__((aligned(16))) char shm_raw[SHM_BYTES];
    cg::grid_group grid = cg::this_grid();
    char* ws = p.ws;
    const int G = gridDim.x, bid = blockIdx.x;
    __attribute__((address_space(3))) bf16_t* shm_g = (__attribute__((address_space(3))) bf16_t*)shm_raw;

    phase_prep(p, shm_raw);
    grid.sync();

#define LAUNDER() do { asm volatile("" : "+s"(p.ws)); asm volatile("" : "+s"(p.out)); asm volatile("" : "+s"(p.x)); ws = p.ws; } while (0)
    for (int grp = 0; grp < NGRP; ++grp) {
        const int gtok0 = grp * TG;
        for (int layer = 0; layer < DEPTH; ++layer) {
            LAUNDER();
            {
                EpiIn epi{&p, layer, gtok0};
                gemm_phase((const bf16_t*)(ws + OFF_WTIN) + (size_t)layer * NPAD * DM, DM, 0, NPAD, (const bf16_t*)(ws + OFF_XB), DM, 0, TG, DM, 1, epi, shm_g);
            }
            grid.sync();
            LAUNDER();
            {
                const int nsel = BG * 256;
                for (int rnd = 0;; ++rnd) {
                    const int it = snake_item(rnd, G, bid);
                    if (rnd * G >= nsel) break;
                    if (it < nsel) select_chunk(p, it % BG, 255 - it / BG, shm_raw);
                }
                for (int it = bid; it < BG * 24 * 16; it += G) attn_a_item(p, it / (24 * 16), (it / 16) % 24, it % 16);
                for (int it = bid; it < BG * 8 * 16; it += G) kmean_item(p, it / 128, (it / 16) & 7, it & 15, shm_raw);
            }
            grid.sync();
            LAUNDER();
            {
                const int nbc = 2 * BG * 8 * 16;
                for (int rnd = 0;; ++rnd) {
                    const int it = snake_item(rnd, G, bid);
                    if (rnd * G >= nbc) break;
                    if (it < nbc) {
                        const int qb = 15 - it / (2 * BG * 8), sub = it % (2 * BG * 8), typ = sub / (BG * 8), bl = (sub / 8) % BG, hd = sub & 7;
                        if (typ == 0) attn_b_item(p, bl, hd, qb); else attn_c_item(p, bl, hd, qb);
                    }
                }
                for (int it = bid; it < TG / 64; it += G) merge_a_item(p, it);
            }
            grid.sync();
            LAUNDER();
            {
                EpiBr epi{&p};
                gemm_phase((const bf16_t*)(ws + OFF_WTBR) + (size_t)layer * 3 * DM * 512, 512, (size_t)DM * 512, DM, (const bf16_t*)(ws + OFF_SZ), 1536, 512, TG, 512, 3, epi, shm_g);
            }
            grid.sync();
            LAUNDER();
            {
                EpiOut epi{&p, layer, gtok0};
                gemm_phase((const bf16_t*)(ws + OFF_WTOUT) + (size_t)layer * DM * DM, DM, 0, DM, (const bf16_t*)(ws + OFF_MB), DM, 0, TG, DM, 1, epi, shm_g);
                if (layer == DEPTH - 1 && grp + 1 < NGRP) {
                    __syncthreads();
                    int per = (TG + G - 1) / G; int tb = bid * per, te = tb + per < TG ? tb + per : TG;
                    xprep_tokens(p.x + (size_t)(grp + 1) * TG * DM, (bf16_t*)(ws + OFF_XB), (float*)(ws + OFF_SS), tb, te);
                }
            }
            grid.sync();
        }
    }
}

extern "C" void kernel_launch(void* const* d_in, const int* in_sizes, int n_in, void* d_out, int out_size, void* d_ws, size_t ws_size, hipStream_t stream) {
    static int grid_blocks = 0;
    if (!grid_blocks) {
        int dev = 0, cus = 0, per_cu = 0;
        hipGetDevice(&dev);
        hipDeviceGetAttribute(&cus, hipDeviceAttributeMultiprocessorCount, dev);
        hipOccupancyMaxActiveBlocksPerMultiprocessor(&per_cu, fwd_megakernel, NTHREADS, 0);
        if (per_cu > 1) per_cu = 1;
        grid_blocks = cus * per_cu;
    }
    if (ws_size < WS_NEED) { fprintf(stderr, "workspace too small: %zu < %zu\n", ws_size, (size_t)WS_NEED); return; }
    Params p{};
    p.x = (const float*)d_in[0]; p.pos = (const int*)d_in[1]; p.norm_g = (const float*)d_in[2]; p.w_in = (const float*)d_in[3];
    p.qk_g = (const float*)d_in[4]; p.w_br = (const float*)d_in[5]; p.w_out = (const float*)d_in[6];
    p.out = (float*)d_out; p.ws = (char*)d_ws;
    void* args[] = {&p};
    hipError_t e = hipLaunchCooperativeKernel((void*)fwd_megakernel, dim3(grid_blocks), dim3(NTHREADS), args, 0, stream);
    if (e != hipSuccess) fprintf(stderr, "cooperative launch failed: %s (grid %d)\n", hipGetErrorString(e), grid_blocks);
}
```

```cpp
#include <hip/hip_runtime.h>
#include <hip/hip_cooperative_groups.h>
#include <cstdio>
#include <cstdint>
namespace cg = cooperative_groups;

typedef unsigned short bf16_t;
typedef short bf16x8 __attribute__((ext_vector_type(8)));
typedef short s16x4 __attribute__((ext_vector_type(4)));
typedef float f32x4 __attribute__((ext_vector_type(4)));
typedef float f32x16 __attribute__((ext_vector_type(16)));
typedef unsigned u32x4 __attribute__((ext_vector_type(4)));
typedef unsigned u32x2 __attribute__((ext_vector_type(2)));
#define DI __device__ __forceinline__

constexpr int S = 4096, DM = 1024, NB = 8, DEPTH = 2;
constexpr int NIN = 12872, NPAD = 13056;
constexpr int BG = 2, TG = BG * S, NGRP = NB / BG;
constexpr int NTHREADS = 512;
constexpr int SHM_BYTES = 131072;
constexpr float QSCALE = 0.125f * 1.4426950408889634f;
constexpr float LN2F = 0.6931471805599453f;
constexpr int SEL_CAP = 768;

constexpr size_t al256(size_t x) { return (x + 255) & ~(size_t)255; }
constexpr size_t OFF_WTIN = 0;
constexpr size_t OFF_WTBR = OFF_WTIN + al256((size_t)DEPTH * NPAD * DM * 2);
constexpr size_t OFF_WTOUT = OFF_WTBR + al256((size_t)DEPTH * 3 * DM * 512 * 2);
constexpr size_t OFF_CS = OFF_WTOUT + al256((size_t)DEPTH * DM * DM * 2);
constexpr size_t OFF_XB = OFF_CS + al256((size_t)NB * S * 8 * 8);
constexpr size_t OFF_SS = OFF_XB + al256((size_t)TG * DM * 2);
constexpr size_t OFF_QA = OFF_SS + al256((size_t)TG * 8 * 4);
constexpr size_t OFF_KA = OFF_QA + al256((size_t)TG * 1536 * 2);
constexpr size_t OFF_VA = OFF_KA + al256((size_t)TG * 1536 * 2);
constexpr size_t OFF_QB = OFF_VA + al256((size_t)TG * 1536 * 2);
constexpr size_t OFF_KB = OFF_QB + al256((size_t)TG * 512 * 2);
constexpr size_t OFF_VB = OFF_KB + al256((size_t)TG * 512 * 2);
constexpr size_t OFF_QC = OFF_VB + al256((size_t)TG * 512 * 2);
constexpr size_t OFF_KC = OFF_QC + al256((size_t)TG * 512 * 2);
constexpr size_t OFF_VC = OFF_KC + al256((size_t)TG * 512 * 2);
constexpr size_t OFF_IQ = OFF_VC + al256((size_t)TG * 512 * 2);
constexpr size_t OFF_IK = OFF_IQ + al256((size_t)TG * 512 * 2);
constexpr size_t OFF_IW = OFF_IK + al256((size_t)TG * 64 * 2);
constexpr size_t OFF_SZ = OFF_IW + al256((size_t)TG * 8 * 4);
constexpr size_t OFF_SG = OFF_SZ + al256((size_t)TG * 1536 * 2);
constexpr size_t OFF_OA = OFF_SG + al256((size_t)TG * 3072 * 2);
constexpr size_t OFF_LSE = OFF_OA + al256((size_t)3 * TG * 512 * 2);
constexpr size_t OFF_MASK = OFF_LSE + al256((size_t)3 * TG * 8 * 4);
constexpr size_t OFF_KM = OFF_MASK + al256((size_t)BG * S * (S / 8));
constexpr size_t OFF_MF = OFF_KM + al256((size_t)BG * 8 * 16 * 64 * 2 * 2);
constexpr size_t OFF_MB = OFF_MF + al256((size_t)TG * DM * 4);
constexpr size_t OFF_BAR = OFF_MB + al256((size_t)TG * DM * 2);
constexpr size_t WS_NEED = OFF_BAR + 256;

struct Params {
    const float* x; const int* pos; const float* norm_g; const float* w_in; const float* qk_g; const float* w_br; const float* w_out;
    float* out; char* ws; int dupmask; int pad_;
};

DI int ltid() { int t = threadIdx.x; asm volatile("" : "+v"(t)); return t; }
DI unsigned cvt_pk_bf16(float lo, float hi) { unsigned r; asm volatile("v_cvt_pk_bf16_f32 %0, %1, %2" : "=v"(r) : "v"(lo), "v"(hi)); return r; }
DI bf16_t f2bf(float x) { return (bf16_t)(cvt_pk_bf16(x, 0.f) & 0xffffu); }
DI float bf2f(bf16_t v) { return __uint_as_float(((unsigned)v) << 16); }
DI float fexp2(float x) { return __builtin_amdgcn_exp2f(x); }
DI float shx(float v, int mask) { const int l = ltid() & 63; return __int_as_float(__builtin_amdgcn_ds_bpermute((l ^ mask) << 2, __float_as_int(v))); }
DI float wave_sum(float v) { for (int o = 32; o > 0; o >>= 1) v += shx(v, o); return v; }
DI int f2sort(float f) { int i = __float_as_int(f); return i ^ ((i >> 31) & 0x7fffffff); }
DI float sort2f(int i) { return __int_as_float(i ^ ((i >> 31) & 0x7fffffff)); }
#define MFMA32(a, b, c) __builtin_amdgcn_mfma_f32_32x32x16_bf16((a), (b), (c), 0, 0, 0)
#define MFMA16(a, b, c) __builtin_amdgcn_mfma_f32_16x16x32_bf16((a), (b), (c), 0, 0, 0)

DI void grid_barrier(unsigned* cnt, unsigned& target, unsigned G) {
    __syncthreads();
    target += G;
    if (threadIdx.x == 0) {
        __threadfence();
        __hip_atomic_fetch_add(cnt, 1u, __ATOMIC_RELAXED, __HIP_MEMORY_SCOPE_AGENT);
        while (__hip_atomic_load(cnt, __ATOMIC_RELAXED, __HIP_MEMORY_SCOPE_AGENT) < target) __builtin_amdgcn_s_sleep(2);
        __threadfence();
    }
    __syncthreads();
}

DI int src_col_of_group(int hg) { return hg <= 104 ? hg * 64 : (hg <= 200 ? 6728 + (hg - 105) * 64 : 6720); }

DI void convert_tile(const float* src, int ld_src, int k0, int n_src0, int n_valid, const float* kscale, bf16_t* dst, int ld_dst, int n_dst0, float* tl  ) {
    const int tid = ltid();
    __syncthreads();
#pragma unroll
    for (int i = 0; i < 8; ++i) {
        int e = tid + i * 512, kk = e >> 6, nn = e & 63;
        float v = 0.f;
        if (nn < n_valid) { v = src[(size_t)(k0 + kk) * ld_src + n_src0 + nn]; if (kscale) v *= kscale[k0 + kk]; }
        tl[kk * 65 + nn] = v;
    }
    __syncthreads();
#pragma unroll
    for (int i = 0; i < 4; ++i) {
        int e = tid + i * 512, nn = e >> 5, kp = (e & 31) * 2;
        unsigned w = cvt_pk_bf16(tl[kp * 65 + nn], tl[(kp + 1) * 65 + nn]);
        *(unsigned*)(dst + (size_t)(n_dst0 + nn) * ld_dst + k0 + kp) = w;
    }
}

DI void xprep_tokens(const float* xsrc  , bf16_t* xb, float* ss, int tok_begin, int tok_end) {
    const int lane = ltid() & 63, wid = ltid() >> 6;
    for (int t = tok_begin + wid; t < tok_end; t += 8) {
        const float* xr = xsrc + (size_t)t * DM;
        float sum = 0.f;
#pragma unroll
        for (int i = 0; i < 4; ++i) {
            f32x4 v = *(const f32x4*)(xr + i * 256 + lane * 4);
            sum += v[0] * v[0] + v[1] * v[1] + v[2] * v[2] + v[3] * v[3];
            u32x2 w; w[0] = cvt_pk_bf16(v[0], v[1]); w[1] = cvt_pk_bf16(v[2], v[3]);
            *(u32x2*)(xb + (size_t)t * DM + i * 256 + lane * 4) = w;
        }
        sum = wave_sum(sum);
        if (lane < 8) ss[(size_t)t * 8 + lane] = lane == 0 ? sum : 0.f;
    }
}

DI void phase_prep(const Params& p, char* shm) {
    char* ws = p.ws;
    const int G = gridDim.x, bid = blockIdx.x, tid = ltid();
    float2* cs = (float2*)(ws + OFF_CS);
    for (int e = bid * NTHREADS + tid; e < NB * S * 8; e += G * NTHREADS) {
        int i = e & 7, t = e >> 3;
        float inv = powf(500000.0f, -(float)(2 * i) / 16.0f);
        float ang = (float)p.pos[t] * inv;
        double rev = (double)ang * 0.15915494309189535;
        rev -= floor(rev);
        float rf = (float)rev;
        cs[e] = make_float2(__builtin_amdgcn_cosf(rf), __builtin_amdgcn_sinf(rf));
    }
    float* tl = (float*)shm;
    const int n_in_tiles = DEPTH * 16 * 204, n_br_tiles = DEPTH * 3 * 8 * 16, n_out_tiles = DEPTH * 16 * 16;
    for (int it = bid; it < n_in_tiles + n_br_tiles + n_out_tiles; it += G) {
        if (it < n_in_tiles) {
            int l = it / (16 * 204), r = it % (16 * 204), hg = r / 16, kt = r % 16;
            int nvalid = hg <= 200 ? 64 : (hg == 201 ? 8 : 0);
            convert_tile(p.w_in + (size_t)l * DM * NIN, NIN, kt * 64, src_col_of_group(hg), nvalid, p.norm_g + l * DM,
                         (bf16_t*)(ws + OFF_WTIN) + (size_t)l * NPAD * DM, DM, hg * 64, tl);
        } else if (it < n_in_tiles + n_br_tiles) {
            int r = it - n_in_tiles; int ln = r / 128, q = r % 128, kt = q / 16, nt = q % 16;
            convert_tile(p.w_br + (size_t)ln * 512 * DM, DM, kt * 64, nt * 64, 64, nullptr, (bf16_t*)(ws + OFF_WTBR) + (size_t)ln * DM * 512, 512, nt * 64, tl);
        } else {
            int r = it - n_in_tiles - n_br_tiles; int l = r / 256, q = r % 256, kt = q / 16, nt = q % 16;
            convert_tile(p.w_out + (size_t)l * DM * DM, DM, kt * 64, nt * 64, 64, nullptr, (bf16_t*)(ws + OFF_WTOUT) + (size_t)l * DM * DM, DM, nt * 64, tl);
        }
    }
    int per = (TG + G - 1) / G;
    int tb = bid * per, te = tb + per < TG ? tb + per : TG;
    xprep_tokens(p.x, (bf16_t*)(ws + OFF_XB), (float*)(ws + OFF_SS), tb, te);
}

constexpr int BM = 256, BK = 64, HALF = 128, NXCD = 8, WGM = 8, HT = HALF * BK;
DI int lds_byte(int r, int c) { int st = (r >> 4) * 2 + (c >> 5), rr = r & 15, cc = c & 31, ob = rr * 64 + cc * 2; return st * 1024 + (ob ^ (((ob >> 9) & 1) << 5)); }
DI void stage_rc(int b, int& R, int& C) { int st = b / 1024, sb = b % 1024, swz = sb ^ (((sb >> 9) & 1) << 5); R = (st >> 1) * 16 + swz / 64; C = (st & 1) * 32 + (swz % 64) / 2; }

#define SA(b, h) (shm + ((b) * 2 + (h)) * HT)
#define SB(b, h) (shm + (4 + (b) * 2 + (h)) * HT)
DI void glds16(const void* sbase, unsigned voff, unsigned lds_dst) {
    unsigned keep;
    asm volatile("s_mov_b32 %0, m0\n\ts_mov_b32 m0, %3\n\ts_nop 0\n\tglobal_load_lds_dwordx4 %1, %2\n\ts_mov_b32 m0, %0"
                 : "=&s"(keep) : "v"(voff), "s"(sbase), "s"(lds_dst) : "memory");
}
#define STAGE(P, BASE, LD, br, kt, VOFF) do { const bf16_t* _gp = (BASE) + (size_t)(br) * (LD) + (size_t)(kt) * BK; \
    const unsigned _l0 = (unsigned)(size_t)(P) + wbase16; \
    glds16(_gp, VOFF[0], _l0); glds16(_gp, VOFF[1], _l0 + 8192u); } while (0)
#define LDA(dst, b, h) _Pragma("unroll") for (int m = 0; m < 4; ++m) _Pragma("unroll") for (int k = 0; k < 2; ++k) \
    dst[m][k] = *reinterpret_cast<const bf16x8*>((char*)SA(b, h) + lds_byte(wr * 64 + m * 16 + fr, k * 32 + fq * 8))
#define LDB(dst, b, h) _Pragma("unroll") for (int n = 0; n < 2; ++n) _Pragma("unroll") for (int k = 0; k < 2; ++k) \
    dst[n][k] = *reinterpret_cast<const bf16x8*>((char*)SB(b, h) + lds_byte(wc * 32 + n * 16 + fr, k * 32 + fq * 8))
#define MMA(ai, bj, At, Bt_) do { __builtin_amdgcn_s_setprio(1); \
    _Pragma("unroll") for (int m = 0; m < 4; ++m) _Pragma("unroll") for (int n = 0; n < 2; ++n) _Pragma("unroll") for (int k = 0; k < 2; ++k) \
      acc[ai][bj][m][n] = MFMA16(At[m][k], Bt_[n][k], acc[ai][bj][m][n]); \
    __builtin_amdgcn_s_setprio(0); } while (0)
#define WAIT_V(n) asm volatile("s_waitcnt vmcnt(" #n ")" ::: "memory")
#define WAIT_L(n) asm volatile("s_waitcnt lgkmcnt(" #n ")" ::: "memory")
#define BAR __builtin_amdgcn_s_barrier()
#define SCHED __builtin_amdgcn_sched_barrier(0)

DI int fold_tok(int rho, int sh) { const int b = rho >> 12, rb = rho & (S - 1); return (b << 12) + (((rb & ((S >> sh) - 1)) << sh) + (rb >> (12 - sh))); }
template <bool FOLD, class Epi>
DI void gemm_phase(const bf16_t* __restrict__ Abase, int lda, size_t a_sub, int M, const bf16_t* __restrict__ Bbase, int ldb, size_t b_sub, int N, int K, int nsub,
                   Epi& epi, __attribute__((address_space(3))) bf16_t* shm) {
    const int nM = M / BM, nN = N / BM, nwg = nM * nN;
    const int wid = ltid() >> 6, lane = ltid() & 63, wr = wid >> 2, wc = wid & 3, fr = lane & 15, fq = lane >> 4;
    const int nt = K / BK;
    unsigned voffA[2], voffB0[2], voffB1[2];
    const unsigned wbase16 = __builtin_amdgcn_readfirstlane((ltid() & ~63u) * 16u);
    int strR[2], strC[2];
#pragma unroll
    for (int i = 0; i < 2; ++i) { stage_rc(ltid() * 16 + i * 8192, strR[i], strC[i]); voffA[i] = (unsigned)(strR[i] * lda + strC[i]) * 2u; }
    for (int L = blockIdx.x; L < nwg; L += gridDim.x) {
        int wgid = L;
        { int q = nwg / NXCD, r = nwg % NXCD, xcd = wgid % NXCD, off = wgid / NXCD; wgid = (xcd < r ? xcd * (q + 1) : r * (q + 1) + (xcd - r) * q) + off; }
        const int nig = WGM * nN, gid = wgid / nig, fm = gid * WGM, gsz = min(nM - fm, WGM);
        const int pm = fm + ((wgid % nig) % gsz), pn = (wgid % nig) / gsz, brow = pm * BM, bcol = pn * BM;
        {
            const int sh = (FOLD && pm < 18) ? 2 * ((pm % 6) >> 1) : 0;
#pragma unroll
            for (int i = 0; i < 2; ++i) {
                voffB0[i] = (unsigned)(fold_tok(bcol + strR[i], sh) * ldb + strC[i]) * 2u;
                voffB1[i] = (unsigned)(fold_tok(bcol + HALF + strR[i], sh) * ldb + strC[i]) * 2u;
            }
        }
        for (int sub = 0; sub < nsub; ++sub) {
            const bf16_t* A = Abase + (size_t)sub * a_sub;
            const bf16_t* Bt = Bbase + (size_t)sub * b_sub;
            f32x4 acc[2][2][4][2] = {};
            bf16x8 At[4][2], B0[2][2], B1[2][2];
            STAGE(SB(0, 0), Bt, ldb, 0, 0, voffB0); STAGE(SA(0, 0), A, lda, brow, 0, voffA);
            STAGE(SB(0, 1), Bt, ldb, 0, 0, voffB1); STAGE(SA(0, 1), A, lda, brow + HALF, 0, voffA);
            if (wr == 1) BAR;
            WAIT_V(4); BAR;
            STAGE(SB(1, 0), Bt, ldb, 0, 1, voffB0); STAGE(SA(1, 0), A, lda, brow, 1, voffA); STAGE(SB(1, 1), Bt, ldb, 0, 1, voffB1);
            WAIT_V(6); BAR;
            for (int t = 0; t < nt - 2; t += 2) {
                LDB(B0, 0, 0); SCHED; LDA(At, 0, 0); STAGE(SA(1, 1), A, lda, brow + HALF, t + 1, voffA);
                WAIT_L(8); BAR; WAIT_L(0); MMA(0, 0, At, B0); BAR; SCHED;
                LDB(B1, 0, 1); STAGE(SB(0, 0), Bt, ldb, 0, t + 2, voffB0);
                BAR; WAIT_L(0); MMA(0, 1, At, B1); BAR;
                LDA(At, 0, 1); STAGE(SA(0, 0), A, lda, brow, t + 2, voffA);
                BAR; WAIT_L(0); MMA(1, 0, At, B0); BAR; SCHED;
                STAGE(SB(0, 1), Bt, ldb, 0, t + 2, voffB1);
                WAIT_V(6); BAR; MMA(1, 1, At, B1); BAR;
                LDB(B0, 1, 0); SCHED; LDA(At, 1, 0); STAGE(SA(0, 1), A, lda, brow + HALF, t + 2, voffA);
                WAIT_L(8); BAR; WAIT_L(0); MMA(0, 0, At, B0); BAR; SCHED;
                LDB(B1, 1, 1); STAGE(SB(1, 0), Bt, ldb, 0, t + 3, voffB0);
                BAR; WAIT_L(0); MMA(0, 1, At, B1); BAR;
                LDA(At, 1, 1); STAGE(SA(1, 0), A, lda, brow, t + 3, voffA);
                BAR; WAIT_L(0); MMA(1, 0, At, B0); BAR; SCHED;
                STAGE(SB(1, 1), Bt, ldb, 0, t + 3, voffB1);
                WAIT_V(6); BAR; MMA(1, 1, At, B1); BAR;
            }
            { LDB(B0, 0, 0); LDA(At, 0, 0); STAGE(SA(1, 1), A, lda, brow + HALF, nt - 1, voffA);
              BAR; WAIT_L(0); MMA(0, 0, At, B0); BAR;
              LDB(B1, 0, 1); BAR; WAIT_L(0); MMA(0, 1, At, B1); BAR;
              LDA(At, 0, 1); WAIT_V(4); BAR; WAIT_L(0); MMA(1, 0, At, B0); MMA(1, 1, At, B1); BAR; }
            { LDB(B0, 1, 0); LDA(At, 1, 0); WAIT_V(2); BAR; WAIT_L(0); MMA(0, 0, At, B0); BAR;
              LDB(B1, 1, 1); WAIT_V(0); BAR; WAIT_L(0); MMA(0, 1, At, B1); BAR;
              LDA(At, 1, 1); BAR; WAIT_L(0); MMA(1, 0, At, B0); MMA(1, 1, At, B1); BAR; }
            if (wr == 0) BAR;
            { int t2 = ltid();
              const int wid2 = t2 >> 6, lane2 = t2 & 63;
              epi(acc, brow, bcol, sub, wid2 >> 2, wid2 & 3, lane2 & 15, lane2 >> 4); }
        }
    }
}

struct EpiIn {
    const Params* p; int layer; int gtok0;
    DI void operator()(const f32x4 (&acc)[2][2][4][2], int brow, int bcol, int sub, int wr, int wc, int fr, int fq) const {
        char* ws = p->ws;
        const float* ss = (const float*)(ws + OFF_SS);
        const float2* cs = (const float2*)(ws + OFF_CS);
        const int lane = ltid() & 63;
#pragma unroll
        for (int bj = 0; bj < 2; ++bj)
#pragma unroll
            for (int n = 0; n < 2; ++n) {
                const int rho = bcol + bj * 128 + wc * 32 + n * 16 + fr;
                const int pm_ = brow >> 8;
                const int shf = pm_ < 18 ? 2 * ((pm_ % 6) >> 1) : 0;
                const int tl = fold_tok(rho, shf);
                const f32x4 s0 = *(const f32x4*)(ss + (size_t)tl * 8), s1 = *(const f32x4*)(ss + (size_t)tl * 8 + 4);
                const float rstd = rsqrtf((s0[0] + s0[1] + s0[2] + s0[3] + s1[0] + s1[1] + s1[2] + s1[3]) * (1.0f / DM) + 1e-6f);
                const int bl = tl >> 12, s = tl & (S - 1), rb = rho & (S - 1);
                const int tg = gtok0 + tl;
#pragma unroll
                for (int ai = 0; ai < 2; ++ai) {
                    const int hg = (brow + ai * 128 + wr * 64) >> 6;
                    float v[16];
#pragma unroll
                    for (int m = 0; m < 4; ++m)
#pragma unroll
                        for (int j = 0; j < 4; ++j) v[m * 4 + j] = acc[ai][bj][m][n][j] * rstd;
                    int kind;
                    int mixer = 0, isk = 0, hh = 0, H = 8; size_t qoff = 0, koff = 0, voff = 0;
                    if (hg < 72) { mixer = 0; H = 24; qoff = OFF_QA; koff = OFF_KA; voff = OFF_VA; kind = hg < 48 ? 0 : 1; isk = hg >= 24; hh = hg % 24; }
                    else if (hg < 96) { mixer = 1; qoff = OFF_QB; koff = OFF_KB; voff = OFF_VB; kind = hg < 88 ? 0 : 1; isk = hg >= 80; hh = (hg - 72) & 7; }
                    else if (hg < 105) { kind = 2; isk = hg == 104; hh = hg - 96; }
                    else if (hg < 129) { mixer = 2; qoff = OFF_QC; koff = OFF_KC; voff = OFF_VC; kind = hg < 121 ? 0 : 1; isk = hg >= 113; hh = (hg - 105) & 7; }
                    else if (hg < 153) kind = 3;
                    else if (hg < 201) kind = 4;
                    else kind = hg == 201 ? 5 : 6;

                    if (kind == 0 || kind == 2) {
                        if (kind == 0) {
                            float sq = 0.f;
#pragma unroll
                            for (int i = 0; i < 16; ++i) sq += v[i] * v[i];
                            sq += shx(sq, 16); sq += shx(sq, 32);
                            const float rn = rsqrtf(sq * (1.0f / 64) + 1e-6f);
                            const float* gq = p->qk_g + ((size_t)(layer * 3 + mixer) * 2 + isk) * 64;
#pragma unroll
                            for (int m = 0; m < 4; ++m) {
                                const f32x4 g4 = *(const f32x4*)(gq + m * 16 + fq * 4);
#pragma unroll
                                for (int j = 0; j < 4; ++j) v[m * 4 + j] *= rn * g4[j];
                            }
                        }
                        {
                            const int ib = (fq & 1) * 4;
                            const f32x4 c01 = *(const f32x4*)(cs + (size_t)tg * 8 + ib), c23 = *(const f32x4*)(cs + (size_t)tg * 8 + ib + 2);
                            const float cj[4] = {c01[0], c01[2], c23[0], c23[2]}, sj[4] = {c01[1], c01[3], c23[1], c23[3]};
#pragma unroll
                            for (int j = 0; j < 4; ++j) {
                                const float mine = v[j], other = shx(mine, 32);
                                v[j] = fq < 2 ? mine * cj[j] - other * sj[j] : mine * cj[j] + other * sj[j];
                            }
                        }
                        bf16_t* dst;
                        if (kind == 0) {
                            const float sc = isk ? 1.0f : QSCALE;
#pragma unroll
                            for (int i = 0; i < 16; ++i) v[i] *= sc;
                            if (isk) dst = (bf16_t*)(ws + koff) + ((size_t)(bl * H + hh) * 128 + (rb >> 5)) * 2048 + (size_t)(rb & 31) * 8;
                            else dst = (bf16_t*)(ws + qoff) + ((size_t)(bl * H + hh) * S + rb) * 64;
                        } else {
                            dst = isk ? (bf16_t*)(ws + OFF_IK) + (size_t)tl * 64 : (bf16_t*)(ws + OFF_IQ) + ((size_t)(bl * 8 + hh) * S + s) * 64;
                        }
                        const bool kfrag = kind == 0 && isk;
#pragma unroll
                        for (int m = 0; m < 4; ++m) {
                            u32x2 w; w[0] = cvt_pk_bf16(v[m * 4], v[m * 4 + 1]); w[1] = cvt_pk_bf16(v[m * 4 + 2], v[m * 4 + 3]);
                            if (kfrag) *(u32x2*)(dst + (m * 64 + (fq >> 1) * 32) * 8 + (fq & 1) * 4) = w;
                            else *(u32x2*)(dst + m * 16 + fq * 4) = w;
                        }
                    } else if (kind == 1) {
                        const int k5 = rb & 31;
                        bf16_t* dst = (bf16_t*)(ws + voff) + ((size_t)(bl * H + hh) * 128 + (rb >> 5)) * 2048 + ((k5 >> 4) * 64 + ((k5 >> 2) & 1) * 32) * 8 + ((k5 >> 3) & 1) * 4 + (k5 & 3);
#pragma unroll
                        for (int m = 0; m < 4; ++m)
#pragma unroll
                            for (int j = 0; j < 4; ++j) dst[((m >> 1) * 128 + (m & 1) * 16 + fq * 4 + j) * 8] = f2bf(v[m * 4 + j]);
                    } else if (kind == 3 || kind == 4) {
                        bf16_t* dst = kind == 3 ? (bf16_t*)(ws + OFF_SZ) + (size_t)tl * 1536 + (hg - 129) * 64 : (bf16_t*)(ws + OFF_SG) + (size_t)tl * 3072 + (hg - 153) * 64;
#pragma unroll
                        for (int i = 0; i < 16; ++i) { const float sg = 1.0f / (1.0f + __expf(-v[i])); v[i] = kind == 3 ? v[i] * sg : sg; }
#pragma unroll
                        for (int m = 0; m < 4; ++m) {
                            u32x2 w; w[0] = cvt_pk_bf16(v[m * 4], v[m * 4 + 1]); w[1] = cvt_pk_bf16(v[m * 4 + 2], v[m * 4 + 3]);
                            *(u32x2*)(dst + m * 16 + fq * 4) = w;
                        }
                    } else if (kind == 5) {
                        if (fq < 2) { f32x4 o = {v[0], v[1], v[2], v[3]}; *(f32x4*)((float*)(ws + OFF_IW) + (size_t)tl * 8 + fq * 4) = o; }
                    }
                }
            }
        (void)lane; (void)sub;
    }
};

struct EpiBr {
    const Params* p;
    DI void operator()(const f32x4 (&acc)[2][2][4][2], int brow, int bcol, int sub, int wr, int wc, int fr, int fq) const {
        char* ws = p->ws;
        const bf16_t* sg = (const bf16_t*)(ws + OFF_SG);
        float* mf = (float*)(ws + OFF_MF);
        bf16_t* mb = (bf16_t*)(ws + OFF_MB);
#pragma unroll
        for (int bj = 0; bj < 2; ++bj)
#pragma unroll
            for (int n = 0; n < 2; ++n) {
                const int tl = bcol + bj * 128 + wc * 32 + n * 16 + fr;
#pragma unroll
                for (int ai = 0; ai < 2; ++ai)
#pragma unroll
                    for (int m = 0; m < 4; ++m) {
                        const int e = brow + ai * 128 + wr * 64 + m * 16 + fq * 4;
                        const u32x2 gw = *(const u32x2*)(sg + (size_t)tl * 3072 + sub * 1024 + e);
                        f32x4 g4 = {__uint_as_float(gw[0] << 16), __uint_as_float(gw[0] & 0xffff0000u), __uint_as_float(gw[1] << 16), __uint_as_float(gw[1] & 0xffff0000u)};
                        f32x4 r = acc[ai][bj][m][n] * g4;
                        float* mp = mf + (size_t)tl * DM + e;
                        if (sub > 0) r += *(const f32x4*)mp;
                        if (sub < 2) *(f32x4*)mp = r;
                        else { u32x2 w; w[0] = cvt_pk_bf16(r[0], r[1]); w[1] = cvt_pk_bf16(r[2], r[3]); *(u32x2*)(mb + (size_t)tl * DM + e) = w; }
                    }
                asm volatile("" ::: "memory");
            }
    }
};

struct EpiOut {
    const Params* p; int layer; int gtok0; bool st;
    DI void operator()(const f32x4 (&acc)[2][2][4][2], int brow, int bcol, int sub, int wr, int wc, int fr, int fq) const {
        char* ws = p->ws;
        const float* xin = layer == 0 ? p->x : p->out;
        bf16_t* xb = (bf16_t*)(ws + OFF_XB);
        float* ss = (float*)(ws + OFF_SS);
#pragma unroll
        for (int bj = 0; bj < 2; ++bj)
#pragma unroll
            for (int n = 0; n < 2; ++n) {
                const int tl = bcol + bj * 128 + wc * 32 + n * 16 + fr;
                const size_t tg = (size_t)gtok0 + tl;
                float sq = 0.f;
#pragma unroll
                for (int ai = 0; ai < 2; ++ai)
#pragma unroll
                    for (int m = 0; m < 4; ++m) {
                        const int e = brow + ai * 128 + wr * 64 + m * 16 + fq * 4;
                        f32x4 r = *(const f32x4*)(xin + tg * DM + e) + acc[ai][bj][m][n];
                        if (st) *(f32x4*)(p->out + tg * DM + e) = r;
                        if (layer == 0 && st) {
                            sq += r[0] * r[0] + r[1] * r[1] + r[2] * r[2] + r[3] * r[3];
                            u32x2 w; w[0] = cvt_pk_bf16(r[0], r[1]); w[1] = cvt_pk_bf16(r[2], r[3]);
                            *(u32x2*)(xb + (size_t)tl * DM + e) = w;
                        }
                    }
                if (layer == 0 && st) {
                    sq += shx(sq, 16); sq += shx(sq, 32);
                    if (fq == 0) ss[(size_t)tl * 8 + (brow >> 8) * 2 + wr] = sq;
                }
            }
        (void)sub;
    }
};

DI void select_chunk(const Params& p, int bl, int c, char* shm) {
    char* ws = p.ws;
    const bf16_t* IQ = (const bf16_t*)(ws + OFF_IQ);
    const bf16_t* IK = (const bf16_t*)(ws + OFF_IK);
    const float* IW = (const float*)(ws + OFF_IW);
    unsigned* hist = (unsigned*)shm; unsigned* bits = (unsigned*)(shm + 16384);
    int* ctl = (int*)(shm + 24576); int* cnt = ctl, *mn = ctl + 16, *mx = ctl + 32, *bsel = ctl + 48, *needp = ctl + 64;
    u32x2* list = (u32x2*)(shm + 32768);
    const int tid = ltid(), lane = tid & 63, w = tid >> 6, q = lane & 15, g = lane >> 4;
    const int t0 = c * 16, tq = t0 + q;
    __syncthreads();
    for (int i = tid; i < 16 * 256 + 16 * 128; i += NTHREADS) hist[i] = 0;
    if (tid < 16) { cnt[tid] = 0; mn[tid] = 0x7fffffff; mx[tid] = (int)0x80000000; }
    bf16x8 qf[8][2]; float wq[8];
#pragma unroll
    for (int hd = 0; hd < 8; ++hd) {
        const bf16_t* qp = IQ + ((size_t)(bl * 8 + hd) * S + tq) * 64 + g * 8;
        qf[hd][0] = *(const bf16x8*)qp; qf[hd][1] = *(const bf16x8*)(qp + 32);
        wq[hd] = IW[(size_t)(bl * S + tq) * 8 + hd];
    }
    auto score = [&](int kt) -> f32x4 {
        const bf16_t* kp = IK + ((size_t)bl * S + kt * 16 + q) * 64 + g * 8;
        const bf16x8 k0 = *(const bf16x8*)kp, k1 = *(const bf16x8*)(kp + 32);
        f32x4 sc = {0.f, 0.f, 0.f, 0.f};
#pragma unroll
        for (int hd = 0; hd < 8; ++hd) {
            f32x4 a = {0.f, 0.f, 0.f, 0.f};
            a = MFMA16(k0, qf[hd][0], a); a = MFMA16(k1, qf[hd][1], a);
#pragma unroll
            for (int j = 0; j < 4; ++j) sc[j] += wq[hd] * fmaxf(a[j], 0.f);
        }
        return sc;
    };
    __syncthreads();
    {
        float lo = 3.0e38f, hi = -3.0e38f;
        for (int kt = w; kt <= c; kt += 8) {
            const f32x4 sc = score(kt);
#pragma unroll
            for (int j = 0; j < 4; ++j) if (kt * 16 + 4 * g + j <= tq) { lo = fminf(lo, sc[j]); hi = fmaxf(hi, sc[j]); }
        }
        lo = fminf(lo, shx(lo, 16)); lo = fminf(lo, shx(lo, 32));
        hi = fmaxf(hi, shx(hi, 16)); hi = fmaxf(hi, shx(hi, 32));
        if (g == 0) { atomicMin(&mn[q], f2sort(lo)); atomicMax(&mx[q], f2sort(hi)); }
    }
    __syncthreads();
    const float rlo = sort2f(mn[q]), rhi = sort2f(mx[q]);
    const float rscale = rhi > rlo ? 256.0f / (rhi - rlo) : 0.f;
    for (int kt = w; kt <= c; kt += 8) {
        const f32x4 sc = score(kt);
#pragma unroll
        for (int j = 0; j < 4; ++j) if (kt * 16 + 4 * g + j <= tq) {
            int b = (int)((sc[j] - rlo) * rscale); b = b > 255 ? 255 : (b < 0 ? 0 : b);
            atomicAdd(&hist[q * 256 + b], 1u);
        }
    }
    __syncthreads();
    {
        const int row = tid >> 5, i = tid & 31;
        unsigned c8[8]; unsigned tot = 0;
#pragma unroll
        for (int k = 0; k < 8; ++k) { c8[k] = hist[row * 256 + i * 8 + k]; tot += c8[k]; }
        unsigned above = 0;
        {
            unsigned run = tot;
#pragma unroll
            for (int o = 1; o < 32; o <<= 1) { const int l_ = tid & 63; unsigned v = (unsigned)__builtin_amdgcn_ds_bpermute(((l_ + o) & 63) << 2, (int)run); if (i + o < 32) run += v; }
            above = run - tot;
        }
        const int trow = t0 + row; const unsigned need = trow + 1 < 256 ? trow + 1 : 256;
        if (above < need && above + tot >= need) {
            unsigned a = above;
#pragma unroll
            for (int k = 7; k >= 0; --k) { if (a < need && a + c8[k] >= need) { bsel[row] = i * 8 + k; needp[row] = (int)(need - a); } a += c8[k]; }
        }
    }
    __syncthreads();
    const int bstar = bsel[q];
    for (int kt = w; kt <= c; kt += 8) {
        const f32x4 sc = score(kt);
        unsigned nib = 0;
#pragma unroll
        for (int j = 0; j < 4; ++j) if (kt * 16 + 4 * g + j <= tq) {
            int b = (int)((sc[j] - rlo) * rscale); b = b > 255 ? 255 : (b < 0 ? 0 : b);
            if (b > bstar) nib |= 1u << j;
            else if (b == bstar) { int pos = atomicAdd(&cnt[q], 1); if (pos < SEL_CAP) { u32x2 e; e[0] = (unsigned)f2sort(sc[j]) ^ 0x80000000u; e[1] = kt * 16 + 4 * g + j; list[q * SEL_CAP + pos] = e; } }
        }
        if (nib) atomicOr(&bits[q * 128 + (kt >> 1)], nib << ((kt & 1) * 16 + 4 * g));
    }
    __syncthreads();
    {
        const int row = tid >> 5, i = tid & 31;
        int n = cnt[row]; n = n < SEL_CAP ? n : SEL_CAP;
        const int need = needp[row];
        for (int a = i; a < n; a += 32) {
            const u32x2 ea = list[row * SEL_CAP + a];
            int rank = 0;
            for (int b = 0; b < n; ++b) { const u32x2 eb = list[row * SEL_CAP + b]; rank += (eb[0] > ea[0]) || (eb[0] == ea[0] && eb[1] < ea[1]); }
            if (rank < need) atomicOr(&bits[row * 128 + (ea[1] >> 5)], 1u << (ea[1] & 31));
        }
    }
    __syncthreads();
    unsigned* mask = (unsigned*)(ws + OFF_MASK) + ((size_t)bl * S + t0) * 128;
    for (int i = tid; i < 16 * 128; i += NTHREADS) mask[i] = bits[i];
}

DI void kmean_item(const Params& p, int bl, int h, int n, char* shm) {
    char* ws = p.ws;
    const bf16_t* K = (const bf16_t*)(ws + OFF_KC) + ((size_t)(bl * 8 + h) * 128 + n * 8) * 2048;
    float* red = (float*)shm;
    const int tid = ltid(), d = tid & 63, part = tid >> 6;
    float s = 0.f;
    for (int k = 0; k < 32; ++k) s += bf2f(K[(size_t)part * 2048 + ((d >> 4) * 64 + ((d >> 3) & 1) * 32 + k) * 8 + (d & 7)]);
    __syncthreads();
    red[part * 64 + d] = s;
    __syncthreads();
    if (tid < 64) {
        float t = 0.f;
        for (int k = 0; k < 8; ++k) t += red[k * 64 + tid];
        t *= (1.0f / 256);
        bf16_t hi = f2bf(t); bf16_t lo = f2bf(t - bf2f(hi));
        bf16_t* km = (bf16_t*)(ws + OFF_KM) + (((size_t)(bl * 8 + h) * 16 + n) * 2) * 64;
        km[tid] = hi; km[64 + tid] = lo;
    }
}

struct AttnAcc { f32x16 o0, o1; float m, l; };
DI void attn_init(AttnAcc& a) {
#pragma unroll
    for (int i = 0; i < 16; ++i) { a.o0[i] = 0.f; a.o1[i] = 0.f; }
    a.m = -1.0e30f; a.l = 0.f;
}
struct KVFrag { bf16x8 k[4]; bf16x8 v[2][2]; };
DI void kv_load(KVFrag& f, const bf16_t* Kt, const bf16_t* Vt, int lane) {
#pragma unroll
    for (int kk = 0; kk < 4; ++kk) f.k[kk] = *(const bf16x8*)(Kt + (kk * 64 + lane) * 8);
#pragma unroll
    for (int db = 0; db < 2; ++db)
#pragma unroll
        for (int u = 0; u < 2; ++u) f.v[db][u] = *(const bf16x8*)(Vt + ((db * 2 + u) * 64 + lane) * 8);
}
DI void attn_step(AttnAcc& a, const KVFrag& f, const bf16x8 (&qf)[4], unsigned vm) {
    f32x16 st;
#pragma unroll
    for (int i = 0; i < 16; ++i) st[i] = 0.f;
#pragma unroll
    for (int kk = 0; kk < 4; ++kk) st = MFMA32(f.k[kk], qf[kk], st);
    float mx = st[0];
#pragma unroll
    for (int i = 1; i < 16; ++i) mx = fmaxf(mx, st[i]);
    mx = fmaxf(mx, shx(mx, 32));
    const float mn = fmaxf(a.m, mx);
    const float alpha = fexp2(a.m - mn);
    a.m = mn;
    float pv[16]; float ps = 0.f;
#pragma unroll
    for (int i = 0; i < 16; ++i) { float e = fexp2(st[i] - mn); e = (vm >> i) & 1u ? e : 0.f; pv[i] = e; ps += e; }
    a.l = a.l * alpha + ps;
#pragma unroll
    for (int i = 0; i < 16; ++i) { a.o0[i] *= alpha; a.o1[i] *= alpha; }
    u32x4 p0, p1;
#pragma unroll
    for (int i = 0; i < 4; ++i) { p0[i] = cvt_pk_bf16(pv[2 * i], pv[2 * i + 1]); p1[i] = cvt_pk_bf16(pv[8 + 2 * i], pv[8 + 2 * i + 1]); }
    const bf16x8 pf0 = __builtin_bit_cast(bf16x8, p0), pf1 = __builtin_bit_cast(bf16x8, p1);
    a.o0 = MFMA32(f.v[0][0], pf0, a.o0); a.o0 = MFMA32(f.v[0][1], pf1, a.o0);
    a.o1 = MFMA32(f.v[1][0], pf0, a.o1); a.o1 = MFMA32(f.v[1][1], pf1, a.o1);
}
DI void load_q(bf16x8 (&qf)[4], const bf16_t* Qrow, int h) {
#pragma unroll
    for (int kk = 0; kk < 4; ++kk) qf[kk] = *(const bf16x8*)(Qrow + kk * 16 + h * 8);
}
DI int koff(int i, int h) { return 8 * (i >> 2) + 4 * h + (i & 3); }

DI void attn_a_item(const Params& p, int bl, int hh, int rb) {
    char* ws = p.ws;
    const int lane = ltid() & 63, w = ltid() >> 6, r = lane & 31, h = lane >> 5;
    const int g = hh >> 3, sh = 2 * g, n = S >> sh;
    const int row0 = rb * 256 + w * 32;
    const int rr = row0 / n, m0 = row0 % n;
    const bf16_t* Q = (const bf16_t*)(ws + OFF_QA) + (size_t)(bl * 24 + hh) * S * 64;
    const bf16_t* K = (const bf16_t*)(ws + OFF_KA) + (size_t)(bl * 24 + hh) * S * 64;
    const bf16_t* Vt = (const bf16_t*)(ws + OFF_VA) + (size_t)(bl * 24 + hh) * 64 * S;
    bf16x8 qf[4]; load_q(qf, Q + (size_t)(row0 + r) * 64, h);
    AttnAcc a; attn_init(a);
    const int kfirst = m0 >= 128 ? 0 : (128 - m0) / 32;
    const int tile0 = (rr * n + m0 - 128) / 32 + 0;
    KVFrag f; kv_load(f, K + (size_t)(tile0 + kfirst) * 2048, Vt + (size_t)(tile0 + kfirst) * 2048, lane);
    for (int k = kfirst; k < 5; ++k) {
        KVFrag fn; const int kn = k + 1 < 5 ? k + 1 : k;
        kv_load(fn, K + (size_t)(tile0 + kn) * 2048, Vt + (size_t)(tile0 + kn) * 2048, lane);
        const int mk0 = m0 - 128 + 32 * k;
        unsigned vm = 0xffffu;
        if (k == 0 || k == 4) {
            vm = 0;
#pragma unroll
            for (int i = 0; i < 16; ++i) { const int d = (m0 + r) - (mk0 + koff(i, h)); if (d >= 0 && d <= 128) vm |= 1u << i; }
        }
        attn_step(a, f, qf, vm);
        f = fn;
    }
    const float l = a.l + shx(a.l, 32);
    const float inv = 1.0f / l;
    const int s = ((m0 + r) << sh) + rr;
    const size_t tl = (size_t)bl * S + s;
    bf16_t* o = (bf16_t*)(ws + OFF_OA) + ((size_t)g * TG + tl) * 512 + (hh & 7) * 64;
#pragma unroll
    for (int q4 = 0; q4 < 4; ++q4) {
        u32x2 w0, w1;
        w0[0] = cvt_pk_bf16(a.o0[q4 * 4] * inv, a.o0[q4 * 4 + 1] * inv); w0[1] = cvt_pk_bf16(a.o0[q4 * 4 + 2] * inv, a.o0[q4 * 4 + 3] * inv);
        w1[0] = cvt_pk_bf16(a.o1[q4 * 4] * inv, a.o1[q4 * 4 + 1] * inv); w1[1] = cvt_pk_bf16(a.o1[q4 * 4 + 2] * inv, a.o1[q4 * 4 + 3] * inv);
        *(u32x2*)(o + 8 * q4 + 4 * h) = w0; *(u32x2*)(o + 32 + 8 * q4 + 4 * h) = w1;
    }
    if (h == 0) ((float*)(ws + OFF_LSE))[((size_t)g * TG + tl) * 8 + (hh & 7)] = (a.m + __log2f(l)) * LN2F;
}

DI void attn_store_gated(const Params& p, const AttnAcc& a, size_t tl, int col0, int h, bool st) {
    const float l = a.l + shx(a.l, 32);
    const float inv = 1.0f / l;
    bf16_t* z = (bf16_t*)(p.ws + OFF_SZ) + tl * 1536 + col0;
#pragma unroll
    for (int q4 = 0; q4 < 4; ++q4) {
#pragma unroll
        for (int db = 0; db < 2; ++db) {
            bf16_t* zp = z + db * 32 + 8 * q4 + 4 * h;
            const u32x2 zw = *(const u32x2*)zp;
            const float z0 = __uint_as_float(zw[0] << 16), z1 = __uint_as_float(zw[0] & 0xffff0000u), z2 = __uint_as_float(zw[1] << 16), z3 = __uint_as_float(zw[1] & 0xffff0000u);
            const f32x16& o = db ? a.o1 : a.o0;
            u32x2 wv; wv[0] = cvt_pk_bf16(o[q4 * 4] * inv * z0, o[q4 * 4 + 1] * inv * z1); wv[1] = cvt_pk_bf16(o[q4 * 4 + 2] * inv * z2, o[q4 * 4 + 3] * inv * z3);
            if (st) *(u32x2*)zp = wv;
        }
    }
}

DI void attn_b_item(const Params& p, int bl, int hd, int qb, bool st) {
    char* ws = p.ws;
    const int lane = ltid() & 63, w = ltid() >> 6, r = lane & 31, h = lane >> 5;
    const int q0 = qb * 256 + w * 32;
    const bf16_t* Q = (const bf16_t*)(ws + OFF_QB) + (size_t)(bl * 8 + hd) * S * 64;
    const bf16_t* K = (const bf16_t*)(ws + OFF_KB) + (size_t)(bl * 8 + hd) * S * 64;
    const bf16_t* Vt = (const bf16_t*)(ws + OFF_VB) + (size_t)(bl * 8 + hd) * 64 * S;
    const unsigned* mrow = (const unsigned*)(ws + OFF_MASK) + ((size_t)bl * S + q0 + r) * 128;
    bf16x8 qf[4]; load_q(qf, Q + (size_t)(q0 + r) * 64, h);
    AttnAcc a; attn_init(a);
    const int nkt = q0 / 32 + 1;
    KVFrag f; kv_load(f, K, Vt, lane);
    unsigned mw = mrow[0];
    for (int kt = 0; kt < nkt; ++kt) {
        KVFrag fn; unsigned mwn = 0;
        const int ktn = kt + 1 < nkt ? kt + 1 : kt;
        kv_load(fn, K + (size_t)ktn * 2048, Vt + (size_t)ktn * 2048, lane); mwn = mrow[ktn];
        const unsigned ws4 = mw >> (4 * h);
        const unsigned vm = (ws4 & 0xfu) | ((ws4 >> 4) & 0xf0u) | ((ws4 >> 8) & 0xf00u) | ((ws4 >> 12) & 0xf000u);
        attn_step(a, f, qf, vm);
        f = fn; mw = mwn;
    }
    attn_store_gated(p, a, (size_t)bl * S + q0 + r, 512 + hd * 64, h, st);
}

DI void attn_c_item(const Params& p, int bl, int hd, int qb, bool st) {
    char* ws = p.ws;
    const int lane = ltid() & 63, w = ltid() >> 6, r = lane & 31, h = lane >> 5;
    const int q0 = qb * 256 + w * 32, own = qb;
    const bf16_t* Q = (const bf16_t*)(ws + OFF_QC) + (size_t)(bl * 8 + hd) * S * 64;
    const bf16_t* K = (const bf16_t*)(ws + OFF_KC) + (size_t)(bl * 8 + hd) * S * 64;
    const bf16_t* Vt = (const bf16_t*)(ws + OFF_VC) + (size_t)(bl * 8 + hd) * 64 * S;
    bf16x8 qf[4]; load_q(qf, Q + (size_t)(q0 + r) * 64, h);
    unsigned sel = 0;
    if (own > 0) {
        const bf16_t* km = (const bf16_t*)(ws + OFF_KM) + (((size_t)(bl * 8 + hd) * 16 + (r & 15)) * 2) * 64;
        f32x16 gt;
#pragma unroll
        for (int i = 0; i < 16; ++i) gt[i] = 0.f;
#pragma unroll
        for (int kk = 0; kk < 4; ++kk) {
            bf16x8 ahi = *(const bf16x8*)(km + kk * 16 + h * 8), alo = *(const bf16x8*)(km + 64 + kk * 16 + h * 8);
            if (r >= 16) { ahi = (bf16x8){0, 0, 0, 0, 0, 0, 0, 0}; alo = ahi; }
            gt = MFMA32(ahi, qf[kk], gt); gt = MFMA32(alo, qf[kk], gt);
        }
        float gl[16];
#pragma unroll
        for (int i = 0; i < 8; ++i) {
            const float mine = gt[i], oth = shx(mine, 32);
            const int blk_mine = 8 * (i >> 2) + 4 * h + (i & 3), blk_oth = 8 * (i >> 2) + 4 * (1 - h) + (i & 3);
            (void)blk_mine; (void)blk_oth;
            gl[8 * (i >> 2) + (i & 3)] = h == 0 ? mine : oth;
            gl[8 * (i >> 2) + 4 + (i & 3)] = h == 0 ? oth : mine;
        }
#pragma unroll
        for (int pick = 0; pick < 3; ++pick) {
            float best = -3.0e38f; int bi = -1;
#pragma unroll
            for (int nb = 0; nb < 16; ++nb) { const bool ok = nb < own && !((sel >> nb) & 1u); if (ok && gl[nb] > best) { best = gl[nb]; bi = nb; } }
            if (bi >= 0) sel |= 1u << bi;
        }
    }
    AttnAcc a; attn_init(a);
    unsigned vis = 0;
    for (int nb = 0; nb < own; ++nb) if (__ballot((sel >> nb) & 1u) != 0ull) vis |= 1u << nb;
    const int ndiag = q0 / 32;
    int cb = vis ? __builtin_ctz(vis) : own, ct = cb * 8;
    unsigned rem = vis ? (vis & (vis - 1)) : 0u;
    KVFrag f; kv_load(f, K + (size_t)ct * 2048, Vt + (size_t)ct * 2048, lane);
    while (true) {
        int nb2 = cb, nt2 = ct + 1; unsigned rem2 = rem; bool last = false;
        if (cb < own) { if ((nt2 & 7) == 0) { if (rem2) { nb2 = __builtin_ctz(rem2); rem2 &= rem2 - 1; } else nb2 = own; nt2 = nb2 * 8; } }
        else if (nt2 > ndiag) { last = true; nt2 = ct; }
        KVFrag fn; kv_load(fn, K + (size_t)nt2 * 2048, Vt + (size_t)nt2 * 2048, lane);
        unsigned vm;
        if (cb < own) vm = ((sel >> cb) & 1u) ? 0xffffu : 0u;
        else if (ct == ndiag) {
            vm = 0;
#pragma unroll
            for (int i = 0; i < 16; ++i) if (koff(i, h) <= r) vm |= 1u << i;
        } else vm = 0xffffu;
        attn_step(a, f, qf, vm);
        if (last) break;
        f = fn; cb = nb2; ct = nt2; rem = rem2;
    }
    attn_store_gated(p, a, (size_t)bl * S + q0 + r, 1024 + hd * 64, h, st);
}

DI void merge_a_item(const Params& p, int item, bool st) {
    char* ws = p.ws;
    const int tid = ltid();
    const bf16_t* oa = (const bf16_t*)(ws + OFF_OA);
    const float* lse = (const float*)(ws + OFF_LSE);
    bf16_t* sz = (bf16_t*)(ws + OFF_SZ);
    for (int it = 0; it < 8; ++it) {
        const size_t tl = (size_t)item * 64 + it * 8 + (tid >> 6);
        const int c8 = (tid & 63) * 8, hd = c8 >> 6;
        const float l0 = lse[(0 * (size_t)TG + tl) * 8 + hd], l1 = lse[(1 * (size_t)TG + tl) * 8 + hd], l2 = lse[(2 * (size_t)TG + tl) * 8 + hd];
        const float mx = fmaxf(l0, fmaxf(l1, l2));
        float w0 = __expf(l0 - mx), w1 = __expf(l1 - mx), w2 = __expf(l2 - mx);
        const float inv = 1.0f / (w0 + w1 + w2); w0 *= inv; w1 *= inv; w2 *= inv;
        const u32x4 a0 = *(const u32x4*)(oa + (0 * (size_t)TG + tl) * 512 + c8), a1 = *(const u32x4*)(oa + (1 * (size_t)TG + tl) * 512 + c8), a2 = *(const u32x4*)(oa + (2 * (size_t)TG + tl) * 512 + c8);
        const u32x4 zz = *(const u32x4*)(sz + tl * 1536 + c8);
        u32x4 res;
#pragma unroll
        for (int k = 0; k < 4; ++k) {
            const float lo = (w0 * __uint_as_float(a0[k] << 16) + w1 * __uint_as_float(a1[k] << 16) + w2 * __uint_as_float(a2[k] << 16)) * __uint_as_float(zz[k] << 16);
            const float hi = (w0 * __uint_as_float(a0[k] & 0xffff0000u) + w1 * __uint_as_float(a1[k] & 0xffff0000u) + w2 * __uint_as_float(a2[k] & 0xffff0000u)) * __uint_as_float(zz[k] & 0xffff0000u);
            res[k] = cvt_pk_bf16(lo, hi);
        }
        if (st) *(u32x4*)(sz + tl * 1536 + c8) = res;
    }
}

DI int snake_item(int round, int G, int bid) { return (round & 1) ? round * G + (G - 1 - bid) : round * G + bid; }

__global__ void __launch_bounds__(NTHREADS) fwd_megakernel(Params p) {
    __shared__ __attribute__((aligned(16))) char shm_raw[SHM_BYTES];
    cg::grid_group grid = cg::this_grid();
    char* ws = p.ws;
    const int G = gridDim.x, bid = blockIdx.x;
    __attribute__((address_space(3))) bf16_t* shm_g = (__attribute__((address_space(3))) bf16_t*)shm_raw;

    unsigned* barcnt = (unsigned*)(ws + OFF_BAR);
    unsigned bartarget = 0;
    if (bid == 0 && threadIdx.x == 0) __hip_atomic_store(barcnt, 0u, __ATOMIC_RELAXED, __HIP_MEMORY_SCOPE_AGENT);
    phase_prep(p, shm_raw);
    grid.sync();

#define LAUNDER() do { asm volatile("" : "+s"(p.ws)); asm volatile("" : "+s"(p.out)); asm volatile("" : "+s"(p.x)); ws = p.ws; } while (0)
    for (int grp = 0; grp < NGRP; ++grp) {
        const int gtok0 = grp * TG;
        for (int layer = 0; layer < DEPTH; ++layer) {
            LAUNDER();
            for (int rep = 0; rep <= (p.dupmask & 1); ++rep) {
                EpiIn epi{&p, layer, gtok0};
                gemm_phase<true>((const bf16_t*)(ws + OFF_WTIN) + (size_t)layer * NPAD * DM, DM, 0, NPAD, (const bf16_t*)(ws + OFF_XB), DM, 0, TG, DM, 1, epi, shm_g);
            }
            grid_barrier(barcnt, bartarget, (unsigned)G);
            LAUNDER();
            for (int rep = 0; rep <= ((p.dupmask >> 1) & 1); ++rep) {
                const int nsel = BG * 256;
                for (int rnd = 0;; ++rnd) {
                    const int it = snake_item(rnd, G, bid);
                    if (rnd * G >= nsel) break;
                    if (it < nsel) select_chunk(p, it % BG, 255 - it / BG, shm_raw);
                }
                for (int it = bid; it < BG * 24 * 16; it += G) attn_a_item(p, it / (24 * 16), (it / 16) % 24, it % 16);
                for (int it = bid; it < BG * 8 * 16; it += G) kmean_item(p, it / 128, (it / 16) & 7, it & 15, shm_raw);
            }
            grid_barrier(barcnt, bartarget, (unsigned)G);
            LAUNDER();
            for (int rep = ((p.dupmask >> 2) & 1); rep >= 0; --rep) {
                const bool st = rep == 0;
                const int nbc = 2 * BG * 8 * 16;
                for (int rnd = 0;; ++rnd) {
                    const int it = snake_item(rnd, G, bid);
                    if (rnd * G >= nbc) break;
                    if (it < nbc) {
                        const int qb = 15 - it / (2 * BG * 8), sub = it % (2 * BG * 8), typ = sub / (BG * 8), bl = (sub / 8) % BG, hd = sub & 7;
                        if (typ == 0) attn_b_item(p, bl, hd, qb, st); else attn_c_item(p, bl, hd, qb, st);
                    }
                }
                for (int it = bid; it < TG / 64; it += G) merge_a_item(p, it, st);
            }
            grid_barrier(barcnt, bartarget, (unsigned)G);
            LAUNDER();
            for (int rep = 0; rep <= ((p.dupmask >> 3) & 1); ++rep) {
                EpiBr epi{&p};
                gemm_phase<false>((const bf16_t*)(ws + OFF_WTBR) + (size_t)layer * 3 * DM * 512, 512, (size_t)DM * 512, DM, (const bf16_t*)(ws + OFF_SZ), 1536, 512, TG, 512, 3, epi, shm_g);
            }
            grid_barrier(barcnt, bartarget, (unsigned)G);
            LAUNDER();
            for (int rep = ((p.dupmask >> 4) & 1); rep >= 0; --rep) {
                EpiOut epi{&p, layer, gtok0, rep == 0};
                gemm_phase<false>((const bf16_t*)(ws + OFF_WTOUT) + (size_t)layer * DM * DM, DM, 0, DM, (const bf16_t*)(ws + OFF_MB), DM, 0, TG, DM, 1, epi, shm_g);
                if (layer == DEPTH - 1 && grp + 1 < NGRP) {
                    __syncthreads();
                    int per = (TG + G - 1) / G; int tb = bid * per, te = tb + per < TG ? tb + per : TG;
                    xprep_tokens(p.x + (size_t)(grp + 1) * TG * DM, (bf16_t*)(ws + OFF_XB), (float*)(ws + OFF_SS), tb, te);
                }
            }
            grid_barrier(barcnt, bartarget, (unsigned)G);
        }
    }
}

extern "C" void kernel_launch(void* const* d_in, const int* in_sizes, int n_in, void* d_out, int out_size, void* d_ws, size_t ws_size, hipStream_t stream) {
    static int grid_blocks = 0;
    if (!grid_blocks) {
        int dev = 0, cus = 0, per_cu = 0;
        hipGetDevice(&dev);
        hipDeviceGetAttribute(&cus, hipDeviceAttributeMultiprocessorCount, dev);
        hipOccupancyMaxActiveBlocksPerMultiprocessor(&per_cu, fwd_megakernel, NTHREADS, 0);
        if (per_cu > 1) per_cu = 1;
        grid_blocks = cus * per_cu;
    }
    if (ws_size < WS_NEED) { fprintf(stderr, "workspace too small: %zu < %zu\n", ws_size, (size_t)WS_NEED); return; }
#ifndef DUPMASK
#define DUPMASK 0
#endif
    Params p{};
    p.dupmask = DUPMASK; p.pad_ = 0;
    p.x = (const float*)d_in[0]; p.pos = (const int*)d_in[1]; p.norm_g = (const float*)d_in[2]; p.w_in = (const float*)d_in[3];
    p.qk_g = (const float*)d_in[4]; p.w_br = (const float*)d_in[5]; p.w_out = (const float*)d_in[6];
    p.out = (float*)d_out; p.ws = (char*)d_ws;
    void* args[] = {&p};
    hipError_t e = hipLaunchCooperativeKernel((void*)fwd_megakernel, dim3(grid_blocks), dim3(NTHREADS), args, 0, stream);
    if (e != hipSuccess) fprintf(stderr, "cooperative launch failed: %s (grid %d)\n", hipGetErrorString(e), grid_blocks);
}
```

```cpp
#include <hip/hip_runtime.h>
#include <hip/hip_cooperative_groups.h>
#include <cstdio>
#include <cstdint>
namespace cg = cooperative_groups;
#define ATTN_LDS 0

typedef unsigned short bf16_t;
typedef short bf16x8 __attribute__((ext_vector_type(8)));
typedef short s16x4 __attribute__((ext_vector_type(4)));
typedef float f32x4 __attribute__((ext_vector_type(4)));
typedef float f32x16 __attribute__((ext_vector_type(16)));
typedef unsigned u32x4 __attribute__((ext_vector_type(4)));
typedef unsigned u32x2 __attribute__((ext_vector_type(2)));
#define DI __device__ __forceinline__

constexpr int S = 4096, DM = 1024, NB = 8, DEPTH = 2;
constexpr int NIN = 12872, NPAD = 13056;
constexpr int BG = 4, TG = BG * S, NGRP = NB / BG;
constexpr int NTHREADS = 512;
constexpr int SHM_BYTES = 131072;
constexpr float QSCALE = 0.125f * 1.4426950408889634f;
constexpr float LN2F = 0.6931471805599453f;
constexpr int SEL_CAP = 768;

constexpr size_t al256(size_t x) { return (x + 255) & ~(size_t)255; }
constexpr size_t OFF_WTIN = 0;
constexpr size_t OFF_WTBR = OFF_WTIN + al256((size_t)NPAD * DM * 2);
constexpr size_t OFF_WTOUT = OFF_WTBR + al256((size_t)DEPTH * 3 * DM * 512 * 2);
constexpr size_t OFF_CS = OFF_WTOUT + al256((size_t)DEPTH * DM * DM * 2);
constexpr size_t OFF_XB = OFF_CS + al256((size_t)NB * S * 8 * 8);
constexpr size_t OFF_OA = OFF_XB;
constexpr size_t OFF_SS = OFF_XB + al256((size_t)3 * TG * 512 * 2);
constexpr size_t OFF_QA = OFF_SS + al256((size_t)TG * 8 * 4);
constexpr size_t OFF_KA = OFF_QA + al256((size_t)TG * 1536 * 2);
constexpr size_t OFF_VA = OFF_KA + al256((size_t)TG * 1536 * 2);
constexpr size_t OFF_MF = OFF_QA;
constexpr size_t OFF_MB = OFF_VA;
constexpr size_t OFF_QB = OFF_VA + al256((size_t)TG * 1536 * 2);
constexpr size_t OFF_KB = OFF_QB + al256((size_t)TG * 512 * 2);
constexpr size_t OFF_VB = OFF_KB + al256((size_t)TG * 512 * 2);
constexpr size_t OFF_QC = OFF_VB + al256((size_t)TG * 512 * 2);
constexpr size_t OFF_KC = OFF_QC + al256((size_t)TG * 512 * 2);
constexpr size_t OFF_VC = OFF_KC + al256((size_t)TG * 512 * 2);
constexpr size_t OFF_IQ = OFF_VC + al256((size_t)TG * 512 * 2);
constexpr size_t OFF_IK = OFF_IQ + al256((size_t)TG * 512 * 2);
constexpr size_t OFF_IW = OFF_IK + al256((size_t)TG * 64 * 2);
constexpr size_t OFF_SZ = OFF_IW + al256((size_t)TG * 8 * 4);
constexpr size_t OFF_SG = OFF_SZ + al256((size_t)TG * 1536 * 2);
constexpr size_t OFF_LSE = OFF_SG + al256((size_t)TG * 3072 * 2);
constexpr size_t OFF_MASK = OFF_LSE + al256((size_t)3 * TG * 8 * 4);
constexpr size_t OFF_KM = OFF_MASK + al256((size_t)BG * S * (S / 8));
static_assert((size_t)TG * DM * 4 <= (size_t)2 * TG * 1536 * 2 && (size_t)TG * DM * 2 <= (size_t)TG * 1536 * 2, "overlay sizes");
constexpr size_t OFF_BAR = OFF_KM + al256((size_t)BG * 8 * 16 * 64 * 2 * 2);
constexpr size_t WS_NEED = OFF_BAR + 256;

struct Params {
    const float* x; const int* pos; const float* norm_g; const float* w_in; const float* qk_g; const float* w_br; const float* w_out;
    float* out; char* ws; int dupmask; int pad_;
};

DI int ltid() { int t = threadIdx.x; asm volatile("" : "+v"(t)); return t; }
DI unsigned cvt_pk_bf16(float lo, float hi) { unsigned r; asm volatile("v_cvt_pk_bf16_f32 %0, %1, %2" : "=v"(r) : "v"(lo), "v"(hi)); return r; }
DI bf16_t f2bf(float x) { return (bf16_t)(cvt_pk_bf16(x, 0.f) & 0xffffu); }
DI float bf2f(bf16_t v) { return __uint_as_float(((unsigned)v) << 16); }
DI float fexp2(float x) { return __builtin_amdgcn_exp2f(x); }
DI float shx(float v, int mask) { const int l = ltid() & 63; return __int_as_float(__builtin_amdgcn_ds_bpermute((l ^ mask) << 2, __float_as_int(v))); }
DI float wave_sum(float v) { for (int o = 32; o > 0; o >>= 1) v += shx(v, o); return v; }
DI int f2sort(float f) { int i = __float_as_int(f); return i ^ ((i >> 31) & 0x7fffffff); }
DI float sort2f(int i) { return __int_as_float(i ^ ((i >> 31) & 0x7fffffff)); }
#define MFMA32(a, b, c) __builtin_amdgcn_mfma_f32_32x32x16_bf16((a), (b), (c), 0, 0, 0)
#define MFMA16(a, b, c) __builtin_amdgcn_mfma_f32_16x16x32_bf16((a), (b), (c), 0, 0, 0)

DI void grid_barrier(unsigned* cnt, unsigned& target, unsigned G) {
    __syncthreads();
    target += G;
    if (threadIdx.x == 0) {
        __threadfence();
        __hip_atomic_fetch_add(cnt, 1u, __ATOMIC_RELAXED, __HIP_MEMORY_SCOPE_AGENT);
        while (__hip_atomic_load(cnt, __ATOMIC_RELAXED, __HIP_MEMORY_SCOPE_AGENT) < target) __builtin_amdgcn_s_sleep(2);
        __threadfence();
    }
    __syncthreads();
}

DI int src_col_of_group(int hg) { return hg <= 104 ? hg * 64 : (hg <= 200 ? 6728 + (hg - 105) * 64 : 6720); }

DI void convert_tile(const float* src, int ld_src, int k0, int n_src0, int n_valid, const float* kscale, bf16_t* dst, int ld_dst, int n_dst0, float* tl  ) {
    const int tid = ltid();
    __syncthreads();
#pragma unroll
    for (int i = 0; i < 8; ++i) {
        int e = tid + i * 512, kk = e >> 6, nn = e & 63;
        float v = 0.f;
        if (nn < n_valid) { v = src[(size_t)(k0 + kk) * ld_src + n_src0 + nn]; if (kscale) v *= kscale[k0 + kk]; }
        tl[kk * 65 + nn] = v;
    }
    __syncthreads();
#pragma unroll
    for (int i = 0; i < 4; ++i) {
        int e = tid + i * 512, nn = e >> 5, kp = (e & 31) * 2;
        unsigned w = cvt_pk_bf16(tl[kp * 65 + nn], tl[(kp + 1) * 65 + nn]);
        *(unsigned*)(dst + (size_t)(n_dst0 + nn) * ld_dst + k0 + kp) = w;
    }
}

DI void xprep_tokens(const float* xsrc  , bf16_t* xb, float* ss, int tok_begin, int tok_end) {
    const int lane = ltid() & 63, wid = ltid() >> 6;
    for (int t = tok_begin + wid; t < tok_end; t += 8) {
        const float* xr = xsrc + (size_t)t * DM;
        float sum = 0.f;
#pragma unroll
        for (int i = 0; i < 4; ++i) {
            f32x4 v = *(const f32x4*)(xr + i * 256 + lane * 4);
            sum += v[0] * v[0] + v[1] * v[1] + v[2] * v[2] + v[3] * v[3];
            u32x2 w; w[0] = cvt_pk_bf16(v[0], v[1]); w[1] = cvt_pk_bf16(v[2], v[3]);
            *(u32x2*)(xb + (size_t)t * DM + i * 256 + lane * 4) = w;
        }
        sum = wave_sum(sum);
        if (lane < 8) ss[(size_t)t * 8 + lane] = lane == 0 ? sum : 0.f;
    }
}

DI void convert_win_tile(const Params& p, int l, int it, float* tl) {
    const int hg = it / 16, kt = it % 16;
    const int nvalid = hg <= 200 ? 64 : (hg == 201 ? 8 : 0);
    convert_tile(p.w_in + (size_t)l * DM * NIN, NIN, kt * 64, src_col_of_group(hg), nvalid, p.norm_g + l * DM, (bf16_t*)(p.ws + OFF_WTIN), DM, hg * 64, tl);
}
DI void phase_prep(const Params& p, char* shm) {
    char* ws = p.ws;
    const int G = gridDim.x, bid = blockIdx.x, tid = ltid();
    float2* cs = (float2*)(ws + OFF_CS);
    for (int e = bid * NTHREADS + tid; e < NB * S * 8; e += G * NTHREADS) {
        int i = e & 7, t = e >> 3;
        float inv = powf(500000.0f, -(float)(2 * i) / 16.0f);
        float ang = (float)p.pos[t] * inv;
        double rev = (double)ang * 0.15915494309189535;
        rev -= floor(rev);
        float rf = (float)rev;
        cs[e] = make_float2(__builtin_amdgcn_cosf(rf), __builtin_amdgcn_sinf(rf));
    }
    float* tl = (float*)shm;
    const int n_in_tiles = 16 * 204, n_br_tiles = DEPTH * 3 * 8 * 16, n_out_tiles = DEPTH * 16 * 16;
    for (int it = bid; it < n_in_tiles + n_br_tiles + n_out_tiles; it += G) {
        if (it < n_in_tiles) {
            convert_win_tile(p, 0, it, tl);
        } else if (it < n_in_tiles + n_br_tiles) {
            int r = it - n_in_tiles; int ln = r / 128, q = r % 128, kt = q / 16, nt = q % 16;
            convert_tile(p.w_br + (size_t)ln * 512 * DM, DM, kt * 64, nt * 64, 64, nullptr, (bf16_t*)(ws + OFF_WTBR) + (size_t)ln * DM * 512, 512, nt * 64, tl);
        } else {
            int r = it - n_in_tiles - n_br_tiles; int l = r / 256, q = r % 256, kt = q / 16, nt = q % 16;
            convert_tile(p.w_out + (size_t)l * DM * DM, DM, kt * 64, nt * 64, 64, nullptr, (bf16_t*)(ws + OFF_WTOUT) + (size_t)l * DM * DM, DM, nt * 64, tl);
        }
    }
    int per = (TG + G - 1) / G;
    int tb = bid * per, te = tb + per < TG ? tb + per : TG;
    xprep_tokens(p.x, (bf16_t*)(ws + OFF_XB), (float*)(ws + OFF_SS), tb, te);
}

constexpr int BM = 256, BK = 64, HALF = 128, NXCD = 8, WGM = 8, HT = HALF * BK;
DI int lds_byte(int r, int c) { int st = (r >> 4) * 2 + (c >> 5), rr = r & 15, cc = c & 31, ob = rr * 64 + cc * 2; return st * 1024 + (ob ^ (((ob >> 9) & 1) << 5)); }
DI void stage_rc(int b, int& R, int& C) { int st = b / 1024, sb = b % 1024, swz = sb ^ (((sb >> 9) & 1) << 5); R = (st >> 1) * 16 + swz / 64; C = (st & 1) * 32 + (swz % 64) / 2; }

#define SA(b, h) (shm + ((b) * 2 + (h)) * HT)
#define SB(b, h) (shm + (4 + (b) * 2 + (h)) * HT)
DI void glds16(const void* sbase, unsigned voff, unsigned lds_dst) {
    unsigned keep;
    asm volatile("s_mov_b32 %0, m0\n\ts_mov_b32 m0, %3\n\ts_nop 0\n\tglobal_load_lds_dwordx4 %1, %2\n\ts_mov_b32 m0, %0"
                 : "=&s"(keep) : "v"(voff), "s"(sbase), "s"(lds_dst) : "memory");
}
#define STAGE(P, BASE, LD, br, kt, VOFF) do { const bf16_t* _gp = (BASE) + (size_t)(br) * (LD) + (size_t)(kt) * BK; \
    const unsigned _l0 = (unsigned)(size_t)(P) + wbase16; \
    glds16(_gp, VOFF[0], _l0); glds16(_gp, VOFF[1], _l0 + 8192u); } while (0)
#define LDA(dst, b, h) _Pragma("unroll") for (int m = 0; m < 4; ++m) _Pragma("unroll") for (int k = 0; k < 2; ++k) \
    dst[m][k] = *reinterpret_cast<const bf16x8*>((char*)SA(b, h) + lds_byte(wr * 64 + m * 16 + fr, k * 32 + fq * 8))
#define LDB(dst, b, h) _Pragma("unroll") for (int n = 0; n < 2; ++n) _Pragma("unroll") for (int k = 0; k < 2; ++k) \
    dst[n][k] = *reinterpret_cast<const bf16x8*>((char*)SB(b, h) + lds_byte(wc * 32 + n * 16 + fr, k * 32 + fq * 8))
#define MMA(ai, bj, At, Bt_) do { __builtin_amdgcn_s_setprio(1); \
    _Pragma("unroll") for (int m = 0; m < 4; ++m) _Pragma("unroll") for (int n = 0; n < 2; ++n) _Pragma("unroll") for (int k = 0; k < 2; ++k) \
      acc[ai][bj][m][n] = MFMA16(At[m][k], Bt_[n][k], acc[ai][bj][m][n]); \
    __builtin_amdgcn_s_setprio(0); } while (0)
#define WAIT_V(n) asm volatile("s_waitcnt vmcnt(" #n ")" ::: "memory")
#define WAIT_L(n) asm volatile("s_waitcnt lgkmcnt(" #n ")" ::: "memory")
#define BAR __builtin_amdgcn_s_barrier()
#define SCHED __builtin_amdgcn_sched_barrier(0)

DI int fold_tok(int rho, int sh) { const int b = rho >> 12, rb = rho & (S - 1); return (b << 12) + (((rb & ((S >> sh) - 1)) << sh) + (rb >> (12 - sh))); }
template <bool FOLD, class Epi>
DI void gemm_phase(const bf16_t* __restrict__ Abase, int lda, size_t a_sub, int M, const bf16_t* __restrict__ Bbase, int ldb, size_t b_sub, int N, int K, int nsub,
                   Epi& epi, __attribute__((address_space(3))) bf16_t* shm) {
    const int nM = M / BM, nN = N / BM, nwg = nM * nN;
    const int wid = ltid() >> 6, lane = ltid() & 63, wr = wid >> 2, wc = wid & 3, fr = lane & 15, fq = lane >> 4;
    const int nt = K / BK;
    unsigned voffA[2], voffB0[2], voffB1[2];
    const unsigned wbase16 = __builtin_amdgcn_readfirstlane((ltid() & ~63u) * 16u);
#pragma unroll
    for (int i = 0; i < 2; ++i) { int r_, c_; stage_rc(ltid() * 16 + i * 8192, r_, c_); voffA[i] = (unsigned)(r_ * lda + c_) * 2u; }
    for (int L = blockIdx.x; L < nwg; L += gridDim.x) {
        int wgid = L;
        { int q = nwg / NXCD, r = nwg % NXCD, xcd = wgid % NXCD, off = wgid / NXCD; wgid = (xcd < r ? xcd * (q + 1) : r * (q + 1) + (xcd - r) * q) + off; }
        const int nig = WGM * nN, gid = wgid / nig, fm = gid * WGM, gsz = min(nM - fm, WGM);
        const int pm = fm + ((wgid % nig) % gsz), pn = (wgid % nig) / gsz, brow = pm * BM, bcol = pn * BM;
        {
            const int sh = (FOLD && pm < 18) ? 2 * ((pm % 6) >> 1) : 0;
            const int t_ = ltid();
#pragma unroll
            for (int i = 0; i < 2; ++i) {
                int r_, c_; stage_rc(t_ * 16 + i * 8192, r_, c_);
                voffB0[i] = (unsigned)(fold_tok(bcol + r_, sh) * ldb + c_) * 2u;
                voffB1[i] = (unsigned)(fold_tok(bcol + HALF + r_, sh) * ldb + c_) * 2u;
            }
        }
        for (int sub = 0; sub < nsub; ++sub) {
            const bf16_t* A = Abase + (size_t)sub * a_sub;
            const bf16_t* Bt = Bbase + (size_t)sub * b_sub;
            f32x4 acc[2][2][4][2] = {};
            bf16x8 At[4][2], B0[2][2], B1[2][2];
            STAGE(SB(0, 0), Bt, ldb, 0, 0, voffB0); STAGE(SA(0, 0), A, lda, brow, 0, voffA);
            STAGE(SB(0, 1), Bt, ldb, 0, 0, voffB1); STAGE(SA(0, 1), A, lda, brow + HALF, 0, voffA);
            if (wr == 1) BAR;
            WAIT_V(4); BAR;
            STAGE(SB(1, 0), Bt, ldb, 0, 1, voffB0); STAGE(SA(1, 0), A, lda, brow, 1, voffA); STAGE(SB(1, 1), Bt, ldb, 0, 1, voffB1);
            WAIT_V(6); BAR;
            for (int t = 0; t < nt - 2; t += 2) {
                LDB(B0, 0, 0); SCHED; LDA(At, 0, 0); STAGE(SA(1, 1), A, lda, brow + HALF, t + 1, voffA);
                WAIT_L(8); BAR; WAIT_L(0); MMA(0, 0, At, B0); BAR; SCHED;
                LDB(B1, 0, 1); STAGE(SB(0, 0), Bt, ldb, 0, t + 2, voffB0);
                BAR; WAIT_L(0); MMA(0, 1, At, B1); BAR;
                LDA(At, 0, 1); STAGE(SA(0, 0), A, lda, brow, t + 2, voffA);
                BAR; WAIT_L(0); MMA(1, 0, At, B0); BAR; SCHED;
                STAGE(SB(0, 1), Bt, ldb, 0, t + 2, voffB1);
                WAIT_V(6); BAR; MMA(1, 1, At, B1); BAR;
                LDB(B0, 1, 0); SCHED; LDA(At, 1, 0); STAGE(SA(0, 1), A, lda, brow + HALF, t + 2, voffA);
                WAIT_L(8); BAR; WAIT_L(0); MMA(0, 0, At, B0); BAR; SCHED;
                LDB(B1, 1, 1); STAGE(SB(1, 0), Bt, ldb, 0, t + 3, voffB0);
                BAR; WAIT_L(0); MMA(0, 1, At, B1); BAR;
                LDA(At, 1, 1); STAGE(SA(1, 0), A, lda, brow, t + 3, voffA);
                BAR; WAIT_L(0); MMA(1, 0, At, B0); BAR; SCHED;
                STAGE(SB(1, 1), Bt, ldb, 0, t + 3, voffB1);
                WAIT_V(6); BAR; MMA(1, 1, At, B1); BAR;
            }
            { LDB(B0, 0, 0); LDA(At, 0, 0); STAGE(SA(1, 1), A, lda, brow + HALF, nt - 1, voffA);
              BAR; WAIT_L(0); MMA(0, 0, At, B0); BAR;
              LDB(B1, 0, 1); BAR; WAIT_L(0); MMA(0, 1, At, B1); BAR;
              LDA(At, 0, 1); WAIT_V(4); BAR; WAIT_L(0); MMA(1, 0, At, B0); MMA(1, 1, At, B1); BAR; }
            { LDB(B0, 1, 0); LDA(At, 1, 0); WAIT_V(2); BAR; WAIT_L(0); MMA(0, 0, At, B0); BAR;
              LDB(B1, 1, 1); WAIT_V(0); BAR; WAIT_L(0); MMA(0, 1, At, B1); BAR;
              LDA(At, 1, 1); BAR; WAIT_L(0); MMA(1, 0, At, B0); MMA(1, 1, At, B1); BAR; }
            if (wr == 0) BAR;
            { int t2 = ltid();
              const int wid2 = t2 >> 6, lane2 = t2 & 63;
              epi(acc, brow, bcol, sub, wid2 >> 2, wid2 & 3, lane2 & 15, lane2 >> 4); }
        }
    }
}

struct EpiIn {
    const Params* p; int layer; int gtok0;
    DI void operator()(const f32x4 (&acc)[2][2][4][2], int brow, int bcol, int sub, int wr, int wc, int fr, int fq) const {
        char* ws = p->ws;
        const float* ss = (const float*)(ws + OFF_SS);
        const float2* cs = (const float2*)(ws + OFF_CS);
        const int lane = ltid() & 63;
#pragma unroll
        for (int bj = 0; bj < 2; ++bj)
#pragma unroll
            for (int n = 0; n < 2; ++n) {
                const int rho = bcol + bj * 128 + wc * 32 + n * 16 + fr;
                const int pm_ = brow >> 8;
                const int shf = pm_ < 18 ? 2 * ((pm_ % 6) >> 1) : 0;
                const int tl = fold_tok(rho, shf);
                const f32x4 s0 = *(const f32x4*)(ss + (size_t)tl * 8), s1 = *(const f32x4*)(ss + (size_t)tl * 8 + 4);
                const float rstd = rsqrtf((s0[0] + s0[1] + s0[2] + s0[3] + s1[0] + s1[1] + s1[2] + s1[3]) * (1.0f / DM) + 1e-6f);
                const int bl = tl >> 12, s = tl & (S - 1), rb = rho & (S - 1);
                const int tg = gtok0 + tl;
#pragma unroll
                for (int ai = 0; ai < 2; ++ai) {
                    const int hg = (brow + ai * 128 + wr * 64) >> 6;
                    float v[16];
#pragma unroll
                    for (int m = 0; m < 4; ++m)
#pragma unroll
                        for (int j = 0; j < 4; ++j) v[m * 4 + j] = acc[ai][bj][m][n][j] * rstd;
                    int kind;
                    int mixer = 0, isk = 0, hh = 0, H = 8; size_t qoff = 0, koff = 0, voff = 0;
                    if (hg < 72) { mixer = 0; H = 24; qoff = OFF_QA; koff = OFF_KA; voff = OFF_VA; kind = hg < 48 ? 0 : 1; isk = hg >= 24; hh = hg % 24; }
                    else if (hg < 96) { mixer = 1; qoff = OFF_QB; koff = OFF_KB; voff = OFF_VB; kind = hg < 88 ? 0 : 1; isk = hg >= 80; hh = (hg - 72) & 7; }
                    else if (hg < 105) { kind = 2; isk = hg == 104; hh = hg - 96; }
                    else if (hg < 129) { mixer = 2; qoff = OFF_QC; koff = OFF_KC; voff = OFF_VC; kind = hg < 121 ? 0 : 1; isk = hg >= 113; hh = (hg - 105) & 7; }
                    else if (hg < 153) kind = 3;
                    else if (hg < 201) kind = 4;
                    else kind = hg == 201 ? 5 : 6;

                    if (kind == 0 || kind == 2) {
                        if (kind == 0) {
                            float sq = 0.f;
#pragma unroll
                            for (int i = 0; i < 16; ++i) sq += v[i] * v[i];
                            sq += shx(sq, 16); sq += shx(sq, 32);
                            const float rn = rsqrtf(sq * (1.0f / 64) + 1e-6f);
                            const float* gq = p->qk_g + ((size_t)(layer * 3 + mixer) * 2 + isk) * 64;
#pragma unroll
                            for (int m = 0; m < 4; ++m) {
                                const f32x4 g4 = *(const f32x4*)(gq + m * 16 + fq * 4);
#pragma unroll
                                for (int j = 0; j < 4; ++j) v[m * 4 + j] *= rn * g4[j];
                            }
                        }
                        {
                            const int ib = (fq & 1) * 4;
                            const f32x4 c01 = *(const f32x4*)(cs + (size_t)tg * 8 + ib), c23 = *(const f32x4*)(cs + (size_t)tg * 8 + ib + 2);
                            const float cj[4] = {c01[0], c01[2], c23[0], c23[2]}, sj[4] = {c01[1], c01[3], c23[1], c23[3]};
#pragma unroll
                            for (int j = 0; j < 4; ++j) {
                                const float mine = v[j], other = shx(mine, 32);
                                v[j] = fq < 2 ? mine * cj[j] - other * sj[j] : mine * cj[j] + other * sj[j];
                            }
                        }
                        bf16_t* dst;
                        if (kind == 0) {
                            const float sc = isk ? 1.0f : QSCALE;
#pragma unroll
                            for (int i = 0; i < 16; ++i) v[i] *= sc;
                            if (isk) dst = (bf16_t*)(ws + koff) + ((size_t)(bl * H + hh) * 128 + (rb >> 5)) * 2048 + (size_t)(rb & 31) * 8;
                            else dst = (bf16_t*)(ws + qoff) + ((size_t)(bl * H + hh) * S + rb) * 64;
                        } else {
                            dst = isk ? (bf16_t*)(ws + OFF_IK) + (size_t)tl * 64 : (bf16_t*)(ws + OFF_IQ) + ((size_t)(bl * 8 + hh) * S + s) * 64;
                        }
                        const bool kfrag = kind == 0 && isk;
#pragma unroll
                        for (int m = 0; m < 4; ++m) {
                            u32x2 w; w[0] = cvt_pk_bf16(v[m * 4], v[m * 4 + 1]); w[1] = cvt_pk_bf16(v[m * 4 + 2], v[m * 4 + 3]);
                            if (kfrag) *(u32x2*)(dst + (m * 64 + (fq >> 1) * 32) * 8 + (fq & 1) * 4) = w;
                            else *(u32x2*)(dst + m * 16 + fq * 4) = w;
                        }
                    } else if (kind == 1) {
                        const int k5 = rb & 31;
                        bf16_t* dst = (bf16_t*)(ws + voff) + ((size_t)(bl * H + hh) * 128 + (rb >> 5)) * 2048 + ((k5 >> 4) * 64 + ((k5 >> 2) & 1) * 32) * 8 + ((k5 >> 3) & 1) * 4 + (k5 & 3);
#pragma unroll
                        for (int m = 0; m < 4; ++m)
#pragma unroll
                            for (int j = 0; j < 4; ++j) dst[((m >> 1) * 128 + (m & 1) * 16 + fq * 4 + j) * 8] = f2bf(v[m * 4 + j]);
                    } else if (kind == 3 || kind == 4) {
                        bf16_t* dst = kind == 3 ? (bf16_t*)(ws + OFF_SZ) + (size_t)tl * 1536 + (hg - 129) * 64 : (bf16_t*)(ws + OFF_SG) + (size_t)tl * 3072 + (hg - 153) * 64;
#pragma unroll
                        for (int i = 0; i < 16; ++i) { const float sg = 1.0f / (1.0f + __expf(-v[i])); v[i] = kind == 3 ? v[i] * sg : sg; }
#pragma unroll
                        for (int m = 0; m < 4; ++m) {
                            u32x2 w; w[0] = cvt_pk_bf16(v[m * 4], v[m * 4 + 1]); w[1] = cvt_pk_bf16(v[m * 4 + 2], v[m * 4 + 3]);
                            *(u32x2*)(dst + m * 16 + fq * 4) = w;
                        }
                    } else if (kind == 5) {
                        if (fq < 2) { f32x4 o = {v[0], v[1], v[2], v[3]}; *(f32x4*)((float*)(ws + OFF_IW) + (size_t)tl * 8 + fq * 4) = o; }
                    }
                }
            }
        (void)lane; (void)sub;
    }
};

struct EpiBr {
    const Params* p;
    DI void operator()(const f32x4 (&acc)[2][2][4][2], int brow, int bcol, int sub, int wr, int wc, int fr, int fq) const {
        char* ws = p->ws;
        const bf16_t* sg = (const bf16_t*)(ws + OFF_SG);
        float* mf = (float*)(ws + OFF_MF);
        bf16_t* mb = (bf16_t*)(ws + OFF_MB);
#pragma unroll
        for (int bj = 0; bj < 2; ++bj)
#pragma unroll
            for (int n = 0; n < 2; ++n) {
                const int tl = bcol + bj * 128 + wc * 32 + n * 16 + fr;
#pragma unroll
                for (int ai = 0; ai < 2; ++ai)
#pragma unroll
                    for (int m = 0; m < 4; ++m) {
                        const int e = brow + ai * 128 + wr * 64 + m * 16 + fq * 4;
                        const u32x2 gw = *(const u32x2*)(sg + (size_t)tl * 3072 + sub * 1024 + e);
                        f32x4 g4 = {__uint_as_float(gw[0] << 16), __uint_as_float(gw[0] & 0xffff0000u), __uint_as_float(gw[1] << 16), __uint_as_float(gw[1] & 0xffff0000u)};
                        f32x4 r = acc[ai][bj][m][n] * g4;
                        float* mp = mf + (size_t)tl * DM + e;
                        if (sub > 0) r += *(const f32x4*)mp;
                        if (sub < 2) *(f32x4*)mp = r;
                        else { u32x2 w; w[0] = cvt_pk_bf16(r[0], r[1]); w[1] = cvt_pk_bf16(r[2], r[3]); *(u32x2*)(mb + (size_t)tl * DM + e) = w; }
                    }
                asm volatile("" ::: "memory");
            }
    }
};

struct EpiOut {
    const Params* p; int layer; int gtok0; bool st;
    DI void operator()(const f32x4 (&acc)[2][2][4][2], int brow, int bcol, int sub, int wr, int wc, int fr, int fq) const {
        char* ws = p->ws;
        const float* xin = layer == 0 ? p->x : p->out;
        bf16_t* xb = (bf16_t*)(ws + OFF_XB);
        float* ss = (float*)(ws + OFF_SS);
#pragma unroll
        for (int bj = 0; bj < 2; ++bj)
#pragma unroll
            for (int n = 0; n < 2; ++n) {
                const int tl = bcol + bj * 128 + wc * 32 + n * 16 + fr;
                const size_t tg = (size_t)gtok0 + tl;
                float sq = 0.f;
#pragma unroll
                for (int ai = 0; ai < 2; ++ai)
#pragma unroll
                    for (int m = 0; m < 4; ++m) {
                        const int e = brow + ai * 128 + wr * 64 + m * 16 + fq * 4;
                        f32x4 r = *(const f32x4*)(xin + tg * DM + e) + acc[ai][bj][m][n];
                        if (st) *(f32x4*)(p->out + tg * DM + e) = r;
                    }
            }
        (void)sub;
    }
};

DI void select_chunk(const Params& p, int bl, int c, char* shm) {
    char* ws = p.ws;
    const bf16_t* IQ = (const bf16_t*)(ws + OFF_IQ);
    const bf16_t* IK = (const bf16_t*)(ws + OFF_IK);
    const float* IW = (const float*)(ws + OFF_IW);
    unsigned* hist = (unsigned*)shm; unsigned* bits = (unsigned*)(shm + 16384);
    int* ctl = (int*)(shm + 24576); int* cnt = ctl, *mn = ctl + 16, *mx = ctl + 32, *bsel = ctl + 48, *needp = ctl + 64;
    u32x2* list = (u32x2*)(shm + 32768);
    const int tid = ltid(), lane = tid & 63, w = tid >> 6, q = lane & 15, g = lane >> 4;
    const int t0 = c * 16, tq = t0 + q;
    __syncthreads();
    for (int i = tid; i < 16 * 256 + 16 * 128; i += NTHREADS) hist[i] = 0;
    if (tid < 16) { cnt[tid] = 0; mn[tid] = 0x7fffffff; mx[tid] = (int)0x80000000; }
    bf16x8 qf[8][2]; float wq[8];
#pragma unroll
    for (int hd = 0; hd < 8; ++hd) {
        const bf16_t* qp = IQ + ((size_t)(bl * 8 + hd) * S + tq) * 64 + g * 8;
        qf[hd][0] = *(const bf16x8*)qp; qf[hd][1] = *(const bf16x8*)(qp + 32);
        wq[hd] = IW[(size_t)(bl * S + tq) * 8 + hd];
    }
    auto loadk = [&](int kt, bf16x8& k0, bf16x8& k1) {
        const bf16_t* kp = IK + ((size_t)bl * S + kt * 16 + q) * 64 + g * 8;
        k0 = *(const bf16x8*)kp; k1 = *(const bf16x8*)(kp + 32);
    };
    auto compute = [&](const bf16x8& k0, const bf16x8& k1) -> f32x4 {
        f32x4 sc = {0.f, 0.f, 0.f, 0.f};
#pragma unroll
        for (int hd = 0; hd < 8; ++hd) {
            f32x4 a = {0.f, 0.f, 0.f, 0.f};
            a = MFMA16(k0, qf[hd][0], a); a = MFMA16(k1, qf[hd][1], a);
#pragma unroll
            for (int j = 0; j < 4; ++j) sc[j] += wq[hd] * fmaxf(a[j], 0.f);
        }
        return sc;
    };
#define SEL_PASS(BODY) do { \
        bf16x8 ka0, ka1, kb0, kb1; int kt = w; \
        if (kt <= c) loadk(kt, ka0, ka1); \
        if (kt + 8 <= c) loadk(kt + 8, kb0, kb1); \
        for (; kt <= c; kt += 16) { \
            { const f32x4 sc = compute(ka0, ka1); if (kt + 16 <= c) loadk(kt + 16, ka0, ka1); const int ktc = kt; BODY } \
            if (kt + 8 <= c) { const f32x4 sc = compute(kb0, kb1); if (kt + 24 <= c) loadk(kt + 24, kb0, kb1); const int ktc = kt + 8; BODY } \
        } } while (0)
    __syncthreads();
    {
        float lo = 3.0e38f, hi = -3.0e38f;
        SEL_PASS({
            _Pragma("unroll") for (int j = 0; j < 4; ++j) if (ktc * 16 + 4 * g + j <= tq) { lo = fminf(lo, sc[j]); hi = fmaxf(hi, sc[j]); }
        });
        lo = fminf(lo, shx(lo, 16)); lo = fminf(lo, shx(lo, 32));
        hi = fmaxf(hi, shx(hi, 16)); hi = fmaxf(hi, shx(hi, 32));
        if (g == 0) { atomicMin(&mn[q], f2sort(lo)); atomicMax(&mx[q], f2sort(hi)); }
    }
    __syncthreads();
    const float rlo = sort2f(mn[q]), rhi = sort2f(mx[q]);
    const float rscale = rhi > rlo ? 256.0f / (rhi - rlo) : 0.f;
    SEL_PASS({
        _Pragma("unroll") for (int j = 0; j < 4; ++j) if (ktc * 16 + 4 * g + j <= tq) {
            int b = (int)((sc[j] - rlo) * rscale); b = b > 255 ? 255 : (b < 0 ? 0 : b);
            atomicAdd(&hist[q * 256 + b], 1u);
        }
    });
    __syncthreads();
    {
        const int row = tid >> 5, i = tid & 31;
        unsigned c8[8]; unsigned tot = 0;
#pragma unroll
        for (int k = 0; k < 8; ++k) { c8[k] = hist[row * 256 + i * 8 + k]; tot += c8[k]; }
        unsigned above = 0;
        {
            unsigned run = tot;
#pragma unroll
            for (int o = 1; o < 32; o <<= 1) { const int l_ = tid & 63; unsigned v = (unsigned)__builtin_amdgcn_ds_bpermute(((l_ + o) & 63) << 2, (int)run); if (i + o < 32) run += v; }
            above = run - tot;
        }
        const int trow = t0 + row; const unsigned need = trow + 1 < 256 ? trow + 1 : 256;
        if (above < need && above + tot >= need) {
            unsigned a = above;
#pragma unroll
            for (int k = 7; k >= 0; --k) { if (a < need && a + c8[k] >= need) { bsel[row] = i * 8 + k; needp[row] = (int)(need - a); } a += c8[k]; }
        }
    }
    __syncthreads();
    const int bstar = bsel[q];
    SEL_PASS({
        unsigned nib = 0;
        _Pragma("unroll") for (int j = 0; j < 4; ++j) if (ktc * 16 + 4 * g + j <= tq) {
            int b = (int)((sc[j] - rlo) * rscale); b = b > 255 ? 255 : (b < 0 ? 0 : b);
            if (b > bstar) nib |= 1u << j;
            else if (b == bstar) { int pos = atomicAdd(&cnt[q], 1); if (pos < SEL_CAP) { u32x2 e; e[0] = (unsigned)f2sort(sc[j]) ^ 0x80000000u; e[1] = ktc * 16 + 4 * g + j; list[q * SEL_CAP + pos] = e; } }
        }
        if (nib) atomicOr(&bits[q * 128 + (ktc >> 1)], nib << ((ktc & 1) * 16 + 4 * g));
    });
    __syncthreads();
    {
        const int row = tid >> 5, i = tid & 31;
        int n = cnt[row]; n = n < SEL_CAP ? n : SEL_CAP;
        const int need = needp[row];
        for (int a = i; a < n; a += 32) {
            const u32x2 ea = list[row * SEL_CAP + a];
            int rank = 0;
            for (int b = 0; b < n; ++b) { const u32x2 eb = list[row * SEL_CAP + b]; rank += (eb[0] > ea[0]) || (eb[0] == ea[0] && eb[1] < ea[1]); }
            if (rank < need) atomicOr(&bits[row * 128 + (ea[1] >> 5)], 1u << (ea[1] & 31));
        }
    }
    __syncthreads();
    unsigned* mask = (unsigned*)(ws + OFF_MASK) + ((size_t)bl * S + t0) * 128;
    for (int i = tid; i < 16 * 128; i += NTHREADS) mask[i] = bits[i];
}

DI void kmean_item(const Params& p, int bl, int h, int n, char* shm) {
    char* ws = p.ws;
    const bf16_t* K = (const bf16_t*)(ws + OFF_KC) + ((size_t)(bl * 8 + h) * 128 + n * 8) * 2048;
    float* red = (float*)shm;
    const int tid = ltid(), d = tid & 63, part = tid >> 6;
    float s = 0.f;
    for (int k = 0; k < 32; ++k) s += bf2f(K[(size_t)part * 2048 + ((d >> 4) * 64 + ((d >> 3) & 1) * 32 + k) * 8 + (d & 7)]);
    __syncthreads();
    red[part * 64 + d] = s;
    __syncthreads();
    if (tid < 64) {
        float t = 0.f;
        for (int k = 0; k < 8; ++k) t += red[k * 64 + tid];
        t *= (1.0f / 256);
        bf16_t hi = f2bf(t); bf16_t lo = f2bf(t - bf2f(hi));
        bf16_t* km = (bf16_t*)(ws + OFF_KM) + (((size_t)(bl * 8 + h) * 16 + n) * 2) * 64;
        km[tid] = hi; km[64 + tid] = lo;
    }
}

struct AttnAcc { f32x16 o0, o1; float nb, l; };
DI void attn_init(AttnAcc& a, float nb) {
    float z = 0.f; asm volatile("" : "+v"(z));
#pragma unroll
    for (int i = 0; i < 16; ++i) { a.o0[i] = z; a.o1[i] = z; }
    a.nb = nb + z; a.l = z;
}
DI float attn_bound(const bf16x8 (&qf)[4], const float* gk) {
    float qs = 0.f;
#pragma unroll
    for (int kk = 0; kk < 4; ++kk)
#pragma unroll
        for (int e = 0; e < 8; ++e) { const float v = bf2f((bf16_t)qf[kk][e]); qs += v * v; }
    qs += shx(qs, 32);
    float gm = fabsf(gk[ltid() & 63]);
    for (int o = 32; o > 0; o >>= 1) gm = fmaxf(gm, shx(gm, o));
    return sqrtf(qs) * gm * 8.1f;
}
struct KVFrag { bf16x8 k[4]; bf16x8 v[2][2]; };
DI void kv_load(KVFrag& f, const bf16_t* Kt, const bf16_t* Vt, int lane) {
#pragma unroll
    for (int kk = 0; kk < 4; ++kk) f.k[kk] = *(const bf16x8*)(Kt + (kk * 64 + lane) * 8);
#pragma unroll
    for (int db = 0; db < 2; ++db)
#pragma unroll
        for (int u = 0; u < 2; ++u) f.v[db][u] = *(const bf16x8*)(Vt + ((db * 2 + u) * 64 + lane) * 8);
}
DI void attn_step(AttnAcc& a, const KVFrag& f, const bf16x8 (&qf)[4], unsigned vm) {
    f32x16 st;
#pragma unroll
    for (int i = 0; i < 16; ++i) st[i] = -a.nb;
#pragma unroll
    for (int kk = 0; kk < 4; ++kk) st = MFMA32(f.k[kk], qf[kk], st);
    float pv[16];
#pragma unroll
    for (int i = 0; i < 16; ++i) pv[i] = fexp2(st[i]);
    if (__ballot(vm != 0xffffu) != 0ull) {
#pragma unroll
        for (int i = 0; i < 16; ++i) pv[i] = __int_as_float(__float_as_int(pv[i]) & __builtin_amdgcn_sbfe((int)vm, i, 1));
    }
    a.l += ((pv[0] + pv[1]) + (pv[2] + pv[3])) + ((pv[4] + pv[5]) + (pv[6] + pv[7])) + (((pv[8] + pv[9]) + (pv[10] + pv[11])) + ((pv[12] + pv[13]) + (pv[14] + pv[15])));
    u32x4 p0, p1;
#pragma unroll
    for (int i = 0; i < 4; ++i) { p0[i] = cvt_pk_bf16(pv[2 * i], pv[2 * i + 1]); p1[i] = cvt_pk_bf16(pv[8 + 2 * i], pv[8 + 2 * i + 1]); }
    const bf16x8 pf0 = __builtin_bit_cast(bf16x8, p0), pf1 = __builtin_bit_cast(bf16x8, p1);
    a.o0 = MFMA32(f.v[0][0], pf0, a.o0); a.o0 = MFMA32(f.v[0][1], pf1, a.o0);
    a.o1 = MFMA32(f.v[1][0], pf0, a.o1); a.o1 = MFMA32(f.v[1][1], pf1, a.o1);
}
DI void load_q(bf16x8 (&qf)[4], const bf16_t* Qrow, int h) {
#pragma unroll
    for (int kk = 0; kk < 4; ++kk) qf[kk] = *(const bf16x8*)(Qrow + kk * 16 + h * 8);
}
DI int koff(int i, int h) { return 8 * (i >> 2) + 4 * h + (i & 3); }

DI void attn_a_item(const Params& p, int layer, int bl, int hh, int rb) {
    char* ws = p.ws;
    const int lane = ltid() & 63, w = ltid() >> 6, r = lane & 31, h = lane >> 5;
    const int g = hh >> 3, sh = 2 * g, n = S >> sh;
    const int row0 = rb * 256 + w * 32;
    const int rr = row0 / n, m0 = row0 % n;
    const bf16_t* Q = (const bf16_t*)(ws + OFF_QA) + (size_t)(bl * 24 + hh) * S * 64;
    const bf16_t* K = (const bf16_t*)(ws + OFF_KA) + (size_t)(bl * 24 + hh) * S * 64;
    const bf16_t* Vt = (const bf16_t*)(ws + OFF_VA) + (size_t)(bl * 24 + hh) * 64 * S;
    bf16x8 qf[4]; load_q(qf, Q + (size_t)(row0 + r) * 64, h);
    AttnAcc a; attn_init(a, attn_bound(qf, p.qk_g + ((size_t)(layer * 3 + 0) * 2 + 1) * 64));
    const int kfirst = m0 >= 128 ? 0 : (128 - m0) / 32;
    const int tile0 = (rr * n + m0 - 128) / 32 + 0;
    KVFrag f; kv_load(f, K + (size_t)(tile0 + kfirst) * 2048, Vt + (size_t)(tile0 + kfirst) * 2048, lane);
    for (int k = kfirst; k < 5; ++k) {
        KVFrag fn; const int kn = k + 1 < 5 ? k + 1 : k;
        kv_load(fn, K + (size_t)(tile0 + kn) * 2048, Vt + (size_t)(tile0 + kn) * 2048, lane);
        const int mk0 = m0 - 128 + 32 * k;
        unsigned vm = 0xffffu;
        if (k == 0 || k == 4) {
            vm = 0;
#pragma unroll
            for (int i = 0; i < 16; ++i) { const int d = (m0 + r) - (mk0 + koff(i, h)); if (d >= 0 && d <= 128) vm |= 1u << i; }
        }
        attn_step(a, f, qf, vm);
        f = fn;
    }
    const float l = a.l + shx(a.l, 32);
    const float inv = 1.0f / l;
    const int s = ((m0 + r) << sh) + rr;
    const size_t tl = (size_t)bl * S + s;
    bf16_t* o = (bf16_t*)(ws + OFF_OA) + ((size_t)g * TG + tl) * 512 + (hh & 7) * 64;
#pragma unroll
    for (int q4 = 0; q4 < 4; ++q4) {
        u32x2 w0, w1;
        w0[0] = cvt_pk_bf16(a.o0[q4 * 4] * inv, a.o0[q4 * 4 + 1] * inv); w0[1] = cvt_pk_bf16(a.o0[q4 * 4 + 2] * inv, a.o0[q4 * 4 + 3] * inv);
        w1[0] = cvt_pk_bf16(a.o1[q4 * 4] * inv, a.o1[q4 * 4 + 1] * inv); w1[1] = cvt_pk_bf16(a.o1[q4 * 4 + 2] * inv, a.o1[q4 * 4 + 3] * inv);
        *(u32x2*)(o + 8 * q4 + 4 * h) = w0; *(u32x2*)(o + 32 + 8 * q4 + 4 * h) = w1;
    }
    if (h == 0) ((float*)(ws + OFF_LSE))[((size_t)g * TG + tl) * 8 + (hh & 7)] = (a.nb + __log2f(l)) * LN2F;
}

DI void attn_store_gated(const Params& p, const AttnAcc& a, size_t tl, int col0, int h, bool st) {
    const float l = a.l + shx(a.l, 32);
    const float inv = 1.0f / l;
    bf16_t* z = (bf16_t*)(p.ws + OFF_SZ) + tl * 1536 + col0;
#pragma unroll
    for (int q4 = 0; q4 < 4; ++q4) {
#pragma unroll
        for (int db = 0; db < 2; ++db) {
            bf16_t* zp = z + db * 32 + 8 * q4 + 4 * h;
            const u32x2 zw = *(const u32x2*)zp;
            const float z0 = __uint_as_float(zw[0] << 16), z1 = __uint_as_float(zw[0] & 0xffff0000u), z2 = __uint_as_float(zw[1] << 16), z3 = __uint_as_float(zw[1] & 0xffff0000u);
            const f32x16& o = db ? a.o1 : a.o0;
            u32x2 wv; wv[0] = cvt_pk_bf16(o[q4 * 4] * inv * z0, o[q4 * 4 + 1] * inv * z1); wv[1] = cvt_pk_bf16(o[q4 * 4 + 2] * inv * z2, o[q4 * 4 + 3] * inv * z3);
            if (st) *(u32x2*)zp = wv;
        }
    }
}

DI void attn_b_item(const Params& p, int layer, int bl, int hd, int qb, bool st) {
    char* ws = p.ws;
    const int lane = ltid() & 63, w = ltid() >> 6, r = lane & 31, h = lane >> 5;
    const int q0 = qb * 256 + w * 32;
    const bf16_t* Q = (const bf16_t*)(ws + OFF_QB) + (size_t)(bl * 8 + hd) * S * 64;
    const bf16_t* K = (const bf16_t*)(ws + OFF_KB) + (size_t)(bl * 8 + hd) * S * 64;
    const bf16_t* Vt = (const bf16_t*)(ws + OFF_VB) + (size_t)(bl * 8 + hd) * 64 * S;
    const unsigned* mrow = (const unsigned*)(ws + OFF_MASK) + ((size_t)bl * S + q0 + r) * 128;
    bf16x8 qf[4]; load_q(qf, Q + (size_t)(q0 + r) * 64, h);
    AttnAcc a; attn_init(a, attn_bound(qf, p.qk_g + ((size_t)(layer * 3 + 1) * 2 + 1) * 64));
    const int nkt = q0 / 32 + 1;
    KVFrag f; kv_load(f, K, Vt, lane);
    unsigned mw = mrow[0];
    for (int kt = 0; kt < nkt; ++kt) {
        KVFrag fn; unsigned mwn = 0;
        const int ktn = kt + 1 < nkt ? kt + 1 : kt;
        kv_load(fn, K + (size_t)ktn * 2048, Vt + (size_t)ktn * 2048, lane); mwn = mrow[ktn];
        const unsigned ws4 = mw >> (4 * h);
        const unsigned vm = (ws4 & 0xfu) | ((ws4 >> 4) & 0xf0u) | ((ws4 >> 8) & 0xf00u) | ((ws4 >> 12) & 0xf000u);
        attn_step(a, f, qf, vm);
        f = fn; mw = mwn;
    }
    attn_store_gated(p, a, (size_t)bl * S + q0 + r, 512 + hd * 64, h, st);
}

DI void attn_c_item(const Params& p, int layer, int bl, int hd, int qb, bool st) {
    char* ws = p.ws;
    const int lane = ltid() & 63, w = ltid() >> 6, r = lane & 31, h = lane >> 5;
    const int q0 = qb * 256 + w * 32, own = qb;
    const bf16_t* Q = (const bf16_t*)(ws + OFF_QC) + (size_t)(bl * 8 + hd) * S * 64;
    const bf16_t* K = (const bf16_t*)(ws + OFF_KC) + (size_t)(bl * 8 + hd) * S * 64;
    const bf16_t* Vt = (const bf16_t*)(ws + OFF_VC) + (size_t)(bl * 8 + hd) * 64 * S;
    bf16x8 qf[4]; load_q(qf, Q + (size_t)(q0 + r) * 64, h);
    unsigned sel = 0;
    if (own > 0) {
        const bf16_t* km = (const bf16_t*)(ws + OFF_KM) + (((size_t)(bl * 8 + hd) * 16 + (r & 15)) * 2) * 64;
        f32x16 gt;
#pragma unroll
        for (int i = 0; i < 16; ++i) gt[i] = 0.f;
#pragma unroll
        for (int kk = 0; kk < 4; ++kk) {
            bf16x8 ahi = *(const bf16x8*)(km + kk * 16 + h * 8), alo = *(const bf16x8*)(km + 64 + kk * 16 + h * 8);
            if (r >= 16) { ahi = (bf16x8){0, 0, 0, 0, 0, 0, 0, 0}; alo = ahi; }
            gt = MFMA32(ahi, qf[kk], gt); gt = MFMA32(alo, qf[kk], gt);
        }
        float gl[16];
#pragma unroll
        for (int i = 0; i < 8; ++i) {
            const float mine = gt[i], oth = shx(mine, 32);
            const int blk_mine = 8 * (i >> 2) + 4 * h + (i & 3), blk_oth = 8 * (i >> 2) + 4 * (1 - h) + (i & 3);
            (void)blk_mine; (void)blk_oth;
            gl[8 * (i >> 2) + (i & 3)] = h == 0 ? mine : oth;
            gl[8 * (i >> 2) + 4 + (i & 3)] = h == 0 ? oth : mine;
        }
#pragma unroll
        for (int pick = 0; pick < 3; ++pick) {
            float best = -3.0e38f; int bi = -1;
#pragma unroll
            for (int nb = 0; nb < 16; ++nb) { const bool ok = nb < own && !((sel >> nb) & 1u); if (ok && gl[nb] > best) { best = gl[nb]; bi = nb; } }
            if (bi >= 0) sel |= 1u << bi;
        }
    }
    AttnAcc a; attn_init(a, attn_bound(qf, p.qk_g + ((size_t)(layer * 3 + 2) * 2 + 1) * 64));
    unsigned vis = 0;
    for (int nb = 0; nb < own; ++nb) if (__ballot((sel >> nb) & 1u) != 0ull) vis |= 1u << nb;
    const int ndiag = q0 / 32;
    int cb = vis ? __builtin_ctz(vis) : own, ct = cb * 8;
    unsigned rem = vis ? (vis & (vis - 1)) : 0u;
    KVFrag f; kv_load(f, K + (size_t)ct * 2048, Vt + (size_t)ct * 2048, lane);
    while (true) {
        int nb2 = cb, nt2 = ct + 1; unsigned rem2 = rem; bool last = false;
        if (cb < own) { if ((nt2 & 7) == 0) { if (rem2) { nb2 = __builtin_ctz(rem2); rem2 &= rem2 - 1; } else nb2 = own; nt2 = nb2 * 8; } }
        else if (nt2 > ndiag) { last = true; nt2 = ct; }
        KVFrag fn; kv_load(fn, K + (size_t)nt2 * 2048, Vt + (size_t)nt2 * 2048, lane);
        unsigned vm;
        if (cb < own) vm = ((sel >> cb) & 1u) ? 0xffffu : 0u;
        else if (ct == ndiag) {
            vm = 0;
#pragma unroll
            for (int i = 0; i < 16; ++i) if (koff(i, h) <= r) vm |= 1u << i;
        } else vm = 0xffffu;
        attn_step(a, f, qf, vm);
        if (last) break;
        f = fn; cb = nb2; ct = nt2; rem = rem2;
    }
    attn_store_gated(p, a, (size_t)bl * S + q0 + r, 1024 + hd * 64, h, st);
}

DI void attn_bc_item(const Params& p, int layer, int typ, int bl, int hd, int qb, bool st, char* shm) {
    char* ws = p.ws;
    const int tid = ltid(), lane = tid & 63, w = tid >> 6, r = lane & 31, h = lane >> 5;
    const int q0 = qb * 256 + w * 32, own = qb, ndiag = q0 / 32;
    const bf16_t* Q = (const bf16_t*)(ws + (typ ? OFF_QC : OFF_QB)) + (size_t)(bl * 8 + hd) * S * 64;
    const bf16_t* K = (const bf16_t*)(ws + (typ ? OFF_KC : OFF_KB)) + (size_t)(bl * 8 + hd) * S * 64;
    const bf16_t* Vt = (const bf16_t*)(ws + (typ ? OFF_VC : OFF_VB)) + (size_t)(bl * 8 + hd) * 64 * S;
    const unsigned* mrow = (const unsigned*)(ws + OFF_MASK) + ((size_t)bl * S + q0 + r) * 128;
    unsigned short* seq = (unsigned short*)(shm + 16384);
    unsigned* wvis = (unsigned*)(shm + 16896);
    bf16x8 qf[4]; load_q(qf, Q + (size_t)(q0 + r) * 64, h);
    unsigned sel = 0, vis = 0;
    if (typ == 1 && own > 0) {
        const bf16_t* km = (const bf16_t*)(ws + OFF_KM) + (((size_t)(bl * 8 + hd) * 16 + (r & 15)) * 2) * 64;
        f32x16 gt;
#pragma unroll
        for (int i = 0; i < 16; ++i) gt[i] = 0.f;
#pragma unroll
        for (int kk = 0; kk < 4; ++kk) {
            bf16x8 ahi = *(const bf16x8*)(km + kk * 16 + h * 8), alo = *(const bf16x8*)(km + 64 + kk * 16 + h * 8);
            if (r >= 16) { ahi = (bf16x8){0, 0, 0, 0, 0, 0, 0, 0}; alo = ahi; }
            gt = MFMA32(ahi, qf[kk], gt); gt = MFMA32(alo, qf[kk], gt);
        }
        float gl[16];
#pragma unroll
        for (int i = 0; i < 8; ++i) {
            const float mine = gt[i], oth = shx(mine, 32);
            gl[8 * (i >> 2) + (i & 3)] = h == 0 ? mine : oth;
            gl[8 * (i >> 2) + 4 + (i & 3)] = h == 0 ? oth : mine;
        }
#pragma unroll
        for (int pick = 0; pick < 3; ++pick) {
            float best = -3.0e38f; int bi = -1;
#pragma unroll
            for (int nb = 0; nb < 16; ++nb) { const bool ok = nb < own && !((sel >> nb) & 1u); if (ok && gl[nb] > best) { best = gl[nb]; bi = nb; } }
            if (bi >= 0) sel |= 1u << bi;
        }
        for (int nb = 0; nb < own; ++nb) if (__ballot((sel >> nb) & 1u) != 0ull) vis |= 1u << nb;
    }
    if (typ == 0) vis = (1u << own) - 1u;
    __syncthreads();
    if (lane == 0) wvis[w] = vis;
    __syncthreads();
    if (tid == 0) {
        unsigned bv = 0;
        for (int i = 0; i < 8; ++i) bv |= wvis[i];
        int n = 0;
        for (int nb = 0; nb < own; ++nb) if ((bv >> nb) & 1u) for (int k = 0; k < 8; ++k) seq[n++] = (unsigned short)(nb * 8 + k);
        for (int k = 0; k < 8; ++k) seq[n++] = (unsigned short)(own * 8 + k);
        seq[255] = (unsigned short)n;
    }
    __syncthreads();
    const int ntl = seq[255];
    const bf16_t* gsrc = (tid < 256 ? K : Vt) + (size_t)(tid & 255) * 8;
    char* lds_dst = shm + tid * 16;
    u32x4 R = *(const u32x4*)(gsrc + (size_t)seq[0] * 2048);
    *(u32x4*)lds_dst = R;
    if (ntl > 1) R = *(const u32x4*)(gsrc + (size_t)seq[1] * 2048);
    AttnAcc a; attn_init(a, attn_bound(qf, p.qk_g + ((size_t)(layer * 3 + 1 + typ) * 2 + 1) * 64));
    unsigned mw = typ == 0 ? mrow[seq[0]] : 0u;
    __syncthreads();
    for (int t = 0; t < ntl; ++t) {
        const int ct = seq[t], cb = ct >> 3;
        unsigned mwn = 0;
        if (typ == 0 && t + 1 < ntl) mwn = mrow[seq[t + 1]];
        const bool need = cb < own ? ((vis >> cb) & 1u) != 0u : ct <= ndiag;
        if (need) {
            const char* buf = shm + (t & 1) * 8192;
            KVFrag f;
#pragma unroll
            for (int kk = 0; kk < 4; ++kk) f.k[kk] = *(const bf16x8*)(buf + (kk * 64 + lane) * 16);
#pragma unroll
            for (int db = 0; db < 2; ++db)
#pragma unroll
                for (int u = 0; u < 2; ++u) f.v[db][u] = *(const bf16x8*)(buf + 4096 + ((db * 2 + u) * 64 + lane) * 16);
            unsigned vm;
            if (typ == 0) {
                const unsigned ws4 = mw >> (4 * h);
                vm = (ws4 & 0xfu) | ((ws4 >> 4) & 0xf0u) | ((ws4 >> 8) & 0xf00u) | ((ws4 >> 12) & 0xf000u);
            } else if (cb < own) vm = ((sel >> cb) & 1u) ? 0xffffu : 0u;
            else if (ct == ndiag) {
                vm = 0;
#pragma unroll
                for (int i = 0; i < 16; ++i) if (koff(i, h) <= r) vm |= 1u << i;
            } else vm = 0xffffu;
            attn_step(a, f, qf, vm);
        }
        if (t + 1 < ntl) {
            *(u32x4*)(lds_dst + ((t + 1) & 1) * 8192) = R;
            if (t + 2 < ntl) R = *(const u32x4*)(gsrc + (size_t)seq[t + 2] * 2048);
        }
        mw = mwn;
        __syncthreads();
    }
    attn_store_gated(p, a, (size_t)bl * S + q0 + r, (typ ? 1024 : 512) + hd * 64, h, st);
}

DI void merge_a_item(const Params& p, int item, bool st) {
    char* ws = p.ws;
    const int tid = ltid();
    const bf16_t* oa = (const bf16_t*)(ws + OFF_OA);
    const float* lse = (const float*)(ws + OFF_LSE);
    bf16_t* sz = (bf16_t*)(ws + OFF_SZ);
    for (int it = 0; it < 8; ++it) {
        const size_t tl = (size_t)item * 64 + it * 8 + (tid >> 6);
        const int c8 = (tid & 63) * 8, hd = c8 >> 6;
        const float l0 = lse[(0 * (size_t)TG + tl) * 8 + hd], l1 = lse[(1 * (size_t)TG + tl) * 8 + hd], l2 = lse[(2 * (size_t)TG + tl) * 8 + hd];
        const float mx = fmaxf(l0, fmaxf(l1, l2));
        float w0 = __expf(l0 - mx), w1 = __expf(l1 - mx), w2 = __expf(l2 - mx);
        const float inv = 1.0f / (w0 + w1 + w2); w0 *= inv; w1 *= inv; w2 *= inv;
        const u32x4 a0 = *(const u32x4*)(oa + (0 * (size_t)TG + tl) * 512 + c8), a1 = *(const u32x4*)(oa + (1 * (size_t)TG + tl) * 512 + c8), a2 = *(const u32x4*)(oa + (2 * (size_t)TG + tl) * 512 + c8);
        const u32x4 zz = *(const u32x4*)(sz + tl * 1536 + c8);
        u32x4 res;
#pragma unroll
        for (int k = 0; k < 4; ++k) {
            const float lo = (w0 * __uint_as_float(a0[k] << 16) + w1 * __uint_as_float(a1[k] << 16) + w2 * __uint_as_float(a2[k] << 16)) * __uint_as_float(zz[k] << 16);
            const float hi = (w0 * __uint_as_float(a0[k] & 0xffff0000u) + w1 * __uint_as_float(a1[k] & 0xffff0000u) + w2 * __uint_as_float(a2[k] & 0xffff0000u)) * __uint_as_float(zz[k] & 0xffff0000u);
            res[k] = cvt_pk_bf16(lo, hi);
        }
        if (st) *(u32x4*)(sz + tl * 1536 + c8) = res;
    }
}

DI int snake_item(int round, int G, int bid) { return (round & 1) ? round * G + (G - 1 - bid) : round * G + bid; }

__global__ void __launch_bounds__(NTHREADS) fwd_megakernel(Params p) {
    __shared__ __attribute__((aligned(16))) char shm_raw[SHM_BYTES];
    cg::grid_group grid = cg::this_grid();
    char* ws = p.ws;
    const int G = gridDim.x, bid = blockIdx.x;
    __attribute__((address_space(3))) bf16_t* shm_g = (__attribute__((address_space(3))) bf16_t*)shm_raw;

    unsigned* barcnt = (unsigned*)(ws + OFF_BAR);
    unsigned bartarget = 0;
    if (bid == 0 && threadIdx.x == 0) __hip_atomic_store(barcnt, 0u, __ATOMIC_RELAXED, __HIP_MEMORY_SCOPE_AGENT);
    phase_prep(p, shm_raw);
    if (p.dupmask & 64) { __syncthreads(); phase_prep(p, shm_raw); }
    grid.sync();

#define LAUNDER() do { } while (0)
    for (int layer = 0; layer < DEPTH; ++layer) {
        for (int grp = 0; grp < NGRP; ++grp) {
            const int gtok0 = grp * TG;
            LAUNDER();
            for (int rep = 0; rep <= (p.dupmask & 1); ++rep) {
                EpiIn epi{&p, layer, gtok0};
                gemm_phase<true>((const bf16_t*)(ws + OFF_WTIN), DM, 0, NPAD, (const bf16_t*)(ws + OFF_XB), DM, 0, TG, DM, 1, epi, shm_g);
            }
            grid_barrier(barcnt, bartarget, (unsigned)G);
            if (p.dupmask & 32) grid_barrier(barcnt, bartarget, (unsigned)G);
            LAUNDER();
            for (int rep = 0; rep <= ((p.dupmask >> 1) & 1); ++rep) {
                const int nsel = BG * 256;
                for (int rnd = 0;; ++rnd) {
                    const int it = snake_item(rnd, G, bid);
                    if (rnd * G >= nsel) break;
                    if (it < nsel) select_chunk(p, it % BG, 255 - it / BG, shm_raw);
                }
                for (int it = bid; it < BG * 24 * 16; it += G) attn_a_item(p, layer, it / (24 * 16), (it / 16) % 24, it % 16);
                for (int it = bid; it < BG * 8 * 16; it += G) kmean_item(p, it / 128, (it / 16) & 7, it & 15, shm_raw);
            }
            grid_barrier(barcnt, bartarget, (unsigned)G);
            if (p.dupmask & 32) grid_barrier(barcnt, bartarget, (unsigned)G);
            LAUNDER();
            for (int rep = ((p.dupmask >> 2) & 1); rep >= 0; --rep) {
                const bool st = rep == 0;
                const int nbc = 2 * BG * 8 * 16;
                for (int rnd = 0;; ++rnd) {
                    const int it = snake_item(rnd, G, bid);
                    if (rnd * G >= nbc) break;
                    if (it < nbc) {
                        const int qb = 15 - it / (2 * BG * 8), sub = it % (2 * BG * 8), typ = sub / (BG * 8), bl = (sub / 8) % BG, hd = sub & 7;
                        {
#if ATTN_LDS
                            attn_bc_item(p, layer, typ, bl, hd, qb, st, shm_raw);
#else
                            if (typ == 0) attn_b_item(p, layer, bl, hd, qb, st); else attn_c_item(p, layer, bl, hd, qb, st);
#endif
                        }
                    }
                }
                for (int it = bid; it < TG / 64; it += G) merge_a_item(p, it, st);
            }
            grid_barrier(barcnt, bartarget, (unsigned)G);
            if (p.dupmask & 32) grid_barrier(barcnt, bartarget, (unsigned)G);
            LAUNDER();
            for (int rep = 0; rep <= ((p.dupmask >> 3) & 1); ++rep) {
                EpiBr epi{&p};
                gemm_phase<false>((const bf16_t*)(ws + OFF_WTBR) + (size_t)layer * 3 * DM * 512, 512, (size_t)DM * 512, DM, (const bf16_t*)(ws + OFF_SZ), 1536, 512, TG, 512, 3, epi, shm_g);
            }
            grid_barrier(barcnt, bartarget, (unsigned)G);
            if (p.dupmask & 32) grid_barrier(barcnt, bartarget, (unsigned)G);
            LAUNDER();
            for (int rep = ((p.dupmask >> 4) & 1); rep >= 0; --rep) {
                EpiOut epi{&p, layer, gtok0, rep == 0};
                gemm_phase<false>((const bf16_t*)(ws + OFF_WTOUT) + (size_t)layer * DM * DM, DM, 0, DM, (const bf16_t*)(ws + OFF_MB), DM, 0, TG, DM, 1, epi, shm_g);
                if (rep == 0) {
                    const int nl = grp + 1 < NGRP ? layer : layer + 1, ng = grp + 1 < NGRP ? grp + 1 : 0;
                    if (nl < DEPTH) {
                        __syncthreads();
                        const float* xsrc = (nl == 0 ? p.x : (const float*)p.out) + (size_t)ng * TG * DM;
                        int per = (TG + G - 1) / G; int tb = bid * per, te = tb + per < TG ? tb + per : TG;
                        xprep_tokens(xsrc, (bf16_t*)(ws + OFF_XB), (float*)(ws + OFF_SS), tb, te);
                        if (nl != layer) for (int it = bid; it < 16 * 204; it += G) convert_win_tile(p, nl, it, (float*)shm_raw);
                    }
                }
            }
            grid_barrier(barcnt, bartarget, (unsigned)G);
            if (p.dupmask & 32) grid_barrier(barcnt, bartarget, (unsigned)G);
        }
    }
}

extern "C" void kernel_launch(void* const* d_in, const int* in_sizes, int n_in, void* d_out, int out_size, void* d_ws, size_t ws_size, hipStream_t stream) {
    static int grid_blocks = 0;
    if (!grid_blocks) {
        int dev = 0, cus = 0, per_cu = 0;
        hipGetDevice(&dev);
        hipDeviceGetAttribute(&cus, hipDeviceAttributeMultiprocessorCount, dev);
        hipOccupancyMaxActiveBlocksPerMultiprocessor(&per_cu, fwd_megakernel, NTHREADS, 0);
        if (per_cu > 1) per_cu = 1;
        grid_blocks = cus * per_cu;
    }
    if (ws_size < WS_NEED) { fprintf(stderr, "workspace too small: %zu < %zu\n", ws_size, (size_t)WS_NEED); return; }
#ifndef DUPMASK
#define DUPMASK 0
#endif
    Params p{};
    p.dupmask = DUPMASK; p.pad_ = 0;
    p.x = (const float*)d_in[0]; p.pos = (const int*)d_in[1]; p.norm_g = (const float*)d_in[2]; p.w_in = (const float*)d_in[3];
    p.qk_g = (const float*)d_in[4]; p.w_br = (const float*)d_in[5]; p.w_out = (const float*)d_in[6];
    p.out = (float*)d_out; p.ws = (char*)d_ws;
    void* args[] = {&p};
    hipError_t e = hipLaunchCooperativeKernel((void*)fwd_megakernel, dim3(grid_blocks), dim3(NTHREADS), args, 0, stream);
    if (e != hipSuccess) fprintf(stderr, "cooperative launch failed: %s (grid %d)\n", hipGetErrorString(e), grid_blocks);
}
```

```cpp
#include <hip/hip_runtime.h>
#include <hip/hip_cooperative_groups.h>
#include <cstdio>
#include <cstdint>
namespace cg = cooperative_groups;
#define ATTN_LDS 0
#define ATTN64 1
#define DUPMASK 0

typedef unsigned short bf16_t;
typedef short bf16x8 __attribute__((ext_vector_type(8)));
typedef short s16x4 __attribute__((ext_vector_type(4)));
typedef float f32x4 __attribute__((ext_vector_type(4)));
typedef float f32x16 __attribute__((ext_vector_type(16)));
typedef unsigned u32x4 __attribute__((ext_vector_type(4)));
typedef unsigned u32x2 __attribute__((ext_vector_type(2)));
#define DI __device__ __forceinline__

constexpr int S = 4096, DM = 1024, NB = 8, DEPTH = 2;
constexpr int NIN = 12872, NPAD = 13056;
constexpr int BG = 4, TG = BG * S, NGRP = NB / BG;
constexpr int NTHREADS = 512;
constexpr int SHM_BYTES = 131072;
constexpr float QSCALE = 0.125f * 1.4426950408889634f;
constexpr float LN2F = 0.6931471805599453f;
constexpr int SEL_CAP = 768;

constexpr size_t al256(size_t x) { return (x + 255) & ~(size_t)255; }
constexpr size_t OFF_WTIN = 0;
constexpr size_t OFF_WTBR = OFF_WTIN + al256((size_t)NPAD * DM * 2);
constexpr size_t OFF_WTOUT = OFF_WTBR + al256((size_t)DEPTH * 3 * DM * 512 * 2);
constexpr size_t OFF_CS = OFF_WTOUT + al256((size_t)DEPTH * DM * DM * 2);
constexpr size_t OFF_XB = OFF_CS + al256((size_t)NB * S * 8 * 8);
constexpr size_t OFF_OA = OFF_XB;
constexpr size_t OFF_SS = OFF_XB + al256((size_t)3 * TG * 512 * 2);
constexpr size_t OFF_QA = OFF_SS + al256((size_t)TG * 8 * 4);
constexpr size_t OFF_KA = OFF_QA + al256((size_t)TG * 1536 * 2);
constexpr size_t OFF_VA = OFF_KA + al256((size_t)TG * 1536 * 2);
constexpr size_t OFF_MF = OFF_QA;
constexpr size_t OFF_MB = OFF_VA;
constexpr size_t OFF_QB = OFF_VA + al256((size_t)TG * 1536 * 2);
constexpr size_t OFF_KB = OFF_QB + al256((size_t)TG * 512 * 2);
constexpr size_t OFF_VB = OFF_KB + al256((size_t)TG * 512 * 2);
constexpr size_t OFF_QC = OFF_VB + al256((size_t)TG * 512 * 2);
constexpr size_t OFF_KC = OFF_QC + al256((size_t)TG * 512 * 2);
constexpr size_t OFF_VC = OFF_KC + al256((size_t)TG * 512 * 2);
constexpr size_t OFF_IQ = OFF_VC + al256((size_t)TG * 512 * 2);
constexpr size_t OFF_IK = OFF_IQ + al256((size_t)TG * 512 * 2);
constexpr size_t OFF_IW = OFF_IK + al256((size_t)TG * 64 * 2);
constexpr size_t OFF_SZ = OFF_IW + al256((size_t)TG * 8 * 4);
constexpr size_t OFF_SG = OFF_SZ + al256((size_t)TG * 1536 * 2);
constexpr size_t OFF_LSE = OFF_SG + al256((size_t)TG * 3072 * 2);
constexpr size_t OFF_MASK = OFF_LSE + al256((size_t)3 * TG * 8 * 4);
constexpr size_t OFF_KM = OFF_MASK + al256((size_t)BG * S * (S / 8));
static_assert((size_t)TG * DM * 4 <= (size_t)2 * TG * 1536 * 2 && (size_t)TG * DM * 2 <= (size_t)TG * 1536 * 2, "overlay sizes");
constexpr size_t OFF_BAR = OFF_KM + al256((size_t)BG * 8 * 16 * 64 * 2 * 2);
constexpr size_t WS_NEED = OFF_BAR + 256;

struct Params {
    const float* x; const int* pos; const float* norm_g; const float* w_in; const float* qk_g; const float* w_br; const float* w_out;
    float* out; char* ws; int dupmask; int pad_;
};

DI int ltid() { int t = threadIdx.x; asm volatile("" : "+v"(t)); return t; }
DI unsigned cvt_pk_bf16(float lo, float hi) { unsigned r; asm volatile("v_cvt_pk_bf16_f32 %0, %1, %2" : "=v"(r) : "v"(lo), "v"(hi)); return r; }
DI bf16_t f2bf(float x) { return (bf16_t)(cvt_pk_bf16(x, 0.f) & 0xffffu); }
DI float bf2f(bf16_t v) { return __uint_as_float(((unsigned)v) << 16); }
DI float fexp2(float x) { return __builtin_amdgcn_exp2f(x); }
DI float shx(float v, int mask) { const int l = ltid() & 63; return __int_as_float(__builtin_amdgcn_ds_bpermute((l ^ mask) << 2, __float_as_int(v))); }
DI float wave_sum(float v) { for (int o = 32; o > 0; o >>= 1) v += shx(v, o); return v; }
DI int f2sort(float f) { int i = __float_as_int(f); return i ^ ((i >> 31) & 0x7fffffff); }
DI float sort2f(int i) { return __int_as_float(i ^ ((i >> 31) & 0x7fffffff)); }
#define MFMA32(a, b, c) __builtin_amdgcn_mfma_f32_32x32x16_bf16((a), (b), (c), 0, 0, 0)
#define MFMA16(a, b, c) __builtin_amdgcn_mfma_f32_16x16x32_bf16((a), (b), (c), 0, 0, 0)

DI void grid_barrier(unsigned* cnt, unsigned& target, unsigned G) {
    __syncthreads();
    target += G;
    if (threadIdx.x == 0) {
        __threadfence();
        __hip_atomic_fetch_add(cnt, 1u, __ATOMIC_RELAXED, __HIP_MEMORY_SCOPE_AGENT);
        while (__hip_atomic_load(cnt, __ATOMIC_RELAXED, __HIP_MEMORY_SCOPE_AGENT) < target) __builtin_amdgcn_s_sleep(2);
        __threadfence();
    }
    __syncthreads();
}

DI int src_col_of_group(int hg) { return hg <= 104 ? hg * 64 : (hg <= 200 ? 6728 + (hg - 105) * 64 : 6720); }

DI void convert_tile(const float* src, int ld_src, int k0, int n_src0, int n_valid, const float* kscale, bf16_t* dst, int ld_dst, int n_dst0, float* tl  ) {
    const int tid = ltid();
    __syncthreads();
#pragma unroll
    for (int i = 0; i < 8; ++i) {
        int e = tid + i * 512, kk = e >> 6, nn = e & 63;
        float v = 0.f;
        if (nn < n_valid) { v = src[(size_t)(k0 + kk) * ld_src + n_src0 + nn]; if (kscale) v *= kscale[k0 + kk]; }
        tl[kk * 65 + nn] = v;
    }
    __syncthreads();
#pragma unroll
    for (int i = 0; i < 4; ++i) {
        int e = tid + i * 512, nn = e >> 5, kp = (e & 31) * 2;
        unsigned w = cvt_pk_bf16(tl[kp * 65 + nn], tl[(kp + 1) * 65 + nn]);
        *(unsigned*)(dst + (size_t)(n_dst0 + nn) * ld_dst + k0 + kp) = w;
    }
}

DI void xprep_tokens(const float* xsrc  , bf16_t* xb, float* ss, int tok_begin, int tok_end) {
    const int lane = ltid() & 63, wid = ltid() >> 6;
    for (int t = tok_begin + wid; t < tok_end; t += 8) {
        const float* xr = xsrc + (size_t)t * DM;
        float sum = 0.f;
#pragma unroll
        for (int i = 0; i < 4; ++i) {
            f32x4 v = *(const f32x4*)(xr + i * 256 + lane * 4);
            sum += v[0] * v[0] + v[1] * v[1] + v[2] * v[2] + v[3] * v[3];
            u32x2 w; w[0] = cvt_pk_bf16(v[0], v[1]); w[1] = cvt_pk_bf16(v[2], v[3]);
            *(u32x2*)(xb + (size_t)t * DM + i * 256 + lane * 4) = w;
        }
        sum = wave_sum(sum);
        if (lane < 8) ss[(size_t)t * 8 + lane] = lane == 0 ? sum : 0.f;
    }
}

DI void convert_win_tile(const Params& p, int l, int it, float* tl) {
    const int hg = it / 16, kt = it % 16;
    const int nvalid = hg <= 200 ? 64 : (hg == 201 ? 8 : 0);
    convert_tile(p.w_in + (size_t)l * DM * NIN, NIN, kt * 64, src_col_of_group(hg), nvalid, p.norm_g + l * DM, (bf16_t*)(p.ws + OFF_WTIN), DM, hg * 64, tl);
}
DI void phase_prep(const Params& p, char* shm) {
    char* ws = p.ws;
    const int G = gridDim.x, bid = blockIdx.x, tid = ltid();
    float2* cs = (float2*)(ws + OFF_CS);
    for (int e = bid * NTHREADS + tid; e < NB * S * 8; e += G * NTHREADS) {
        int i = e & 7, t = e >> 3;
        float inv = powf(500000.0f, -(float)(2 * i) / 16.0f);
        float ang = (float)p.pos[t] * inv;
        double rev = (double)ang * 0.15915494309189535;
        rev -= floor(rev);
        float rf = (float)rev;
        cs[e] = make_float2(__builtin_amdgcn_cosf(rf), __builtin_amdgcn_sinf(rf));
    }
    float* tl = (float*)shm;
    const int n_in_tiles = 16 * 204, n_br_tiles = DEPTH * 3 * 8 * 16, n_out_tiles = DEPTH * 16 * 16;
    for (int it = bid; it < n_in_tiles + n_br_tiles + n_out_tiles; it += G) {
        if (it < n_in_tiles) {
            convert_win_tile(p, 0, it, tl);
        } else if (it < n_in_tiles + n_br_tiles) {
            int r = it - n_in_tiles; int ln = r / 128, q = r % 128, kt = q / 16, nt = q % 16;
            convert_tile(p.w_br + (size_t)ln * 512 * DM, DM, kt * 64, nt * 64, 64, nullptr, (bf16_t*)(ws + OFF_WTBR) + (size_t)ln * DM * 512, 512, nt * 64, tl);
        } else {
            int r = it - n_in_tiles - n_br_tiles; int l = r / 256, q = r % 256, kt = q / 16, nt = q % 16;
            convert_tile(p.w_out + (size_t)l * DM * DM, DM, kt * 64, nt * 64, 64, nullptr, (bf16_t*)(ws + OFF_WTOUT) + (size_t)l * DM * DM, DM, nt * 64, tl);
        }
    }
    int per = (TG + G - 1) / G;
    int tb = bid * per, te = tb + per < TG ? tb + per : TG;
    xprep_tokens(p.x, (bf16_t*)(ws + OFF_XB), (float*)(ws + OFF_SS), tb, te);
}

constexpr int BM = 256, BK = 64, HALF = 128, NXCD = 8, WGM = 8, HT = HALF * BK;
DI int lds_byte(int r, int c) { int st = (r >> 4) * 2 + (c >> 5), rr = r & 15, cc = c & 31, ob = rr * 64 + cc * 2; return st * 1024 + (ob ^ (((ob >> 9) & 1) << 5)); }
DI void stage_rc(int b, int& R, int& C) { int st = b / 1024, sb = b % 1024, swz = sb ^ (((sb >> 9) & 1) << 5); R = (st >> 1) * 16 + swz / 64; C = (st & 1) * 32 + (swz % 64) / 2; }

#define SA(b, h) (shm + ((b) * 2 + (h)) * HT)
#define SB(b, h) (shm + (4 + (b) * 2 + (h)) * HT)
DI void glds16(const void* sbase, unsigned voff, unsigned lds_dst) {
    unsigned keep;
    asm volatile("s_mov_b32 %0, m0\n\ts_mov_b32 m0, %3\n\ts_nop 0\n\tglobal_load_lds_dwordx4 %1, %2\n\ts_mov_b32 m0, %0"
                 : "=&s"(keep) : "v"(voff), "s"(sbase), "s"(lds_dst) : "memory");
}
#define STAGE(P, BASE, LD, br, kt, VOFF) do { const bf16_t* _gp = (BASE) + (size_t)(br) * (LD) + (size_t)(kt) * BK; \
    const unsigned _l0 = (unsigned)(size_t)(P) + wbase16; \
    glds16(_gp, VOFF[0], _l0); glds16(_gp, VOFF[1], _l0 + 8192u); } while (0)
#define LDA(dst, b, h) _Pragma("unroll") for (int m = 0; m < 4; ++m) _Pragma("unroll") for (int k = 0; k < 2; ++k) \
    dst[m][k] = *reinterpret_cast<const bf16x8*>((char*)SA(b, h) + lds_byte(wr * 64 + m * 16 + fr, k * 32 + fq * 8))
#define LDB(dst, b, h) _Pragma("unroll") for (int n = 0; n < 2; ++n) _Pragma("unroll") for (int k = 0; k < 2; ++k) \
    dst[n][k] = *reinterpret_cast<const bf16x8*>((char*)SB(b, h) + lds_byte(wc * 32 + n * 16 + fr, k * 32 + fq * 8))
#define MMA(ai, bj, At, Bt_) do { __builtin_amdgcn_s_setprio(1); \
    _Pragma("unroll") for (int m = 0; m < 4; ++m) _Pragma("unroll") for (int n = 0; n < 2; ++n) _Pragma("unroll") for (int k = 0; k < 2; ++k) \
      acc[ai][bj][m][n] = MFMA16(At[m][k], Bt_[n][k], acc[ai][bj][m][n]); \
    __builtin_amdgcn_s_setprio(0); } while (0)
#define WAIT_V(n) asm volatile("s_waitcnt vmcnt(" #n ")" ::: "memory")
#define WAIT_L(n) asm volatile("s_waitcnt lgkmcnt(" #n ")" ::: "memory")
#define BAR __builtin_amdgcn_s_barrier()
#define SCHED __builtin_amdgcn_sched_barrier(0)

DI int fold_tok(int rho, int sh) { const int b = rho >> 12, rb = rho & (S - 1); return (b << 12) + (((rb & ((S >> sh) - 1)) << sh) + (rb >> (12 - sh))); }
template <bool FOLD, class Epi>
DI void gemm_phase(const bf16_t* __restrict__ Abase, int lda, size_t a_sub, int M, const bf16_t* __restrict__ Bbase, int ldb, size_t b_sub, int N, int K, int nsub,
                   Epi& epi, __attribute__((address_space(3))) bf16_t* shm) {
    const int nM = M / BM, nN = N / BM, nwg = nM * nN;
    const int wid = ltid() >> 6, lane = ltid() & 63, wr = wid >> 2, wc = wid & 3, fr = lane & 15, fq = lane >> 4;
    const int nt = K / BK;
    unsigned voffA[2], voffB0[2], voffB1[2];
    const unsigned wbase16 = __builtin_amdgcn_readfirstlane((ltid() & ~63u) * 16u);
#pragma unroll
    for (int i = 0; i < 2; ++i) {
        int r_, c_; stage_rc(ltid() * 16 + i * 8192, r_, c_);
        const int x_ = r_ & 63, pr_ = (r_ & 64) + ((x_ & 15) >> 2) * 16 + (x_ >> 4) * 4 + (x_ & 3);
        voffA[i] = (unsigned)(pr_ * lda + c_) * 2u;
    }
    int L = blockIdx.x, sub = 0, brow = 0, bcol = 0;
    bool have = L < nwg, prefetched = false;
    const bf16_t* A = Abase; const bf16_t* Bt = Bbase;
    auto setup = [&](int L_, int sub_) {
        int wgid = L_;
        { int q = nwg / NXCD, r = nwg % NXCD, xcd = wgid % NXCD, off = wgid / NXCD; wgid = (xcd < r ? xcd * (q + 1) : r * (q + 1) + (xcd - r) * q) + off; }
        const int nig = WGM * nN, gid = wgid / nig, fm = gid * WGM, gsz = min(nM - fm, WGM);
        const int pm = fm + ((wgid % nig) % gsz), pn = (wgid % nig) / gsz;
        brow = pm * BM; bcol = pn * BM;
        const int sh = (FOLD && pm < 18) ? 2 * ((pm % 6) >> 1) : 0;
        const int t_ = ltid();
#pragma unroll
        for (int i = 0; i < 2; ++i) {
            int r_, c_; stage_rc(t_ * 16 + i * 8192, r_, c_);
            voffB0[i] = (unsigned)(fold_tok(bcol + r_, sh) * ldb + c_) * 2u;
            voffB1[i] = (unsigned)(fold_tok(bcol + HALF + r_, sh) * ldb + c_) * 2u;
        }
        A = Abase + (size_t)sub_ * a_sub; Bt = Bbase + (size_t)sub_ * b_sub;
    };
    while (have) {
        {
            setup(L, sub);
            f32x4 acc[2][2][4][2] = {};
            bf16x8 At[4][2], B0[2][2], B1[2][2];
            if (!prefetched) {
                STAGE(SB(0, 0), Bt, ldb, 0, 0, voffB0); STAGE(SA(0, 0), A, lda, brow, 0, voffA);
                STAGE(SB(0, 1), Bt, ldb, 0, 0, voffB1); STAGE(SA(0, 1), A, lda, brow + HALF, 0, voffA);
            }
            if (wr == 1) BAR;
            if (prefetched) WAIT_V(0); else WAIT_V(4);
            BAR;
            STAGE(SB(1, 0), Bt, ldb, 0, 1, voffB0); STAGE(SA(1, 0), A, lda, brow, 1, voffA); STAGE(SB(1, 1), Bt, ldb, 0, 1, voffB1);
            WAIT_V(6); BAR;
            for (int t = 0; t < nt - 2; t += 2) {
                LDB(B0, 0, 0); SCHED; LDA(At, 0, 0); STAGE(SA(1, 1), A, lda, brow + HALF, t + 1, voffA);
                WAIT_L(8); BAR; WAIT_L(0); MMA(0, 0, At, B0); BAR; SCHED;
                LDB(B1, 0, 1); STAGE(SB(0, 0), Bt, ldb, 0, t + 2, voffB0);
                BAR; WAIT_L(0); MMA(0, 1, At, B1); BAR;
                LDA(At, 0, 1); STAGE(SA(0, 0), A, lda, brow, t + 2, voffA);
                BAR; WAIT_L(0); MMA(1, 0, At, B0); BAR; SCHED;
                STAGE(SB(0, 1), Bt, ldb, 0, t + 2, voffB1);
                WAIT_V(6); BAR; MMA(1, 1, At, B1); BAR;
                LDB(B0, 1, 0); SCHED; LDA(At, 1, 0); STAGE(SA(0, 1), A, lda, brow + HALF, t + 2, voffA);
                WAIT_L(8); BAR; WAIT_L(0); MMA(0, 0, At, B0); BAR; SCHED;
                LDB(B1, 1, 1); STAGE(SB(1, 0), Bt, ldb, 0, t + 3, voffB0);
                BAR; WAIT_L(0); MMA(0, 1, At, B1); BAR;
                LDA(At, 1, 1); STAGE(SA(1, 0), A, lda, brow, t + 3, voffA);
                BAR; WAIT_L(0); MMA(1, 0, At, B0); BAR; SCHED;
                STAGE(SB(1, 1), Bt, ldb, 0, t + 3, voffB1);
                WAIT_V(6); BAR; MMA(1, 1, At, B1); BAR;
            }
            { LDB(B0, 0, 0); LDA(At, 0, 0); STAGE(SA(1, 1), A, lda, brow + HALF, nt - 1, voffA);
              BAR; WAIT_L(0); MMA(0, 0, At, B0); BAR;
              LDB(B1, 0, 1); BAR; WAIT_L(0); MMA(0, 1, At, B1); BAR;
              LDA(At, 0, 1); WAIT_V(4); BAR; WAIT_L(0); MMA(1, 0, At, B0); MMA(1, 1, At, B1); BAR; }
            { LDB(B0, 1, 0); LDA(At, 1, 0); WAIT_V(2); BAR; WAIT_L(0); MMA(0, 0, At, B0); BAR;
              LDB(B1, 1, 1); WAIT_V(0); BAR; WAIT_L(0); MMA(0, 1, At, B1); BAR;
              LDA(At, 1, 1); BAR; WAIT_L(0); MMA(1, 0, At, B0); MMA(1, 1, At, B1); BAR; }
            if (wr == 0) BAR;
            const int e_brow = brow, e_bcol = bcol, e_sub = sub;
            if (++sub == nsub) { sub = 0; L += gridDim.x; }
            have = L < nwg;
            if (have) {
                setup(L, sub);
                STAGE(SB(0, 0), Bt, ldb, 0, 0, voffB0); STAGE(SA(0, 0), A, lda, brow, 0, voffA);
                STAGE(SB(0, 1), Bt, ldb, 0, 0, voffB1); STAGE(SA(0, 1), A, lda, brow + HALF, 0, voffA);
                prefetched = true;
            }
            { int t2 = ltid();
              const int wid2 = t2 >> 6, lane2 = t2 & 63;
              epi(acc, e_brow, e_bcol, e_sub, wid2 >> 2, wid2 & 3, lane2 & 15, lane2 >> 4); }
        }
    }
}

struct EpiIn {
    const Params* p; int layer; int gtok0;
    DI void operator()(const f32x4 (&acc)[2][2][4][2], int brow, int bcol, int sub, int wr, int wc, int fr, int fq) const {
        char* ws = p->ws;
        const float* ss = (const float*)(ws + OFF_SS);
        const float2* cs = (const float2*)(ws + OFF_CS);
        const int lane = ltid() & 63;
#pragma unroll
        for (int bj = 0; bj < 2; ++bj)
#pragma unroll
            for (int n = 0; n < 2; ++n) {
                const int rho = bcol + bj * 128 + wc * 32 + n * 16 + fr;
                const int pm_ = brow >> 8;
                const int shf = pm_ < 18 ? 2 * ((pm_ % 6) >> 1) : 0;
                const int tl = fold_tok(rho, shf);
                const f32x4 s0 = *(const f32x4*)(ss + (size_t)tl * 8), s1 = *(const f32x4*)(ss + (size_t)tl * 8 + 4);
                const float rstd = rsqrtf((s0[0] + s0[1] + s0[2] + s0[3] + s1[0] + s1[1] + s1[2] + s1[3]) * (1.0f / DM) + 1e-6f);
                const int bl = tl >> 12, s = tl & (S - 1), rb = rho & (S - 1);
                const int tg = gtok0 + tl;
#pragma unroll
                for (int ai = 0; ai < 2; ++ai) {
                    const int hg = (brow + ai * 128 + wr * 64) >> 6;
                    float v[16];
#pragma unroll
                    for (int m = 0; m < 4; ++m)
#pragma unroll
                        for (int j = 0; j < 4; ++j) v[m * 4 + j] = acc[ai][bj][m][n][j] * rstd;
                    int kind;
                    int mixer = 0, isk = 0, hh = 0, H = 8; size_t qoff = 0, koff = 0, voff = 0;
                    if (hg < 72) { mixer = 0; H = 24; qoff = OFF_QA; koff = OFF_KA; voff = OFF_VA; kind = hg < 48 ? 0 : 1; isk = hg >= 24; hh = hg % 24; }
                    else if (hg < 96) { mixer = 1; qoff = OFF_QB; koff = OFF_KB; voff = OFF_VB; kind = hg < 88 ? 0 : 1; isk = hg >= 80; hh = (hg - 72) & 7; }
                    else if (hg < 105) { kind = 2; isk = hg == 104; hh = hg - 96; }
                    else if (hg < 129) { mixer = 2; qoff = OFF_QC; koff = OFF_KC; voff = OFF_VC; kind = hg < 121 ? 0 : 1; isk = hg >= 113; hh = (hg - 105) & 7; }
                    else if (hg < 153) kind = 3;
                    else if (hg < 201) kind = 4;
                    else kind = hg == 201 ? 5 : 6;

                    if (kind == 0 || kind == 2) {
                        if (kind == 0) {
                            float sq = 0.f;
#pragma unroll
                            for (int i = 0; i < 16; ++i) sq += v[i] * v[i];
                            sq += shx(sq, 16); sq += shx(sq, 32);
                            const float rn = rsqrtf(sq * (1.0f / 64) + 1e-6f) * (isk ? 1.0f : QSCALE);
                            const float* gq = p->qk_g + ((size_t)(layer * 3 + mixer) * 2 + isk) * 64 + fq * 16;
#pragma unroll
                            for (int m = 0; m < 4; ++m) {
                                const f32x4 g4 = *(const f32x4*)(gq + m * 4);
#pragma unroll
                                for (int j = 0; j < 4; ++j) v[m * 4 + j] *= rn * g4[j];
                            }
                        }
                        if (fq == 0) {
                            const f32x4* cp = (const f32x4*)(cs + (size_t)tg * 8);
#pragma unroll
                            for (int i2 = 0; i2 < 4; ++i2) {
                                const f32x4 c2 = cp[i2];
                                const float x1a = v[2 * i2], x2a = v[8 + 2 * i2], x1b = v[2 * i2 + 1], x2b = v[8 + 2 * i2 + 1];
                                v[2 * i2] = x1a * c2[0] - x2a * c2[1]; v[8 + 2 * i2] = x2a * c2[0] + x1a * c2[1];
                                v[2 * i2 + 1] = x1b * c2[2] - x2b * c2[3]; v[8 + 2 * i2 + 1] = x2b * c2[2] + x1b * c2[3];
                            }
                        }
                        u32x4 w0, w1;
#pragma unroll
                        for (int i = 0; i < 4; ++i) { w0[i] = cvt_pk_bf16(v[2 * i], v[2 * i + 1]); w1[i] = cvt_pk_bf16(v[8 + 2 * i], v[8 + 2 * i + 1]); }
                        if (kind == 0 && isk) {
                            bf16_t* dst = (bf16_t*)(ws + koff) + ((size_t)(bl * H + hh) * 128 + (rb >> 5)) * 2048 + (size_t)(fq * 64 + (rb & 31)) * 8;
                            *(u32x4*)dst = w0; *(u32x4*)(dst + 32 * 8) = w1;
                        } else {
                            bf16_t* dst;
                            if (kind == 0) dst = (bf16_t*)(ws + qoff) + ((size_t)(bl * H + hh) * S + rb) * 64;
                            else dst = isk ? (bf16_t*)(ws + OFF_IK) + (size_t)tl * 64 : (bf16_t*)(ws + OFF_IQ) + ((size_t)(bl * 8 + hh) * S + s) * 64;
                            *(u32x4*)(dst + fq * 16) = w0; *(u32x4*)(dst + fq * 16 + 8) = w1;
                        }
                    } else if (kind == 1) {
                        const int k5 = rb & 31;
                        bf16_t* dst = (bf16_t*)(ws + voff) + ((size_t)(bl * H + hh) * 128 + (rb >> 5)) * 2048 + ((k5 >> 4) * 64 + ((k5 >> 2) & 1) * 32) * 8 + ((k5 >> 3) & 1) * 4 + (k5 & 3)
                                      + ((fq >> 1) * 128 + (fq & 1) * 16) * 8;
#pragma unroll
                        for (int i = 0; i < 16; ++i) dst[i * 8] = f2bf(v[i]);
                    } else if (kind == 3 || kind == 4) {
                        bf16_t* dst = (kind == 3 ? (bf16_t*)(ws + OFF_SZ) + (size_t)tl * 1536 + (hg - 129) * 64 : (bf16_t*)(ws + OFF_SG) + (size_t)tl * 3072 + (hg - 153) * 64) + fq * 16;
#pragma unroll
                        for (int i = 0; i < 16; ++i) { const float sg = __builtin_amdgcn_rcpf(1.0f + __expf(-v[i])); v[i] = kind == 3 ? v[i] * sg : sg; }
                        u32x4 w0, w1;
#pragma unroll
                        for (int i = 0; i < 4; ++i) { w0[i] = cvt_pk_bf16(v[2 * i], v[2 * i + 1]); w1[i] = cvt_pk_bf16(v[8 + 2 * i], v[8 + 2 * i + 1]); }
                        *(u32x4*)dst = w0; *(u32x4*)(dst + 8) = w1;
                    } else if (kind == 5) {
                        if (fq == 0) { f32x4 o0 = {v[0], v[1], v[2], v[3]}, o1 = {v[4], v[5], v[6], v[7]}; float* d = (float*)(ws + OFF_IW) + (size_t)tl * 8; *(f32x4*)d = o0; *(f32x4*)(d + 4) = o1; }
                    }
                }
            }
        (void)lane; (void)sub;
    }
};

struct EpiBr {
    const Params* p;
    DI void operator()(const f32x4 (&acc)[2][2][4][2], int brow, int bcol, int sub, int wr, int wc, int fr, int fq) const {
        char* ws = p->ws;
        const bf16_t* sg = (const bf16_t*)(ws + OFF_SG);
        float* mf = (float*)(ws + OFF_MF);
        bf16_t* mb = (bf16_t*)(ws + OFF_MB);
#pragma unroll
        for (int bj = 0; bj < 2; ++bj)
#pragma unroll
            for (int n = 0; n < 2; ++n) {
                const int tl = bcol + bj * 128 + wc * 32 + n * 16 + fr;
#pragma unroll
                for (int ai = 0; ai < 2; ++ai)
#pragma unroll
                    for (int m = 0; m < 4; ++m) {
                        const int e = brow + ai * 128 + wr * 64 + fq * 16 + m * 4;
                        const u32x2 gw = *(const u32x2*)(sg + (size_t)tl * 3072 + sub * 1024 + e);
                        f32x4 g4 = {__uint_as_float(gw[0] << 16), __uint_as_float(gw[0] & 0xffff0000u), __uint_as_float(gw[1] << 16), __uint_as_float(gw[1] & 0xffff0000u)};
                        f32x4 r = acc[ai][bj][m][n] * g4;
                        float* mp = mf + (size_t)tl * DM + e;
                        if (sub > 0) r += *(const f32x4*)mp;
                        if (sub < 2) *(f32x4*)mp = r;
                        else { u32x2 w; w[0] = cvt_pk_bf16(r[0], r[1]); w[1] = cvt_pk_bf16(r[2], r[3]); *(u32x2*)(mb + (size_t)tl * DM + e) = w; }
                    }
                asm volatile("" ::: "memory");
            }
    }
};

struct EpiOut {
    const Params* p; int layer; int gtok0; bool st;
    DI void operator()(const f32x4 (&acc)[2][2][4][2], int brow, int bcol, int sub, int wr, int wc, int fr, int fq) const {
        char* ws = p->ws;
        const float* xin = layer == 0 ? p->x : p->out;
        bf16_t* xb = (bf16_t*)(ws + OFF_XB);
        float* ss = (float*)(ws + OFF_SS);
#pragma unroll
        for (int bj = 0; bj < 2; ++bj)
#pragma unroll
            for (int n = 0; n < 2; ++n) {
                const int tl = bcol + bj * 128 + wc * 32 + n * 16 + fr;
                const size_t tg = (size_t)gtok0 + tl;
                float sq = 0.f;
#pragma unroll
                for (int ai = 0; ai < 2; ++ai)
#pragma unroll
                    for (int m = 0; m < 4; ++m) {
                        const int e = brow + ai * 128 + wr * 64 + fq * 16 + m * 4;
                        f32x4 r = *(const f32x4*)(xin + tg * DM + e) + acc[ai][bj][m][n];
                        if (st) *(f32x4*)(p->out + tg * DM + e) = r;
                    }
            }
        (void)sub;
    }
};

DI void select_chunk(const Params& p, int bl, int c, char* shm) {
    char* ws = p.ws;
    const bf16_t* IQ = (const bf16_t*)(ws + OFF_IQ);
    const bf16_t* IK = (const bf16_t*)(ws + OFF_IK);
    const float* IW = (const float*)(ws + OFF_IW);
    unsigned* hist = (unsigned*)shm; unsigned* bits = (unsigned*)(shm + 16384);
    int* ctl = (int*)(shm + 24576); int* cnt = ctl, *mn = ctl + 16, *mx = ctl + 32, *bsel = ctl + 48, *needp = ctl + 64;
    u32x2* list = (u32x2*)(shm + 32768);
    const int tid = ltid(), lane = tid & 63, w = tid >> 6, q = lane & 15, g = lane >> 4;
    const int t0 = c * 16, tq = t0 + q;
    __syncthreads();
    for (int i = tid; i < 16 * 256 + 16 * 128; i += NTHREADS) hist[i] = 0;
    if (tid < 16) { cnt[tid] = 0; mn[tid] = 0x7fffffff; mx[tid] = (int)0x80000000; }
    bf16x8 qf[8][2]; float wq[8];
#pragma unroll
    for (int hd = 0; hd < 8; ++hd) {
        const bf16_t* qp = IQ + ((size_t)(bl * 8 + hd) * S + tq) * 64 + g * 8;
        qf[hd][0] = *(const bf16x8*)qp; qf[hd][1] = *(const bf16x8*)(qp + 32);
        wq[hd] = IW[(size_t)(bl * S + tq) * 8 + hd];
    }
    auto loadk = [&](int kt, bf16x8& k0, bf16x8& k1) {
        const bf16_t* kp = IK + ((size_t)bl * S + kt * 16 + q) * 64 + g * 8;
        k0 = *(const bf16x8*)kp; k1 = *(const bf16x8*)(kp + 32);
    };
    auto compute = [&](const bf16x8& k0, const bf16x8& k1) -> f32x4 {
        f32x4 sc = {0.f, 0.f, 0.f, 0.f};
#pragma unroll
        for (int hd = 0; hd < 8; ++hd) {
            f32x4 a = {0.f, 0.f, 0.f, 0.f};
            a = MFMA16(k0, qf[hd][0], a); a = MFMA16(k1, qf[hd][1], a);
#pragma unroll
            for (int j = 0; j < 4; ++j) sc[j] += wq[hd] * fmaxf(a[j], 0.f);
        }
        return sc;
    };
#define SEL_PASS(BODY) do { \
        bf16x8 ka0, ka1, kb0, kb1; int kt = w; \
        if (kt <= c) loadk(kt, ka0, ka1); \
        if (kt + 8 <= c) loadk(kt + 8, kb0, kb1); \
        for (; kt <= c; kt += 16) { \
            { const f32x4 sc = compute(ka0, ka1); if (kt + 16 <= c) loadk(kt + 16, ka0, ka1); const int ktc = kt; BODY } \
            if (kt + 8 <= c) { const f32x4 sc = compute(kb0, kb1); if (kt + 24 <= c) loadk(kt + 24, kb0, kb1); const int ktc = kt + 8; BODY } \
        } } while (0)
    __syncthreads();
    {
        float lo = 3.0e38f, hi = -3.0e38f;
        SEL_PASS({
            _Pragma("unroll") for (int j = 0; j < 4; ++j) if (ktc * 16 + 4 * g + j <= tq) { lo = fminf(lo, sc[j]); hi = fmaxf(hi, sc[j]); }
        });
        lo = fminf(lo, shx(lo, 16)); lo = fminf(lo, shx(lo, 32));
        hi = fmaxf(hi, shx(hi, 16)); hi = fmaxf(hi, shx(hi, 32));
        if (g == 0) { atomicMin(&mn[q], f2sort(lo)); atomicMax(&mx[q], f2sort(hi)); }
    }
    __syncthreads();
    const float rlo = sort2f(mn[q]), rhi = sort2f(mx[q]);
    const float rscale = rhi > rlo ? 256.0f / (rhi - rlo) : 0.f;
    SEL_PASS({
        _Pragma("unroll") for (int j = 0; j < 4; ++j) if (ktc * 16 + 4 * g + j <= tq) {
            int b = (int)((sc[j] - rlo) * rscale); b = b > 255 ? 255 : (b < 0 ? 0 : b);
            atomicAdd(&hist[q * 256 + b], 1u);
        }
    });
    __syncthreads();
    {
        const int row = tid >> 5, i = tid & 31;
        unsigned c8[8]; unsigned tot = 0;
#pragma unroll
        for (int k = 0; k < 8; ++k) { c8[k] = hist[row * 256 + i * 8 + k]; tot += c8[k]; }
        unsigned above = 0;
        {
            unsigned run = tot;
#pragma unroll
            for (int o = 1; o < 32; o <<= 1) { const int l_ = tid & 63; unsigned v = (unsigned)__builtin_amdgcn_ds_bpermute(((l_ + o) & 63) << 2, (int)run); if (i + o < 32) run += v; }
            above = run - tot;
        }
        const int trow = t0 + row; const unsigned need = trow + 1 < 256 ? trow + 1 : 256;
        if (above < need && above + tot >= need) {
            unsigned a = above;
#pragma unroll
            for (int k = 7; k >= 0; --k) { if (a < need && a + c8[k] >= need) { bsel[row] = i * 8 + k; needp[row] = (int)(need - a); } a += c8[k]; }
        }
    }
    __syncthreads();
    const int bstar = bsel[q];
    SEL_PASS({
        unsigned nib = 0;
        _Pragma("unroll") for (int j = 0; j < 4; ++j) if (ktc * 16 + 4 * g + j <= tq) {
            int b = (int)((sc[j] - rlo) * rscale); b = b > 255 ? 255 : (b < 0 ? 0 : b);
            if (b > bstar) nib |= 1u << j;
            else if (b == bstar) { int pos = atomicAdd(&cnt[q], 1); if (pos < SEL_CAP) { u32x2 e; e[0] = (unsigned)f2sort(sc[j]) ^ 0x80000000u; e[1] = ktc * 16 + 4 * g + j; list[q * SEL_CAP + pos] = e; } }
        }
        if (nib) atomicOr(&bits[q * 128 + (ktc >> 1)], nib << ((ktc & 1) * 16 + 4 * g));
    });
    __syncthreads();
    {
        const int row = tid >> 5, i = tid & 31;
        int n = cnt[row]; n = n < SEL_CAP ? n : SEL_CAP;
        const int need = needp[row];
        for (int a = i; a < n; a += 32) {
            const u32x2 ea = list[row * SEL_CAP + a];
            int rank = 0;
            for (int b = 0; b < n; ++b) { const u32x2 eb = list[row * SEL_CAP + b]; rank += (eb[0] > ea[0]) || (eb[0] == ea[0] && eb[1] < ea[1]); }
            if (rank < need) atomicOr(&bits[row * 128 + (ea[1] >> 5)], 1u << (ea[1] & 31));
        }
    }
    __syncthreads();
    unsigned* mask = (unsigned*)(ws + OFF_MASK) + ((size_t)bl * S + t0) * 128;
    for (int i = tid; i < 16 * 128; i += NTHREADS) mask[i] = bits[i];
}

DI void kmean_item(const Params& p, int bl, int h, int n, char* shm) {
    char* ws = p.ws;
    const bf16_t* K = (const bf16_t*)(ws + OFF_KC) + ((size_t)(bl * 8 + h) * 128 + n * 8) * 2048;
    float* red = (float*)shm;
    const int tid = ltid(), d = tid & 63, part = tid >> 6;
    float s = 0.f;
    for (int k = 0; k < 32; ++k) s += bf2f(K[(size_t)part * 2048 + ((d >> 4) * 64 + ((d >> 3) & 1) * 32 + k) * 8 + (d & 7)]);
    __syncthreads();
    red[part * 64 + d] = s;
    __syncthreads();
    if (tid < 64) {
        float t = 0.f;
        for (int k = 0; k < 8; ++k) t += red[k * 64 + tid];
        t *= (1.0f / 256);
        bf16_t hi = f2bf(t); bf16_t lo = f2bf(t - bf2f(hi));
        bf16_t* km = (bf16_t*)(ws + OFF_KM) + (((size_t)(bl * 8 + h) * 16 + n) * 2) * 64;
        km[tid] = hi; km[64 + tid] = lo;
    }
}

struct AttnAcc { f32x16 o0, o1; float nb, l; bool shifted; };
DI void attn_init(AttnAcc& a, float nb) {
    float z = 0.f; asm volatile("" : "+v"(z));
#pragma unroll
    for (int i = 0; i < 16; ++i) { a.o0[i] = z; a.o1[i] = z; }
    a.shifted = __ballot(nb > 90.f) != 0ull;
    a.nb = a.shifted ? nb + z : z; a.l = z;
}
DI float attn_bound(const bf16x8 (&qf)[4], const float* gk) {
    float qs = 0.f;
#pragma unroll
    for (int kk = 0; kk < 4; ++kk)
#pragma unroll
        for (int e = 0; e < 8; ++e) { const float v = bf2f((bf16_t)qf[kk][e]); qs += v * v; }
    qs += shx(qs, 32);
    float gm = fabsf(gk[ltid() & 63]);
    for (int o = 32; o > 0; o >>= 1) gm = fmaxf(gm, shx(gm, o));
    return sqrtf(qs) * gm * 8.1f;
}
struct KVFrag { bf16x8 k[4]; bf16x8 v[2][2]; };
DI void kv_load(KVFrag& f, const bf16_t* Kt, const bf16_t* Vt, int lane) {
#pragma unroll
    for (int kk = 0; kk < 4; ++kk) f.k[kk] = *(const bf16x8*)(Kt + (kk * 64 + lane) * 8);
#pragma unroll
    for (int db = 0; db < 2; ++db)
#pragma unroll
        for (int u = 0; u < 2; ++u) f.v[db][u] = *(const bf16x8*)(Vt + ((db * 2 + u) * 64 + lane) * 8);
}
DI void attn_step(AttnAcc& a, const KVFrag& f, const bf16x8 (&qf)[4], unsigned vm) {
    f32x16 st;
    if (a.shifted) {
#pragma unroll
        for (int i = 0; i < 16; ++i) st[i] = -a.nb;
        st = MFMA32(f.k[0], qf[0], st);
    } else {
        st = MFMA32(f.k[0], qf[0], ((f32x16){0.f, 0.f, 0.f, 0.f, 0.f, 0.f, 0.f, 0.f, 0.f, 0.f, 0.f, 0.f, 0.f, 0.f, 0.f, 0.f}));
    }
#pragma unroll
    for (int kk = 1; kk < 4; ++kk) st = MFMA32(f.k[kk], qf[kk], st);
    float pv[16];
#pragma unroll
    for (int i = 0; i < 16; ++i) pv[i] = fexp2(st[i]);
    if (__ballot(vm != 0xffffu) != 0ull) {
#pragma unroll
        for (int i = 0; i < 16; ++i) pv[i] = __int_as_float(__float_as_int(pv[i]) & __builtin_amdgcn_sbfe((int)vm, i, 1));
    }
    a.l += ((pv[0] + pv[1]) + (pv[2] + pv[3])) + ((pv[4] + pv[5]) + (pv[6] + pv[7])) + (((pv[8] + pv[9]) + (pv[10] + pv[11])) + ((pv[12] + pv[13]) + (pv[14] + pv[15])));
    u32x4 p0, p1;
#pragma unroll
    for (int i = 0; i < 4; ++i) { p0[i] = cvt_pk_bf16(pv[2 * i], pv[2 * i + 1]); p1[i] = cvt_pk_bf16(pv[8 + 2 * i], pv[8 + 2 * i + 1]); }
    const bf16x8 pf0 = __builtin_bit_cast(bf16x8, p0), pf1 = __builtin_bit_cast(bf16x8, p1);
    a.o0 = MFMA32(f.v[0][0], pf0, a.o0); a.o0 = MFMA32(f.v[0][1], pf1, a.o0);
    a.o1 = MFMA32(f.v[1][0], pf0, a.o1); a.o1 = MFMA32(f.v[1][1], pf1, a.o1);
}
DI void load_q(bf16x8 (&qf)[4], const bf16_t* Qrow, int h) {
#pragma unroll
    for (int kk = 0; kk < 4; ++kk) qf[kk] = *(const bf16x8*)(Qrow + kk * 16 + h * 8);
}
DI int koff(int i, int h) { return 8 * (i >> 2) + 4 * h + (i & 3); }

DI void attn_a_item(const Params& p, int layer, int bl, int hh, int rb) {
    char* ws = p.ws;
    const int lane = ltid() & 63, w = ltid() >> 6, r = lane & 31, h = lane >> 5;
    const int g = hh >> 3, sh = 2 * g, n = S >> sh;
    const int row0 = rb * 256 + w * 32;
    const int rr = row0 / n, m0 = row0 % n;
    const bf16_t* Q = (const bf16_t*)(ws + OFF_QA) + (size_t)(bl * 24 + hh) * S * 64;
    const bf16_t* K = (const bf16_t*)(ws + OFF_KA) + (size_t)(bl * 24 + hh) * S * 64;
    const bf16_t* Vt = (const bf16_t*)(ws + OFF_VA) + (size_t)(bl * 24 + hh) * 64 * S;
    bf16x8 qf[4]; load_q(qf, Q + (size_t)(row0 + r) * 64, h);
    AttnAcc a; attn_init(a, attn_bound(qf, p.qk_g + ((size_t)(layer * 3 + 0) * 2 + 1) * 64));
    const int kfirst = m0 >= 128 ? 0 : (128 - m0) / 32;
    const int tile0 = (rr * n + m0 - 128) / 32 + 0;
    auto amask = [&](int k) -> unsigned {
        if (k != 0 && k != 4) return 0xffffu;
        const int mk0 = m0 - 128 + 32 * k; unsigned vm = 0;
#pragma unroll
        for (int i = 0; i < 16; ++i) { const int d = (m0 + r) - (mk0 + koff(i, h)); if (d >= 0 && d <= 128) vm |= 1u << i; }
        return vm;
    };
    KVFrag f0, f1; kv_load(f0, K + (size_t)(tile0 + kfirst) * 2048, Vt + (size_t)(tile0 + kfirst) * 2048, lane);
    for (int k = kfirst; k < 5; k += 2) {
        { const int kn = k + 1 < 5 ? k + 1 : k; kv_load(f1, K + (size_t)(tile0 + kn) * 2048, Vt + (size_t)(tile0 + kn) * 2048, lane); }
        attn_step(a, f0, qf, amask(k));
        if (k + 1 < 5) {
            { const int kn = k + 2 < 5 ? k + 2 : k + 1; kv_load(f0, K + (size_t)(tile0 + kn) * 2048, Vt + (size_t)(tile0 + kn) * 2048, lane); }
            attn_step(a, f1, qf, amask(k + 1));
        }
    }
    const float l = a.l + shx(a.l, 32);
    const float inv = 1.0f / l;
    const int s = ((m0 + r) << sh) + rr;
    const size_t tl = (size_t)bl * S + s;
    bf16_t* o = (bf16_t*)(ws + OFF_OA) + ((size_t)g * TG + tl) * 512 + (hh & 7) * 64;
#pragma unroll
    for (int q4 = 0; q4 < 4; ++q4) {
        u32x2 w0, w1;
        w0[0] = cvt_pk_bf16(a.o0[q4 * 4] * inv, a.o0[q4 * 4 + 1] * inv); w0[1] = cvt_pk_bf16(a.o0[q4 * 4 + 2] * inv, a.o0[q4 * 4 + 3] * inv);
        w1[0] = cvt_pk_bf16(a.o1[q4 * 4] * inv, a.o1[q4 * 4 + 1] * inv); w1[1] = cvt_pk_bf16(a.o1[q4 * 4 + 2] * inv, a.o1[q4 * 4 + 3] * inv);
        *(u32x2*)(o + 8 * q4 + 4 * h) = w0; *(u32x2*)(o + 32 + 8 * q4 + 4 * h) = w1;
    }
    if (h == 0) ((float*)(ws + OFF_LSE))[((size_t)g * TG + tl) * 8 + (hh & 7)] = (a.nb + __log2f(l)) * LN2F;
}

DI void attn_store_gated(const Params& p, const AttnAcc& a, size_t tl, int col0, int h, bool st) {
    const float l = a.l + shx(a.l, 32);
    const float inv = 1.0f / l;
    bf16_t* z = (bf16_t*)(p.ws + OFF_SZ) + tl * 1536 + col0;
#pragma unroll
    for (int q4 = 0; q4 < 4; ++q4) {
#pragma unroll
        for (int db = 0; db < 2; ++db) {
            bf16_t* zp = z + db * 32 + 8 * q4 + 4 * h;
            const u32x2 zw = *(const u32x2*)zp;
            const float z0 = __uint_as_float(zw[0] << 16), z1 = __uint_as_float(zw[0] & 0xffff0000u), z2 = __uint_as_float(zw[1] << 16), z3 = __uint_as_float(zw[1] & 0xffff0000u);
            const f32x16& o = db ? a.o1 : a.o0;
            u32x2 wv; wv[0] = cvt_pk_bf16(o[q4 * 4] * inv * z0, o[q4 * 4 + 1] * inv * z1); wv[1] = cvt_pk_bf16(o[q4 * 4 + 2] * inv * z2, o[q4 * 4 + 3] * inv * z3);
            if (st) *(u32x2*)zp = wv;
        }
    }
}

DI void attn_b_item(const Params& p, int layer, int bl, int hd, int qb, bool st, int var) {
    char* ws = p.ws;
    const int lane = ltid() & 63, w = ltid() >> 6, r = lane & 31, h = lane >> 5;
    const int q0 = qb * 256 + w * 32;
    const bf16_t* Q = (const bf16_t*)(ws + OFF_QB) + (size_t)(bl * 8 + hd) * S * 64;
    const bf16_t* K = (const bf16_t*)(ws + OFF_KB) + (size_t)(bl * 8 + hd) * S * 64;
    const bf16_t* Vt = (const bf16_t*)(ws + OFF_VB) + (size_t)(bl * 8 + hd) * 64 * S;
    const unsigned* mrow = (const unsigned*)(ws + OFF_MASK) + ((size_t)bl * S + q0 + r) * 128;
    bf16x8 qf[4]; load_q(qf, Q + (size_t)(q0 + r) * 64, h);
    AttnAcc a; attn_init(a, attn_bound(qf, p.qk_g + ((size_t)(layer * 3 + 1) * 2 + 1) * 64));
    const int nkt = q0 / 32 + 1;
    auto bmask = [&](unsigned mw) -> unsigned {
        const unsigned ws4 = mw >> (4 * h);
        return (ws4 & 0xfu) | ((ws4 >> 4) & 0xf0u) | ((ws4 >> 8) & 0xf00u) | ((ws4 >> 12) & 0xf000u);
    };
    KVFrag f0, f1; kv_load(f0, K, Vt, lane);
    unsigned mw0 = mrow[0], mw1 = 0;
    const int tmul = var == 1 ? 0 : 1;
    for (int kt = 0; kt < nkt; kt += 2) {
        { const int kn = (kt + 1 < nkt ? kt + 1 : kt) * tmul; kv_load(f1, K + (size_t)kn * 2048, Vt + (size_t)kn * 2048, lane); mw1 = mrow[kn]; }
        if (var == 2) a.l += __int_as_float((int)f0.k[0][0] + (int)f0.k[3][7] + (int)f0.v[0][0][0] + (int)f0.v[1][1][7] + (int)mw0); else
        attn_step(a, f0, qf, bmask(mw0));
        if (kt + 1 < nkt) {
            { const int kn = (kt + 2 < nkt ? kt + 2 : kt + 1) * tmul; kv_load(f0, K + (size_t)kn * 2048, Vt + (size_t)kn * 2048, lane); mw0 = mrow[kn]; }
            if (var == 2) a.l += __int_as_float((int)f1.k[0][0] + (int)f1.k[3][7] + (int)f1.v[0][0][0] + (int)f1.v[1][1][7] + (int)mw1); else
            attn_step(a, f1, qf, bmask(mw1));
        }
    }
    attn_store_gated(p, a, (size_t)bl * S + q0 + r, 512 + hd * 64, h, st);
}

DI void attn_c_item(const Params& p, int layer, int bl, int hd, int qb, bool st) {
    char* ws = p.ws;
    const int lane = ltid() & 63, w = ltid() >> 6, r = lane & 31, h = lane >> 5;
    const int q0 = qb * 256 + w * 32, own = qb;
    const bf16_t* Q = (const bf16_t*)(ws + OFF_QC) + (size_t)(bl * 8 + hd) * S * 64;
    const bf16_t* K = (const bf16_t*)(ws + OFF_KC) + (size_t)(bl * 8 + hd) * S * 64;
    const bf16_t* Vt = (const bf16_t*)(ws + OFF_VC) + (size_t)(bl * 8 + hd) * 64 * S;
    bf16x8 qf[4]; load_q(qf, Q + (size_t)(q0 + r) * 64, h);
    unsigned sel = 0;
    if (own > 0) {
        const bf16_t* km = (const bf16_t*)(ws + OFF_KM) + (((size_t)(bl * 8 + hd) * 16 + (r & 15)) * 2) * 64;
        f32x16 gt;
#pragma unroll
        for (int i = 0; i < 16; ++i) gt[i] = 0.f;
#pragma unroll
        for (int kk = 0; kk < 4; ++kk) {
            bf16x8 ahi = *(const bf16x8*)(km + kk * 16 + h * 8), alo = *(const bf16x8*)(km + 64 + kk * 16 + h * 8);
            if (r >= 16) { ahi = (bf16x8){0, 0, 0, 0, 0, 0, 0, 0}; alo = ahi; }
            gt = MFMA32(ahi, qf[kk], gt); gt = MFMA32(alo, qf[kk], gt);
        }
        float gl[16];
#pragma unroll
        for (int i = 0; i < 8; ++i) {
            const float mine = gt[i], oth = shx(mine, 32);
            const int blk_mine = 8 * (i >> 2) + 4 * h + (i & 3), blk_oth = 8 * (i >> 2) + 4 * (1 - h) + (i & 3);
            (void)blk_mine; (void)blk_oth;
            gl[8 * (i >> 2) + (i & 3)] = h == 0 ? mine : oth;
            gl[8 * (i >> 2) + 4 + (i & 3)] = h == 0 ? oth : mine;
        }
#pragma unroll
        for (int pick = 0; pick < 3; ++pick) {
            float best = -3.0e38f; int bi = -1;
#pragma unroll
            for (int nb = 0; nb < 16; ++nb) { const bool ok = nb < own && !((sel >> nb) & 1u); if (ok && gl[nb] > best) { best = gl[nb]; bi = nb; } }
            if (bi >= 0) sel |= 1u << bi;
        }
    }
    AttnAcc a; attn_init(a, attn_bound(qf, p.qk_g + ((size_t)(layer * 3 + 2) * 2 + 1) * 64));
    unsigned vis = 0;
    for (int nb = 0; nb < own; ++nb) if (__ballot((sel >> nb) & 1u) != 0ull) vis |= 1u << nb;
    const int ndiag = q0 / 32;
    unsigned long long tm0 = 0ull, tm1 = 0ull;
    for (int nb = 0; nb < own; ++nb) if ((vis >> nb) & 1u) { if (nb < 8) tm0 |= 0xffull << (8 * nb); else tm1 |= 0xffull << (8 * (nb - 8)); }
    for (int t = own * 8; t <= ndiag; ++t) { if (t < 64) tm0 |= 1ull << t; else tm1 |= 1ull << (t - 64); }
    int ntl = __builtin_popcountll(tm0) + __builtin_popcountll(tm1);
    auto pop = [&]() -> int { int t; if (tm0) { t = __builtin_ctzll(tm0); tm0 &= tm0 - 1; } else if (tm1) { t = 64 + __builtin_ctzll(tm1); tm1 &= tm1 - 1; } else t = ndiag; return t; };
    auto cmask = [&](int t) -> unsigned {
        const int cb = t >> 3;
        if (cb < own) return ((sel >> cb) & 1u) ? 0xffffu : 0u;
        if (t != ndiag) return 0xffffu;
        unsigned vm = 0;
#pragma unroll
        for (int i = 0; i < 16; ++i) if (koff(i, h) <= r) vm |= 1u << i;
        return vm;
    };
    KVFrag f0, f1; int t0 = pop(), t1 = 0;
    kv_load(f0, K + (size_t)t0 * 2048, Vt + (size_t)t0 * 2048, lane);
    for (int it = 0; it < ntl; it += 2) {
        t1 = pop(); kv_load(f1, K + (size_t)t1 * 2048, Vt + (size_t)t1 * 2048, lane);
        attn_step(a, f0, qf, cmask(t0));
        if (it + 1 < ntl) {
            t0 = pop(); kv_load(f0, K + (size_t)t0 * 2048, Vt + (size_t)t0 * 2048, lane);
            attn_step(a, f1, qf, cmask(t1));
        }
    }
    attn_store_gated(p, a, (size_t)bl * S + q0 + r, 1024 + hd * 64, h, st);
}

DI void attn_bc_item(const Params& p, int layer, int typ, int bl, int hd, int qb, bool st, char* shm) {
    char* ws = p.ws;
    const int tid = ltid(), lane = tid & 63, w = tid >> 6, r = lane & 31, h = lane >> 5;
    const int q0 = qb * 256 + w * 32, own = qb, ndiag = q0 / 32;
    const bf16_t* Q = (const bf16_t*)(ws + (typ ? OFF_QC : OFF_QB)) + (size_t)(bl * 8 + hd) * S * 64;
    const bf16_t* K = (const bf16_t*)(ws + (typ ? OFF_KC : OFF_KB)) + (size_t)(bl * 8 + hd) * S * 64;
    const bf16_t* Vt = (const bf16_t*)(ws + (typ ? OFF_VC : OFF_VB)) + (size_t)(bl * 8 + hd) * 64 * S;
    const unsigned* mrow = (const unsigned*)(ws + OFF_MASK) + ((size_t)bl * S + q0 + r) * 128;
    unsigned short* seq = (unsigned short*)(shm + 16384);
    unsigned* wvis = (unsigned*)(shm + 16896);
    bf16x8 qf[4]; load_q(qf, Q + (size_t)(q0 + r) * 64, h);
    unsigned sel = 0, vis = 0;
    if (typ == 1 && own > 0) {
        const bf16_t* km = (const bf16_t*)(ws + OFF_KM) + (((size_t)(bl * 8 + hd) * 16 + (r & 15)) * 2) * 64;
        f32x16 gt;
#pragma unroll
        for (int i = 0; i < 16; ++i) gt[i] = 0.f;
#pragma unroll
        for (int kk = 0; kk < 4; ++kk) {
            bf16x8 ahi = *(const bf16x8*)(km + kk * 16 + h * 8), alo = *(const bf16x8*)(km + 64 + kk * 16 + h * 8);
            if (r >= 16) { ahi = (bf16x8){0, 0, 0, 0, 0, 0, 0, 0}; alo = ahi; }
            gt = MFMA32(ahi, qf[kk], gt); gt = MFMA32(alo, qf[kk], gt);
        }
        float gl[16];
#pragma unroll
        for (int i = 0; i < 8; ++i) {
            const float mine = gt[i], oth = shx(mine, 32);
            gl[8 * (i >> 2) + (i & 3)] = h == 0 ? mine : oth;
            gl[8 * (i >> 2) + 4 + (i & 3)] = h == 0 ? oth : mine;
        }
#pragma unroll
        for (int pick = 0; pick < 3; ++pick) {
            float best = -3.0e38f; int bi = -1;
#pragma unroll
            for (int nb = 0; nb < 16; ++nb) { const bool ok = nb < own && !((sel >> nb) & 1u); if (ok && gl[nb] > best) { best = gl[nb]; bi = nb; } }
            if (bi >= 0) sel |= 1u << bi;
        }
        for (int nb = 0; nb < own; ++nb) if (__ballot((sel >> nb) & 1u) != 0ull) vis |= 1u << nb;
    }
    if (typ == 0) vis = (1u << own) - 1u;
    __syncthreads();
    if (lane == 0) wvis[w] = vis;
    __syncthreads();
    if (tid == 0) {
        unsigned bv = 0;
        for (int i = 0; i < 8; ++i) bv |= wvis[i];
        int n = 0;
        for (int nb = 0; nb < own; ++nb) if ((bv >> nb) & 1u) for (int k = 0; k < 8; ++k) seq[n++] = (unsigned short)(nb * 8 + k);
        for (int k = 0; k < 8; ++k) seq[n++] = (unsigned short)(own * 8 + k);
        seq[255] = (unsigned short)n;
    }
    __syncthreads();
    const int ntl = seq[255];
    const bf16_t* gsrc = (tid < 256 ? K : Vt) + (size_t)(tid & 255) * 8;
    char* lds_dst = shm + tid * 16;
    u32x4 R = *(const u32x4*)(gsrc + (size_t)seq[0] * 2048);
    *(u32x4*)lds_dst = R;
    if (ntl > 1) R = *(const u32x4*)(gsrc + (size_t)seq[1] * 2048);
    AttnAcc a; attn_init(a, attn_bound(qf, p.qk_g + ((size_t)(layer * 3 + 1 + typ) * 2 + 1) * 64));
    unsigned mw = typ == 0 ? mrow[seq[0]] : 0u;
    __syncthreads();
    for (int t = 0; t < ntl; ++t) {
        const int ct = seq[t], cb = ct >> 3;
        unsigned mwn = 0;
        if (typ == 0 && t + 1 < ntl) mwn = mrow[seq[t + 1]];
        const bool need = cb < own ? ((vis >> cb) & 1u) != 0u : ct <= ndiag;
        if (need) {
            const char* buf = shm + (t & 1) * 8192;
            KVFrag f;
#pragma unroll
            for (int kk = 0; kk < 4; ++kk) f.k[kk] = *(const bf16x8*)(buf + (kk * 64 + lane) * 16);
#pragma unroll
            for (int db = 0; db < 2; ++db)
#pragma unroll
                for (int u = 0; u < 2; ++u) f.v[db][u] = *(const bf16x8*)(buf + 4096 + ((db * 2 + u) * 64 + lane) * 16);
            unsigned vm;
            if (typ == 0) {
                const unsigned ws4 = mw >> (4 * h);
                vm = (ws4 & 0xfu) | ((ws4 >> 4) & 0xf0u) | ((ws4 >> 8) & 0xf00u) | ((ws4 >> 12) & 0xf000u);
            } else if (cb < own) vm = ((sel >> cb) & 1u) ? 0xffffu : 0u;
            else if (ct == ndiag) {
                vm = 0;
#pragma unroll
                for (int i = 0; i < 16; ++i) if (koff(i, h) <= r) vm |= 1u << i;
            } else vm = 0xffffu;
            attn_step(a, f, qf, vm);
        }
        if (t + 1 < ntl) {
            *(u32x4*)(lds_dst + ((t + 1) & 1) * 8192) = R;
            if (t + 2 < ntl) R = *(const u32x4*)(gsrc + (size_t)seq[t + 2] * 2048);
        }
        mw = mwn;
        __syncthreads();
    }
    attn_store_gated(p, a, (size_t)bl * S + q0 + r, (typ ? 1024 : 512) + hd * 64, h, st);
}

template <int TYP>
DI void attn_step2(AttnAcc& a0, AttnAcc& a1, KVFrag& f, const bf16x8 (&qa)[4], const bf16x8 (&qb)[4], unsigned vm0, unsigned vm1, bool shifted, const bf16_t* Kn, const bf16_t* Vn, int lane) {
    f32x16 s0, s1;
    if (shifted) {
#pragma unroll
        for (int i = 0; i < 16; ++i) { s0[i] = -a0.nb; s1[i] = -a1.nb; }
        s0 = MFMA32(f.k[0], qa[0], s0); s1 = MFMA32(f.k[0], qb[0], s1);
    } else {
        const f32x16 z = {0.f, 0.f, 0.f, 0.f, 0.f, 0.f, 0.f, 0.f, 0.f, 0.f, 0.f, 0.f, 0.f, 0.f, 0.f, 0.f};
        s0 = MFMA32(f.k[0], qa[0], z); s1 = MFMA32(f.k[0], qb[0], z);
    }
#pragma unroll
    for (int kk = 1; kk < 4; ++kk) { s0 = MFMA32(f.k[kk], qa[kk], s0); s1 = MFMA32(f.k[kk], qb[kk], s1); }
#pragma unroll
    for (int kk = 0; kk < 4; ++kk) f.k[kk] = *(const bf16x8*)(Kn + (kk * 64 + lane) * 8);
    float p0[16], p1[16];
#pragma unroll
    for (int i = 0; i < 16; ++i) { p0[i] = fexp2(s0[i]); p1[i] = fexp2(s1[i]); }
    if (TYP == 0 || __ballot((vm0 & vm1) != 0xffffu) != 0ull) {
#pragma unroll
        for (int i = 0; i < 16; ++i) {
            p0[i] = __int_as_float(__float_as_int(p0[i]) & __builtin_amdgcn_sbfe((int)vm0, i, 1));
            p1[i] = __int_as_float(__float_as_int(p1[i]) & __builtin_amdgcn_sbfe((int)vm1, i, 1));
        }
    }
    a0.l += ((p0[0] + p0[1]) + (p0[2] + p0[3])) + ((p0[4] + p0[5]) + (p0[6] + p0[7])) + (((p0[8] + p0[9]) + (p0[10] + p0[11])) + ((p0[12] + p0[13]) + (p0[14] + p0[15])));
    a1.l += ((p1[0] + p1[1]) + (p1[2] + p1[3])) + ((p1[4] + p1[5]) + (p1[6] + p1[7])) + (((p1[8] + p1[9]) + (p1[10] + p1[11])) + ((p1[12] + p1[13]) + (p1[14] + p1[15])));
    u32x4 w00, w01, w10, w11;
#pragma unroll
    for (int i = 0; i < 4; ++i) {
        w00[i] = cvt_pk_bf16(p0[2 * i], p0[2 * i + 1]); w01[i] = cvt_pk_bf16(p0[8 + 2 * i], p0[8 + 2 * i + 1]);
        w10[i] = cvt_pk_bf16(p1[2 * i], p1[2 * i + 1]); w11[i] = cvt_pk_bf16(p1[8 + 2 * i], p1[8 + 2 * i + 1]);
    }
    const bf16x8 f00 = __builtin_bit_cast(bf16x8, w00), f01 = __builtin_bit_cast(bf16x8, w01), f10 = __builtin_bit_cast(bf16x8, w10), f11 = __builtin_bit_cast(bf16x8, w11);
    a0.o0 = MFMA32(f.v[0][0], f00, a0.o0); a1.o0 = MFMA32(f.v[0][0], f10, a1.o0);
    a0.o0 = MFMA32(f.v[0][1], f01, a0.o0); a1.o0 = MFMA32(f.v[0][1], f11, a1.o0);
    a0.o1 = MFMA32(f.v[1][0], f00, a0.o1); a1.o1 = MFMA32(f.v[1][0], f10, a1.o1);
    a0.o1 = MFMA32(f.v[1][1], f01, a0.o1); a1.o1 = MFMA32(f.v[1][1], f11, a1.o1);
#pragma unroll
    for (int db = 0; db < 2; ++db)
#pragma unroll
        for (int u = 0; u < 2; ++u) f.v[db][u] = *(const bf16x8*)(Vn + ((db * 2 + u) * 64 + lane) * 8);
}
template <int TYP>
DI void attn_bc2_item(const Params& p, int layer, int bl, int hd, int qp, bool st) {
    char* ws = p.ws;
    const int lane = ltid() & 63, w = ltid() >> 6, r = lane & 31, h = lane >> 5;
    const int own = qp * 2 + (w >> 2), q0 = own * 256 + (w & 3) * 64;
    const bf16_t* Q = (const bf16_t*)(ws + (TYP ? OFF_QC : OFF_QB)) + (size_t)(bl * 8 + hd) * S * 64;
    const bf16_t* K = (const bf16_t*)(ws + (TYP ? OFF_KC : OFF_KB)) + (size_t)(bl * 8 + hd) * S * 64;
    const bf16_t* Vt = (const bf16_t*)(ws + (TYP ? OFF_VC : OFF_VB)) + (size_t)(bl * 8 + hd) * 64 * S;
    const unsigned* mrow0 = (const unsigned*)(ws + OFF_MASK) + ((size_t)bl * S + q0 + r) * 128;
    const unsigned* mrow1 = mrow0 + 32 * 128;
    bf16x8 qa[4], qb[4];
    load_q(qa, Q + (size_t)(q0 + r) * 64, h); load_q(qb, Q + (size_t)(q0 + 32 + r) * 64, h);
    const float* gk = p.qk_g + ((size_t)(layer * 3 + 1 + TYP) * 2 + 1) * 64;
    AttnAcc a0, a1; attn_init(a0, attn_bound(qa, gk)); attn_init(a1, attn_bound(qb, gk));
    const bool shifted = a0.shifted || a1.shifted;
    if (shifted && !a0.shifted) a0.nb = 0.f;
    if (shifted && !a1.shifted) a1.nb = 0.f;
    const int d0 = q0 / 32, d1 = d0 + 1;
    unsigned sel0 = 0, sel1 = 0;
    unsigned long long tm0 = 0ull, tm1 = 0ull;
    if (TYP == 1) {
        if (own > 0) {
            const bf16_t* km = (const bf16_t*)(ws + OFF_KM) + (((size_t)(bl * 8 + hd) * 16 + (r & 15)) * 2) * 64;
            f32x16 g0, g1;
#pragma unroll
            for (int i = 0; i < 16; ++i) { g0[i] = 0.f; g1[i] = 0.f; }
#pragma unroll
            for (int kk = 0; kk < 4; ++kk) {
                bf16x8 ahi = *(const bf16x8*)(km + kk * 16 + h * 8), alo = *(const bf16x8*)(km + 64 + kk * 16 + h * 8);
                if (r >= 16) { ahi = (bf16x8){0, 0, 0, 0, 0, 0, 0, 0}; alo = ahi; }
                g0 = MFMA32(ahi, qa[kk], g0); g0 = MFMA32(alo, qa[kk], g0);
                g1 = MFMA32(ahi, qb[kk], g1); g1 = MFMA32(alo, qb[kk], g1);
            }
            auto top3 = [&](const f32x16& gt) -> unsigned {
                float gl[16];
#pragma unroll
                for (int i = 0; i < 8; ++i) {
                    const float mine = gt[i], oth = shx(mine, 32);
                    gl[8 * (i >> 2) + (i & 3)] = h == 0 ? mine : oth;
                    gl[8 * (i >> 2) + 4 + (i & 3)] = h == 0 ? oth : mine;
                }
                unsigned sel = 0;
#pragma unroll
                for (int pick = 0; pick < 3; ++pick) {
                    float best = -3.0e38f; int bi = -1;
#pragma unroll
                    for (int nb = 0; nb < 16; ++nb) { const bool ok = nb < own && !((sel >> nb) & 1u); if (ok && gl[nb] > best) { best = gl[nb]; bi = nb; } }
                    if (bi >= 0) sel |= 1u << bi;
                }
                return sel;
            };
            sel0 = top3(g0); sel1 = top3(g1);
        }
        for (int nb = 0; nb < own; ++nb) if (__ballot(((sel0 | sel1) >> nb) & 1u) != 0ull) { if (nb < 8) tm0 |= 0xffull << (8 * nb); else tm1 |= 0xffull << (8 * (nb - 8)); }
        for (int t = own * 8; t <= d1; ++t) { if (t < 64) tm0 |= 1ull << t; else tm1 |= 1ull << (t - 64); }
    } else {
        for (int t = 0; t <= d1; ++t) { if (t < 64) tm0 |= 1ull << t; else tm1 |= 1ull << (t - 64); }
    }
    const int ntl = __builtin_popcountll(tm0) + __builtin_popcountll(tm1);
    auto pop = [&]() -> int { int t; if (tm0) { t = __builtin_ctzll(tm0); tm0 &= tm0 - 1; } else if (tm1) { t = 64 + __builtin_ctzll(tm1); tm1 &= tm1 - 1; } else t = d1; return t; };
    auto cmask = [&](int t, unsigned sel, int dg) -> unsigned {
        const int cb = t >> 3;
        if (cb < own) return ((sel >> cb) & 1u) ? 0xffffu : 0u;
        if (t < dg) return 0xffffu;
        if (t > dg) return 0u;
        unsigned vm = 0;
#pragma unroll
        for (int i = 0; i < 16; ++i) if (koff(i, h) <= r) vm |= 1u << i;
        return vm;
    };
    auto bmask = [&](unsigned mw) -> unsigned {
        const unsigned ws4 = mw >> (4 * h);
        return (ws4 & 0xfu) | ((ws4 >> 4) & 0xf0u) | ((ws4 >> 8) & 0xf00u) | ((ws4 >> 12) & 0xf000u);
    };
    KVFrag f; int tc = pop(), tn = 0;
    kv_load(f, K + (size_t)tc * 2048, Vt + (size_t)tc * 2048, lane);
    unsigned mwa = 0, mwb = 0, mwan = 0, mwbn = 0;
    if (TYP == 0) { mwa = mrow0[tc]; mwb = mrow1[tc]; }
    for (int it = 0; it < ntl; ++it) {
        tn = pop();
        if (TYP == 0) { mwan = mrow0[tn]; mwbn = mrow1[tn]; }
        unsigned vm0, vm1;
        if (TYP == 0) { vm0 = bmask(mwa); vm1 = bmask(mwb); } else { vm0 = cmask(tc, sel0, d0); vm1 = cmask(tc, sel1, d1); }
        attn_step2<TYP>(a0, a1, f, qa, qb, vm0, vm1, shifted, K + (size_t)tn * 2048, Vt + (size_t)tn * 2048, lane);
        tc = tn; mwa = mwan; mwb = mwbn;
    }
    attn_store_gated(p, a0, (size_t)bl * S + q0 + r, (TYP ? 1024 : 512) + hd * 64, h, st);
    attn_store_gated(p, a1, (size_t)bl * S + q0 + 32 + r, (TYP ? 1024 : 512) + hd * 64, h, st);
}

DI void merge_a_item(const Params& p, int item, bool st) {
    char* ws = p.ws;
    const int tid = ltid();
    const bf16_t* oa = (const bf16_t*)(ws + OFF_OA);
    const float* lse = (const float*)(ws + OFF_LSE);
    bf16_t* sz = (bf16_t*)(ws + OFF_SZ);
    for (int it = 0; it < 8; ++it) {
        const size_t tl = (size_t)item * 64 + it * 8 + (tid >> 6);
        const int c8 = (tid & 63) * 8, hd = c8 >> 6;
        const float l0 = lse[(0 * (size_t)TG + tl) * 8 + hd], l1 = lse[(1 * (size_t)TG + tl) * 8 + hd], l2 = lse[(2 * (size_t)TG + tl) * 8 + hd];
        const float mx = fmaxf(l0, fmaxf(l1, l2));
        float w0 = __expf(l0 - mx), w1 = __expf(l1 - mx), w2 = __expf(l2 - mx);
        const float inv = 1.0f / (w0 + w1 + w2); w0 *= inv; w1 *= inv; w2 *= inv;
        const u32x4 a0 = *(const u32x4*)(oa + (0 * (size_t)TG + tl) * 512 + c8), a1 = *(const u32x4*)(oa + (1 * (size_t)TG + tl) * 512 + c8), a2 = *(const u32x4*)(oa + (2 * (size_t)TG + tl) * 512 + c8);
        const u32x4 zz = *(const u32x4*)(sz + tl * 1536 + c8);
        u32x4 res;
#pragma unroll
        for (int k = 0; k < 4; ++k) {
            const float lo = (w0 * __uint_as_float(a0[k] << 16) + w1 * __uint_as_float(a1[k] << 16) + w2 * __uint_as_float(a2[k] << 16)) * __uint_as_float(zz[k] << 16);
            const float hi = (w0 * __uint_as_float(a0[k] & 0xffff0000u) + w1 * __uint_as_float(a1[k] & 0xffff0000u) + w2 * __uint_as_float(a2[k] & 0xffff0000u)) * __uint_as_float(zz[k] & 0xffff0000u);
            res[k] = cvt_pk_bf16(lo, hi);
        }
        if (st) *(u32x4*)(sz + tl * 1536 + c8) = res;
    }
}

DI int snake_item(int round, int G, int bid) { return (round & 1) ? round * G + (G - 1 - bid) : round * G + bid; }

__global__ void __launch_bounds__(NTHREADS) fwd_megakernel(Params p) {
    __shared__ __attribute__((aligned(16))) char shm_raw[SHM_BYTES];
    cg::grid_group grid = cg::this_grid();
    char* ws = p.ws;
    const int G = gridDim.x, bid = blockIdx.x;
    __attribute__((address_space(3))) bf16_t* shm_g = (__attribute__((address_space(3))) bf16_t*)shm_raw;

    unsigned* barcnt = (unsigned*)(ws + OFF_BAR);
    unsigned bartarget = 0;
    if (bid == 0 && threadIdx.x == 0) __hip_atomic_store(barcnt, 0u, __ATOMIC_RELAXED, __HIP_MEMORY_SCOPE_AGENT);
    phase_prep(p, shm_raw);
    if (DUPMASK & 64) { __syncthreads(); phase_prep(p, shm_raw); }
    grid.sync();

#define LAUNDER() do { } while (0)
    for (int layer = 0; layer < DEPTH; ++layer) {
        for (int grp = 0; grp < NGRP; ++grp) {
            const int gtok0 = grp * TG;
            LAUNDER();
            for (int rep = 0; rep <= (DUPMASK & 1); ++rep) {
                EpiIn epi{&p, layer, gtok0};
                gemm_phase<true>((const bf16_t*)(ws + OFF_WTIN), DM, 0, NPAD, (const bf16_t*)(ws + OFF_XB), DM, 0, TG, DM, 1, epi, shm_g);
            }
            grid_barrier(barcnt, bartarget, (unsigned)G);
            if (DUPMASK & 32) grid_barrier(barcnt, bartarget, (unsigned)G);
            LAUNDER();
            for (int rep = 0; rep <= ((DUPMASK >> 1) & 1); ++rep) {
                const int nsel = BG * 256;
                for (int rnd = 0;; ++rnd) {
                    const int it = snake_item(rnd, G, bid);
                    if (rnd * G >= nsel) break;
                    if (it < nsel) select_chunk(p, it % BG, 255 - it / BG, shm_raw);
                }
                for (int it = bid; it < BG * 24 * 16; it += G) attn_a_item(p, layer, it / (24 * 16), (it / 16) % 24, it % 16);
                for (int it = bid; it < BG * 8 * 16; it += G) kmean_item(p, it / 128, (it / 16) & 7, it & 15, shm_raw);
            }
            grid_barrier(barcnt, bartarget, (unsigned)G);
            if (DUPMASK & 32) grid_barrier(barcnt, bartarget, (unsigned)G);
            LAUNDER();
            for (int rep = ((DUPMASK >> 2) & 1); rep >= 0; --rep) {
                const bool st = rep == 0 || p.dupmask == 0x7fffffff;
#if ATTN64
                const int nbc = 2 * BG * 8 * 8;
                for (int rnd = 0;; ++rnd) {
                    const int it = snake_item(rnd, G, bid);
                    if (rnd * G >= nbc) break;
                    if (it < nbc) {
                        const int qp = 7 - it / (2 * BG * 8), sub = it % (2 * BG * 8), typ = sub / (BG * 8), bl = (sub / 8) % BG, hd = sub & 7;
                        if (typ == 0) attn_bc2_item<0>(p, layer, bl, hd, qp, st); else attn_bc2_item<1>(p, layer, bl, hd, qp, st);
                    }
                }
#else
                const int nbc = 2 * BG * 8 * 16;
                for (int rnd = 0;; ++rnd) {
                    const int it = snake_item(rnd, G, bid);
                    if (rnd * G >= nbc) break;
                    if (it < nbc) {
                        const int qb = 15 - it / (2 * BG * 8), sub = it % (2 * BG * 8), typ = sub / (BG * 8), bl = (sub / 8) % BG, hd = sub & 7;
                        {
#if ATTN_LDS
                            attn_bc_item(p, layer, typ, bl, hd, qb, st, shm_raw);
#else
                            if (typ == 0) attn_b_item(p, layer, bl, hd, qb, st, st ? 0 : ((p.dupmask >> 8) & 3)); else if (st || ((p.dupmask >> 10) & 1) == 0) attn_c_item(p, layer, bl, hd, qb, st);
#endif
                        }
                    }
                }
#endif
                for (int it = bid; it < TG / 64; it += G) merge_a_item(p, it, st);
            }
            grid_barrier(barcnt, bartarget, (unsigned)G);
            if (DUPMASK & 32) grid_barrier(barcnt, bartarget, (unsigned)G);
            LAUNDER();
            for (int rep = 0; rep <= ((DUPMASK >> 3) & 1); ++rep) {
                EpiBr epi{&p};
                gemm_phase<false>((const bf16_t*)(ws + OFF_WTBR) + (size_t)layer * 3 * DM * 512, 512, (size_t)DM * 512, DM, (const bf16_t*)(ws + OFF_SZ), 1536, 512, TG, 512, 3, epi, shm_g);
            }
            grid_barrier(barcnt, bartarget, (unsigned)G);
            if (DUPMASK & 32) grid_barrier(barcnt, bartarget, (unsigned)G);
            LAUNDER();
            for (int rep = ((DUPMASK >> 4) & 1); rep >= 0; --rep) {
                EpiOut epi{&p, layer, gtok0, rep == 0 || p.dupmask == 0x7fffffff};
                gemm_phase<false>((const bf16_t*)(ws + OFF_WTOUT) + (size_t)layer * DM * DM, DM, 0, DM, (const bf16_t*)(ws + OFF_MB), DM, 0, TG, DM, 1, epi, shm_g);
                if (rep == 0) {
                    const int nl = grp + 1 < NGRP ? layer : layer + 1, ng = grp + 1 < NGRP ? grp + 1 : 0;
                    if (nl < DEPTH) {
                        __syncthreads();
                        const float* xsrc = (nl == 0 ? p.x : (const float*)p.out) + (size_t)ng * TG * DM;
                        int per = (TG + G - 1) / G; int tb = bid * per, te = tb + per < TG ? tb + per : TG;
                        xprep_tokens(xsrc, (bf16_t*)(ws + OFF_XB), (float*)(ws + OFF_SS), tb, te);
                        if (nl != layer) for (int it = bid; it < 16 * 204; it += G) convert_win_tile(p, nl, it, (float*)shm_raw);
                    }
                }
            }
            grid_barrier(barcnt, bartarget, (unsigned)G);
            if (DUPMASK & 32) grid_barrier(barcnt, bartarget, (unsigned)G);
        }
    }
}

extern "C" void kernel_launch(void* const* d_in, const int* in_sizes, int n_in, void* d_out, int out_size, void* d_ws, size_t ws_size, hipStream_t stream) {
    static int grid_blocks = 0;
    if (!grid_blocks) {
        int dev = 0, cus = 0, per_cu = 0;
        hipGetDevice(&dev);
        hipDeviceGetAttribute(&cus, hipDeviceAttributeMultiprocessorCount, dev);
        hipOccupancyMaxActiveBlocksPerMultiprocessor(&per_cu, fwd_megakernel, NTHREADS, 0);
        if (per_cu > 1) per_cu = 1;
        grid_blocks = cus * per_cu;
    }
    if (ws_size < WS_NEED) { fprintf(stderr, "workspace too small: %zu < %zu\n", ws_size, (size_t)WS_NEED); return; }
    Params p{};
    p.dupmask = DUPMASK; p.pad_ = 0;
    p.x = (const float*)d_in[0]; p.pos = (const int*)d_in[1]; p.norm_g = (const float*)d_in[2]; p.w_in = (const float*)d_in[3];
    p.qk_g = (const float*)d_in[4]; p.w_br = (const float*)d_in[5]; p.w_out = (const float*)d_in[6];
    p.out = (float*)d_out; p.ws = (char*)d_ws;
    void* args[] = {&p};
    hipError_t e = hipLaunchCooperativeKernel((void*)fwd_megakernel, dim3(grid_blocks), dim3(NTHREADS), args, 0, stream);
    if (e != hipSuccess) fprintf(stderr, "cooperative launch failed: %s (grid %d)\n", hipGetErrorString(e), grid_blocks);
}
```

```cpp
#include <hip/hip_runtime.h>
#include <hip/hip_cooperative_groups.h>
#include <cstdio>
#include <cstdint>
namespace cg = cooperative_groups;
#define ATTN_LDS 0
#define ATTN64 1
#define SPINSEL 0
#define DUPMASK 0

typedef unsigned short bf16_t;
typedef short bf16x8 __attribute__((ext_vector_type(8)));
typedef short s16x4 __attribute__((ext_vector_type(4)));
typedef float f32x4 __attribute__((ext_vector_type(4)));
typedef float f32x16 __attribute__((ext_vector_type(16)));
typedef unsigned u32x4 __attribute__((ext_vector_type(4)));
typedef unsigned u32x2 __attribute__((ext_vector_type(2)));
#define DI __device__ __forceinline__

constexpr int S = 4096, DM = 1024, NB = 8, DEPTH = 2;
constexpr int NIN = 12872, NPAD = 13056;
constexpr int BG = 4, TG = BG * S, NGRP = NB / BG;
constexpr int NTHREADS = 512;
constexpr int SHM_BYTES = 131072;
constexpr float QSCALE = 0.125f * 1.4426950408889634f;
constexpr float LN2F = 0.6931471805599453f;
constexpr int SEL_CAP = 768;

constexpr size_t al256(size_t x) { return (x + 255) & ~(size_t)255; }
constexpr size_t OFF_WTIN = 0;
constexpr size_t OFF_WTBR = OFF_WTIN + al256((size_t)NPAD * DM * 2);
constexpr size_t OFF_WTOUT = OFF_WTBR + al256((size_t)DEPTH * 3 * DM * 512 * 2);
constexpr size_t OFF_CS = OFF_WTOUT + al256((size_t)DEPTH * DM * DM * 2);
constexpr size_t OFF_XB = OFF_CS + al256((size_t)NB * S * 8 * 8);
constexpr size_t OFF_OA = OFF_XB;
constexpr size_t OFF_SS = OFF_XB + al256((size_t)3 * TG * 512 * 2);
constexpr size_t OFF_QA = OFF_SS + al256((size_t)TG * 8 * 4);
constexpr size_t OFF_KA = OFF_QA + al256((size_t)TG * 1536 * 2);
constexpr size_t OFF_VA = OFF_KA + al256((size_t)TG * 1536 * 2);
constexpr size_t OFF_MF = OFF_QA;
constexpr size_t OFF_MB = OFF_VA;
constexpr size_t OFF_QB = OFF_VA + al256((size_t)TG * 1536 * 2);
constexpr size_t OFF_KB = OFF_QB + al256((size_t)TG * 512 * 2);
constexpr size_t OFF_VB = OFF_KB + al256((size_t)TG * 512 * 2);
constexpr size_t OFF_QC = OFF_VB + al256((size_t)TG * 512 * 2);
constexpr size_t OFF_KC = OFF_QC + al256((size_t)TG * 512 * 2);
constexpr size_t OFF_VC = OFF_KC + al256((size_t)TG * 512 * 2);
constexpr size_t OFF_IQ = OFF_VC + al256((size_t)TG * 512 * 2);
constexpr size_t OFF_IK = OFF_IQ + al256((size_t)TG * 512 * 2);
constexpr size_t OFF_IW = OFF_IK + al256((size_t)TG * 64 * 2);
constexpr size_t OFF_SZ = OFF_IW + al256((size_t)TG * 8 * 4);
constexpr size_t OFF_SG = OFF_SZ + al256((size_t)TG * 1536 * 2);
constexpr size_t OFF_LSE = OFF_SG + al256((size_t)TG * 3072 * 2);
constexpr size_t OFF_MASK = OFF_LSE + al256((size_t)3 * TG * 8 * 4);
constexpr size_t OFF_KM = OFF_MASK + al256((size_t)BG * S * (S / 8));
static_assert((size_t)TG * DM * 4 <= (size_t)2 * TG * 1536 * 2 && (size_t)TG * DM * 2 <= (size_t)TG * 1536 * 2, "overlay sizes");
constexpr size_t OFF_BAR = OFF_KM + al256((size_t)BG * 8 * 16 * 64 * 2 * 2);
constexpr size_t OFF_FLAG = OFF_BAR + 256;
constexpr size_t WS_NEED = OFF_FLAG + (size_t)DEPTH * NGRP * 64 * 4;

struct Params {
    const float* x; const int* pos; const float* norm_g; const float* w_in; const float* qk_g; const float* w_br; const float* w_out;
    float* out; char* ws; int dupmask; int pad_;
};

DI int ltid() { int t = threadIdx.x; asm volatile("" : "+v"(t)); return t; }
DI unsigned cvt_pk_bf16(float lo, float hi) { unsigned r; asm volatile("v_cvt_pk_bf16_f32 %0, %1, %2" : "=v"(r) : "v"(lo), "v"(hi)); return r; }
DI bf16_t f2bf(float x) { return (bf16_t)(cvt_pk_bf16(x, 0.f) & 0xffffu); }
DI float bf2f(bf16_t v) { return __uint_as_float(((unsigned)v) << 16); }
DI float fexp2(float x) { return __builtin_amdgcn_exp2f(x); }
DI float shx(float v, int mask) { const int l = ltid() & 63; return __int_as_float(__builtin_amdgcn_ds_bpermute((l ^ mask) << 2, __float_as_int(v))); }
DI float wave_sum(float v) { for (int o = 32; o > 0; o >>= 1) v += shx(v, o); return v; }
DI int f2sort(float f) { int i = __float_as_int(f); return i ^ ((i >> 31) & 0x7fffffff); }
DI float sort2f(int i) { return __int_as_float(i ^ ((i >> 31) & 0x7fffffff)); }
#define MFMA32(a, b, c) __builtin_amdgcn_mfma_f32_32x32x16_bf16((a), (b), (c), 0, 0, 0)
#define MFMA16(a, b, c) __builtin_amdgcn_mfma_f32_16x16x32_bf16((a), (b), (c), 0, 0, 0)

DI void grid_barrier(unsigned* cnt, unsigned& target, unsigned G) {
    __syncthreads();
    target += G;
    if (threadIdx.x == 0) {
        __builtin_amdgcn_fence(__ATOMIC_RELEASE, "agent");
        __hip_atomic_fetch_add(cnt, 1u, __ATOMIC_RELAXED, __HIP_MEMORY_SCOPE_AGENT);
        while (__hip_atomic_load(cnt, __ATOMIC_RELAXED, __HIP_MEMORY_SCOPE_AGENT) < target) __builtin_amdgcn_s_sleep(2);
        __builtin_amdgcn_fence(__ATOMIC_ACQUIRE, "agent");
    }
    __syncthreads();
}

DI int src_col_of_group(int hg) { return hg <= 104 ? hg * 64 : (hg <= 200 ? 6728 + (hg - 105) * 64 : 6720); }

DI void convert_tile(const float* src, int ld_src, int k0, int n_src0, int n_valid, const float* kscale, bf16_t* dst, int ld_dst, int n_dst0, float* tl  ) {
    const int tid = ltid();
    __syncthreads();
#pragma unroll
    for (int i = 0; i < 8; ++i) {
        int e = tid + i * 512, kk = e >> 6, nn = e & 63;
        float v = 0.f;
        if (nn < n_valid) { v = src[(size_t)(k0 + kk) * ld_src + n_src0 + nn]; if (kscale) v *= kscale[k0 + kk]; }
        tl[kk * 65 + nn] = v;
    }
    __syncthreads();
#pragma unroll
    for (int i = 0; i < 4; ++i) {
        int e = tid + i * 512, nn = e >> 5, kp = (e & 31) * 2;
        unsigned w = cvt_pk_bf16(tl[kp * 65 + nn], tl[(kp + 1) * 65 + nn]);
        *(unsigned*)(dst + (size_t)(n_dst0 + nn) * ld_dst + k0 + kp) = w;
    }
}

DI void xprep_tokens(const float* xsrc  , bf16_t* xb, float* ss, int tok_begin, int tok_end) {
    const int lane = ltid() & 63, wid = ltid() >> 6;
    for (int t = tok_begin + wid; t < tok_end; t += 8) {
        const float* xr = xsrc + (size_t)t * DM;
        float sum = 0.f;
#pragma unroll
        for (int i = 0; i < 4; ++i) {
            f32x4 v = *(const f32x4*)(xr + i * 256 + lane * 4);
            sum += v[0] * v[0] + v[1] * v[1] + v[2] * v[2] + v[3] * v[3];
            u32x2 w; w[0] = cvt_pk_bf16(v[0], v[1]); w[1] = cvt_pk_bf16(v[2], v[3]);
            *(u32x2*)(xb + (size_t)t * DM + i * 256 + lane * 4) = w;
        }
        sum = wave_sum(sum);
        if (lane < 8) ss[(size_t)t * 8 + lane] = lane == 0 ? sum : 0.f;
    }
}

DI void convert_win_tile(const Params& p, int l, int it, float* tl) {
    const int hg = it / 16, kt = it % 16;
    const int nvalid = hg <= 200 ? 64 : (hg == 201 ? 8 : 0);
    convert_tile(p.w_in + (size_t)l * DM * NIN, NIN, kt * 64, src_col_of_group(hg), nvalid, p.norm_g + l * DM, (bf16_t*)(p.ws + OFF_WTIN), DM, hg * 64, tl);
}
DI void phase_prep(const Params& p, char* shm) {
    char* ws = p.ws;
    const int G = gridDim.x, bid = blockIdx.x, tid = ltid();
    float2* cs = (float2*)(ws + OFF_CS);
    for (int e = bid * NTHREADS + tid; e < NB * S * 8; e += G * NTHREADS) {
        int i = e & 7, t = e >> 3;
        float inv = powf(500000.0f, -(float)(2 * i) / 16.0f);
        float ang = (float)p.pos[t] * inv;
        double rev = (double)ang * 0.15915494309189535;
        rev -= floor(rev);
        float rf = (float)rev;
        cs[e] = make_float2(__builtin_amdgcn_cosf(rf), __builtin_amdgcn_sinf(rf));
    }
    float* tl = (float*)shm;
    const int n_in_tiles = 16 * 204, n_br_tiles = DEPTH * 3 * 8 * 16, n_out_tiles = DEPTH * 16 * 16;
    for (int it = bid; it < n_in_tiles + n_br_tiles + n_out_tiles; it += G) {
        if (it < n_in_tiles) {
            convert_win_tile(p, 0, it, tl);
        } else if (it < n_in_tiles + n_br_tiles) {
            int r = it - n_in_tiles; int ln = r / 128, q = r % 128, kt = q / 16, nt = q % 16;
            convert_tile(p.w_br + (size_t)ln * 512 * DM, DM, kt * 64, nt * 64, 64, nullptr, (bf16_t*)(ws + OFF_WTBR) + (size_t)ln * DM * 512, 512, nt * 64, tl);
        } else {
            int r = it - n_in_tiles - n_br_tiles; int l = r / 256, q = r % 256, kt = q / 16, nt = q % 16;
            convert_tile(p.w_out + (size_t)l * DM * DM, DM, kt * 64, nt * 64, 64, nullptr, (bf16_t*)(ws + OFF_WTOUT) + (size_t)l * DM * DM, DM, nt * 64, tl);
        }
    }
    int per = (TG + G - 1) / G;
    int tb = bid * per, te = tb + per < TG ? tb + per : TG;
    xprep_tokens(p.x, (bf16_t*)(ws + OFF_XB), (float*)(ws + OFF_SS), tb, te);
}

constexpr int BM = 256, BK = 64, HALF = 128, NXCD = 8, WGM = 8, HT = HALF * BK;
DI int lds_byte(int r, int c) { int st = (r >> 4) * 2 + (c >> 5), rr = r & 15, cc = c & 31, ob = rr * 64 + cc * 2; return st * 1024 + (ob ^ (((ob >> 9) & 1) << 5)); }
DI void stage_rc(int b, int& R, int& C) { int st = b / 1024, sb = b % 1024, swz = sb ^ (((sb >> 9) & 1) << 5); R = (st >> 1) * 16 + swz / 64; C = (st & 1) * 32 + (swz % 64) / 2; }

#define SA(b, h) (shm + ((b) * 2 + (h)) * HT)
#define SB(b, h) (shm + (4 + (b) * 2 + (h)) * HT)
DI void glds16(const void* sbase, unsigned voff, unsigned lds_dst) {
    unsigned keep;
    asm volatile("s_mov_b32 %0, m0\n\ts_mov_b32 m0, %3\n\ts_nop 0\n\tglobal_load_lds_dwordx4 %1, %2\n\ts_mov_b32 m0, %0"
                 : "=&s"(keep) : "v"(voff), "s"(sbase), "s"(lds_dst) : "memory");
}
#define STAGE(P, BASE, LD, br, kt, VOFF) do { const bf16_t* _gp = (BASE) + (size_t)(br) * (LD) + (size_t)(kt) * BK; \
    const unsigned _l0 = (unsigned)(size_t)(P) + wbase16; \
    glds16(_gp, VOFF[0], _l0); glds16(_gp, VOFF[1], _l0 + 8192u); } while (0)
#define LDA(dst, b, h) _Pragma("unroll") for (int m = 0; m < 4; ++m) _Pragma("unroll") for (int k = 0; k < 2; ++k) \
    dst[m][k] = *reinterpret_cast<const bf16x8*>((char*)SA(b, h) + lds_byte(wr * 64 + m * 16 + fr, k * 32 + fq * 8))
#define LDB(dst, b, h) _Pragma("unroll") for (int n = 0; n < 2; ++n) _Pragma("unroll") for (int k = 0; k < 2; ++k) \
    dst[n][k] = *reinterpret_cast<const bf16x8*>((char*)SB(b, h) + lds_byte(wc * 32 + n * 16 + fr, k * 32 + fq * 8))
#define MMA(ai, bj, At, Bt_) do { __builtin_amdgcn_s_setprio(1); \
    _Pragma("unroll") for (int m = 0; m < 4; ++m) _Pragma("unroll") for (int n = 0; n < 2; ++n) _Pragma("unroll") for (int k = 0; k < 2; ++k) \
      acc[ai][bj][m][n] = MFMA16(At[m][k], Bt_[n][k], acc[ai][bj][m][n]); \
    __builtin_amdgcn_s_setprio(0); } while (0)
#define WAIT_V(n) asm volatile("s_waitcnt vmcnt(" #n ")" ::: "memory")
#define WAIT_L(n) asm volatile("s_waitcnt lgkmcnt(" #n ")" ::: "memory")
#define BAR __builtin_amdgcn_s_barrier()
#define SCHED __builtin_amdgcn_sched_barrier(0)

DI int fold_tok(int rho, int sh) { const int b = rho >> 12, rb = rho & (S - 1); return (b << 12) + (((rb & ((S >> sh) - 1)) << sh) + (rb >> (12 - sh))); }
DI void gemm_tile_of(int L, int nM, int nN, int& pm, int& pn) {
    const int nwg = nM * nN; int wgid = L;
    { int q = nwg / NXCD, r = nwg % NXCD, xcd = wgid % NXCD, off = wgid / NXCD; wgid = (xcd < r ? xcd * (q + 1) : r * (q + 1) + (xcd - r) * q) + off; }
    const int nig = WGM * nN, gid = wgid / nig, fm = gid * WGM, gsz = min(nM - fm, WGM);
    pm = fm + ((wgid % nig) % gsz); pn = (wgid % nig) / gsz;
}
template <bool FOLD, class Epi>
DI void gemm_phase(const bf16_t* __restrict__ Abase, int lda, size_t a_sub, int M, const bf16_t* __restrict__ Bbase, int ldb, size_t b_sub, int N, int K, int nsub,
                   Epi& epi, __attribute__((address_space(3))) bf16_t* shm) {
    const int nM = M / BM, nN = N / BM, nwg = nM * nN;
    const int wid = ltid() >> 6, lane = ltid() & 63, wr = wid >> 2, wc = wid & 3, fr = lane & 15, fq = lane >> 4;
    const int nt = K / BK;
    unsigned voffA[2], voffB0[2], voffB1[2];
    const unsigned wbase16 = __builtin_amdgcn_readfirstlane((ltid() & ~63u) * 16u);
#pragma unroll
    for (int i = 0; i < 2; ++i) {
        int r_, c_; stage_rc(ltid() * 16 + i * 8192, r_, c_);
        const int x_ = r_ & 63, pr_ = (r_ & 64) + ((x_ & 15) >> 2) * 16 + (x_ >> 4) * 4 + (x_ & 3);
        voffA[i] = (unsigned)(pr_ * lda + c_) * 2u;
    }
    int L = blockIdx.x, sub = 0, brow = 0, bcol = 0;
    bool have = L < nwg, prefetched = false;
    const bf16_t* A = Abase; const bf16_t* Bt = Bbase;
    auto setup = [&](int L_, int sub_) {
        int wgid = L_;
        { int q = nwg / NXCD, r = nwg % NXCD, xcd = wgid % NXCD, off = wgid / NXCD; wgid = (xcd < r ? xcd * (q + 1) : r * (q + 1) + (xcd - r) * q) + off; }
        const int nig = WGM * nN, gid = wgid / nig, fm = gid * WGM, gsz = min(nM - fm, WGM);
        const int pm = fm + ((wgid % nig) % gsz), pn = (wgid % nig) / gsz;
        brow = pm * BM; bcol = pn * BM;
        const int sh = (FOLD && pm < 18) ? 2 * ((pm % 6) >> 1) : 0;
        const int t_ = ltid();
#pragma unroll
        for (int i = 0; i < 2; ++i) {
            int r_, c_; stage_rc(t_ * 16 + i * 8192, r_, c_);
            voffB0[i] = (unsigned)(fold_tok(bcol + r_, sh) * ldb + c_) * 2u;
            voffB1[i] = (unsigned)(fold_tok(bcol + HALF + r_, sh) * ldb + c_) * 2u;
        }
        A = Abase + (size_t)sub_ * a_sub; Bt = Bbase + (size_t)sub_ * b_sub;
    };
    while (have) {
        {
            setup(L, sub);
            f32x4 acc[2][2][4][2] = {};
            bf16x8 At[4][2], B0[2][2], B1[2][2];
            if (!prefetched) {
                STAGE(SB(0, 0), Bt, ldb, 0, 0, voffB0); STAGE(SA(0, 0), A, lda, brow, 0, voffA);
                STAGE(SB(0, 1), Bt, ldb, 0, 0, voffB1); STAGE(SA(0, 1), A, lda, brow + HALF, 0, voffA);
            }
            if (wr == 1) BAR;
            if (prefetched) WAIT_V(0); else WAIT_V(4);
            BAR;
            STAGE(SB(1, 0), Bt, ldb, 0, 1, voffB0); STAGE(SA(1, 0), A, lda, brow, 1, voffA); STAGE(SB(1, 1), Bt, ldb, 0, 1, voffB1);
            WAIT_V(6); BAR;
            for (int t = 0; t < nt - 2; t += 2) {
                LDB(B0, 0, 0); SCHED; LDA(At, 0, 0); STAGE(SA(1, 1), A, lda, brow + HALF, t + 1, voffA);
                WAIT_L(8); BAR; WAIT_L(0); MMA(0, 0, At, B0); BAR; SCHED;
                LDB(B1, 0, 1); STAGE(SB(0, 0), Bt, ldb, 0, t + 2, voffB0);
                BAR; WAIT_L(0); MMA(0, 1, At, B1); BAR;
                LDA(At, 0, 1); STAGE(SA(0, 0), A, lda, brow, t + 2, voffA);
                BAR; WAIT_L(0); MMA(1, 0, At, B0); BAR; SCHED;
                STAGE(SB(0, 1), Bt, ldb, 0, t + 2, voffB1);
                WAIT_V(6); BAR; MMA(1, 1, At, B1); BAR;
                LDB(B0, 1, 0); SCHED; LDA(At, 1, 0); STAGE(SA(0, 1), A, lda, brow + HALF, t + 2, voffA);
                WAIT_L(8); BAR; WAIT_L(0); MMA(0, 0, At, B0); BAR; SCHED;
                LDB(B1, 1, 1); STAGE(SB(1, 0), Bt, ldb, 0, t + 3, voffB0);
                BAR; WAIT_L(0); MMA(0, 1, At, B1); BAR;
                LDA(At, 1, 1); STAGE(SA(1, 0), A, lda, brow, t + 3, voffA);
                BAR; WAIT_L(0); MMA(1, 0, At, B0); BAR; SCHED;
                STAGE(SB(1, 1), Bt, ldb, 0, t + 3, voffB1);
                WAIT_V(6); BAR; MMA(1, 1, At, B1); BAR;
            }
            { LDB(B0, 0, 0); LDA(At, 0, 0); STAGE(SA(1, 1), A, lda, brow + HALF, nt - 1, voffA);
              BAR; WAIT_L(0); MMA(0, 0, At, B0); BAR;
              LDB(B1, 0, 1); BAR; WAIT_L(0); MMA(0, 1, At, B1); BAR;
              LDA(At, 0, 1); WAIT_V(4); BAR; WAIT_L(0); MMA(1, 0, At, B0); MMA(1, 1, At, B1); BAR; }
            { LDB(B0, 1, 0); LDA(At, 1, 0); WAIT_V(2); BAR; WAIT_L(0); MMA(0, 0, At, B0); BAR;
              LDB(B1, 1, 1); WAIT_V(0); BAR; WAIT_L(0); MMA(0, 1, At, B1); BAR;
              LDA(At, 1, 1); BAR; WAIT_L(0); MMA(1, 0, At, B0); MMA(1, 1, At, B1); BAR; }
            if (wr == 0) BAR;
            const int e_brow = brow, e_bcol = bcol, e_sub = sub;
            if (++sub == nsub) { sub = 0; L += gridDim.x; }
            have = L < nwg;
            if (have) {
                setup(L, sub);
                STAGE(SB(0, 0), Bt, ldb, 0, 0, voffB0); STAGE(SA(0, 0), A, lda, brow, 0, voffA);
                STAGE(SB(0, 1), Bt, ldb, 0, 0, voffB1); STAGE(SA(0, 1), A, lda, brow + HALF, 0, voffA);
                prefetched = true;
            }
            { int t2 = ltid();
              const int wid2 = t2 >> 6, lane2 = t2 & 63;
              epi(acc, e_brow, e_bcol, e_sub, wid2 >> 2, wid2 & 3, lane2 & 15, lane2 >> 4); }
        }
    }
}

struct EpiIn {
    const Params* p; int layer; int gtok0;
    DI void operator()(const f32x4 (&acc)[2][2][4][2], int brow, int bcol, int sub, int wr, int wc, int fr, int fq) const {
        char* ws = p->ws;
        const float* ss = (const float*)(ws + OFF_SS);
        const float2* cs = (const float2*)(ws + OFF_CS);
        const int lane = ltid() & 63;
#pragma unroll
        for (int bj = 0; bj < 2; ++bj)
#pragma unroll
            for (int n = 0; n < 2; ++n) {
                const int rho = bcol + bj * 128 + wc * 32 + n * 16 + fr;
                const int pm_ = brow >> 8;
                const int shf = pm_ < 18 ? 2 * ((pm_ % 6) >> 1) : 0;
                const int tl = fold_tok(rho, shf);
                const f32x4 s0 = *(const f32x4*)(ss + (size_t)tl * 8), s1 = *(const f32x4*)(ss + (size_t)tl * 8 + 4);
                const float rstd = rsqrtf((s0[0] + s0[1] + s0[2] + s0[3] + s1[0] + s1[1] + s1[2] + s1[3]) * (1.0f / DM) + 1e-6f);
                const int bl = tl >> 12, s = tl & (S - 1), rb = rho & (S - 1);
                const int tg = gtok0 + tl;
#pragma unroll
                for (int ai = 0; ai < 2; ++ai) {
                    const int hg = (brow + ai * 128 + wr * 64) >> 6;
                    float v[16];
#pragma unroll
                    for (int m = 0; m < 4; ++m)
#pragma unroll
                        for (int j = 0; j < 4; ++j) v[m * 4 + j] = acc[ai][bj][m][n][j] * rstd;
                    int kind;
                    int mixer = 0, isk = 0, hh = 0, H = 8; size_t qoff = 0, koff = 0, voff = 0;
                    if (hg < 72) { mixer = 0; H = 24; qoff = OFF_QA; koff = OFF_KA; voff = OFF_VA; kind = hg < 48 ? 0 : 1; isk = hg >= 24; hh = hg % 24; }
                    else if (hg < 96) { mixer = 1; qoff = OFF_QB; koff = OFF_KB; voff = OFF_VB; kind = hg < 88 ? 0 : 1; isk = hg >= 80; hh = (hg - 72) & 7; }
                    else if (hg < 105) { kind = 2; isk = hg == 104; hh = hg - 96; }
                    else if (hg < 129) { mixer = 2; qoff = OFF_QC; koff = OFF_KC; voff = OFF_VC; kind = hg < 121 ? 0 : 1; isk = hg >= 113; hh = (hg - 105) & 7; }
                    else if (hg < 153) kind = 3;
                    else if (hg < 201) kind = 4;
                    else kind = hg == 201 ? 5 : 6;

                    if (kind == 0 || kind == 2) {
                        if (kind == 0) {
                            float sq = 0.f;
#pragma unroll
                            for (int i = 0; i < 16; ++i) sq += v[i] * v[i];
                            sq += shx(sq, 16); sq += shx(sq, 32);
                            const float rn = rsqrtf(sq * (1.0f / 64) + 1e-6f) * (isk ? 1.0f : QSCALE);
                            const float* gq = p->qk_g + ((size_t)(layer * 3 + mixer) * 2 + isk) * 64 + fq * 16;
#pragma unroll
                            for (int m = 0; m < 4; ++m) {
                                const f32x4 g4 = *(const f32x4*)(gq + m * 4);
#pragma unroll
                                for (int j = 0; j < 4; ++j) v[m * 4 + j] *= rn * g4[j];
                            }
                        }
                        if (fq == 0) {
                            const f32x4* cp = (const f32x4*)(cs + (size_t)tg * 8);
#pragma unroll
                            for (int i2 = 0; i2 < 4; ++i2) {
                                const f32x4 c2 = cp[i2];
                                const float x1a = v[2 * i2], x2a = v[8 + 2 * i2], x1b = v[2 * i2 + 1], x2b = v[8 + 2 * i2 + 1];
                                v[2 * i2] = x1a * c2[0] - x2a * c2[1]; v[8 + 2 * i2] = x2a * c2[0] + x1a * c2[1];
                                v[2 * i2 + 1] = x1b * c2[2] - x2b * c2[3]; v[8 + 2 * i2 + 1] = x2b * c2[2] + x1b * c2[3];
                            }
                        }
                        u32x4 w0, w1;
#pragma unroll
                        for (int i = 0; i < 4; ++i) { w0[i] = cvt_pk_bf16(v[2 * i], v[2 * i + 1]); w1[i] = cvt_pk_bf16(v[8 + 2 * i], v[8 + 2 * i + 1]); }
                        if (kind == 0 && isk) {
                            bf16_t* dst = (bf16_t*)(ws + koff) + ((size_t)(bl * H + hh) * 128 + (rb >> 5)) * 2048 + (size_t)(fq * 64 + (rb & 31)) * 8;
                            *(u32x4*)dst = w0; *(u32x4*)(dst + 32 * 8) = w1;
                        } else {
                            bf16_t* dst;
                            if (kind == 0) dst = (bf16_t*)(ws + qoff) + ((size_t)(bl * H + hh) * S + rb) * 64;
                            else dst = isk ? (bf16_t*)(ws + OFF_IK) + (size_t)tl * 64 : (bf16_t*)(ws + OFF_IQ) + ((size_t)(bl * 8 + hh) * S + s) * 64;
                            *(u32x4*)(dst + fq * 16) = w0; *(u32x4*)(dst + fq * 16 + 8) = w1;
                        }
                    } else if (kind == 1) {
                        const int k5 = rb & 31;
                        bf16_t* dst = (bf16_t*)(ws + voff) + ((size_t)(bl * H + hh) * 128 + (rb >> 5)) * 2048 + ((k5 >> 4) * 64 + ((k5 >> 2) & 1) * 32) * 8 + ((k5 >> 3) & 1) * 4 + (k5 & 3)
                                      + ((fq >> 1) * 128 + (fq & 1) * 16) * 8;
#pragma unroll
                        for (int i = 0; i < 16; ++i) dst[i * 8] = f2bf(v[i]);
                    } else if (kind == 3 || kind == 4) {
                        bf16_t* dst = (kind == 3 ? (bf16_t*)(ws + OFF_SZ) + (size_t)tl * 1536 + (hg - 129) * 64 : (bf16_t*)(ws + OFF_SG) + (size_t)tl * 3072 + (hg - 153) * 64) + fq * 16;
#pragma unroll
                        for (int i = 0; i < 16; ++i) { const float sg = __builtin_amdgcn_rcpf(1.0f + __expf(-v[i])); v[i] = kind == 3 ? v[i] * sg : sg; }
                        u32x4 w0, w1;
#pragma unroll
                        for (int i = 0; i < 4; ++i) { w0[i] = cvt_pk_bf16(v[2 * i], v[2 * i + 1]); w1[i] = cvt_pk_bf16(v[8 + 2 * i], v[8 + 2 * i + 1]); }
                        *(u32x4*)dst = w0; *(u32x4*)(dst + 8) = w1;
                    } else if (kind == 5) {
                        if (fq == 0) { f32x4 o0 = {v[0], v[1], v[2], v[3]}, o1 = {v[4], v[5], v[6], v[7]}; float* d = (float*)(ws + OFF_IW) + (size_t)tl * 8; *(f32x4*)d = o0; *(f32x4*)(d + 4) = o1; }
                    }
                }
            }
        (void)lane; (void)sub;
    }
};

struct EpiBr {
    const Params* p;
    DI void operator()(const f32x4 (&acc)[2][2][4][2], int brow, int bcol, int sub, int wr, int wc, int fr, int fq) const {
        char* ws = p->ws;
        const bf16_t* sg = (const bf16_t*)(ws + OFF_SG);
        float* mf = (float*)(ws + OFF_MF);
        bf16_t* mb = (bf16_t*)(ws + OFF_MB);
#pragma unroll
        for (int bj = 0; bj < 2; ++bj)
#pragma unroll
            for (int n = 0; n < 2; ++n) {
                const int tl = bcol + bj * 128 + wc * 32 + n * 16 + fr;
#pragma unroll
                for (int ai = 0; ai < 2; ++ai)
#pragma unroll
                    for (int m2 = 0; m2 < 2; ++m2) {
                        const int e = brow + ai * 128 + wr * 64 + fq * 16 + m2 * 8;
                        const u32x4 gw = *(const u32x4*)(sg + (size_t)tl * 3072 + sub * 1024 + e);
                        bf16_t* mp = mb + (size_t)tl * DM + e;
                        u32x4 pw = {0u, 0u, 0u, 0u};
                        if (sub > 0) pw = *(const u32x4*)mp;
                        u32x4 ow;
#pragma unroll
                        for (int hh2 = 0; hh2 < 2; ++hh2) {
                            const f32x4 g4 = {__uint_as_float(gw[2 * hh2] << 16), __uint_as_float(gw[2 * hh2] & 0xffff0000u), __uint_as_float(gw[2 * hh2 + 1] << 16), __uint_as_float(gw[2 * hh2 + 1] & 0xffff0000u)};
                            f32x4 r = acc[ai][bj][m2 * 2 + hh2][n] * g4;
                            if (sub > 0) r += (f32x4){__uint_as_float(pw[2 * hh2] << 16), __uint_as_float(pw[2 * hh2] & 0xffff0000u), __uint_as_float(pw[2 * hh2 + 1] << 16), __uint_as_float(pw[2 * hh2 + 1] & 0xffff0000u)};
                            ow[2 * hh2] = cvt_pk_bf16(r[0], r[1]); ow[2 * hh2 + 1] = cvt_pk_bf16(r[2], r[3]);
                        }
                        *(u32x4*)mp = ow;
                    }
                asm volatile("" ::: "memory");
            }
    }
};

struct EpiOut {
    const Params* p; int layer; int gtok0; bool st;
    DI void operator()(const f32x4 (&acc)[2][2][4][2], int brow, int bcol, int sub, int wr, int wc, int fr, int fq) const {
        char* ws = p->ws;
        const float* xin = layer == 0 ? p->x : p->out;
        bf16_t* xb = (bf16_t*)(ws + OFF_XB);
        float* ss = (float*)(ws + OFF_SS);
#pragma unroll
        for (int bj = 0; bj < 2; ++bj)
#pragma unroll
            for (int n = 0; n < 2; ++n) {
                const int tl = bcol + bj * 128 + wc * 32 + n * 16 + fr;
                const size_t tg = (size_t)gtok0 + tl;
                float sq = 0.f;
#pragma unroll
                for (int ai = 0; ai < 2; ++ai)
#pragma unroll
                    for (int m = 0; m < 4; ++m) {
                        const int e = brow + ai * 128 + wr * 64 + fq * 16 + m * 4;
                        f32x4 r = *(const f32x4*)(xin + tg * DM + e) + acc[ai][bj][m][n];
                        if (st) *(f32x4*)(p->out + tg * DM + e) = r;
                    }
            }
        (void)sub;
    }
};

DI void select_chunk(const Params& p, int bl, int c, char* shm) {
    char* ws = p.ws;
    const bf16_t* IQ = (const bf16_t*)(ws + OFF_IQ);
    const bf16_t* IK = (const bf16_t*)(ws + OFF_IK);
    const float* IW = (const float*)(ws + OFF_IW);
    unsigned* hist = (unsigned*)shm; unsigned* bits = (unsigned*)(shm + 16384);
    int* ctl = (int*)(shm + 24576); int* cnt = ctl, *mn = ctl + 16, *mx = ctl + 32, *bsel = ctl + 48, *needp = ctl + 64;
    u32x2* list = (u32x2*)(shm + 32768);
    const int tid = ltid(), lane = tid & 63, w = __builtin_amdgcn_readfirstlane(tid >> 6), q = lane & 15, g = lane >> 4;
    const int t0 = c * 16, tq = t0 + q;
    __syncthreads();
    for (int i = tid; i < 16 * 256 + 16 * 128; i += NTHREADS) hist[i] = 0;
    if (tid < 16) { cnt[tid] = 0; mn[tid] = 0x7fffffff; mx[tid] = (int)0x80000000; }
    bf16x8 qf[8][2]; float wq[8];
#pragma unroll
    for (int hd = 0; hd < 8; ++hd) {
        const bf16_t* qp = IQ + ((size_t)(bl * 8 + hd) * S + tq) * 64 + g * 8;
        qf[hd][0] = *(const bf16x8*)qp; qf[hd][1] = *(const bf16x8*)(qp + 32);
        wq[hd] = IW[(size_t)(bl * S + tq) * 8 + hd];
    }
    auto loadk = [&](int kt, bf16x8& k0, bf16x8& k1) {
        const bf16_t* kp = IK + ((size_t)bl * S + kt * 16 + q) * 64 + g * 8;
        k0 = *(const bf16x8*)kp; k1 = *(const bf16x8*)(kp + 32);
    };
    auto compute = [&](const bf16x8& k0, const bf16x8& k1) -> f32x4 {
        f32x4 sc = {0.f, 0.f, 0.f, 0.f};
#pragma unroll
        for (int hd = 0; hd < 8; ++hd) {
            f32x4 a = {0.f, 0.f, 0.f, 0.f};
            a = MFMA16(k0, qf[hd][0], a); a = MFMA16(k1, qf[hd][1], a);
#pragma unroll
            for (int j = 0; j < 4; ++j) sc[j] += wq[hd] * fmaxf(a[j], 0.f);
        }
        return sc;
    };
#define SEL_PASS(BODY) do { \
        const int cl = c - 1;     \
        bf16x8 ka0, ka1, kb0, kb1; int kt = w; \
        if (kt <= cl) loadk(kt, ka0, ka1); \
        if (kt + 8 <= cl) loadk(kt + 8, kb0, kb1); \
        for (; kt <= cl; kt += 16) { \
            { const f32x4 sc = compute(ka0, ka1); if (kt + 16 <= cl) loadk(kt + 16, ka0, ka1); const int ktc = kt; const bool diag = false; BODY } \
            if (kt + 8 <= cl) { const f32x4 sc = compute(kb0, kb1); if (kt + 24 <= cl) loadk(kt + 24, kb0, kb1); const int ktc = kt + 8; const bool diag = false; BODY } \
        } \
        if (w == (c & 7)) { loadk(c, ka0, ka1); const f32x4 sc = compute(ka0, ka1); const int ktc = c; const bool diag = true; BODY } \
    } while (0)
#define SEL_OK(j) (!diag || 4 * g + (j) <= q)
    __syncthreads();
    {
        float lo = 3.0e38f, hi = -3.0e38f;
        SEL_PASS({
            _Pragma("unroll") for (int j = 0; j < 4; ++j) if (SEL_OK(j)) { lo = fminf(lo, sc[j]); hi = fmaxf(hi, sc[j]); }
        });
        lo = fminf(lo, shx(lo, 16)); lo = fminf(lo, shx(lo, 32));
        hi = fmaxf(hi, shx(hi, 16)); hi = fmaxf(hi, shx(hi, 32));
        if (g == 0) { atomicMin(&mn[q], f2sort(lo)); atomicMax(&mx[q], f2sort(hi)); }
    }
    __syncthreads();
    const float rlo = sort2f(mn[q]), rhi = sort2f(mx[q]);
    const float rscale = rhi > rlo ? 256.0f / (rhi - rlo) : 0.f;
    SEL_PASS({
        _Pragma("unroll") for (int j = 0; j < 4; ++j) if (SEL_OK(j)) {
            int b = (int)((sc[j] - rlo) * rscale); b = b > 255 ? 255 : (b < 0 ? 0 : b);
            atomicAdd(&hist[q * 256 + b], 1u);
        }
    });
    __syncthreads();
    {
        const int row = tid >> 5, i = tid & 31;
        unsigned c8[8]; unsigned tot = 0;
#pragma unroll
        for (int k = 0; k < 8; ++k) { c8[k] = hist[row * 256 + i * 8 + k]; tot += c8[k]; }
        unsigned above = 0;
        {
            unsigned run = tot;
#pragma unroll
            for (int o = 1; o < 32; o <<= 1) { const int l_ = tid & 63; unsigned v = (unsigned)__builtin_amdgcn_ds_bpermute(((l_ + o) & 63) << 2, (int)run); if (i + o < 32) run += v; }
            above = run - tot;
        }
        const int trow = t0 + row; const unsigned need = trow + 1 < 256 ? trow + 1 : 256;
        if (above < need && above + tot >= need) {
            unsigned a = above;
#pragma unroll
            for (int k = 7; k >= 0; --k) { if (a < need && a + c8[k] >= need) { bsel[row] = i * 8 + k; needp[row] = (int)(need - a); } a += c8[k]; }
        }
    }
    __syncthreads();
    const int bstar = bsel[q];
    SEL_PASS({
        unsigned nib = 0;
        _Pragma("unroll") for (int j = 0; j < 4; ++j) if (SEL_OK(j)) {
            int b = (int)((sc[j] - rlo) * rscale); b = b > 255 ? 255 : (b < 0 ? 0 : b);
            if (b > bstar) nib |= 1u << j;
            else if (b == bstar) { int pos = atomicAdd(&cnt[q], 1); if (pos < SEL_CAP) { u32x2 e; e[0] = (unsigned)f2sort(sc[j]) ^ 0x80000000u; e[1] = ktc * 16 + 4 * g + j; list[q * SEL_CAP + pos] = e; } }
        }
        if (nib) atomicOr(&bits[q * 128 + (ktc >> 1)], nib << ((ktc & 1) * 16 + 4 * g));
    });
    __syncthreads();
    {
        const int row = tid >> 5, i = tid & 31;
        int n = cnt[row]; n = n < SEL_CAP ? n : SEL_CAP;
        const int need = needp[row];
        for (int a = i; a < n; a += 32) {
            const u32x2 ea = list[row * SEL_CAP + a];
            int rank = 0;
            for (int b = 0; b < n; ++b) { const u32x2 eb = list[row * SEL_CAP + b]; rank += (eb[0] > ea[0]) || (eb[0] == ea[0] && eb[1] < ea[1]); }
            if (rank < need) atomicOr(&bits[row * 128 + (ea[1] >> 5)], 1u << (ea[1] & 31));
        }
    }
    __syncthreads();
    unsigned* mask = (unsigned*)(ws + OFF_MASK) + ((size_t)bl * S + t0) * 128;
    for (int i = tid; i < 16 * 128; i += NTHREADS) mask[i] = bits[i];
}

DI void kmean_item(const Params& p, int bl, int h, int n, char* shm) {
    char* ws = p.ws;
    const bf16_t* K = (const bf16_t*)(ws + OFF_KC) + ((size_t)(bl * 8 + h) * 128 + n * 8) * 2048;
    float* red = (float*)shm;
    const int tid = ltid(), c = tid & 255, par = tid >> 8;
    float acc[8] = {0.f, 0.f, 0.f, 0.f, 0.f, 0.f, 0.f, 0.f};
#pragma unroll
    for (int it = 0; it < 4; ++it) {
        const u32x4 v = *(const u32x4*)(K + (size_t)(it * 2 + par) * 2048 + c * 8);
#pragma unroll
        for (int e = 0; e < 4; ++e) { acc[2 * e] += __uint_as_float(v[e] << 16); acc[2 * e + 1] += __uint_as_float(v[e] & 0xffff0000u); }
    }
    __syncthreads();
#pragma unroll
    for (int e = 0; e < 8; ++e) red[(par * 256 + c) * 8 + e] = acc[e];
    __syncthreads();
    if (tid < 64) {
        const int grp = tid >> 3, e = tid & 7;
        float t = 0.f;
        for (int pr = 0; pr < 2; ++pr) for (int r = 0; r < 32; ++r) t += red[(pr * 256 + grp * 32 + r) * 8 + e];
        t *= (1.0f / 256);
        bf16_t hi = f2bf(t); bf16_t lo = f2bf(t - bf2f(hi));
        bf16_t* km = (bf16_t*)(ws + OFF_KM) + (((size_t)(bl * 8 + h) * 16 + n) * 2) * 64;
        km[tid] = hi; km[64 + tid] = lo;
    }
}

struct AttnAcc { f32x16 o0, o1; float nb, l; bool shifted; };
DI void attn_init(AttnAcc& a, float nb) {
    float z = 0.f; asm volatile("" : "+v"(z));
#pragma unroll
    for (int i = 0; i < 16; ++i) { a.o0[i] = z; a.o1[i] = z; }
    a.shifted = __ballot(nb > 90.f) != 0ull;
    a.nb = a.shifted ? nb + z : z; a.l = z;
}
DI float attn_bound(const bf16x8 (&qf)[4], const float* gk) {
    float qs = 0.f;
#pragma unroll
    for (int kk = 0; kk < 4; ++kk)
#pragma unroll
        for (int e = 0; e < 8; ++e) { const float v = bf2f((bf16_t)qf[kk][e]); qs += v * v; }
    qs += shx(qs, 32);
    float gm = fabsf(gk[ltid() & 63]);
    for (int o = 32; o > 0; o >>= 1) gm = fmaxf(gm, shx(gm, o));
    return sqrtf(qs) * gm * 8.1f;
}
struct KVFrag { bf16x8 k[4]; bf16x8 v[2][2]; };
DI void kv_load(KVFrag& f, const bf16_t* Kt, const bf16_t* Vt, int lane) {
#pragma unroll
    for (int kk = 0; kk < 4; ++kk) f.k[kk] = *(const bf16x8*)(Kt + (kk * 64 + lane) * 8);
#pragma unroll
    for (int db = 0; db < 2; ++db)
#pragma unroll
        for (int u = 0; u < 2; ++u) f.v[db][u] = *(const bf16x8*)(Vt + ((db * 2 + u) * 64 + lane) * 8);
}
DI void attn_step(AttnAcc& a, const KVFrag& f, const bf16x8 (&qf)[4], unsigned vm) {
    f32x16 st;
    if (a.shifted) {
#pragma unroll
        for (int i = 0; i < 16; ++i) st[i] = -a.nb;
        st = MFMA32(f.k[0], qf[0], st);
    } else {
        st = MFMA32(f.k[0], qf[0], ((f32x16){0.f, 0.f, 0.f, 0.f, 0.f, 0.f, 0.f, 0.f, 0.f, 0.f, 0.f, 0.f, 0.f, 0.f, 0.f, 0.f}));
    }
#pragma unroll
    for (int kk = 1; kk < 4; ++kk) st = MFMA32(f.k[kk], qf[kk], st);
    float pv[16];
#pragma unroll
    for (int i = 0; i < 16; ++i) pv[i] = fexp2(st[i]);
    if (__ballot(vm != 0xffffu) != 0ull) {
#pragma unroll
        for (int i = 0; i < 16; ++i) pv[i] = __int_as_float(__float_as_int(pv[i]) & __builtin_amdgcn_sbfe((int)vm, i, 1));
    }
    a.l += ((pv[0] + pv[1]) + (pv[2] + pv[3])) + ((pv[4] + pv[5]) + (pv[6] + pv[7])) + (((pv[8] + pv[9]) + (pv[10] + pv[11])) + ((pv[12] + pv[13]) + (pv[14] + pv[15])));
    u32x4 p0, p1;
#pragma unroll
    for (int i = 0; i < 4; ++i) { p0[i] = cvt_pk_bf16(pv[2 * i], pv[2 * i + 1]); p1[i] = cvt_pk_bf16(pv[8 + 2 * i], pv[8 + 2 * i + 1]); }
    const bf16x8 pf0 = __builtin_bit_cast(bf16x8, p0), pf1 = __builtin_bit_cast(bf16x8, p1);
    a.o0 = MFMA32(f.v[0][0], pf0, a.o0); a.o0 = MFMA32(f.v[0][1], pf1, a.o0);
    a.o1 = MFMA32(f.v[1][0], pf0, a.o1); a.o1 = MFMA32(f.v[1][1], pf1, a.o1);
}
DI void load_q(bf16x8 (&qf)[4], const bf16_t* Qrow, int h) {
#pragma unroll
    for (int kk = 0; kk < 4; ++kk) qf[kk] = *(const bf16x8*)(Qrow + kk * 16 + h * 8);
}
DI int koff(int i, int h) { return 8 * (i >> 2) + 4 * h + (i & 3); }

DI void attn_a_item(const Params& p, int layer, int bl, int hh, int rb) {
    char* ws = p.ws;
    const int lane = ltid() & 63, w = __builtin_amdgcn_readfirstlane(ltid() >> 6), r = lane & 31, h = lane >> 5;
    const int g = hh >> 3, sh = 2 * g, n = S >> sh;
    const int row0 = rb * 256 + w * 32;
    const int rr = row0 / n, m0 = row0 % n;
    const bf16_t* Q = (const bf16_t*)(ws + OFF_QA) + (size_t)(bl * 24 + hh) * S * 64;
    const bf16_t* K = (const bf16_t*)(ws + OFF_KA) + (size_t)(bl * 24 + hh) * S * 64;
    const bf16_t* Vt = (const bf16_t*)(ws + OFF_VA) + (size_t)(bl * 24 + hh) * 64 * S;
    bf16x8 qf[4]; load_q(qf, Q + (size_t)(row0 + r) * 64, h);
    AttnAcc a; attn_init(a, attn_bound(qf, p.qk_g + ((size_t)(layer * 3 + 0) * 2 + 1) * 64));
    const int kfirst = m0 >= 128 ? 0 : (128 - m0) / 32;
    const int tile0 = (rr * n + m0 - 128) / 32 + 0;
    auto amask = [&](int k) -> unsigned {
        if (k != 0 && k != 4) return 0xffffu;
        const int mk0 = m0 - 128 + 32 * k; unsigned vm = 0;
#pragma unroll
        for (int i = 0; i < 16; ++i) { const int d = (m0 + r) - (mk0 + koff(i, h)); if (d >= 0 && d <= 128) vm |= 1u << i; }
        return vm;
    };
    KVFrag f0, f1; kv_load(f0, K + (size_t)(tile0 + kfirst) * 2048, Vt + (size_t)(tile0 + kfirst) * 2048, lane);
    for (int k = kfirst; k < 5; k += 2) {
        { const int kn = k + 1 < 5 ? k + 1 : k; kv_load(f1, K + (size_t)(tile0 + kn) * 2048, Vt + (size_t)(tile0 + kn) * 2048, lane); }
        attn_step(a, f0, qf, amask(k));
        if (k + 1 < 5) {
            { const int kn = k + 2 < 5 ? k + 2 : k + 1; kv_load(f0, K + (size_t)(tile0 + kn) * 2048, Vt + (size_t)(tile0 + kn) * 2048, lane); }
            attn_step(a, f1, qf, amask(k + 1));
        }
    }
    const float l = a.l + shx(a.l, 32);
    const float inv = 1.0f / l;
    const int s = ((m0 + r) << sh) + rr;
    const size_t tl = (size_t)bl * S + s;
    bf16_t* o = (bf16_t*)(ws + OFF_OA) + ((size_t)g * TG + tl) * 512 + (hh & 7) * 64;
#pragma unroll
    for (int q4 = 0; q4 < 4; ++q4) {
        u32x2 w0, w1;
        w0[0] = cvt_pk_bf16(a.o0[q4 * 4] * inv, a.o0[q4 * 4 + 1] * inv); w0[1] = cvt_pk_bf16(a.o0[q4 * 4 + 2] * inv, a.o0[q4 * 4 + 3] * inv);
        w1[0] = cvt_pk_bf16(a.o1[q4 * 4] * inv, a.o1[q4 * 4 + 1] * inv); w1[1] = cvt_pk_bf16(a.o1[q4 * 4 + 2] * inv, a.o1[q4 * 4 + 3] * inv);
        *(u32x2*)(o + 8 * q4 + 4 * h) = w0; *(u32x2*)(o + 32 + 8 * q4 + 4 * h) = w1;
    }
    if (h == 0) ((float*)(ws + OFF_LSE))[((size_t)g * TG + tl) * 8 + (hh & 7)] = (a.nb + __log2f(l)) * LN2F;
}

DI void attn_store_gated(const Params& p, const AttnAcc& a, size_t tl, int col0, int h, bool st) {
    const float l = a.l + shx(a.l, 32);
    const float inv = 1.0f / l;
    bf16_t* z = (bf16_t*)(p.ws + OFF_SZ) + tl * 1536 + col0;
#pragma unroll
    for (int q4 = 0; q4 < 4; ++q4) {
#pragma unroll
        for (int db = 0; db < 2; ++db) {
            bf16_t* zp = z + db * 32 + 8 * q4 + 4 * h;
            const u32x2 zw = *(const u32x2*)zp;
            const float z0 = __uint_as_float(zw[0] << 16), z1 = __uint_as_float(zw[0] & 0xffff0000u), z2 = __uint_as_float(zw[1] << 16), z3 = __uint_as_float(zw[1] & 0xffff0000u);
            const f32x16& o = db ? a.o1 : a.o0;
            u32x2 wv; wv[0] = cvt_pk_bf16(o[q4 * 4] * inv * z0, o[q4 * 4 + 1] * inv * z1); wv[1] = cvt_pk_bf16(o[q4 * 4 + 2] * inv * z2, o[q4 * 4 + 3] * inv * z3);
            if (st) *(u32x2*)zp = wv;
        }
    }
}

DI void attn_b_item(const Params& p, int layer, int bl, int hd, int qb, bool st, int var) {
    char* ws = p.ws;
    const int lane = ltid() & 63, w = __builtin_amdgcn_readfirstlane(ltid() >> 6), r = lane & 31, h = lane >> 5;
    const int q0 = qb * 256 + w * 32;
    const bf16_t* Q = (const bf16_t*)(ws + OFF_QB) + (size_t)(bl * 8 + hd) * S * 64;
    const bf16_t* K = (const bf16_t*)(ws + OFF_KB) + (size_t)(bl * 8 + hd) * S * 64;
    const bf16_t* Vt = (const bf16_t*)(ws + OFF_VB) + (size_t)(bl * 8 + hd) * 64 * S;
    const unsigned* mrow = (const unsigned*)(ws + OFF_MASK) + ((size_t)bl * S + q0 + r) * 128;
    bf16x8 qf[4]; load_q(qf, Q + (size_t)(q0 + r) * 64, h);
    AttnAcc a; attn_init(a, attn_bound(qf, p.qk_g + ((size_t)(layer * 3 + 1) * 2 + 1) * 64));
    const int nkt = q0 / 32 + 1;
    auto bmask = [&](unsigned mw) -> unsigned {
        const unsigned ws4 = mw >> (4 * h);
        return (ws4 & 0xfu) | ((ws4 >> 4) & 0xf0u) | ((ws4 >> 8) & 0xf00u) | ((ws4 >> 12) & 0xf000u);
    };
    KVFrag f0, f1; kv_load(f0, K, Vt, lane);
    unsigned mw0 = mrow[0], mw1 = 0;
    const int tmul = var == 1 ? 0 : 1;
    for (int kt = 0; kt < nkt; kt += 2) {
        { const int kn = (kt + 1 < nkt ? kt + 1 : kt) * tmul; kv_load(f1, K + (size_t)kn * 2048, Vt + (size_t)kn * 2048, lane); mw1 = mrow[kn]; }
        if (var == 2) a.l += __int_as_float((int)f0.k[0][0] + (int)f0.k[3][7] + (int)f0.v[0][0][0] + (int)f0.v[1][1][7] + (int)mw0); else
        attn_step(a, f0, qf, bmask(mw0));
        if (kt + 1 < nkt) {
            { const int kn = (kt + 2 < nkt ? kt + 2 : kt + 1) * tmul; kv_load(f0, K + (size_t)kn * 2048, Vt + (size_t)kn * 2048, lane); mw0 = mrow[kn]; }
            if (var == 2) a.l += __int_as_float((int)f1.k[0][0] + (int)f1.k[3][7] + (int)f1.v[0][0][0] + (int)f1.v[1][1][7] + (int)mw1); else
            attn_step(a, f1, qf, bmask(mw1));
        }
    }
    attn_store_gated(p, a, (size_t)bl * S + q0 + r, 512 + hd * 64, h, st);
}

DI void attn_c_item(const Params& p, int layer, int bl, int hd, int qb, bool st) {
    char* ws = p.ws;
    const int lane = ltid() & 63, w = __builtin_amdgcn_readfirstlane(ltid() >> 6), r = lane & 31, h = lane >> 5;
    const int q0 = qb * 256 + w * 32, own = qb;
    const bf16_t* Q = (const bf16_t*)(ws + OFF_QC) + (size_t)(bl * 8 + hd) * S * 64;
    const bf16_t* K = (const bf16_t*)(ws + OFF_KC) + (size_t)(bl * 8 + hd) * S * 64;
    const bf16_t* Vt = (const bf16_t*)(ws + OFF_VC) + (size_t)(bl * 8 + hd) * 64 * S;
    bf16x8 qf[4]; load_q(qf, Q + (size_t)(q0 + r) * 64, h);
    unsigned sel = 0;
    if (own > 0) {
        const bf16_t* km = (const bf16_t*)(ws + OFF_KM) + (((size_t)(bl * 8 + hd) * 16 + (r & 15)) * 2) * 64;
        f32x16 gt;
#pragma unroll
        for (int i = 0; i < 16; ++i) gt[i] = 0.f;
#pragma unroll
        for (int kk = 0; kk < 4; ++kk) {
            bf16x8 ahi = *(const bf16x8*)(km + kk * 16 + h * 8), alo = *(const bf16x8*)(km + 64 + kk * 16 + h * 8);
            if (r >= 16) { ahi = (bf16x8){0, 0, 0, 0, 0, 0, 0, 0}; alo = ahi; }
            gt = MFMA32(ahi, qf[kk], gt); gt = MFMA32(alo, qf[kk], gt);
        }
        float gl[16];
#pragma unroll
        for (int i = 0; i < 8; ++i) {
            const float mine = gt[i], oth = shx(mine, 32);
            const int blk_mine = 8 * (i >> 2) + 4 * h + (i & 3), blk_oth = 8 * (i >> 2) + 4 * (1 - h) + (i & 3);
            (void)blk_mine; (void)blk_oth;
            gl[8 * (i >> 2) + (i & 3)] = h == 0 ? mine : oth;
            gl[8 * (i >> 2) + 4 + (i & 3)] = h == 0 ? oth : mine;
        }
#pragma unroll
        for (int pick = 0; pick < 3; ++pick) {
            float best = -3.0e38f; int bi = -1;
#pragma unroll
            for (int nb = 0; nb < 16; ++nb) { const bool ok = nb < own && !((sel >> nb) & 1u); if (ok && gl[nb] > best) { best = gl[nb]; bi = nb; } }
            if (bi >= 0) sel |= 1u << bi;
        }
    }
    AttnAcc a; attn_init(a, attn_bound(qf, p.qk_g + ((size_t)(layer * 3 + 2) * 2 + 1) * 64));
    unsigned vis = 0;
    for (int nb = 0; nb < own; ++nb) if (__ballot((sel >> nb) & 1u) != 0ull) vis |= 1u << nb;
    const int ndiag = q0 / 32;
    unsigned long long tm0 = 0ull, tm1 = 0ull;
    for (int nb = 0; nb < own; ++nb) if ((vis >> nb) & 1u) { if (nb < 8) tm0 |= 0xffull << (8 * nb); else tm1 |= 0xffull << (8 * (nb - 8)); }
    for (int t = own * 8; t <= ndiag; ++t) { if (t < 64) tm0 |= 1ull << t; else tm1 |= 1ull << (t - 64); }
    int ntl = __builtin_popcountll(tm0) + __builtin_popcountll(tm1);
    auto pop = [&]() -> int { int t; if (tm0) { t = __builtin_ctzll(tm0); tm0 &= tm0 - 1; } else if (tm1) { t = 64 + __builtin_ctzll(tm1); tm1 &= tm1 - 1; } else t = ndiag; return t; };
    auto cmask = [&](int t) -> unsigned {
        const int cb = t >> 3;
        if (cb < own) return ((sel >> cb) & 1u) ? 0xffffu : 0u;
        if (t != ndiag) return 0xffffu;
        unsigned vm = 0;
#pragma unroll
        for (int i = 0; i < 16; ++i) if (koff(i, h) <= r) vm |= 1u << i;
        return vm;
    };
    KVFrag f0, f1; int t0 = pop(), t1 = 0;
    kv_load(f0, K + (size_t)t0 * 2048, Vt + (size_t)t0 * 2048, lane);
    for (int it = 0; it < ntl; it += 2) {
        t1 = pop(); kv_load(f1, K + (size_t)t1 * 2048, Vt + (size_t)t1 * 2048, lane);
        attn_step(a, f0, qf, cmask(t0));
        if (it + 1 < ntl) {
            t0 = pop(); kv_load(f0, K + (size_t)t0 * 2048, Vt + (size_t)t0 * 2048, lane);
            attn_step(a, f1, qf, cmask(t1));
        }
    }
    attn_store_gated(p, a, (size_t)bl * S + q0 + r, 1024 + hd * 64, h, st);
}

DI void attn_bc_item(const Params& p, int layer, int typ, int bl, int hd, int qb, bool st, char* shm) {
    char* ws = p.ws;
    const int tid = ltid(), lane = tid & 63, w = tid >> 6, r = lane & 31, h = lane >> 5;
    const int q0 = qb * 256 + w * 32, own = qb, ndiag = q0 / 32;
    const bf16_t* Q = (const bf16_t*)(ws + (typ ? OFF_QC : OFF_QB)) + (size_t)(bl * 8 + hd) * S * 64;
    const bf16_t* K = (const bf16_t*)(ws + (typ ? OFF_KC : OFF_KB)) + (size_t)(bl * 8 + hd) * S * 64;
    const bf16_t* Vt = (const bf16_t*)(ws + (typ ? OFF_VC : OFF_VB)) + (size_t)(bl * 8 + hd) * 64 * S;
    const unsigned* mrow = (const unsigned*)(ws + OFF_MASK) + ((size_t)bl * S + q0 + r) * 128;
    unsigned short* seq = (unsigned short*)(shm + 16384);
    unsigned* wvis = (unsigned*)(shm + 16896);
    bf16x8 qf[4]; load_q(qf, Q + (size_t)(q0 + r) * 64, h);
    unsigned sel = 0, vis = 0;
    if (typ == 1 && own > 0) {
        const bf16_t* km = (const bf16_t*)(ws + OFF_KM) + (((size_t)(bl * 8 + hd) * 16 + (r & 15)) * 2) * 64;
        f32x16 gt;
#pragma unroll
        for (int i = 0; i < 16; ++i) gt[i] = 0.f;
#pragma unroll
        for (int kk = 0; kk < 4; ++kk) {
            bf16x8 ahi = *(const bf16x8*)(km + kk * 16 + h * 8), alo = *(const bf16x8*)(km + 64 + kk * 16 + h * 8);
            if (r >= 16) { ahi = (bf16x8){0, 0, 0, 0, 0, 0, 0, 0}; alo = ahi; }
            gt = MFMA32(ahi, qf[kk], gt); gt = MFMA32(alo, qf[kk], gt);
        }
        float gl[16];
#pragma unroll
        for (int i = 0; i < 8; ++i) {
            const float mine = gt[i], oth = shx(mine, 32);
            gl[8 * (i >> 2) + (i & 3)] = h == 0 ? mine : oth;
            gl[8 * (i >> 2) + 4 + (i & 3)] = h == 0 ? oth : mine;
        }
#pragma unroll
        for (int pick = 0; pick < 3; ++pick) {
            float best = -3.0e38f; int bi = -1;
#pragma unroll
            for (int nb = 0; nb < 16; ++nb) { const bool ok = nb < own && !((sel >> nb) & 1u); if (ok && gl[nb] > best) { best = gl[nb]; bi = nb; } }
            if (bi >= 0) sel |= 1u << bi;
        }
        for (int nb = 0; nb < own; ++nb) if (__ballot((sel >> nb) & 1u) != 0ull) vis |= 1u << nb;
    }
    if (typ == 0) vis = (1u << own) - 1u;
    __syncthreads();
    if (lane == 0) wvis[w] = vis;
    __syncthreads();
    if (tid == 0) {
        unsigned bv = 0;
        for (int i = 0; i < 8; ++i) bv |= wvis[i];
        int n = 0;
        for (int nb = 0; nb < own; ++nb) if ((bv >> nb) & 1u) for (int k = 0; k < 8; ++k) seq[n++] = (unsigned short)(nb * 8 + k);
        for (int k = 0; k < 8; ++k) seq[n++] = (unsigned short)(own * 8 + k);
        seq[255] = (unsigned short)n;
    }
    __syncthreads();
    const int ntl = seq[255];
    const bf16_t* gsrc = (tid < 256 ? K : Vt) + (size_t)(tid & 255) * 8;
    char* lds_dst = shm + tid * 16;
    u32x4 R = *(const u32x4*)(gsrc + (size_t)seq[0] * 2048);
    *(u32x4*)lds_dst = R;
    if (ntl > 1) R = *(const u32x4*)(gsrc + (size_t)seq[1] * 2048);
    AttnAcc a; attn_init(a, attn_bound(qf, p.qk_g + ((size_t)(layer * 3 + 1 + typ) * 2 + 1) * 64));
    unsigned mw = typ == 0 ? mrow[seq[0]] : 0u;
    __syncthreads();
    for (int t = 0; t < ntl; ++t) {
        const int ct = seq[t], cb = ct >> 3;
        unsigned mwn = 0;
        if (typ == 0 && t + 1 < ntl) mwn = mrow[seq[t + 1]];
        const bool need = cb < own ? ((vis >> cb) & 1u) != 0u : ct <= ndiag;
        if (need) {
            const char* buf = shm + (t & 1) * 8192;
            KVFrag f;
#pragma unroll
            for (int kk = 0; kk < 4; ++kk) f.k[kk] = *(const bf16x8*)(buf + (kk * 64 + lane) * 16);
#pragma unroll
            for (int db = 0; db < 2; ++db)
#pragma unroll
                for (int u = 0; u < 2; ++u) f.v[db][u] = *(const bf16x8*)(buf + 4096 + ((db * 2 + u) * 64 + lane) * 16);
            unsigned vm;
            if (typ == 0) {
                const unsigned ws4 = mw >> (4 * h);
                vm = (ws4 & 0xfu) | ((ws4 >> 4) & 0xf0u) | ((ws4 >> 8) & 0xf00u) | ((ws4 >> 12) & 0xf000u);
            } else if (cb < own) vm = ((sel >> cb) & 1u) ? 0xffffu : 0u;
            else if (ct == ndiag) {
                vm = 0;
#pragma unroll
                for (int i = 0; i < 16; ++i) if (koff(i, h) <= r) vm |= 1u << i;
            } else vm = 0xffffu;
            attn_step(a, f, qf, vm);
        }
        if (t + 1 < ntl) {
            *(u32x4*)(lds_dst + ((t + 1) & 1) * 8192) = R;
            if (t + 2 < ntl) R = *(const u32x4*)(gsrc + (size_t)seq[t + 2] * 2048);
        }
        mw = mwn;
        __syncthreads();
    }
    attn_store_gated(p, a, (size_t)bl * S + q0 + r, (typ ? 1024 : 512) + hd * 64, h, st);
}

template <int TYP>
DI void attn_step2(AttnAcc& a0, AttnAcc& a1, KVFrag& f, const bf16x8 (&qa)[4], const bf16x8 (&qb)[4], unsigned vm0, unsigned vm1, bool shifted, const bf16_t* Kn, const bf16_t* Vn, int lane) {
    f32x16 s0, s1;
    __builtin_amdgcn_s_setprio(1);
    if (shifted) {
#pragma unroll
        for (int i = 0; i < 16; ++i) { s0[i] = -a0.nb; s1[i] = -a1.nb; }
        s0 = MFMA32(f.k[0], qa[0], s0); s1 = MFMA32(f.k[0], qb[0], s1);
    } else {
        const f32x16 z = {0.f, 0.f, 0.f, 0.f, 0.f, 0.f, 0.f, 0.f, 0.f, 0.f, 0.f, 0.f, 0.f, 0.f, 0.f, 0.f};
        s0 = MFMA32(f.k[0], qa[0], z); s1 = MFMA32(f.k[0], qb[0], z);
    }
#pragma unroll
    for (int kk = 1; kk < 4; ++kk) { s0 = MFMA32(f.k[kk], qa[kk], s0); s1 = MFMA32(f.k[kk], qb[kk], s1); }
    __builtin_amdgcn_s_setprio(0);
#pragma unroll
    for (int kk = 0; kk < 4; ++kk) f.k[kk] = *(const bf16x8*)(Kn + (kk * 64 + lane) * 8);
    float p0[16], p1[16];
#pragma unroll
    for (int i = 0; i < 16; ++i) { p0[i] = fexp2(s0[i]); p1[i] = fexp2(s1[i]); }
    if (TYP == 0 || __ballot((vm0 & vm1) != 0xffffu) != 0ull) {
#pragma unroll
        for (int i = 0; i < 16; ++i) {
            p0[i] = __int_as_float(__float_as_int(p0[i]) & __builtin_amdgcn_sbfe((int)vm0, i, 1));
            p1[i] = __int_as_float(__float_as_int(p1[i]) & __builtin_amdgcn_sbfe((int)vm1, i, 1));
        }
    }
    a0.l += ((p0[0] + p0[1]) + (p0[2] + p0[3])) + ((p0[4] + p0[5]) + (p0[6] + p0[7])) + (((p0[8] + p0[9]) + (p0[10] + p0[11])) + ((p0[12] + p0[13]) + (p0[14] + p0[15])));
    a1.l += ((p1[0] + p1[1]) + (p1[2] + p1[3])) + ((p1[4] + p1[5]) + (p1[6] + p1[7])) + (((p1[8] + p1[9]) + (p1[10] + p1[11])) + ((p1[12] + p1[13]) + (p1[14] + p1[15])));
    u32x4 w00, w01, w10, w11;
#pragma unroll
    for (int i = 0; i < 4; ++i) {
        w00[i] = cvt_pk_bf16(p0[2 * i], p0[2 * i + 1]); w01[i] = cvt_pk_bf16(p0[8 + 2 * i], p0[8 + 2 * i + 1]);
        w10[i] = cvt_pk_bf16(p1[2 * i], p1[2 * i + 1]); w11[i] = cvt_pk_bf16(p1[8 + 2 * i], p1[8 + 2 * i + 1]);
    }
    const bf16x8 f00 = __builtin_bit_cast(bf16x8, w00), f01 = __builtin_bit_cast(bf16x8, w01), f10 = __builtin_bit_cast(bf16x8, w10), f11 = __builtin_bit_cast(bf16x8, w11);
    __builtin_amdgcn_s_setprio(1);
    a0.o0 = MFMA32(f.v[0][0], f00, a0.o0); a1.o0 = MFMA32(f.v[0][0], f10, a1.o0);
    a0.o0 = MFMA32(f.v[0][1], f01, a0.o0); a1.o0 = MFMA32(f.v[0][1], f11, a1.o0);
    a0.o1 = MFMA32(f.v[1][0], f00, a0.o1); a1.o1 = MFMA32(f.v[1][0], f10, a1.o1);
    a0.o1 = MFMA32(f.v[1][1], f01, a0.o1); a1.o1 = MFMA32(f.v[1][1], f11, a1.o1);
    __builtin_amdgcn_s_setprio(0);
#pragma unroll
    for (int db = 0; db < 2; ++db)
#pragma unroll
        for (int u = 0; u < 2; ++u) f.v[db][u] = *(const bf16x8*)(Vn + ((db * 2 + u) * 64 + lane) * 8);
}
template <int TYP>
DI void attn_bc2_chunk(const Params& p, int layer, int bl, int hd, int cidx  , bool st) {
    char* ws = p.ws;
    const int lane = ltid() & 63, w = __builtin_amdgcn_readfirstlane(ltid() >> 6), r = lane & 31, h = lane >> 5;
    const int own = cidx >> 2, q0 = cidx * 64;
    const bf16_t* Q = (const bf16_t*)(ws + (TYP ? OFF_QC : OFF_QB)) + (size_t)(bl * 8 + hd) * S * 64;
    const bf16_t* K = (const bf16_t*)(ws + (TYP ? OFF_KC : OFF_KB)) + (size_t)(bl * 8 + hd) * S * 64;
    const bf16_t* Vt = (const bf16_t*)(ws + (TYP ? OFF_VC : OFF_VB)) + (size_t)(bl * 8 + hd) * 64 * S;
    const unsigned* mrow0 = (const unsigned*)(ws + OFF_MASK) + ((size_t)bl * S + q0 + r) * 128;
    const unsigned* mrow1 = mrow0 + 32 * 128;
    bf16x8 qa[4], qb[4];
    load_q(qa, Q + (size_t)(q0 + r) * 64, h); load_q(qb, Q + (size_t)(q0 + 32 + r) * 64, h);
    const float* gk = p.qk_g + ((size_t)(layer * 3 + 1 + TYP) * 2 + 1) * 64;
    AttnAcc a0, a1; attn_init(a0, attn_bound(qa, gk)); attn_init(a1, attn_bound(qb, gk));
    const bool shifted = a0.shifted || a1.shifted;
    if (shifted && !a0.shifted) a0.nb = 0.f;
    if (shifted && !a1.shifted) a1.nb = 0.f;
    const int d0 = q0 / 32, d1 = d0 + 1;
    unsigned sel0 = 0, sel1 = 0;
    unsigned long long tm0 = 0ull, tm1 = 0ull;
    if (TYP == 1) {
        if (own > 0) {
            const bf16_t* km = (const bf16_t*)(ws + OFF_KM) + (((size_t)(bl * 8 + hd) * 16 + (r & 15)) * 2) * 64;
            f32x16 g0, g1;
#pragma unroll
            for (int i = 0; i < 16; ++i) { g0[i] = 0.f; g1[i] = 0.f; }
#pragma unroll
            for (int kk = 0; kk < 4; ++kk) {
                bf16x8 ahi = *(const bf16x8*)(km + kk * 16 + h * 8), alo = *(const bf16x8*)(km + 64 + kk * 16 + h * 8);
                if (r >= 16) { ahi = (bf16x8){0, 0, 0, 0, 0, 0, 0, 0}; alo = ahi; }
                g0 = MFMA32(ahi, qa[kk], g0); g0 = MFMA32(alo, qa[kk], g0);
                g1 = MFMA32(ahi, qb[kk], g1); g1 = MFMA32(alo, qb[kk], g1);
            }
            auto top3 = [&](const f32x16& gt) -> unsigned {
                float gl[16];
#pragma unroll
                for (int i = 0; i < 8; ++i) {
                    const float mine = gt[i], oth = shx(mine, 32);
                    gl[8 * (i >> 2) + (i & 3)] = h == 0 ? mine : oth;
                    gl[8 * (i >> 2) + 4 + (i & 3)] = h == 0 ? oth : mine;
                }
                unsigned sel = 0;
#pragma unroll
                for (int pick = 0; pick < 3; ++pick) {
                    float best = -3.0e38f; int bi = -1;
#pragma unroll
                    for (int nb = 0; nb < 16; ++nb) { const bool ok = nb < own && !((sel >> nb) & 1u); if (ok && gl[nb] > best) { best = gl[nb]; bi = nb; } }
                    if (bi >= 0) sel |= 1u << bi;
                }
                return sel;
            };
            sel0 = top3(g0); sel1 = top3(g1);
        }
        for (int nb = 0; nb < own; ++nb) if (__ballot(((sel0 | sel1) >> nb) & 1u) != 0ull) { if (nb < 8) tm0 |= 0xffull << (8 * nb); else tm1 |= 0xffull << (8 * (nb - 8)); }
        for (int t = own * 8; t <= d1; ++t) { if (t < 64) tm0 |= 1ull << t; else tm1 |= 1ull << (t - 64); }
    } else {
        for (int t = 0; t <= d1; ++t) { if (t < 64) tm0 |= 1ull << t; else tm1 |= 1ull << (t - 64); }
    }
    const int ntl = __builtin_popcountll(tm0) + __builtin_popcountll(tm1);
    auto pop = [&]() -> int { int t; if (tm0) { t = __builtin_ctzll(tm0); tm0 &= tm0 - 1; } else if (tm1) { t = 64 + __builtin_ctzll(tm1); tm1 &= tm1 - 1; } else t = d1; return t; };
    auto cmask = [&](int t, unsigned sel, int dg) -> unsigned {
        const int cb = t >> 3;
        if (cb < own) return ((sel >> cb) & 1u) ? 0xffffu : 0u;
        if (t < dg) return 0xffffu;
        if (t > dg) return 0u;
        unsigned vm = 0;
#pragma unroll
        for (int i = 0; i < 16; ++i) if (koff(i, h) <= r) vm |= 1u << i;
        return vm;
    };
    auto bmask = [&](unsigned mw) -> unsigned {
        const unsigned ws4 = mw >> (4 * h);
        return (ws4 & 0xfu) | ((ws4 >> 4) & 0xf0u) | ((ws4 >> 8) & 0xf00u) | ((ws4 >> 12) & 0xf000u);
    };
    KVFrag f; int tc = pop(), tn = 0;
    kv_load(f, K + (size_t)tc * 2048, Vt + (size_t)tc * 2048, lane);
    unsigned mwa = 0, mwb = 0, mwan = 0, mwbn = 0;
    if (TYP == 0) { mwa = mrow0[tc]; mwb = mrow1[tc]; }
    for (int it = 0; it < ntl; ++it) {
        tn = pop();
        if (TYP == 0) { mwan = mrow0[tn]; mwbn = mrow1[tn]; }
        unsigned vm0, vm1;
        if (TYP == 0) { vm0 = bmask(mwa); vm1 = bmask(mwb); } else { vm0 = cmask(tc, sel0, d0); vm1 = cmask(tc, sel1, d1); }
        attn_step2<TYP>(a0, a1, f, qa, qb, vm0, vm1, shifted, K + (size_t)tn * 2048, Vt + (size_t)tn * 2048, lane);
        tc = tn; mwa = mwan; mwb = mwbn;
    }
    attn_store_gated(p, a0, (size_t)bl * S + q0 + r, (TYP ? 1024 : 512) + hd * 64, h, st);
    attn_store_gated(p, a1, (size_t)bl * S + q0 + 32 + r, (TYP ? 1024 : 512) + hd * 64, h, st);
}

DI void attn_a2_item(const Params& p, int layer, int bl, int hh, int rb2) {
    char* ws = p.ws;
    const int lane = ltid() & 63, w = __builtin_amdgcn_readfirstlane(ltid() >> 6), r = lane & 31, h = lane >> 5;
    const int g = hh >> 3, sh = 2 * g, n = S >> sh;
    const int row0 = rb2 * 512 + w * 64;
    const int rr = row0 / n, m0 = row0 % n;
    const bf16_t* Q = (const bf16_t*)(ws + OFF_QA) + (size_t)(bl * 24 + hh) * S * 64;
    const bf16_t* K = (const bf16_t*)(ws + OFF_KA) + (size_t)(bl * 24 + hh) * S * 64;
    const bf16_t* Vt = (const bf16_t*)(ws + OFF_VA) + (size_t)(bl * 24 + hh) * 64 * S;
    bf16x8 qa[4], qb[4];
    load_q(qa, Q + (size_t)(row0 + r) * 64, h); load_q(qb, Q + (size_t)(row0 + 32 + r) * 64, h);
    const float* gk = p.qk_g + ((size_t)(layer * 3 + 0) * 2 + 1) * 64;
    AttnAcc a0, a1; attn_init(a0, attn_bound(qa, gk)); attn_init(a1, attn_bound(qb, gk));
    const bool shifted = a0.shifted || a1.shifted;
    if (shifted && !a0.shifted) a0.nb = 0.f;
    if (shifted && !a1.shifted) a1.nb = 0.f;
    const int kfirst = m0 >= 128 ? 0 : (128 - m0) / 32;
    const int tile0 = (rr * n + m0 - 128) / 32;
    auto amask = [&](int k, int sb) -> unsigned {
        const int base = 128 + 32 * sb - 32 * k + r;
        if (base - 31 >= 0 && base <= 128) return 0xffffu;
        if (base < 0 || base - 31 > 128) return 0u;
        unsigned vm = 0;
#pragma unroll
        for (int i = 0; i < 16; ++i) { const int d = base - koff(i, h); if (d >= 0 && d <= 128) vm |= 1u << i; }
        return vm;
    };
    KVFrag f; kv_load(f, K + (size_t)(tile0 + kfirst) * 2048, Vt + (size_t)(tile0 + kfirst) * 2048, lane);
    for (int k = kfirst; k < 6; ++k) {
        const int kn = k + 1 < 6 ? k + 1 : k;
        attn_step2<1>(a0, a1, f, qa, qb, amask(k, 0), amask(k, 1), shifted, K + (size_t)(tile0 + kn) * 2048, Vt + (size_t)(tile0 + kn) * 2048, lane);
    }
#pragma unroll
    for (int sb = 0; sb < 2; ++sb) {
        const AttnAcc& a = sb ? a1 : a0;
        const float l = a.l + shx(a.l, 32);
        const float inv = 1.0f / l;
        const int s_ = ((m0 + 32 * sb + r) << sh) + rr;
        const size_t tl = (size_t)bl * S + s_;
        bf16_t* o = (bf16_t*)(ws + OFF_OA) + ((size_t)g * TG + tl) * 512 + (hh & 7) * 64;
#pragma unroll
        for (int q4 = 0; q4 < 4; ++q4) {
            u32x2 w0, w1;
            w0[0] = cvt_pk_bf16(a.o0[q4 * 4] * inv, a.o0[q4 * 4 + 1] * inv); w0[1] = cvt_pk_bf16(a.o0[q4 * 4 + 2] * inv, a.o0[q4 * 4 + 3] * inv);
            w1[0] = cvt_pk_bf16(a.o1[q4 * 4] * inv, a.o1[q4 * 4 + 1] * inv); w1[1] = cvt_pk_bf16(a.o1[q4 * 4 + 2] * inv, a.o1[q4 * 4 + 3] * inv);
            *(u32x2*)(o + 8 * q4 + 4 * h) = w0; *(u32x2*)(o + 32 + 8 * q4 + 4 * h) = w1;
        }
        if (h == 0) ((float*)(ws + OFF_LSE))[((size_t)g * TG + tl) * 8 + (hh & 7)] = (a.nb + __log2f(l)) * LN2F;
    }
}

DI void merge_a_item(const Params& p, int item, bool st) {
    char* ws = p.ws;
    const int tid = ltid();
    const bf16_t* oa = (const bf16_t*)(ws + OFF_OA);
    const float* lse = (const float*)(ws + OFF_LSE);
    bf16_t* sz = (bf16_t*)(ws + OFF_SZ);
    for (int it = 0; it < 8; ++it) {
        const size_t tl = (size_t)item * 64 + it * 8 + (tid >> 6);
        const int c8 = (tid & 63) * 8, hd = c8 >> 6;
        const float l0 = lse[(0 * (size_t)TG + tl) * 8 + hd], l1 = lse[(1 * (size_t)TG + tl) * 8 + hd], l2 = lse[(2 * (size_t)TG + tl) * 8 + hd];
        const float mx = fmaxf(l0, fmaxf(l1, l2));
        float w0 = __expf(l0 - mx), w1 = __expf(l1 - mx), w2 = __expf(l2 - mx);
        const float inv = 1.0f / (w0 + w1 + w2); w0 *= inv; w1 *= inv; w2 *= inv;
        const u32x4 a0 = *(const u32x4*)(oa + (0 * (size_t)TG + tl) * 512 + c8), a1 = *(const u32x4*)(oa + (1 * (size_t)TG + tl) * 512 + c8), a2 = *(const u32x4*)(oa + (2 * (size_t)TG + tl) * 512 + c8);
        const u32x4 zz = *(const u32x4*)(sz + tl * 1536 + c8);
        u32x4 res;
#pragma unroll
        for (int k = 0; k < 4; ++k) {
            const float lo = (w0 * __uint_as_float(a0[k] << 16) + w1 * __uint_as_float(a1[k] << 16) + w2 * __uint_as_float(a2[k] << 16)) * __uint_as_float(zz[k] << 16);
            const float hi = (w0 * __uint_as_float(a0[k] & 0xffff0000u) + w1 * __uint_as_float(a1[k] & 0xffff0000u) + w2 * __uint_as_float(a2[k] & 0xffff0000u)) * __uint_as_float(zz[k] & 0xffff0000u);
            res[k] = cvt_pk_bf16(lo, hi);
        }
        if (st) *(u32x4*)(sz + tl * 1536 + c8) = res;
    }
}

DI int snake_item(int round, int G, int bid) { return (round & 1) ? round * G + (G - 1 - bid) : round * G + bid; }

__global__ void __launch_bounds__(NTHREADS) fwd_megakernel(Params p) {
    __shared__ __attribute__((aligned(16))) char shm_raw[SHM_BYTES];
    cg::grid_group grid = cg::this_grid();
    char* ws = p.ws;
    const int G = gridDim.x, bid = blockIdx.x;
    __attribute__((address_space(3))) bf16_t* shm_g = (__attribute__((address_space(3))) bf16_t*)shm_raw;

    unsigned* barcnt = (unsigned*)(ws + OFF_BAR);
    unsigned bartarget = 0;
    if (bid == 0 && threadIdx.x == 0) __hip_atomic_store(barcnt, 0u, __ATOMIC_RELAXED, __HIP_MEMORY_SCOPE_AGENT);
    if (bid == 0 && threadIdx.x < DEPTH * NGRP * 64) ((unsigned*)(ws + OFF_FLAG))[threadIdx.x] = 0u;
    phase_prep(p, shm_raw);
    if (DUPMASK & 64) { __syncthreads(); phase_prep(p, shm_raw); }
    grid.sync();

#define LAUNDER() do { } while (0)
    unsigned long long tspan = 0ull, tprev = SPINSEL ? wall_clock64() : 0ull;
#define PHASE_END(k) do { if (SPINSEL) { const unsigned long long tn_ = wall_clock64(); if (SPINSEL == (k)) tspan += tn_ - tprev; tprev = tn_; } } while (0)
    for (int layer = 0; layer < DEPTH; ++layer) {
        for (int grp = 0; grp < NGRP; ++grp) {
            const int gtok0 = grp * TG;
            LAUNDER();
            for (int rep = 0; rep <= (DUPMASK & 1); ++rep) {
                EpiIn epi{&p, layer, gtok0};
                gemm_phase<true>((const bf16_t*)(ws + OFF_WTIN), DM, 0, NPAD, (const bf16_t*)(ws + OFF_XB), DM, 0, TG, DM, 1, epi, shm_g);
            }
            grid_barrier(barcnt, bartarget, (unsigned)G);
            if (DUPMASK & 32) grid_barrier(barcnt, bartarget, (unsigned)G);
            PHASE_END(1);
            LAUNDER();
            for (int rep = 0; rep <= ((DUPMASK >> 1) & 1); ++rep) {
                const int nsel = BG * 256;
                const int nA = BG * 24 * 8, nK = BG * 8 * 16;
                const int rS = (nsel + G - 1) / G, rA = (nA + G - 1) / G, rK = (nK + G - 1) / G, rT = rS + rA + rK;
                const int off = (bid & 1) ? rS : 0;
                for (int st_ = 0; st_ < rT; ++st_) {
                    int s2 = st_ + off; if (s2 >= rT) s2 -= rT;
                    if (s2 < rS) {
                        const int it = snake_item(s2, G, bid);
                        if (it < nsel) select_chunk(p, it % BG, 255 - it / BG, shm_raw);
                    } else if (s2 < rS + rA) {
                        const int it = (s2 - rS) * G + bid;
                        if (it < nA) attn_a2_item(p, layer, it / (24 * 8), (it / 8) % 24, it % 8);
                    } else {
                        const int it = (s2 - rS - rA) * G + bid;
                        if (it < nK) kmean_item(p, it / 128, (it / 16) & 7, it & 15, shm_raw);
                    }
                }
            }
            grid_barrier(barcnt, bartarget, (unsigned)G);
            if (DUPMASK & 32) grid_barrier(barcnt, bartarget, (unsigned)G);
            PHASE_END(2);
            LAUNDER();
            for (int rep = ((DUPMASK >> 2) & 1); rep >= 0; --rep) {
                const bool st = rep == 0 || p.dupmask == 0x7fffffff;
#if ATTN64
                const int nbc = 2 * BG * 8 * 4;
                const int wv = __builtin_amdgcn_readfirstlane(ltid() >> 6);
                for (int it = bid; it < nbc; it += G) {
                    const int j = it & 3, sub = it >> 2, typ = sub / (BG * 8), bl = (sub / 8) % BG, hd = sub & 7;
                    const int c0 = j * 8 + wv, c1 = 63 - c0;
                    if (typ == 0) { attn_bc2_chunk<0>(p, layer, bl, hd, c1, st); attn_bc2_chunk<0>(p, layer, bl, hd, c0, st); }
                    else { attn_bc2_chunk<1>(p, layer, bl, hd, c1, st); attn_bc2_chunk<1>(p, layer, bl, hd, c0, st); }
                }
#else
                const int nbc = 2 * BG * 8 * 16;
                for (int rnd = 0;; ++rnd) {
                    const int it = snake_item(rnd, G, bid);
                    if (rnd * G >= nbc) break;
                    if (it < nbc) {
                        const int qb = 15 - it / (2 * BG * 8), sub = it % (2 * BG * 8), typ = sub / (BG * 8), bl = (sub / 8) % BG, hd = sub & 7;
                        {
#if ATTN_LDS
                            attn_bc_item(p, layer, typ, bl, hd, qb, st, shm_raw);
#else
                            if (typ == 0) attn_b_item(p, layer, bl, hd, qb, st, st ? 0 : ((p.dupmask >> 8) & 3)); else if (st || ((p.dupmask >> 10) & 1) == 0) attn_c_item(p, layer, bl, hd, qb, st);
#endif
                        }
                    }
                }
#endif
                for (int it = bid; it < TG / 64; it += G) merge_a_item(p, it, st);
            }
            grid_barrier(barcnt, bartarget, (unsigned)G);
            if (DUPMASK & 32) grid_barrier(barcnt, bartarget, (unsigned)G);
            PHASE_END(3);
            LAUNDER();
            for (int rep = 0; rep <= ((DUPMASK >> 3) & 1); ++rep) {
                EpiBr epi{&p};
                gemm_phase<false>((const bf16_t*)(ws + OFF_WTBR) + (size_t)layer * 3 * DM * 512, 512, (size_t)DM * 512, DM, (const bf16_t*)(ws + OFF_SZ), 1536, 512, TG, 512, 3, epi, shm_g);
            }
            {
                const bool handoff = (DUPMASK == 0) && G == (DM / BM) * (TG / BM);
                if (handoff) {
                    int pm_, pn_; gemm_tile_of(bid, DM / BM, TG / BM, pm_, pn_);
                    unsigned* fl = (unsigned*)(ws + OFF_FLAG) + (layer * NGRP + grp) * 64 + pn_;
                    __syncthreads();
                    if (threadIdx.x == 0) {
                        __builtin_amdgcn_fence(__ATOMIC_RELEASE, "agent");
                        __hip_atomic_fetch_add(fl, 1u, __ATOMIC_RELAXED, __HIP_MEMORY_SCOPE_AGENT);
                        while (__hip_atomic_load(fl, __ATOMIC_RELAXED, __HIP_MEMORY_SCOPE_AGENT) < (unsigned)(DM / BM)) __builtin_amdgcn_s_sleep(1);
                        __builtin_amdgcn_fence(__ATOMIC_ACQUIRE, "agent");
                    }
                    __syncthreads();
                } else {
                    grid_barrier(barcnt, bartarget, (unsigned)G);
                    if (DUPMASK & 32) grid_barrier(barcnt, bartarget, (unsigned)G);
                }
            }
            PHASE_END(4);
            LAUNDER();
            for (int rep = ((DUPMASK >> 4) & 1); rep >= 0; --rep) {
                EpiOut epi{&p, layer, gtok0, rep == 0 || p.dupmask == 0x7fffffff};
                gemm_phase<false>((const bf16_t*)(ws + OFF_WTOUT) + (size_t)layer * DM * DM, DM, 0, DM, (const bf16_t*)(ws + OFF_MB), DM, 0, TG, DM, 1, epi, shm_g);
                if (rep == 0) {
                    const int nl = grp + 1 < NGRP ? layer : layer + 1, ng = grp + 1 < NGRP ? grp + 1 : 0;
                    if (nl < DEPTH) {
                        __syncthreads();
                        const float* xsrc = (nl == 0 ? p.x : (const float*)p.out) + (size_t)ng * TG * DM;
                        int per = (TG + G - 1) / G; int tb = bid * per, te = tb + per < TG ? tb + per : TG;
                        xprep_tokens(xsrc, (bf16_t*)(ws + OFF_XB), (float*)(ws + OFF_SS), tb, te);
                        if (nl != layer) for (int it = bid; it < 16 * 204; it += G) convert_win_tile(p, nl, it, (float*)shm_raw);
                    }
                }
            }
            grid_barrier(barcnt, bartarget, (unsigned)G);
            if (DUPMASK & 32) grid_barrier(barcnt, bartarget, (unsigned)G);
            PHASE_END(5);
        }
    }
    if (SPINSEL) { const unsigned long long t0_ = wall_clock64(); while (wall_clock64() - t0_ < tspan) __builtin_amdgcn_s_sleep(8); }
}

extern "C" void kernel_launch(void* const* d_in, const int* in_sizes, int n_in, void* d_out, int out_size, void* d_ws, size_t ws_size, hipStream_t stream) {
    static int grid_blocks = 0;
    if (!grid_blocks) {
        int dev = 0, cus = 0, per_cu = 0;
        hipGetDevice(&dev);
        hipDeviceGetAttribute(&cus, hipDeviceAttributeMultiprocessorCount, dev);
        hipOccupancyMaxActiveBlocksPerMultiprocessor(&per_cu, fwd_megakernel, NTHREADS, 0);
        if (per_cu > 1) per_cu = 1;
        grid_blocks = cus * per_cu;
    }
    if (ws_size < WS_NEED) { fprintf(stderr, "workspace too small: %zu < %zu\n", ws_size, (size_t)WS_NEED); return; }
    Params p{};
    p.dupmask = DUPMASK; p.pad_ = 0;
    p.x = (const float*)d_in[0]; p.pos = (const int*)d_in[1]; p.norm_g = (const float*)d_in[2]; p.w_in = (const float*)d_in[3];
    p.qk_g = (const float*)d_in[4]; p.w_br = (const float*)d_in[5]; p.w_out = (const float*)d_in[6];
    p.out = (float*)d_out; p.ws = (char*)d_ws;
    void* args[] = {&p};
    hipError_t e = hipLaunchCooperativeKernel((void*)fwd_megakernel, dim3(grid_blocks), dim3(NTHREADS), args, 0, stream);
    if (e != hipSuccess) fprintf(stderr, "cooperative launch failed: %s (grid %d)\n", hipGetErrorString(e), grid_blocks);
}
```

```cpp
#include <hip/hip_runtime.h>
#include <hip/hip_cooperative_groups.h>
#include <cstdio>
#include <cstdint>
namespace cg = cooperative_groups;
#define ATTN_LDS 0
#define ATTN64 1
#define SPINSEL 0
#define DUPMASK 0

typedef unsigned short bf16_t;
typedef short bf16x8 __attribute__((ext_vector_type(8)));
typedef short s16x4 __attribute__((ext_vector_type(4)));
typedef float f32x4 __attribute__((ext_vector_type(4)));
typedef float f32x16 __attribute__((ext_vector_type(16)));
typedef unsigned u32x4 __attribute__((ext_vector_type(4)));
typedef unsigned u32x2 __attribute__((ext_vector_type(2)));
#define DI __device__ __forceinline__

constexpr int S = 4096, DM = 1024, NB = 8, DEPTH = 2;
constexpr int NIN = 12872, NPAD = 13056;
constexpr int BG = 4, TG = BG * S, NGRP = NB / BG;
constexpr int NTHREADS = 512;
constexpr int SHM_BYTES = 131072;
constexpr float QSCALE = 0.125f * 1.4426950408889634f;
constexpr float LN2F = 0.6931471805599453f;
constexpr int SEL_CAP = 768;

constexpr size_t al256(size_t x) { return (x + 255) & ~(size_t)255; }
constexpr size_t OFF_WTIN = 0;
constexpr size_t OFF_WTBR = OFF_WTIN + al256((size_t)NPAD * DM * 2);
constexpr size_t OFF_WTOUT = OFF_WTBR + al256((size_t)DEPTH * 3 * DM * 512 * 2);
constexpr size_t OFF_CS = OFF_WTOUT + al256((size_t)DEPTH * DM * DM * 2);
constexpr size_t OFF_XB = OFF_CS + al256((size_t)NB * S * 8 * 8);
constexpr size_t OFF_OA = OFF_XB;
constexpr size_t OFF_SS = OFF_XB + al256((size_t)3 * TG * 512 * 2);
constexpr size_t OFF_QA = OFF_SS + al256((size_t)TG * 8 * 4);
constexpr size_t OFF_KA = OFF_QA + al256((size_t)TG * 1536 * 2);
constexpr size_t OFF_VA = OFF_KA + al256((size_t)TG * 1536 * 2);
constexpr size_t OFF_MF = OFF_QA;
constexpr size_t OFF_MB = OFF_VA;
constexpr size_t OFF_QB = OFF_VA + al256((size_t)TG * 1536 * 2);
constexpr size_t OFF_KB = OFF_QB + al256((size_t)TG * 512 * 2);
constexpr size_t OFF_VB = OFF_KB + al256((size_t)TG * 512 * 2);
constexpr size_t OFF_QC = OFF_VB + al256((size_t)TG * 512 * 2);
constexpr size_t OFF_KC = OFF_QC + al256((size_t)TG * 512 * 2);
constexpr size_t OFF_VC = OFF_KC + al256((size_t)TG * 512 * 2);
constexpr size_t OFF_IQ = OFF_VC + al256((size_t)TG * 512 * 2);
constexpr size_t OFF_IK = OFF_IQ + al256((size_t)TG * 512 * 2);
constexpr size_t OFF_IW = OFF_IK + al256((size_t)TG * 64 * 2);
constexpr size_t OFF_SZ = OFF_IW + al256((size_t)TG * 8 * 4);
constexpr size_t OFF_SG = OFF_SZ + al256((size_t)TG * 1536 * 2);
constexpr size_t OFF_LSE = OFF_SG + al256((size_t)TG * 3072 * 2);
constexpr size_t OFF_MASK = OFF_LSE + al256((size_t)3 * TG * 8 * 4);
constexpr size_t OFF_KM = OFF_MASK + al256((size_t)BG * S * (S / 8));
static_assert((size_t)TG * DM * 4 <= (size_t)2 * TG * 1536 * 2 && (size_t)TG * DM * 2 <= (size_t)TG * 1536 * 2, "overlay sizes");
constexpr size_t OFF_BAR = OFF_KM + al256((size_t)BG * 8 * 16 * 64 * 2 * 2);
constexpr size_t OFF_FLAG = OFF_BAR + 256;
constexpr size_t OFF_BAR2 = OFF_FLAG + (size_t)DEPTH * NGRP * 64 * 4;
constexpr size_t WS_NEED = OFF_BAR2 + 9 * 128;

struct Params {
    const float* x; const int* pos; const float* norm_g; const float* w_in; const float* qk_g; const float* w_br; const float* w_out;
    float* out; char* ws; int dupmask; int pad_;
};

DI int ltid() { int t = threadIdx.x; asm volatile("" : "+v"(t)); return t; }
DI unsigned cvt_pk_bf16(float lo, float hi) { unsigned r; asm volatile("v_cvt_pk_bf16_f32 %0, %1, %2" : "=v"(r) : "v"(lo), "v"(hi)); return r; }
DI bf16_t f2bf(float x) { return (bf16_t)(cvt_pk_bf16(x, 0.f) & 0xffffu); }
DI float bf2f(bf16_t v) { return __uint_as_float(((unsigned)v) << 16); }
DI float fexp2(float x) { return __builtin_amdgcn_exp2f(x); }
DI float shx(float v, int mask) { const int l = ltid() & 63; return __int_as_float(__builtin_amdgcn_ds_bpermute((l ^ mask) << 2, __float_as_int(v))); }
DI float wave_sum(float v) { for (int o = 32; o > 0; o >>= 1) v += shx(v, o); return v; }
DI int f2sort(float f) { int i = __float_as_int(f); return i ^ ((i >> 31) & 0x7fffffff); }
DI float sort2f(int i) { return __int_as_float(i ^ ((i >> 31) & 0x7fffffff)); }
#define MFMA32(a, b, c) __builtin_amdgcn_mfma_f32_32x32x16_bf16((a), (b), (c), 0, 0, 0)
#define MFMA16(a, b, c) __builtin_amdgcn_mfma_f32_16x16x32_bf16((a), (b), (c), 0, 0, 0)

DI void grid_barrier(unsigned* bar, unsigned& gen, unsigned G) {
    __syncthreads();
    gen += 1;
    if (threadIdx.x == 0) {
        __builtin_amdgcn_fence(__ATOMIC_RELEASE, "agent");
        const unsigned sh = blockIdx.x & 7u, per = (G + 7u - sh) >> 3, nsh = G < 8u ? G : 8u;
        const unsigned old = __hip_atomic_fetch_add(bar + 32 * (1 + sh), 1u, __ATOMIC_RELAXED, __HIP_MEMORY_SCOPE_AGENT);
        if (old + 1u == per * gen) __hip_atomic_fetch_add(bar, 1u, __ATOMIC_RELAXED, __HIP_MEMORY_SCOPE_AGENT);
        while (__hip_atomic_load(bar, __ATOMIC_RELAXED, __HIP_MEMORY_SCOPE_AGENT) < nsh * gen) __builtin_amdgcn_s_sleep(2);
        __builtin_amdgcn_fence(__ATOMIC_ACQUIRE, "agent");
    }
    __syncthreads();
}

DI int src_col_of_group(int hg) { return hg <= 104 ? hg * 64 : (hg <= 200 ? 6728 + (hg - 105) * 64 : 6720); }

DI void convert_tile(const float* src, int ld_src, int k0, int n_src0, int n_valid, const float* kscale, bf16_t* dst, int ld_dst, int n_dst0, float* tl  ) {
    const int tid = ltid();
    __syncthreads();
#pragma unroll
    for (int i = 0; i < 8; ++i) {
        int e = tid + i * 512, kk = e >> 6, nn = e & 63;
        float v = 0.f;
        if (nn < n_valid) { v = src[(size_t)(k0 + kk) * ld_src + n_src0 + nn]; if (kscale) v *= kscale[k0 + kk]; }
        tl[kk * 65 + nn] = v;
    }
    __syncthreads();
#pragma unroll
    for (int i = 0; i < 4; ++i) {
        int e = tid + i * 512, nn = e >> 5, kp = (e & 31) * 2;
        unsigned w = cvt_pk_bf16(tl[kp * 65 + nn], tl[(kp + 1) * 65 + nn]);
        *(unsigned*)(dst + (size_t)(n_dst0 + nn) * ld_dst + k0 + kp) = w;
    }
}

DI void xprep_tokens(const float* xsrc  , bf16_t* xb, float* ss, int tok_begin, int tok_end) {
    const int lane = ltid() & 63, wid = ltid() >> 6;
    for (int t = tok_begin + wid; t < tok_end; t += 8) {
        const float* xr = xsrc + (size_t)t * DM;
        float sum = 0.f;
#pragma unroll
        for (int i = 0; i < 4; ++i) {
            f32x4 v = *(const f32x4*)(xr + i * 256 + lane * 4);
            sum += v[0] * v[0] + v[1] * v[1] + v[2] * v[2] + v[3] * v[3];
            u32x2 w; w[0] = cvt_pk_bf16(v[0], v[1]); w[1] = cvt_pk_bf16(v[2], v[3]);
            *(u32x2*)(xb + (size_t)t * DM + i * 256 + lane * 4) = w;
        }
        sum = wave_sum(sum);
        if (lane < 8) ss[(size_t)t * 8 + lane] = lane == 0 ? sum : 0.f;
    }
}

DI void convert_win_tile(const Params& p, int l, int it, float* tl) {
    const int hg = it / 16, kt = it % 16;
    const int nvalid = hg <= 200 ? 64 : (hg == 201 ? 8 : 0);
    convert_tile(p.w_in + (size_t)l * DM * NIN, NIN, kt * 64, src_col_of_group(hg), nvalid, p.norm_g + l * DM, (bf16_t*)(p.ws + OFF_WTIN), DM, hg * 64, tl);
}
DI void phase_prep(const Params& p, char* shm) {
    char* ws = p.ws;
    const int G = gridDim.x, bid = blockIdx.x, tid = ltid();
    float2* cs = (float2*)(ws + OFF_CS);
    for (int e = bid * NTHREADS + tid; e < NB * S * 8; e += G * NTHREADS) {
        int i = e & 7, t = e >> 3;
        float inv = powf(500000.0f, -(float)(2 * i) / 16.0f);
        float ang = (float)p.pos[t] * inv;
        double rev = (double)ang * 0.15915494309189535;
        rev -= floor(rev);
        float rf = (float)rev;
        cs[e] = make_float2(__builtin_amdgcn_cosf(rf), __builtin_amdgcn_sinf(rf));
    }
    float* tl = (float*)shm;
    const int n_in_tiles = 16 * 204, n_br_tiles = DEPTH * 3 * 8 * 16, n_out_tiles = DEPTH * 16 * 16;
    for (int it = bid; it < n_in_tiles + n_br_tiles + n_out_tiles; it += G) {
        if (it < n_in_tiles) {
            convert_win_tile(p, 0, it, tl);
        } else if (it < n_in_tiles + n_br_tiles) {
            int r = it - n_in_tiles; int ln = r / 128, q = r % 128, kt = q / 16, nt = q % 16;
            convert_tile(p.w_br + (size_t)ln * 512 * DM, DM, kt * 64, nt * 64, 64, nullptr, (bf16_t*)(ws + OFF_WTBR) + (size_t)ln * DM * 512, 512, nt * 64, tl);
        } else {
            int r = it - n_in_tiles - n_br_tiles; int l = r / 256, q = r % 256, kt = q / 16, nt = q % 16;
            convert_tile(p.w_out + (size_t)l * DM * DM, DM, kt * 64, nt * 64, 64, nullptr, (bf16_t*)(ws + OFF_WTOUT) + (size_t)l * DM * DM, DM, nt * 64, tl);
        }
    }
    int per = (TG + G - 1) / G;
    int tb = bid * per, te = tb + per < TG ? tb + per : TG;
    xprep_tokens(p.x, (bf16_t*)(ws + OFF_XB), (float*)(ws + OFF_SS), tb, te);
}

constexpr int BM = 256, BK = 64, HALF = 128, NXCD = 8, WGM = 8, HT = HALF * BK;
DI int lds_byte(int r, int c) { int st = (r >> 4) * 2 + (c >> 5), rr = r & 15, cc = c & 31, ob = rr * 64 + cc * 2; return st * 1024 + (ob ^ (((ob >> 9) & 1) << 5)); }
DI void stage_rc(int b, int& R, int& C) { int st = b / 1024, sb = b % 1024, swz = sb ^ (((sb >> 9) & 1) << 5); R = (st >> 1) * 16 + swz / 64; C = (st & 1) * 32 + (swz % 64) / 2; }

#define SA(b, h) (shm + ((b) * 2 + (h)) * HT)
#define SB(b, h) (shm + (4 + (b) * 2 + (h)) * HT)
DI void glds16(const void* sbase, unsigned voff, unsigned lds_dst) {
    unsigned keep;
    asm volatile("s_mov_b32 %0, m0\n\ts_mov_b32 m0, %3\n\ts_nop 0\n\tglobal_load_lds_dwordx4 %1, %2\n\ts_mov_b32 m0, %0"
                 : "=&s"(keep) : "v"(voff), "s"(sbase), "s"(lds_dst) : "memory");
}
#define STAGE(P, BASE, LD, br, kt, VOFF) do { const bf16_t* _gp = (BASE) + (size_t)(br) * (LD) + (size_t)(kt) * BK; \
    const unsigned _l0 = (unsigned)(size_t)(P) + wbase16; \
    glds16(_gp, VOFF[0], _l0); glds16(_gp, VOFF[1], _l0 + 8192u); } while (0)
#define LDA(dst, b, h) _Pragma("unroll") for (int m = 0; m < 4; ++m) _Pragma("unroll") for (int k = 0; k < 2; ++k) \
    dst[m][k] = *reinterpret_cast<const bf16x8*>((char*)SA(b, h) + lds_byte(wr * 64 + m * 16 + fr, k * 32 + fq * 8))
#define LDB(dst, b, h) _Pragma("unroll") for (int n = 0; n < 2; ++n) _Pragma("unroll") for (int k = 0; k < 2; ++k) \
    dst[n][k] = *reinterpret_cast<const bf16x8*>((char*)SB(b, h) + lds_byte(wc * 32 + n * 16 + fr, k * 32 + fq * 8))
#define MMA(ai, bj, At, Bt_) do { __builtin_amdgcn_s_setprio(1); \
    _Pragma("unroll") for (int m = 0; m < 4; ++m) _Pragma("unroll") for (int n = 0; n < 2; ++n) _Pragma("unroll") for (int k = 0; k < 2; ++k) \
      acc[ai][bj][m][n] = MFMA16(At[m][k], Bt_[n][k], acc[ai][bj][m][n]); \
    __builtin_amdgcn_s_setprio(0); } while (0)
#define WAIT_V(n) asm volatile("s_waitcnt vmcnt(" #n ")" ::: "memory")
#define WAIT_L(n) asm volatile("s_waitcnt lgkmcnt(" #n ")" ::: "memory")
#define BAR __builtin_amdgcn_s_barrier()
#define SCHED __builtin_amdgcn_sched_barrier(0)

DI int fold_tok(int rho, int sh) { const int b = rho >> 12, rb = rho & (S - 1); return (b << 12) + (((rb & ((S >> sh) - 1)) << sh) + (rb >> (12 - sh))); }
DI void gemm_tile_of(int L, int nM, int nN, int& pm, int& pn) {
    const int nwg = nM * nN; int wgid = L;
    { int q = nwg / NXCD, r = nwg % NXCD, xcd = wgid % NXCD, off = wgid / NXCD; wgid = (xcd < r ? xcd * (q + 1) : r * (q + 1) + (xcd - r) * q) + off; }
    const int nig = WGM * nN, gid = wgid / nig, fm = gid * WGM, gsz = min(nM - fm, WGM);
    pm = fm + ((wgid % nig) % gsz); pn = (wgid % nig) / gsz;
}
template <bool FOLD, class Epi>
DI void gemm_phase(const bf16_t* __restrict__ Abase, int lda, size_t a_sub, int M, const bf16_t* __restrict__ Bbase, int ldb, size_t b_sub, int N, int K, int nsub,
                   Epi& epi, __attribute__((address_space(3))) bf16_t* shm) {
    const int nM = M / BM, nN = N / BM, nwg = nM * nN;
    const int wid = ltid() >> 6, lane = ltid() & 63, wr = wid >> 2, wc = wid & 3, fr = lane & 15, fq = lane >> 4;
    const int nt = K / BK;
    unsigned voffA[2], voffB0[2], voffB1[2];
    const unsigned wbase16 = __builtin_amdgcn_readfirstlane((ltid() & ~63u) * 16u);
#pragma unroll
    for (int i = 0; i < 2; ++i) {
        int r_, c_; stage_rc(ltid() * 16 + i * 8192, r_, c_);
        const int x_ = r_ & 63, pr_ = (r_ & 64) + ((x_ & 15) >> 2) * 16 + (x_ >> 4) * 4 + (x_ & 3);
        voffA[i] = (unsigned)(pr_ * lda + c_) * 2u;
    }
    int L = blockIdx.x, sub = 0, brow = 0, bcol = 0;
    bool have = L < nwg, prefetched = false;
    const bf16_t* A = Abase; const bf16_t* Bt = Bbase;
    auto setup = [&](int L_, int sub_) {
        int wgid = L_;
        { int q = nwg / NXCD, r = nwg % NXCD, xcd = wgid % NXCD, off = wgid / NXCD; wgid = (xcd < r ? xcd * (q + 1) : r * (q + 1) + (xcd - r) * q) + off; }
        const int nig = WGM * nN, gid = wgid / nig, fm = gid * WGM, gsz = min(nM - fm, WGM);
        const int pm = fm + ((wgid % nig) % gsz), pn = (wgid % nig) / gsz;
        brow = pm * BM; bcol = pn * BM;
        const int sh = (FOLD && pm < 18) ? 2 * ((pm % 6) >> 1) : 0;
        const int t_ = ltid();
#pragma unroll
        for (int i = 0; i < 2; ++i) {
            int r_, c_; stage_rc(t_ * 16 + i * 8192, r_, c_);
            voffB0[i] = (unsigned)(fold_tok(bcol + r_, sh) * ldb + c_) * 2u;
            voffB1[i] = (unsigned)(fold_tok(bcol + HALF + r_, sh) * ldb + c_) * 2u;
        }
        A = Abase + (size_t)sub_ * a_sub; Bt = Bbase + (size_t)sub_ * b_sub;
    };
    while (have) {
        {
            setup(L, sub);
            f32x4 acc[2][2][4][2] = {};
            bf16x8 At[4][2], B0[2][2], B1[2][2];
            if (!prefetched) {
                STAGE(SB(0, 0), Bt, ldb, 0, 0, voffB0); STAGE(SA(0, 0), A, lda, brow, 0, voffA);
                STAGE(SB(0, 1), Bt, ldb, 0, 0, voffB1); STAGE(SA(0, 1), A, lda, brow + HALF, 0, voffA);
            }
            if (wr == 1) BAR;
            if (prefetched) WAIT_V(0); else WAIT_V(4);
            BAR;
            STAGE(SB(1, 0), Bt, ldb, 0, 1, voffB0); STAGE(SA(1, 0), A, lda, brow, 1, voffA); STAGE(SB(1, 1), Bt, ldb, 0, 1, voffB1);
            WAIT_V(6); BAR;
            for (int t = 0; t < nt - 2; t += 2) {
                LDB(B0, 0, 0); SCHED; LDA(At, 0, 0); STAGE(SA(1, 1), A, lda, brow + HALF, t + 1, voffA);
                WAIT_L(8); BAR; WAIT_L(0); MMA(0, 0, At, B0); BAR; SCHED;
                LDB(B1, 0, 1); STAGE(SB(0, 0), Bt, ldb, 0, t + 2, voffB0);
                BAR; WAIT_L(0); MMA(0, 1, At, B1); BAR;
                LDA(At, 0, 1); STAGE(SA(0, 0), A, lda, brow, t + 2, voffA);
                BAR; WAIT_L(0); MMA(1, 0, At, B0); BAR; SCHED;
                STAGE(SB(0, 1), Bt, ldb, 0, t + 2, voffB1);
                WAIT_V(6); BAR; MMA(1, 1, At, B1); BAR;
                LDB(B0, 1, 0); SCHED; LDA(At, 1, 0); STAGE(SA(0, 1), A, lda, brow + HALF, t + 2, voffA);
                WAIT_L(8); BAR; WAIT_L(0); MMA(0, 0, At, B0); BAR; SCHED;
                LDB(B1, 1, 1); STAGE(SB(1, 0), Bt, ldb, 0, t + 3, voffB0);
                BAR; WAIT_L(0); MMA(0, 1, At, B1); BAR;
                LDA(At, 1, 1); STAGE(SA(1, 0), A, lda, brow, t + 3, voffA);
                BAR; WAIT_L(0); MMA(1, 0, At, B0); BAR; SCHED;
                STAGE(SB(1, 1), Bt, ldb, 0, t + 3, voffB1);
                WAIT_V(6); BAR; MMA(1, 1, At, B1); BAR;
            }
            { LDB(B0, 0, 0); LDA(At, 0, 0); STAGE(SA(1, 1), A, lda, brow + HALF, nt - 1, voffA);
              BAR; WAIT_L(0); MMA(0, 0, At, B0); BAR;
              LDB(B1, 0, 1); BAR; WAIT_L(0); MMA(0, 1, At, B1); BAR;
              LDA(At, 0, 1); WAIT_V(4); BAR; WAIT_L(0); MMA(1, 0, At, B0); MMA(1, 1, At, B1); BAR; }
            { LDB(B0, 1, 0); LDA(At, 1, 0); WAIT_V(2); BAR; WAIT_L(0); MMA(0, 0, At, B0); BAR;
              LDB(B1, 1, 1); WAIT_V(0); BAR; WAIT_L(0); MMA(0, 1, At, B1); BAR;
              LDA(At, 1, 1); BAR; WAIT_L(0); MMA(1, 0, At, B0); MMA(1, 1, At, B1); BAR; }
            if (wr == 0) BAR;
            const int e_brow = brow, e_bcol = bcol, e_sub = sub;
            if (++sub == nsub) { sub = 0; L += gridDim.x; }
            have = L < nwg;
            if (have) {
                setup(L, sub);
                STAGE(SB(0, 0), Bt, ldb, 0, 0, voffB0); STAGE(SA(0, 0), A, lda, brow, 0, voffA);
                STAGE(SB(0, 1), Bt, ldb, 0, 0, voffB1); STAGE(SA(0, 1), A, lda, brow + HALF, 0, voffA);
                prefetched = true;
            }
            { int t2 = ltid();
              const int wid2 = t2 >> 6, lane2 = t2 & 63;
              epi(acc, e_brow, e_bcol, e_sub, wid2 >> 2, wid2 & 3, lane2 & 15, lane2 >> 4); }
        }
    }
}

struct EpiIn {
    const Params* p; int layer; int gtok0;
    DI void operator()(const f32x4 (&acc)[2][2][4][2], int brow, int bcol, int sub, int wr, int wc, int fr, int fq) const {
        char* ws = p->ws;
        const float* ss = (const float*)(ws + OFF_SS);
        const float2* cs = (const float2*)(ws + OFF_CS);
        const int lane = ltid() & 63;
#pragma unroll
        for (int bj = 0; bj < 2; ++bj)
#pragma unroll
            for (int n = 0; n < 2; ++n) {
                const int rho = bcol + bj * 128 + wc * 32 + n * 16 + fr;
                const int pm_ = brow >> 8;
                const int shf = pm_ < 18 ? 2 * ((pm_ % 6) >> 1) : 0;
                const int tl = fold_tok(rho, shf);
                const f32x4 s0 = *(const f32x4*)(ss + (size_t)tl * 8), s1 = *(const f32x4*)(ss + (size_t)tl * 8 + 4);
                const float rstd = rsqrtf((s0[0] + s0[1] + s0[2] + s0[3] + s1[0] + s1[1] + s1[2] + s1[3]) * (1.0f / DM) + 1e-6f);
                const int bl = tl >> 12, s = tl & (S - 1), rb = rho & (S - 1);
                const int tg = gtok0 + tl;
#pragma unroll
                for (int ai = 0; ai < 2; ++ai) {
                    const int hg = (brow + ai * 128 + wr * 64) >> 6;
                    float v[16];
#pragma unroll
                    for (int m = 0; m < 4; ++m)
#pragma unroll
                        for (int j = 0; j < 4; ++j) v[m * 4 + j] = acc[ai][bj][m][n][j] * rstd;
                    int kind;
                    int mixer = 0, isk = 0, hh = 0, H = 8; size_t qoff = 0, koff = 0, voff = 0;
                    if (hg < 72) { mixer = 0; H = 24; qoff = OFF_QA; koff = OFF_KA; voff = OFF_VA; kind = hg < 48 ? 0 : 1; isk = hg >= 24; hh = hg % 24; }
                    else if (hg < 96) { mixer = 1; qoff = OFF_QB; koff = OFF_KB; voff = OFF_VB; kind = hg < 88 ? 0 : 1; isk = hg >= 80; hh = (hg - 72) & 7; }
                    else if (hg < 105) { kind = 2; isk = hg == 104; hh = hg - 96; }
                    else if (hg < 129) { mixer = 2; qoff = OFF_QC; koff = OFF_KC; voff = OFF_VC; kind = hg < 121 ? 0 : 1; isk = hg >= 113; hh = (hg - 105) & 7; }
                    else if (hg < 153) kind = 3;
                    else if (hg < 201) kind = 4;
                    else kind = hg == 201 ? 5 : 6;

                    if (kind == 0 || kind == 2) {
                        if (kind == 0) {
                            float sq = 0.f;
#pragma unroll
                            for (int i = 0; i < 16; ++i) sq += v[i] * v[i];
                            sq += shx(sq, 16); sq += shx(sq, 32);
                            const float rn = rsqrtf(sq * (1.0f / 64) + 1e-6f) * (isk ? 1.0f : QSCALE);
                            const float* gq = p->qk_g + ((size_t)(layer * 3 + mixer) * 2 + isk) * 64 + fq * 16;
#pragma unroll
                            for (int m = 0; m < 4; ++m) {
                                const f32x4 g4 = *(const f32x4*)(gq + m * 4);
#pragma unroll
                                for (int j = 0; j < 4; ++j) v[m * 4 + j] *= rn * g4[j];
                            }
                        }
                        if (fq == 0) {
                            const f32x4* cp = (const f32x4*)(cs + (size_t)tg * 8);
#pragma unroll
                            for (int i2 = 0; i2 < 4; ++i2) {
                                const f32x4 c2 = cp[i2];
                                const float x1a = v[2 * i2], x2a = v[8 + 2 * i2], x1b = v[2 * i2 + 1], x2b = v[8 + 2 * i2 + 1];
                                v[2 * i2] = x1a * c2[0] - x2a * c2[1]; v[8 + 2 * i2] = x2a * c2[0] + x1a * c2[1];
                                v[2 * i2 + 1] = x1b * c2[2] - x2b * c2[3]; v[8 + 2 * i2 + 1] = x2b * c2[2] + x1b * c2[3];
                            }
                        }
                        u32x4 w0, w1;
#pragma unroll
                        for (int i = 0; i < 4; ++i) { w0[i] = cvt_pk_bf16(v[2 * i], v[2 * i + 1]); w1[i] = cvt_pk_bf16(v[8 + 2 * i], v[8 + 2 * i + 1]); }
                        if (kind == 0 && isk) {
                            bf16_t* dst = (bf16_t*)(ws + koff) + ((size_t)(bl * H + hh) * 128 + (rb >> 5)) * 2048 + (size_t)(fq * 64 + (rb & 31)) * 8;
                            *(u32x4*)dst = w0; *(u32x4*)(dst + 32 * 8) = w1;
                        } else {
                            bf16_t* dst;
                            if (kind == 0) dst = (bf16_t*)(ws + qoff) + ((size_t)(bl * H + hh) * S + rb) * 64;
                            else dst = isk ? (bf16_t*)(ws + OFF_IK) + (size_t)tl * 64 : (bf16_t*)(ws + OFF_IQ) + ((size_t)(bl * 8 + hh) * S + s) * 64;
                            *(u32x4*)(dst + fq * 16) = w0; *(u32x4*)(dst + fq * 16 + 8) = w1;
                        }
                    } else if (kind == 1) {
                        const int k5 = rb & 31;
                        bf16_t* dst = (bf16_t*)(ws + voff) + ((size_t)(bl * H + hh) * 128 + (rb >> 5)) * 2048 + ((k5 >> 4) * 64 + ((k5 >> 2) & 1) * 32) * 8 + ((k5 >> 3) & 1) * 4 + (k5 & 3)
                                      + ((fq >> 1) * 128 + (fq & 1) * 16) * 8;
#pragma unroll
                        for (int i = 0; i < 16; ++i) dst[i * 8] = f2bf(v[i]);
                    } else if (kind == 3 || kind == 4) {
                        bf16_t* dst = (kind == 3 ? (bf16_t*)(ws + OFF_SZ) + (size_t)tl * 1536 + (hg - 129) * 64 : (bf16_t*)(ws + OFF_SG) + (size_t)tl * 3072 + (hg - 153) * 64) + fq * 16;
#pragma unroll
                        for (int i = 0; i < 16; ++i) { const float sg = __builtin_amdgcn_rcpf(1.0f + __expf(-v[i])); v[i] = kind == 3 ? v[i] * sg : sg; }
                        u32x4 w0, w1;
#pragma unroll
                        for (int i = 0; i < 4; ++i) { w0[i] = cvt_pk_bf16(v[2 * i], v[2 * i + 1]); w1[i] = cvt_pk_bf16(v[8 + 2 * i], v[8 + 2 * i + 1]); }
                        *(u32x4*)dst = w0; *(u32x4*)(dst + 8) = w1;
                    } else if (kind == 5) {
                        if (fq == 0) { f32x4 o0 = {v[0], v[1], v[2], v[3]}, o1 = {v[4], v[5], v[6], v[7]}; float* d = (float*)(ws + OFF_IW) + (size_t)tl * 8; *(f32x4*)d = o0; *(f32x4*)(d + 4) = o1; }
                    }
                }
            }
        (void)lane; (void)sub;
    }
};

struct EpiBr {
    const Params* p;
    DI void operator()(const f32x4 (&acc)[2][2][4][2], int brow, int bcol, int sub, int wr, int wc, int fr, int fq) const {
        char* ws = p->ws;
        const bf16_t* sg = (const bf16_t*)(ws + OFF_SG);
        float* mf = (float*)(ws + OFF_MF);
        bf16_t* mb = (bf16_t*)(ws + OFF_MB);
#pragma unroll
        for (int bj = 0; bj < 2; ++bj)
#pragma unroll
            for (int n = 0; n < 2; ++n) {
                const int tl = bcol + bj * 128 + wc * 32 + n * 16 + fr;
#pragma unroll
                for (int ai = 0; ai < 2; ++ai)
#pragma unroll
                    for (int m = 0; m < 4; ++m) {
                        const int e = brow + ai * 128 + wr * 64 + fq * 16 + m * 4;
                        const u32x2 gw = *(const u32x2*)(sg + (size_t)tl * 3072 + sub * 1024 + e);
                        f32x4 g4 = {__uint_as_float(gw[0] << 16), __uint_as_float(gw[0] & 0xffff0000u), __uint_as_float(gw[1] << 16), __uint_as_float(gw[1] & 0xffff0000u)};
                        f32x4 r = acc[ai][bj][m][n] * g4;
                        bf16_t* mp = mb + (size_t)tl * DM + e;
                        if (sub > 0) { const u32x2 pw = *(const u32x2*)mp; r += (f32x4){__uint_as_float(pw[0] << 16), __uint_as_float(pw[0] & 0xffff0000u), __uint_as_float(pw[1] << 16), __uint_as_float(pw[1] & 0xffff0000u)}; }
                        { u32x2 w; w[0] = cvt_pk_bf16(r[0], r[1]); w[1] = cvt_pk_bf16(r[2], r[3]); *(u32x2*)mp = w; }
                    }
                asm volatile("" ::: "memory");
            }
    }
};

struct EpiOut {
    const Params* p; int layer; int gtok0; bool st;
    DI void operator()(const f32x4 (&acc)[2][2][4][2], int brow, int bcol, int sub, int wr, int wc, int fr, int fq) const {
        char* ws = p->ws;
        const float* xin = layer == 0 ? p->x : p->out;
        bf16_t* xb = (bf16_t*)(ws + OFF_XB);
        float* ss = (float*)(ws + OFF_SS);
#pragma unroll
        for (int bj = 0; bj < 2; ++bj)
#pragma unroll
            for (int n = 0; n < 2; ++n) {
                const int tl = bcol + bj * 128 + wc * 32 + n * 16 + fr;
                const size_t tg = (size_t)gtok0 + tl;
                float sq = 0.f;
#pragma unroll
                for (int ai = 0; ai < 2; ++ai)
#pragma unroll
                    for (int m = 0; m < 4; ++m) {
                        const int e = brow + ai * 128 + wr * 64 + fq * 16 + m * 4;
                        f32x4 r = *(const f32x4*)(xin + tg * DM + e) + acc[ai][bj][m][n];
                        if (st) *(f32x4*)(p->out + tg * DM + e) = r;
                    }
            }
        (void)sub;
    }
};

DI void select_chunk(const Params& p, int bl, int c, char* shm) {
    char* ws = p.ws;
    const bf16_t* IQ = (const bf16_t*)(ws + OFF_IQ);
    const bf16_t* IK = (const bf16_t*)(ws + OFF_IK);
    const float* IW = (const float*)(ws + OFF_IW);
    unsigned* hist = (unsigned*)shm; unsigned* bits = (unsigned*)(shm + 16384);
    int* ctl = (int*)(shm + 24576); int* cnt = ctl, *mn = ctl + 16, *mx = ctl + 32, *bsel = ctl + 48, *needp = ctl + 64;
    u32x2* list = (u32x2*)(shm + 32768);
    const int tid = ltid(), lane = tid & 63, w = __builtin_amdgcn_readfirstlane(tid >> 6), q = lane & 15, g = lane >> 4;
    const int t0 = c * 16, tq = t0 + q;
    __syncthreads();
    for (int i = tid; i < 16 * 256 + 16 * 128; i += NTHREADS) hist[i] = 0;
    if (tid < 16) { cnt[tid] = 0; mn[tid] = 0x7fffffff; mx[tid] = (int)0x80000000; }
    bf16x8 qf[8][2]; float wq[8];
#pragma unroll
    for (int hd = 0; hd < 8; ++hd) {
        const bf16_t* qp = IQ + ((size_t)(bl * 8 + hd) * S + tq) * 64 + g * 8;
        qf[hd][0] = *(const bf16x8*)qp; qf[hd][1] = *(const bf16x8*)(qp + 32);
        wq[hd] = IW[(size_t)(bl * S + tq) * 8 + hd];
    }
    auto loadk = [&](int kt, bf16x8& k0, bf16x8& k1) {
        const bf16_t* kp = IK + ((size_t)bl * S + kt * 16 + q) * 64 + g * 8;
        k0 = *(const bf16x8*)kp; k1 = *(const bf16x8*)(kp + 32);
    };
    auto compute = [&](const bf16x8& k0, const bf16x8& k1) -> f32x4 {
        f32x4 sc = {0.f, 0.f, 0.f, 0.f};
#pragma unroll
        for (int hd = 0; hd < 8; ++hd) {
            f32x4 a = {0.f, 0.f, 0.f, 0.f};
            a = MFMA16(k0, qf[hd][0], a); a = MFMA16(k1, qf[hd][1], a);
#pragma unroll
            for (int j = 0; j < 4; ++j) sc[j] += wq[hd] * fmaxf(a[j], 0.f);
        }
        return sc;
    };
#define SEL_PASS(BODY) do { \
        const int cl = c - 1;     \
        bf16x8 ka0, ka1, kb0, kb1; int kt = w; \
        if (kt <= cl) loadk(kt, ka0, ka1); \
        if (kt + 8 <= cl) loadk(kt + 8, kb0, kb1); \
        for (; kt <= cl; kt += 16) { \
            { const f32x4 sc = compute(ka0, ka1); if (kt + 16 <= cl) loadk(kt + 16, ka0, ka1); const int ktc = kt; const bool diag = false; BODY } \
            if (kt + 8 <= cl) { const f32x4 sc = compute(kb0, kb1); if (kt + 24 <= cl) loadk(kt + 24, kb0, kb1); const int ktc = kt + 8; const bool diag = false; BODY } \
        } \
        if (w == (c & 7)) { loadk(c, ka0, ka1); const f32x4 sc = compute(ka0, ka1); const int ktc = c; const bool diag = true; BODY } \
    } while (0)
#define SEL_OK(j) (!diag || 4 * g + (j) <= q)
    __syncthreads();
    {
        float lo = 3.0e38f, hi = -3.0e38f;
        SEL_PASS({
            _Pragma("unroll") for (int j = 0; j < 4; ++j) if (SEL_OK(j)) { lo = fminf(lo, sc[j]); hi = fmaxf(hi, sc[j]); }
        });
        lo = fminf(lo, shx(lo, 16)); lo = fminf(lo, shx(lo, 32));
        hi = fmaxf(hi, shx(hi, 16)); hi = fmaxf(hi, shx(hi, 32));
        if (g == 0) { atomicMin(&mn[q], f2sort(lo)); atomicMax(&mx[q], f2sort(hi)); }
    }
    __syncthreads();
    const float rlo = sort2f(mn[q]), rhi = sort2f(mx[q]);
    const float rscale = rhi > rlo ? 256.0f / (rhi - rlo) : 0.f;
    SEL_PASS({
        _Pragma("unroll") for (int j = 0; j < 4; ++j) if (SEL_OK(j)) {
            int b = (int)((sc[j] - rlo) * rscale); b = b > 255 ? 255 : (b < 0 ? 0 : b);
            atomicAdd(&hist[q * 256 + b], 1u);
        }
    });
    __syncthreads();
    {
        const int row = tid >> 5, i = tid & 31;
        unsigned c8[8]; unsigned tot = 0;
#pragma unroll
        for (int k = 0; k < 8; ++k) { c8[k] = hist[row * 256 + i * 8 + k]; tot += c8[k]; }
        unsigned above = 0;
        {
            unsigned run = tot;
#pragma unroll
            for (int o = 1; o < 32; o <<= 1) { const int l_ = tid & 63; unsigned v = (unsigned)__builtin_amdgcn_ds_bpermute(((l_ + o) & 63) << 2, (int)run); if (i + o < 32) run += v; }
            above = run - tot;
        }
        const int trow = t0 + row; const unsigned need = trow + 1 < 256 ? trow + 1 : 256;
        if (above < need && above + tot >= need) {
            unsigned a = above;
#pragma unroll
            for (int k = 7; k >= 0; --k) { if (a < need && a + c8[k] >= need) { bsel[row] = i * 8 + k; needp[row] = (int)(need - a); } a += c8[k]; }
        }
    }
    __syncthreads();
    const int bstar = bsel[q];
    SEL_PASS({
        unsigned nib = 0;
        _Pragma("unroll") for (int j = 0; j < 4; ++j) if (SEL_OK(j)) {
            int b = (int)((sc[j] - rlo) * rscale); b = b > 255 ? 255 : (b < 0 ? 0 : b);
            if (b > bstar) nib |= 1u << j;
            else if (b == bstar) { int pos = atomicAdd(&cnt[q], 1); if (pos < SEL_CAP) { u32x2 e; e[0] = (unsigned)f2sort(sc[j]) ^ 0x80000000u; e[1] = ktc * 16 + 4 * g + j; list[q * SEL_CAP + pos] = e; } }
        }
        if (nib) atomicOr(&bits[q * 128 + (ktc >> 1)], nib << ((ktc & 1) * 16 + 4 * g));
    });
    __syncthreads();
    {
        const int row = tid >> 5, i = tid & 31;
        int n = cnt[row]; n = n < SEL_CAP ? n : SEL_CAP;
        const int need = needp[row];
        for (int a = i; a < n; a += 32) {
            const u32x2 ea = list[row * SEL_CAP + a];
            int rank = 0;
            for (int b = 0; b < n; ++b) { const u32x2 eb = list[row * SEL_CAP + b]; rank += (eb[0] > ea[0]) || (eb[0] == ea[0] && eb[1] < ea[1]); }
            if (rank < need) atomicOr(&bits[row * 128 + (ea[1] >> 5)], 1u << (ea[1] & 31));
        }
    }
    __syncthreads();
    unsigned* mask = (unsigned*)(ws + OFF_MASK) + ((size_t)bl * S + t0) * 128;
    for (int i = tid; i < 16 * 128; i += NTHREADS) mask[i] = bits[i];
}

DI void kmean_item(const Params& p, int bl, int h, int n, char* shm) {
    char* ws = p.ws;
    const bf16_t* K = (const bf16_t*)(ws + OFF_KC) + ((size_t)(bl * 8 + h) * 128 + n * 8) * 2048;
    float* red = (float*)shm;
    const int tid = ltid(), c = tid & 255, par = tid >> 8;
    float acc[8] = {0.f, 0.f, 0.f, 0.f, 0.f, 0.f, 0.f, 0.f};
#pragma unroll
    for (int it = 0; it < 4; ++it) {
        const u32x4 v = *(const u32x4*)(K + (size_t)(it * 2 + par) * 2048 + c * 8);
#pragma unroll
        for (int e = 0; e < 4; ++e) { acc[2 * e] += __uint_as_float(v[e] << 16); acc[2 * e + 1] += __uint_as_float(v[e] & 0xffff0000u); }
    }
    __syncthreads();
#pragma unroll
    for (int e = 0; e < 8; ++e) red[(par * 256 + c) * 8 + e] = acc[e];
    __syncthreads();
    if (tid < 64) {
        const int grp = tid >> 3, e = tid & 7;
        float t = 0.f;
        for (int pr = 0; pr < 2; ++pr) for (int r = 0; r < 32; ++r) t += red[(pr * 256 + grp * 32 + r) * 8 + e];
        t *= (1.0f / 256);
        bf16_t hi = f2bf(t); bf16_t lo = f2bf(t - bf2f(hi));
        bf16_t* km = (bf16_t*)(ws + OFF_KM) + (((size_t)(bl * 8 + h) * 16 + n) * 2) * 64;
        km[tid] = hi; km[64 + tid] = lo;
    }
}

struct AttnAcc { f32x16 o0, o1; float nb, l; bool shifted; };
DI void attn_init(AttnAcc& a, float nb) {
    float z = 0.f; asm volatile("" : "+v"(z));
#pragma unroll
    for (int i = 0; i < 16; ++i) { a.o0[i] = z; a.o1[i] = z; }
    a.shifted = __ballot(nb > 90.f) != 0ull;
    a.nb = a.shifted ? nb + z : z; a.l = z;
}
DI float attn_bound(const bf16x8 (&qf)[4], const float* gk) {
    float qs = 0.f;
#pragma unroll
    for (int kk = 0; kk < 4; ++kk)
#pragma unroll
        for (int e = 0; e < 8; ++e) { const float v = bf2f((bf16_t)qf[kk][e]); qs += v * v; }
    qs += shx(qs, 32);
    float gm = fabsf(gk[ltid() & 63]);
    for (int o = 32; o > 0; o >>= 1) gm = fmaxf(gm, shx(gm, o));
    return sqrtf(qs) * gm * 8.1f;
}
struct KVFrag { bf16x8 k[4]; bf16x8 v[2][2]; };
DI void kv_load(KVFrag& f, const bf16_t* Kt, const bf16_t* Vt, int lane) {
#pragma unroll
    for (int kk = 0; kk < 4; ++kk) f.k[kk] = *(const bf16x8*)(Kt + (kk * 64 + lane) * 8);
#pragma unroll
    for (int db = 0; db < 2; ++db)
#pragma unroll
        for (int u = 0; u < 2; ++u) f.v[db][u] = *(const bf16x8*)(Vt + ((db * 2 + u) * 64 + lane) * 8);
}
DI void attn_step(AttnAcc& a, const KVFrag& f, const bf16x8 (&qf)[4], unsigned vm) {
    f32x16 st;
    if (a.shifted) {
#pragma unroll
        for (int i = 0; i < 16; ++i) st[i] = -a.nb;
        st = MFMA32(f.k[0], qf[0], st);
    } else {
        st = MFMA32(f.k[0], qf[0], ((f32x16){0.f, 0.f, 0.f, 0.f, 0.f, 0.f, 0.f, 0.f, 0.f, 0.f, 0.f, 0.f, 0.f, 0.f, 0.f, 0.f}));
    }
#pragma unroll
    for (int kk = 1; kk < 4; ++kk) st = MFMA32(f.k[kk], qf[kk], st);
    float pv[16];
#pragma unroll
    for (int i = 0; i < 16; ++i) pv[i] = fexp2(st[i]);
    if (__ballot(vm != 0xffffu) != 0ull) {
#pragma unroll
        for (int i = 0; i < 16; ++i) pv[i] = __int_as_float(__float_as_int(pv[i]) & __builtin_amdgcn_sbfe((int)vm, i, 1));
    }
    a.l += ((pv[0] + pv[1]) + (pv[2] + pv[3])) + ((pv[4] + pv[5]) + (pv[6] + pv[7])) + (((pv[8] + pv[9]) + (pv[10] + pv[11])) + ((pv[12] + pv[13]) + (pv[14] + pv[15])));
    u32x4 p0, p1;
#pragma unroll
    for (int i = 0; i < 4; ++i) { p0[i] = cvt_pk_bf16(pv[2 * i], pv[2 * i + 1]); p1[i] = cvt_pk_bf16(pv[8 + 2 * i], pv[8 + 2 * i + 1]); }
    const bf16x8 pf0 = __builtin_bit_cast(bf16x8, p0), pf1 = __builtin_bit_cast(bf16x8, p1);
    a.o0 = MFMA32(f.v[0][0], pf0, a.o0); a.o0 = MFMA32(f.v[0][1], pf1, a.o0);
    a.o1 = MFMA32(f.v[1][0], pf0, a.o1); a.o1 = MFMA32(f.v[1][1], pf1, a.o1);
}
DI void load_q(bf16x8 (&qf)[4], const bf16_t* Qrow, int h) {
#pragma unroll
    for (int kk = 0; kk < 4; ++kk) qf[kk] = *(const bf16x8*)(Qrow + kk * 16 + h * 8);
}
DI int koff(int i, int h) { return 8 * (i >> 2) + 4 * h + (i & 3); }

DI void attn_a_item(const Params& p, int layer, int bl, int hh, int rb) {
    char* ws = p.ws;
    const int lane = ltid() & 63, w = __builtin_amdgcn_readfirstlane(ltid() >> 6), r = lane & 31, h = lane >> 5;
    const int g = hh >> 3, sh = 2 * g, n = S >> sh;
    const int row0 = rb * 256 + w * 32;
    const int rr = row0 / n, m0 = row0 % n;
    const bf16_t* Q = (const bf16_t*)(ws + OFF_QA) + (size_t)(bl * 24 + hh) * S * 64;
    const bf16_t* K = (const bf16_t*)(ws + OFF_KA) + (size_t)(bl * 24 + hh) * S * 64;
    const bf16_t* Vt = (const bf16_t*)(ws + OFF_VA) + (size_t)(bl * 24 + hh) * 64 * S;
    bf16x8 qf[4]; load_q(qf, Q + (size_t)(row0 + r) * 64, h);
    AttnAcc a; attn_init(a, attn_bound(qf, p.qk_g + ((size_t)(layer * 3 + 0) * 2 + 1) * 64));
    const int kfirst = m0 >= 128 ? 0 : (128 - m0) / 32;
    const int tile0 = (rr * n + m0 - 128) / 32 + 0;
    auto amask = [&](int k) -> unsigned {
        if (k != 0 && k != 4) return 0xffffu;
        const int mk0 = m0 - 128 + 32 * k; unsigned vm = 0;
#pragma unroll
        for (int i = 0; i < 16; ++i) { const int d = (m0 + r) - (mk0 + koff(i, h)); if (d >= 0 && d <= 128) vm |= 1u << i; }
        return vm;
    };
    KVFrag f0, f1; kv_load(f0, K + (size_t)(tile0 + kfirst) * 2048, Vt + (size_t)(tile0 + kfirst) * 2048, lane);
    for (int k = kfirst; k < 5; k += 2) {
        { const int kn = k + 1 < 5 ? k + 1 : k; kv_load(f1, K + (size_t)(tile0 + kn) * 2048, Vt + (size_t)(tile0 + kn) * 2048, lane); }
        attn_step(a, f0, qf, amask(k));
        if (k + 1 < 5) {
            { const int kn = k + 2 < 5 ? k + 2 : k + 1; kv_load(f0, K + (size_t)(tile0 + kn) * 2048, Vt + (size_t)(tile0 + kn) * 2048, lane); }
            attn_step(a, f1, qf, amask(k + 1));
        }
    }
    const float l = a.l + shx(a.l, 32);
    const float inv = 1.0f / l;
    const int s = ((m0 + r) << sh) + rr;
    const size_t tl = (size_t)bl * S + s;
    bf16_t* o = (bf16_t*)(ws + OFF_OA) + ((size_t)g * TG + tl) * 512 + (hh & 7) * 64;
#pragma unroll
    for (int q4 = 0; q4 < 4; ++q4) {
        u32x2 w0, w1;
        w0[0] = cvt_pk_bf16(a.o0[q4 * 4] * inv, a.o0[q4 * 4 + 1] * inv); w0[1] = cvt_pk_bf16(a.o0[q4 * 4 + 2] * inv, a.o0[q4 * 4 + 3] * inv);
        w1[0] = cvt_pk_bf16(a.o1[q4 * 4] * inv, a.o1[q4 * 4 + 1] * inv); w1[1] = cvt_pk_bf16(a.o1[q4 * 4 + 2] * inv, a.o1[q4 * 4 + 3] * inv);
        *(u32x2*)(o + 8 * q4 + 4 * h) = w0; *(u32x2*)(o + 32 + 8 * q4 + 4 * h) = w1;
    }
    if (h == 0) ((float*)(ws + OFF_LSE))[((size_t)g * TG + tl) * 8 + (hh & 7)] = (a.nb + __log2f(l)) * LN2F;
}

DI void attn_store_gated(const Params& p, const AttnAcc& a, size_t tl, int col0, int h, bool st) {
    const float l = a.l + shx(a.l, 32);
    const float inv = 1.0f / l;
    bf16_t* z = (bf16_t*)(p.ws + OFF_SZ) + tl * 1536 + col0;
#pragma unroll
    for (int q4 = 0; q4 < 4; ++q4) {
#pragma unroll
        for (int db = 0; db < 2; ++db) {
            bf16_t* zp = z + db * 32 + 8 * q4 + 4 * h;
            const u32x2 zw = *(const u32x2*)zp;
            const float z0 = __uint_as_float(zw[0] << 16), z1 = __uint_as_float(zw[0] & 0xffff0000u), z2 = __uint_as_float(zw[1] << 16), z3 = __uint_as_float(zw[1] & 0xffff0000u);
            const f32x16& o = db ? a.o1 : a.o0;
            u32x2 wv; wv[0] = cvt_pk_bf16(o[q4 * 4] * inv * z0, o[q4 * 4 + 1] * inv * z1); wv[1] = cvt_pk_bf16(o[q4 * 4 + 2] * inv * z2, o[q4 * 4 + 3] * inv * z3);
            if (st) *(u32x2*)zp = wv;
        }
    }
}

DI void attn_b_item(const Params& p, int layer, int bl, int hd, int qb, bool st, int var) {
    char* ws = p.ws;
    const int lane = ltid() & 63, w = __builtin_amdgcn_readfirstlane(ltid() >> 6), r = lane & 31, h = lane >> 5;
    const int q0 = qb * 256 + w * 32;
    const bf16_t* Q = (const bf16_t*)(ws + OFF_QB) + (size_t)(bl * 8 + hd) * S * 64;
    const bf16_t* K = (const bf16_t*)(ws + OFF_KB) + (size_t)(bl * 8 + hd) * S * 64;
    const bf16_t* Vt = (const bf16_t*)(ws + OFF_VB) + (size_t)(bl * 8 + hd) * 64 * S;
    const unsigned* mrow = (const unsigned*)(ws + OFF_MASK) + ((size_t)bl * S + q0 + r) * 128;
    bf16x8 qf[4]; load_q(qf, Q + (size_t)(q0 + r) * 64, h);
    AttnAcc a; attn_init(a, attn_bound(qf, p.qk_g + ((size_t)(layer * 3 + 1) * 2 + 1) * 64));
    const int nkt = q0 / 32 + 1;
    auto bmask = [&](unsigned mw) -> unsigned {
        const unsigned ws4 = mw >> (4 * h);
        return (ws4 & 0xfu) | ((ws4 >> 4) & 0xf0u) | ((ws4 >> 8) & 0xf00u) | ((ws4 >> 12) & 0xf000u);
    };
    KVFrag f0, f1; kv_load(f0, K, Vt, lane);
    unsigned mw0 = mrow[0], mw1 = 0;
    const int tmul = var == 1 ? 0 : 1;
    for (int kt = 0; kt < nkt; kt += 2) {
        { const int kn = (kt + 1 < nkt ? kt + 1 : kt) * tmul; kv_load(f1, K + (size_t)kn * 2048, Vt + (size_t)kn * 2048, lane); mw1 = mrow[kn]; }
        if (var == 2) a.l += __int_as_float((int)f0.k[0][0] + (int)f0.k[3][7] + (int)f0.v[0][0][0] + (int)f0.v[1][1][7] + (int)mw0); else
        attn_step(a, f0, qf, bmask(mw0));
        if (kt + 1 < nkt) {
            { const int kn = (kt + 2 < nkt ? kt + 2 : kt + 1) * tmul; kv_load(f0, K + (size_t)kn * 2048, Vt + (size_t)kn * 2048, lane); mw0 = mrow[kn]; }
            if (var == 2) a.l += __int_as_float((int)f1.k[0][0] + (int)f1.k[3][7] + (int)f1.v[0][0][0] + (int)f1.v[1][1][7] + (int)mw1); else
            attn_step(a, f1, qf, bmask(mw1));
        }
    }
    attn_store_gated(p, a, (size_t)bl * S + q0 + r, 512 + hd * 64, h, st);
}

DI void attn_c_item(const Params& p, int layer, int bl, int hd, int qb, bool st) {
    char* ws = p.ws;
    const int lane = ltid() & 63, w = __builtin_amdgcn_readfirstlane(ltid() >> 6), r = lane & 31, h = lane >> 5;
    const int q0 = qb * 256 + w * 32, own = qb;
    const bf16_t* Q = (const bf16_t*)(ws + OFF_QC) + (size_t)(bl * 8 + hd) * S * 64;
    const bf16_t* K = (const bf16_t*)(ws + OFF_KC) + (size_t)(bl * 8 + hd) * S * 64;
    const bf16_t* Vt = (const bf16_t*)(ws + OFF_VC) + (size_t)(bl * 8 + hd) * 64 * S;
    bf16x8 qf[4]; load_q(qf, Q + (size_t)(q0 + r) * 64, h);
    unsigned sel = 0;
    if (own > 0) {
        const bf16_t* km = (const bf16_t*)(ws + OFF_KM) + (((size_t)(bl * 8 + hd) * 16 + (r & 15)) * 2) * 64;
        f32x16 gt;
#pragma unroll
        for (int i = 0; i < 16; ++i) gt[i] = 0.f;
#pragma unroll
        for (int kk = 0; kk < 4; ++kk) {
            bf16x8 ahi = *(const bf16x8*)(km + kk * 16 + h * 8), alo = *(const bf16x8*)(km + 64 + kk * 16 + h * 8);
            if (r >= 16) { ahi = (bf16x8){0, 0, 0, 0, 0, 0, 0, 0}; alo = ahi; }
            gt = MFMA32(ahi, qf[kk], gt); gt = MFMA32(alo, qf[kk], gt);
        }
        float gl[16];
#pragma unroll
        for (int i = 0; i < 8; ++i) {
            const float mine = gt[i], oth = shx(mine, 32);
            const int blk_mine = 8 * (i >> 2) + 4 * h + (i & 3), blk_oth = 8 * (i >> 2) + 4 * (1 - h) + (i & 3);
            (void)blk_mine; (void)blk_oth;
            gl[8 * (i >> 2) + (i & 3)] = h == 0 ? mine : oth;
            gl[8 * (i >> 2) + 4 + (i & 3)] = h == 0 ? oth : mine;
        }
#pragma unroll
        for (int pick = 0; pick < 3; ++pick) {
            float best = -3.0e38f; int bi = -1;
#pragma unroll
            for (int nb = 0; nb < 16; ++nb) { const bool ok = nb < own && !((sel >> nb) & 1u); if (ok && gl[nb] > best) { best = gl[nb]; bi = nb; } }
            if (bi >= 0) sel |= 1u << bi;
        }
    }
    AttnAcc a; attn_init(a, attn_bound(qf, p.qk_g + ((size_t)(layer * 3 + 2) * 2 + 1) * 64));
    unsigned vis = 0;
    for (int nb = 0; nb < own; ++nb) if (__ballot((sel >> nb) & 1u) != 0ull) vis |= 1u << nb;
    const int ndiag = q0 / 32;
    unsigned long long tm0 = 0ull, tm1 = 0ull;
    for (int nb = 0; nb < own; ++nb) if ((vis >> nb) & 1u) { if (nb < 8) tm0 |= 0xffull << (8 * nb); else tm1 |= 0xffull << (8 * (nb - 8)); }
    for (int t = own * 8; t <= ndiag; ++t) { if (t < 64) tm0 |= 1ull << t; else tm1 |= 1ull << (t - 64); }
    int ntl = __builtin_popcountll(tm0) + __builtin_popcountll(tm1);
    auto pop = [&]() -> int { int t; if (tm0) { t = __builtin_ctzll(tm0); tm0 &= tm0 - 1; } else if (tm1) { t = 64 + __builtin_ctzll(tm1); tm1 &= tm1 - 1; } else t = ndiag; return t; };
    auto cmask = [&](int t) -> unsigned {
        const int cb = t >> 3;
        if (cb < own) return ((sel >> cb) & 1u) ? 0xffffu : 0u;
        if (t != ndiag) return 0xffffu;
        unsigned vm = 0;
#pragma unroll
        for (int i = 0; i < 16; ++i) if (koff(i, h) <= r) vm |= 1u << i;
        return vm;
    };
    KVFrag f0, f1; int t0 = pop(), t1 = 0;
    kv_load(f0, K + (size_t)t0 * 2048, Vt + (size_t)t0 * 2048, lane);
    for (int it = 0; it < ntl; it += 2) {
        t1 = pop(); kv_load(f1, K + (size_t)t1 * 2048, Vt + (size_t)t1 * 2048, lane);
        attn_step(a, f0, qf, cmask(t0));
        if (it + 1 < ntl) {
            t0 = pop(); kv_load(f0, K + (size_t)t0 * 2048, Vt + (size_t)t0 * 2048, lane);
            attn_step(a, f1, qf, cmask(t1));
        }
    }
    attn_store_gated(p, a, (size_t)bl * S + q0 + r, 1024 + hd * 64, h, st);
}

DI void attn_bc_item(const Params& p, int layer, int typ, int bl, int hd, int qb, bool st, char* shm) {
    char* ws = p.ws;
    const int tid = ltid(), lane = tid & 63, w = tid >> 6, r = lane & 31, h = lane >> 5;
    const int q0 = qb * 256 + w * 32, own = qb, ndiag = q0 / 32;
    const bf16_t* Q = (const bf16_t*)(ws + (typ ? OFF_QC : OFF_QB)) + (size_t)(bl * 8 + hd) * S * 64;
    const bf16_t* K = (const bf16_t*)(ws + (typ ? OFF_KC : OFF_KB)) + (size_t)(bl * 8 + hd) * S * 64;
    const bf16_t* Vt = (const bf16_t*)(ws + (typ ? OFF_VC : OFF_VB)) + (size_t)(bl * 8 + hd) * 64 * S;
    const unsigned* mrow = (const unsigned*)(ws + OFF_MASK) + ((size_t)bl * S + q0 + r) * 128;
    unsigned short* seq = (unsigned short*)(shm + 16384);
    unsigned* wvis = (unsigned*)(shm + 16896);
    bf16x8 qf[4]; load_q(qf, Q + (size_t)(q0 + r) * 64, h);
    unsigned sel = 0, vis = 0;
    if (typ == 1 && own > 0) {
        const bf16_t* km = (const bf16_t*)(ws + OFF_KM) + (((size_t)(bl * 8 + hd) * 16 + (r & 15)) * 2) * 64;
        f32x16 gt;
#pragma unroll
        for (int i = 0; i < 16; ++i) gt[i] = 0.f;
#pragma unroll
        for (int kk = 0; kk < 4; ++kk) {
            bf16x8 ahi = *(const bf16x8*)(km + kk * 16 + h * 8), alo = *(const bf16x8*)(km + 64 + kk * 16 + h * 8);
            if (r >= 16) { ahi = (bf16x8){0, 0, 0, 0, 0, 0, 0, 0}; alo = ahi; }
            gt = MFMA32(ahi, qf[kk], gt); gt = MFMA32(alo, qf[kk], gt);
        }
        float gl[16];
#pragma unroll
        for (int i = 0; i < 8; ++i) {
            const float mine = gt[i], oth = shx(mine, 32);
            gl[8 * (i >> 2) + (i & 3)] = h == 0 ? mine : oth;
            gl[8 * (i >> 2) + 4 + (i & 3)] = h == 0 ? oth : mine;
        }
#pragma unroll
        for (int pick = 0; pick < 3; ++pick) {
            float best = -3.0e38f; int bi = -1;
#pragma unroll
            for (int nb = 0; nb < 16; ++nb) { const bool ok = nb < own && !((sel >> nb) & 1u); if (ok && gl[nb] > best) { best = gl[nb]; bi = nb; } }
            if (bi >= 0) sel |= 1u << bi;
        }
        for (int nb = 0; nb < own; ++nb) if (__ballot((sel >> nb) & 1u) != 0ull) vis |= 1u << nb;
    }
    if (typ == 0) vis = (1u << own) - 1u;
    __syncthreads();
    if (lane == 0) wvis[w] = vis;
    __syncthreads();
    if (tid == 0) {
        unsigned bv = 0;
        for (int i = 0; i < 8; ++i) bv |= wvis[i];
        int n = 0;
        for (int nb = 0; nb < own; ++nb) if ((bv >> nb) & 1u) for (int k = 0; k < 8; ++k) seq[n++] = (unsigned short)(nb * 8 + k);
        for (int k = 0; k < 8; ++k) seq[n++] = (unsigned short)(own * 8 + k);
        seq[255] = (unsigned short)n;
    }
    __syncthreads();
    const int ntl = seq[255];
    const bf16_t* gsrc = (tid < 256 ? K : Vt) + (size_t)(tid & 255) * 8;
    char* lds_dst = shm + tid * 16;
    u32x4 R = *(const u32x4*)(gsrc + (size_t)seq[0] * 2048);
    *(u32x4*)lds_dst = R;
    if (ntl > 1) R = *(const u32x4*)(gsrc + (size_t)seq[1] * 2048);
    AttnAcc a; attn_init(a, attn_bound(qf, p.qk_g + ((size_t)(layer * 3 + 1 + typ) * 2 + 1) * 64));
    unsigned mw = typ == 0 ? mrow[seq[0]] : 0u;
    __syncthreads();
    for (int t = 0; t < ntl; ++t) {
        const int ct = seq[t], cb = ct >> 3;
        unsigned mwn = 0;
        if (typ == 0 && t + 1 < ntl) mwn = mrow[seq[t + 1]];
        const bool need = cb < own ? ((vis >> cb) & 1u) != 0u : ct <= ndiag;
        if (need) {
            const char* buf = shm + (t & 1) * 8192;
            KVFrag f;
#pragma unroll
            for (int kk = 0; kk < 4; ++kk) f.k[kk] = *(const bf16x8*)(buf + (kk * 64 + lane) * 16);
#pragma unroll
            for (int db = 0; db < 2; ++db)
#pragma unroll
                for (int u = 0; u < 2; ++u) f.v[db][u] = *(const bf16x8*)(buf + 4096 + ((db * 2 + u) * 64 + lane) * 16);
            unsigned vm;
            if (typ == 0) {
                const unsigned ws4 = mw >> (4 * h);
                vm = (ws4 & 0xfu) | ((ws4 >> 4) & 0xf0u) | ((ws4 >> 8) & 0xf00u) | ((ws4 >> 12) & 0xf000u);
            } else if (cb < own) vm = ((sel >> cb) & 1u) ? 0xffffu : 0u;
            else if (ct == ndiag) {
                vm = 0;
#pragma unroll
                for (int i = 0; i < 16; ++i) if (koff(i, h) <= r) vm |= 1u << i;
            } else vm = 0xffffu;
            attn_step(a, f, qf, vm);
        }
        if (t + 1 < ntl) {
            *(u32x4*)(lds_dst + ((t + 1) & 1) * 8192) = R;
            if (t + 2 < ntl) R = *(const u32x4*)(gsrc + (size_t)seq[t + 2] * 2048);
        }
        mw = mwn;
        __syncthreads();
    }
    attn_store_gated(p, a, (size_t)bl * S + q0 + r, (typ ? 1024 : 512) + hd * 64, h, st);
}

template <int TYP>
DI void attn_step2(AttnAcc& a0, AttnAcc& a1, KVFrag& f, const bf16x8 (&qa)[4], const bf16x8 (&qb)[4], unsigned vm0, unsigned vm1, bool shifted, const bf16_t* Kn, const bf16_t* Vn, int lane) {
    f32x16 s0, s1;
    __builtin_amdgcn_s_setprio(1);
    if (shifted) {
#pragma unroll
        for (int i = 0; i < 16; ++i) { s0[i] = -a0.nb; s1[i] = -a1.nb; }
        s0 = MFMA32(f.k[0], qa[0], s0); s1 = MFMA32(f.k[0], qb[0], s1);
    } else {
        const f32x16 z = {0.f, 0.f, 0.f, 0.f, 0.f, 0.f, 0.f, 0.f, 0.f, 0.f, 0.f, 0.f, 0.f, 0.f, 0.f, 0.f};
        s0 = MFMA32(f.k[0], qa[0], z); s1 = MFMA32(f.k[0], qb[0], z);
    }
#pragma unroll
    for (int kk = 1; kk < 4; ++kk) { s0 = MFMA32(f.k[kk], qa[kk], s0); s1 = MFMA32(f.k[kk], qb[kk], s1); }
    __builtin_amdgcn_s_setprio(0);
#pragma unroll
    for (int kk = 0; kk < 4; ++kk) f.k[kk] = *(const bf16x8*)(Kn + (kk * 64 + lane) * 8);
    float p0[16], p1[16];
#pragma unroll
    for (int i = 0; i < 16; ++i) { p0[i] = fexp2(s0[i]); p1[i] = fexp2(s1[i]); }
    if (TYP == 0 || __ballot((vm0 & vm1) != 0xffffu) != 0ull) {
#pragma unroll
        for (int i = 0; i < 16; ++i) {
            p0[i] = __int_as_float(__float_as_int(p0[i]) & __builtin_amdgcn_sbfe((int)vm0, i, 1));
            p1[i] = __int_as_float(__float_as_int(p1[i]) & __builtin_amdgcn_sbfe((int)vm1, i, 1));
        }
    }
    a0.l += ((p0[0] + p0[1]) + (p0[2] + p0[3])) + ((p0[4] + p0[5]) + (p0[6] + p0[7])) + (((p0[8] + p0[9]) + (p0[10] + p0[11])) + ((p0[12] + p0[13]) + (p0[14] + p0[15])));
    a1.l += ((p1[0] + p1[1]) + (p1[2] + p1[3])) + ((p1[4] + p1[5]) + (p1[6] + p1[7])) + (((p1[8] + p1[9]) + (p1[10] + p1[11])) + ((p1[12] + p1[13]) + (p1[14] + p1[15])));
    u32x4 w00, w01, w10, w11;
#pragma unroll
    for (int i = 0; i < 4; ++i) {
        w00[i] = cvt_pk_bf16(p0[2 * i], p0[2 * i + 1]); w01[i] = cvt_pk_bf16(p0[8 + 2 * i], p0[8 + 2 * i + 1]);
        w10[i] = cvt_pk_bf16(p1[2 * i], p1[2 * i + 1]); w11[i] = cvt_pk_bf16(p1[8 + 2 * i], p1[8 + 2 * i + 1]);
    }
    const bf16x8 f00 = __builtin_bit_cast(bf16x8, w00), f01 = __builtin_bit_cast(bf16x8, w01), f10 = __builtin_bit_cast(bf16x8, w10), f11 = __builtin_bit_cast(bf16x8, w11);
    __builtin_amdgcn_s_setprio(1);
    a0.o0 = MFMA32(f.v[0][0], f00, a0.o0); a1.o0 = MFMA32(f.v[0][0], f10, a1.o0);
    a0.o0 = MFMA32(f.v[0][1], f01, a0.o0); a1.o0 = MFMA32(f.v[0][1], f11, a1.o0);
    a0.o1 = MFMA32(f.v[1][0], f00, a0.o1); a1.o1 = MFMA32(f.v[1][0], f10, a1.o1);
    a0.o1 = MFMA32(f.v[1][1], f01, a0.o1); a1.o1 = MFMA32(f.v[1][1], f11, a1.o1);
    __builtin_amdgcn_s_setprio(0);
#pragma unroll
    for (int db = 0; db < 2; ++db)
#pragma unroll
        for (int u = 0; u < 2; ++u) f.v[db][u] = *(const bf16x8*)(Vn + ((db * 2 + u) * 64 + lane) * 8);
}
template <int TYP>
DI void attn_bc2_chunk(const Params& p, int layer, int bl, int hd, int cidx  , bool st) {
    char* ws = p.ws;
    const int lane = ltid() & 63, w = __builtin_amdgcn_readfirstlane(ltid() >> 6), r = lane & 31, h = lane >> 5;
    const int own = cidx >> 2, q0 = cidx * 64;
    const bf16_t* Q = (const bf16_t*)(ws + (TYP ? OFF_QC : OFF_QB)) + (size_t)(bl * 8 + hd) * S * 64;
    const bf16_t* K = (const bf16_t*)(ws + (TYP ? OFF_KC : OFF_KB)) + (size_t)(bl * 8 + hd) * S * 64;
    const bf16_t* Vt = (const bf16_t*)(ws + (TYP ? OFF_VC : OFF_VB)) + (size_t)(bl * 8 + hd) * 64 * S;
    const unsigned* mrow0 = (const unsigned*)(ws + OFF_MASK) + ((size_t)bl * S + q0 + r) * 128;
    const unsigned* mrow1 = mrow0 + 32 * 128;
    bf16x8 qa[4], qb[4];
    load_q(qa, Q + (size_t)(q0 + r) * 64, h); load_q(qb, Q + (size_t)(q0 + 32 + r) * 64, h);
    const float* gk = p.qk_g + ((size_t)(layer * 3 + 1 + TYP) * 2 + 1) * 64;
    AttnAcc a0, a1; attn_init(a0, attn_bound(qa, gk)); attn_init(a1, attn_bound(qb, gk));
    const bool shifted = a0.shifted || a1.shifted;
    if (shifted && !a0.shifted) a0.nb = 0.f;
    if (shifted && !a1.shifted) a1.nb = 0.f;
    const int d0 = q0 / 32, d1 = d0 + 1;
    unsigned sel0 = 0, sel1 = 0;
    unsigned long long tm0 = 0ull, tm1 = 0ull;
    if (TYP == 1) {
        if (own > 0) {
            const bf16_t* km = (const bf16_t*)(ws + OFF_KM) + (((size_t)(bl * 8 + hd) * 16 + (r & 15)) * 2) * 64;
            f32x16 g0, g1;
#pragma unroll
            for (int i = 0; i < 16; ++i) { g0[i] = 0.f; g1[i] = 0.f; }
#pragma unroll
            for (int kk = 0; kk < 4; ++kk) {
                bf16x8 ahi = *(const bf16x8*)(km + kk * 16 + h * 8), alo = *(const bf16x8*)(km + 64 + kk * 16 + h * 8);
                if (r >= 16) { ahi = (bf16x8){0, 0, 0, 0, 0, 0, 0, 0}; alo = ahi; }
                g0 = MFMA32(ahi, qa[kk], g0); g0 = MFMA32(alo, qa[kk], g0);
                g1 = MFMA32(ahi, qb[kk], g1); g1 = MFMA32(alo, qb[kk], g1);
            }
            auto top3 = [&](const f32x16& gt) -> unsigned {
                float gl[16];
#pragma unroll
                for (int i = 0; i < 8; ++i) {
                    const float mine = gt[i], oth = shx(mine, 32);
                    gl[8 * (i >> 2) + (i & 3)] = h == 0 ? mine : oth;
                    gl[8 * (i >> 2) + 4 + (i & 3)] = h == 0 ? oth : mine;
                }
                unsigned sel = 0;
#pragma unroll
                for (int pick = 0; pick < 3; ++pick) {
                    float best = -3.0e38f; int bi = -1;
#pragma unroll
                    for (int nb = 0; nb < 16; ++nb) { const bool ok = nb < own && !((sel >> nb) & 1u); if (ok && gl[nb] > best) { best = gl[nb]; bi = nb; } }
                    if (bi >= 0) sel |= 1u << bi;
                }
                return sel;
            };
            sel0 = top3(g0); sel1 = top3(g1);
        }
        for (int nb = 0; nb < own; ++nb) if (__ballot(((sel0 | sel1) >> nb) & 1u) != 0ull) { if (nb < 8) tm0 |= 0xffull << (8 * nb); else tm1 |= 0xffull << (8 * (nb - 8)); }
        for (int t = own * 8; t <= d1; ++t) { if (t < 64) tm0 |= 1ull << t; else tm1 |= 1ull << (t - 64); }
    } else {
        for (int t = 0; t <= d1; ++t) { if (t < 64) tm0 |= 1ull << t; else tm1 |= 1ull << (t - 64); }
    }
    const int ntl = __builtin_popcountll(tm0) + __builtin_popcountll(tm1);
    auto pop = [&]() -> int { int t; if (tm0) { t = __builtin_ctzll(tm0); tm0 &= tm0 - 1; } else if (tm1) { t = 64 + __builtin_ctzll(tm1); tm1 &= tm1 - 1; } else t = d1; return t; };
    auto cmask = [&](int t, unsigned sel, int dg) -> unsigned {
        const int cb = t >> 3;
        if (cb < own) return ((sel >> cb) & 1u) ? 0xffffu : 0u;
        if (t < dg) return 0xffffu;
        if (t > dg) return 0u;
        unsigned vm = 0;
#pragma unroll
        for (int i = 0; i < 16; ++i) if (koff(i, h) <= r) vm |= 1u << i;
        return vm;
    };
    auto bmask = [&](unsigned mw) -> unsigned {
        const unsigned ws4 = mw >> (4 * h);
        return (ws4 & 0xfu) | ((ws4 >> 4) & 0xf0u) | ((ws4 >> 8) & 0xf00u) | ((ws4 >> 12) & 0xf000u);
    };
    KVFrag f; int tc = pop(), tn = 0;
    kv_load(f, K + (size_t)tc * 2048, Vt + (size_t)tc * 2048, lane);
    unsigned mwa = 0, mwb = 0, mwan = 0, mwbn = 0;
    if (TYP == 0) { mwa = mrow0[tc]; mwb = mrow1[tc]; }
    for (int it = 0; it < ntl; ++it) {
        tn = pop();
        if (TYP == 0) { mwan = mrow0[tn]; mwbn = mrow1[tn]; }
        unsigned vm0, vm1;
        if (TYP == 0) { vm0 = bmask(mwa); vm1 = bmask(mwb); } else { vm0 = cmask(tc, sel0, d0); vm1 = cmask(tc, sel1, d1); }
        attn_step2<TYP>(a0, a1, f, qa, qb, vm0, vm1, shifted, K + (size_t)tn * 2048, Vt + (size_t)tn * 2048, lane);
        tc = tn; mwa = mwan; mwb = mwbn;
    }
    attn_store_gated(p, a0, (size_t)bl * S + q0 + r, (TYP ? 1024 : 512) + hd * 64, h, st);
    attn_store_gated(p, a1, (size_t)bl * S + q0 + 32 + r, (TYP ? 1024 : 512) + hd * 64, h, st);
}

DI void attn_a2_item(const Params& p, int layer, int bl, int hh, int rb2) {
    char* ws = p.ws;
    const int lane = ltid() & 63, w = __builtin_amdgcn_readfirstlane(ltid() >> 6), r = lane & 31, h = lane >> 5;
    const int g = hh >> 3, sh = 2 * g, n = S >> sh;
    const int row0 = rb2 * 512 + w * 64;
    const int rr = row0 / n, m0 = row0 % n;
    const bf16_t* Q = (const bf16_t*)(ws + OFF_QA) + (size_t)(bl * 24 + hh) * S * 64;
    const bf16_t* K = (const bf16_t*)(ws + OFF_KA) + (size_t)(bl * 24 + hh) * S * 64;
    const bf16_t* Vt = (const bf16_t*)(ws + OFF_VA) + (size_t)(bl * 24 + hh) * 64 * S;
    bf16x8 qa[4], qb[4];
    load_q(qa, Q + (size_t)(row0 + r) * 64, h); load_q(qb, Q + (size_t)(row0 + 32 + r) * 64, h);
    const float* gk = p.qk_g + ((size_t)(layer * 3 + 0) * 2 + 1) * 64;
    AttnAcc a0, a1; attn_init(a0, attn_bound(qa, gk)); attn_init(a1, attn_bound(qb, gk));
    const bool shifted = a0.shifted || a1.shifted;
    if (shifted && !a0.shifted) a0.nb = 0.f;
    if (shifted && !a1.shifted) a1.nb = 0.f;
    const int kfirst = m0 >= 128 ? 0 : (128 - m0) / 32;
    const int tile0 = (rr * n + m0 - 128) / 32;
    auto amask = [&](int k, int sb) -> unsigned {
        const int base = 128 + 32 * sb - 32 * k + r;
        if (base - 31 >= 0 && base <= 128) return 0xffffu;
        if (base < 0 || base - 31 > 128) return 0u;
        unsigned vm = 0;
#pragma unroll
        for (int i = 0; i < 16; ++i) { const int d = base - koff(i, h); if (d >= 0 && d <= 128) vm |= 1u << i; }
        return vm;
    };
    KVFrag f; kv_load(f, K + (size_t)(tile0 + kfirst) * 2048, Vt + (size_t)(tile0 + kfirst) * 2048, lane);
    for (int k = kfirst; k < 6; ++k) {
        const int kn = k + 1 < 6 ? k + 1 : k;
        attn_step2<1>(a0, a1, f, qa, qb, amask(k, 0), amask(k, 1), shifted, K + (size_t)(tile0 + kn) * 2048, Vt + (size_t)(tile0 + kn) * 2048, lane);
    }
#pragma unroll
    for (int sb = 0; sb < 2; ++sb) {
        const AttnAcc& a = sb ? a1 : a0;
        const float l = a.l + shx(a.l, 32);
        const float inv = 1.0f / l;
        const int s_ = ((m0 + 32 * sb + r) << sh) + rr;
        const size_t tl = (size_t)bl * S + s_;
        bf16_t* o = (bf16_t*)(ws + OFF_OA) + ((size_t)g * TG + tl) * 512 + (hh & 7) * 64;
#pragma unroll
        for (int q4 = 0; q4 < 4; ++q4) {
            u32x2 w0, w1;
            w0[0] = cvt_pk_bf16(a.o0[q4 * 4] * inv, a.o0[q4 * 4 + 1] * inv); w0[1] = cvt_pk_bf16(a.o0[q4 * 4 + 2] * inv, a.o0[q4 * 4 + 3] * inv);
            w1[0] = cvt_pk_bf16(a.o1[q4 * 4] * inv, a.o1[q4 * 4 + 1] * inv); w1[1] = cvt_pk_bf16(a.o1[q4 * 4 + 2] * inv, a.o1[q4 * 4 + 3] * inv);
            *(u32x2*)(o + 8 * q4 + 4 * h) = w0; *(u32x2*)(o + 32 + 8 * q4 + 4 * h) = w1;
        }
        if (h == 0) ((float*)(ws + OFF_LSE))[((size_t)g * TG + tl) * 8 + (hh & 7)] = (a.nb + __log2f(l)) * LN2F;
    }
}

DI void merge_a_item(const Params& p, int item, bool st) {
    char* ws = p.ws;
    const int tid = ltid();
    const bf16_t* oa = (const bf16_t*)(ws + OFF_OA);
    const float* lse = (const float*)(ws + OFF_LSE);
    bf16_t* sz = (bf16_t*)(ws + OFF_SZ);
    for (int it = 0; it < 8; ++it) {
        const size_t tl = (size_t)item * 64 + it * 8 + (tid >> 6);
        const int c8 = (tid & 63) * 8, hd = c8 >> 6;
        const float l0 = lse[(0 * (size_t)TG + tl) * 8 + hd], l1 = lse[(1 * (size_t)TG + tl) * 8 + hd], l2 = lse[(2 * (size_t)TG + tl) * 8 + hd];
        const float mx = fmaxf(l0, fmaxf(l1, l2));
        float w0 = __expf(l0 - mx), w1 = __expf(l1 - mx), w2 = __expf(l2 - mx);
        const float inv = 1.0f / (w0 + w1 + w2); w0 *= inv; w1 *= inv; w2 *= inv;
        const u32x4 a0 = *(const u32x4*)(oa + (0 * (size_t)TG + tl) * 512 + c8), a1 = *(const u32x4*)(oa + (1 * (size_t)TG + tl) * 512 + c8), a2 = *(const u32x4*)(oa + (2 * (size_t)TG + tl) * 512 + c8);
        const u32x4 zz = *(const u32x4*)(sz + tl * 1536 + c8);
        u32x4 res;
#pragma unroll
        for (int k = 0; k < 4; ++k) {
            const float lo = (w0 * __uint_as_float(a0[k] << 16) + w1 * __uint_as_float(a1[k] << 16) + w2 * __uint_as_float(a2[k] << 16)) * __uint_as_float(zz[k] << 16);
            const float hi = (w0 * __uint_as_float(a0[k] & 0xffff0000u) + w1 * __uint_as_float(a1[k] & 0xffff0000u) + w2 * __uint_as_float(a2[k] & 0xffff0000u)) * __uint_as_float(zz[k] & 0xffff0000u);
            res[k] = cvt_pk_bf16(lo, hi);
        }
        if (st) *(u32x4*)(sz + tl * 1536 + c8) = res;
    }
}

DI int snake_item(int round, int G, int bid) { return (round & 1) ? round * G + (G - 1 - bid) : round * G + bid; }

__global__ void __launch_bounds__(NTHREADS) fwd_megakernel(Params p) {
    __shared__ __attribute__((aligned(16))) char shm_raw[SHM_BYTES];
    cg::grid_group grid = cg::this_grid();
    char* ws = p.ws;
    const int G = gridDim.x, bid = blockIdx.x;
    __attribute__((address_space(3))) bf16_t* shm_g = (__attribute__((address_space(3))) bf16_t*)shm_raw;

    unsigned* barcnt = (unsigned*)(ws + OFF_BAR2);
    unsigned bartarget = 0;
    if (bid == 0 && threadIdx.x < 9) __hip_atomic_store(barcnt + 32 * threadIdx.x, 0u, __ATOMIC_RELAXED, __HIP_MEMORY_SCOPE_AGENT);
    if (bid == 0 && threadIdx.x < DEPTH * NGRP * 64) ((unsigned*)(ws + OFF_FLAG))[threadIdx.x] = 0u;
    phase_prep(p, shm_raw);
    if (DUPMASK & 64) { __syncthreads(); phase_prep(p, shm_raw); }
    grid.sync();

#define LAUNDER() do { } while (0)
    unsigned long long tspan = 0ull, tprev = SPINSEL ? wall_clock64() : 0ull;
#define PHASE_END(k) do { if (SPINSEL) { const unsigned long long tn_ = wall_clock64(); if (SPINSEL == (k)) tspan += tn_ - tprev; tprev = tn_; } } while (0)
    for (int layer = 0; layer < DEPTH; ++layer) {
        for (int grp = 0; grp < NGRP; ++grp) {
            const int gtok0 = grp * TG;
            LAUNDER();
            for (int rep = 0; rep <= (DUPMASK & 1); ++rep) {
                EpiIn epi{&p, layer, gtok0};
                gemm_phase<true>((const bf16_t*)(ws + OFF_WTIN), DM, 0, NPAD, (const bf16_t*)(ws + OFF_XB), DM, 0, TG, DM, 1, epi, shm_g);
            }
            grid_barrier(barcnt, bartarget, (unsigned)G);
            if (DUPMASK & 32) grid_barrier(barcnt, bartarget, (unsigned)G);
            PHASE_END(1);
            LAUNDER();
            for (int rep = 0; rep <= ((DUPMASK >> 1) & 1); ++rep) {
                const int nsel = BG * 256;
                const int nA = BG * 24 * 8, nK = BG * 8 * 16;
                const int rS = (nsel + G - 1) / G, rA = (nA + G - 1) / G, rK = (nK + G - 1) / G, rT = rS + rA + rK;
                const int off = (bid & 1) ? rS : 0;
                for (int st_ = 0; st_ < rT; ++st_) {
                    int s2 = st_ + off; if (s2 >= rT) s2 -= rT;
                    if (s2 < rS) {
                        const int it = snake_item(s2, G, bid);
                        if (it < nsel) select_chunk(p, it % BG, 255 - it / BG, shm_raw);
                    } else if (s2 < rS + rA) {
                        const int it = (s2 - rS) * G + bid;
                        if (it < nA) attn_a2_item(p, layer, it / (24 * 8), (it / 8) % 24, it % 8);
                    } else {
                        const int it = (s2 - rS - rA) * G + bid;
                        if (it < nK) kmean_item(p, it / 128, (it / 16) & 7, it & 15, shm_raw);
                    }
                }
            }
            grid_barrier(barcnt, bartarget, (unsigned)G);
            if (DUPMASK & 32) grid_barrier(barcnt, bartarget, (unsigned)G);
            PHASE_END(2);
            LAUNDER();
            for (int rep = ((DUPMASK >> 2) & 1); rep >= 0; --rep) {
                const bool st = rep == 0 || p.dupmask == 0x7fffffff;
#if ATTN64
                const int nbc = 2 * BG * 8 * 4;
                const int wv = __builtin_amdgcn_readfirstlane(ltid() >> 6);
                for (int it = bid; it < nbc; it += G) {
                    const int j = it & 3, sub = it >> 2, typ = sub / (BG * 8), bl = (sub / 8) % BG, hd = sub & 7;
                    const int c0 = j * 8 + wv, c1 = 63 - c0;
                    if (typ == 0) { attn_bc2_chunk<0>(p, layer, bl, hd, c1, st); attn_bc2_chunk<0>(p, layer, bl, hd, c0, st); }
                    else { attn_bc2_chunk<1>(p, layer, bl, hd, c1, st); attn_bc2_chunk<1>(p, layer, bl, hd, c0, st); }
                }
#else
                const int nbc = 2 * BG * 8 * 16;
                for (int rnd = 0;; ++rnd) {
                    const int it = snake_item(rnd, G, bid);
                    if (rnd * G >= nbc) break;
                    if (it < nbc) {
                        const int qb = 15 - it / (2 * BG * 8), sub = it % (2 * BG * 8), typ = sub / (BG * 8), bl = (sub / 8) % BG, hd = sub & 7;
                        {
#if ATTN_LDS
                            attn_bc_item(p, layer, typ, bl, hd, qb, st, shm_raw);
#else
                            if (typ == 0) attn_b_item(p, layer, bl, hd, qb, st, st ? 0 : ((p.dupmask >> 8) & 3)); else if (st || ((p.dupmask >> 10) & 1) == 0) attn_c_item(p, layer, bl, hd, qb, st);
#endif
                        }
                    }
                }
#endif
                for (int it = bid; it < TG / 64; it += G) merge_a_item(p, it, st);
            }
            grid_barrier(barcnt, bartarget, (unsigned)G);
            if (DUPMASK & 32) grid_barrier(barcnt, bartarget, (unsigned)G);
            PHASE_END(3);
            LAUNDER();
            for (int rep = 0; rep <= ((DUPMASK >> 3) & 1); ++rep) {
                EpiBr epi{&p};
                gemm_phase<false>((const bf16_t*)(ws + OFF_WTBR) + (size_t)layer * 3 * DM * 512, 512, (size_t)DM * 512, DM, (const bf16_t*)(ws + OFF_SZ), 1536, 512, TG, 512, 3, epi, shm_g);
            }
            {
                const bool handoff = (DUPMASK == 0) && G == (DM / BM) * (TG / BM);
                if (handoff) {
                    int pm_, pn_; gemm_tile_of(bid, DM / BM, TG / BM, pm_, pn_);
                    unsigned* fl = (unsigned*)(ws + OFF_FLAG) + (layer * NGRP + grp) * 64 + pn_;
                    __syncthreads();
                    if (threadIdx.x == 0) {
                        __builtin_amdgcn_fence(__ATOMIC_RELEASE, "agent");
                        __hip_atomic_fetch_add(fl, 1u, __ATOMIC_RELAXED, __HIP_MEMORY_SCOPE_AGENT);
                        while (__hip_atomic_load(fl, __ATOMIC_RELAXED, __HIP_MEMORY_SCOPE_AGENT) < (unsigned)(DM / BM)) __builtin_amdgcn_s_sleep(1);
                        __builtin_amdgcn_fence(__ATOMIC_ACQUIRE, "agent");
                    }
                    __syncthreads();
                } else {
                    grid_barrier(barcnt, bartarget, (unsigned)G);
                    if (DUPMASK & 32) grid_barrier(barcnt, bartarget, (unsigned)G);
                }
            }
            PHASE_END(4);
            LAUNDER();
            for (int rep = ((DUPMASK >> 4) & 1); rep >= 0; --rep) {
                EpiOut epi{&p, layer, gtok0, rep == 0 || p.dupmask == 0x7fffffff};
                gemm_phase<false>((const bf16_t*)(ws + OFF_WTOUT) + (size_t)layer * DM * DM, DM, 0, DM, (const bf16_t*)(ws + OFF_MB), DM, 0, TG, DM, 1, epi, shm_g);
                if (rep == 0) {
                    const int nl = grp + 1 < NGRP ? layer : layer + 1, ng = grp + 1 < NGRP ? grp + 1 : 0;
                    if (nl < DEPTH) {
                        __syncthreads();
                        const float* xsrc = (nl == 0 ? p.x : (const float*)p.out) + (size_t)ng * TG * DM;
                        int per = (TG + G - 1) / G; int tb = bid * per, te = tb + per < TG ? tb + per : TG;
                        xprep_tokens(xsrc, (bf16_t*)(ws + OFF_XB), (float*)(ws + OFF_SS), tb, te);
                        if (nl != layer) for (int it = bid; it < 16 * 204; it += G) convert_win_tile(p, nl, it, (float*)shm_raw);
                    }
                }
            }
            grid_barrier(barcnt, bartarget, (unsigned)G);
            if (DUPMASK & 32) grid_barrier(barcnt, bartarget, (unsigned)G);
            PHASE_END(5);
        }
    }
    if (SPINSEL) { const unsigned long long t0_ = wall_clock64(); while (wall_clock64() - t0_ < tspan) __builtin_amdgcn_s_sleep(8); }
}

extern "C" void kernel_launch(void* const* d_in, const int* in_sizes, int n_in, void* d_out, int out_size, void* d_ws, size_t ws_size, hipStream_t stream) {
    static int grid_blocks = 0;
    if (!grid_blocks) {
        int dev = 0, cus = 0, per_cu = 0;
        hipGetDevice(&dev);
        hipDeviceGetAttribute(&cus, hipDeviceAttributeMultiprocessorCount, dev);
        hipOccupancyMaxActiveBlocksPerMultiprocessor(&per_cu, fwd_megakernel, NTHREADS, 0);
        if (per_cu > 1) per_cu = 1;
        grid_blocks = cus * per_cu;
    }
    if (ws_size < WS_NEED) { fprintf(stderr, "workspace too small: %zu < %zu\n", ws_size, (size_t)WS_NEED); return; }
    Params p{};
    p.dupmask = DUPMASK; p.pad_ = 0;
    p.x = (const float*)d_in[0]; p.pos = (const int*)d_in[1]; p.norm_g = (const float*)d_in[2]; p.w_in = (const float*)d_in[3];
    p.qk_g = (const float*)d_in[4]; p.w_br = (const float*)d_in[5]; p.w_out = (const float*)d_in[6];
    p.out = (float*)d_out; p.ws = (char*)d_ws;
    void* args[] = {&p};
    hipError_t e = hipLaunchCooperativeKernel((void*)fwd_megakernel, dim3(grid_blocks), dim3(NTHREADS), args, 0, stream);
    if (e != hipSuccess) fprintf(stderr, "cooperative launch failed: %s (grid %d)\n", hipGetErrorString(e), grid_blocks);
}
```

```cpp
#include <hip/hip_runtime.h>
#include <hip/hip_cooperative_groups.h>
#include <cstdio>
#include <cstdint>
namespace cg = cooperative_groups;
#define ATTN_LDS 0
#define ATTN64 1
#define SPINSEL 0
#define DUPMASK 0

typedef unsigned short bf16_t;
typedef short bf16x8 __attribute__((ext_vector_type(8)));
typedef short s16x4 __attribute__((ext_vector_type(4)));
typedef float f32x4 __attribute__((ext_vector_type(4)));
typedef float f32x16 __attribute__((ext_vector_type(16)));
typedef unsigned u32x4 __attribute__((ext_vector_type(4)));
typedef unsigned u32x2 __attribute__((ext_vector_type(2)));
#define DI __device__ __forceinline__

constexpr int S = 4096, DM = 1024, NB = 8, DEPTH = 2;
constexpr int NIN = 12872, NPAD = 13056;
constexpr int BG = 4, TG = BG * S, NGRP = NB / BG;
constexpr int NTHREADS = 512;
constexpr int SHM_BYTES = 131072;
constexpr float QSCALE = 0.125f * 1.4426950408889634f;
constexpr float LN2F = 0.6931471805599453f;
constexpr int SEL_CAP = 768;

constexpr size_t al256(size_t x) { return (x + 255) & ~(size_t)255; }
constexpr size_t OFF_WTIN = 0;
constexpr size_t OFF_WTBR = OFF_WTIN + al256((size_t)NPAD * DM * 2);
constexpr size_t OFF_WTOUT = OFF_WTBR + al256((size_t)DEPTH * 3 * DM * 512 * 2);
constexpr size_t OFF_CS = OFF_WTOUT + al256((size_t)DEPTH * DM * DM * 2);
constexpr size_t OFF_XB = OFF_CS + al256((size_t)NB * S * 8 * 8);
constexpr size_t OFF_OA = OFF_XB;
constexpr size_t OFF_SS = OFF_XB + al256((size_t)3 * TG * 512 * 2);
constexpr size_t OFF_QA = OFF_SS + al256((size_t)TG * 8 * 4);
constexpr size_t OFF_KA = OFF_QA + al256((size_t)TG * 1536 * 2);
constexpr size_t OFF_VA = OFF_KA + al256((size_t)TG * 1536 * 2);
constexpr size_t OFF_MF = OFF_QA;
constexpr size_t OFF_MB = OFF_VA;
constexpr size_t OFF_QB = OFF_VA + al256((size_t)TG * 1536 * 2);
constexpr size_t OFF_KB = OFF_QB + al256((size_t)TG * 512 * 2);
constexpr size_t OFF_VB = OFF_KB + al256((size_t)TG * 512 * 2);
constexpr size_t OFF_QC = OFF_VB + al256((size_t)TG * 512 * 2);
constexpr size_t OFF_KC = OFF_QC + al256((size_t)TG * 512 * 2);
constexpr size_t OFF_VC = OFF_KC + al256((size_t)TG * 512 * 2);
constexpr size_t OFF_IQ = OFF_VC + al256((size_t)TG * 512 * 2);
constexpr size_t OFF_IK = OFF_IQ + al256((size_t)TG * 512 * 2);
constexpr size_t OFF_IW = OFF_IK + al256((size_t)TG * 64 * 2);
constexpr size_t OFF_SZ = OFF_IW + al256((size_t)TG * 8 * 4);
constexpr size_t OFF_SG = OFF_SZ + al256((size_t)TG * 1536 * 2);
constexpr size_t OFF_LSE = OFF_SG + al256((size_t)TG * 3072 * 2);
constexpr size_t OFF_MASK = OFF_LSE + al256((size_t)3 * TG * 8 * 4);
constexpr size_t OFF_KM = OFF_MASK + al256((size_t)BG * S * (S / 8));
static_assert((size_t)TG * DM * 4 <= (size_t)2 * TG * 1536 * 2 && (size_t)TG * DM * 2 <= (size_t)TG * 1536 * 2, "overlay sizes");
constexpr size_t OFF_BAR = OFF_KM + al256((size_t)BG * 8 * 16 * 64 * 2 * 2);
constexpr size_t OFF_FLAG = OFF_BAR + 256;
constexpr size_t OFF_BAR2 = OFF_FLAG + (size_t)DEPTH * NGRP * 64 * 4;
constexpr size_t WS_NEED = OFF_BAR2 + 9 * 128;

struct Params {
    const float* x; const int* pos; const float* norm_g; const float* w_in; const float* qk_g; const float* w_br; const float* w_out;
    float* out; char* ws; int dupmask; int pad_;
};

DI int ltid() { int t = threadIdx.x; asm volatile("" : "+v"(t)); return t; }
DI unsigned cvt_pk_bf16(float lo, float hi) { unsigned r; asm volatile("v_cvt_pk_bf16_f32 %0, %1, %2" : "=v"(r) : "v"(lo), "v"(hi)); return r; }
DI bf16_t f2bf(float x) { return (bf16_t)(cvt_pk_bf16(x, 0.f) & 0xffffu); }
DI float bf2f(bf16_t v) { return __uint_as_float(((unsigned)v) << 16); }
DI float fexp2(float x) { return __builtin_amdgcn_exp2f(x); }
DI float shx(float v, int mask) { const int l = ltid() & 63; return __int_as_float(__builtin_amdgcn_ds_bpermute((l ^ mask) << 2, __float_as_int(v))); }
DI float wave_sum(float v) { for (int o = 32; o > 0; o >>= 1) v += shx(v, o); return v; }
DI int f2sort(float f) { int i = __float_as_int(f); return i ^ ((i >> 31) & 0x7fffffff); }
DI float sort2f(int i) { return __int_as_float(i ^ ((i >> 31) & 0x7fffffff)); }
#define MFMA32(a, b, c) __builtin_amdgcn_mfma_f32_32x32x16_bf16((a), (b), (c), 0, 0, 0)
#define MFMA16(a, b, c) __builtin_amdgcn_mfma_f32_16x16x32_bf16((a), (b), (c), 0, 0, 0)

DI void grid_barrier(unsigned* bar, unsigned& gen, unsigned G) {
    __syncthreads();
    gen += 1;
    if (threadIdx.x == 0) {
        __builtin_amdgcn_fence(__ATOMIC_RELEASE, "agent");
        const unsigned sh = blockIdx.x & 7u, per = (G + 7u - sh) >> 3, nsh = G < 8u ? G : 8u;
        const unsigned old = __hip_atomic_fetch_add(bar + 32 * (1 + sh), 1u, __ATOMIC_RELAXED, __HIP_MEMORY_SCOPE_AGENT);
        if (old + 1u == per * gen) __hip_atomic_fetch_add(bar, 1u, __ATOMIC_RELAXED, __HIP_MEMORY_SCOPE_AGENT);
        while (__hip_atomic_load(bar, __ATOMIC_RELAXED, __HIP_MEMORY_SCOPE_AGENT) < nsh * gen) __builtin_amdgcn_s_sleep(2);
        __builtin_amdgcn_fence(__ATOMIC_ACQUIRE, "agent");
    }
    __syncthreads();
}

DI int src_col_of_group(int hg) { return hg <= 104 ? hg * 64 : (hg <= 200 ? 6728 + (hg - 105) * 64 : 6720); }

DI void convert_tile(const float* src, int ld_src, int k0, int n_src0, int n_valid, const float* kscale, bf16_t* dst, int ld_dst, int n_dst0, float* tl  ) {
    const int tid = ltid();
    __syncthreads();
#pragma unroll
    for (int i = 0; i < 8; ++i) {
        int e = tid + i * 512, kk = e >> 6, nn = e & 63;
        float v = 0.f;
        if (nn < n_valid) { v = src[(size_t)(k0 + kk) * ld_src + n_src0 + nn]; if (kscale) v *= kscale[k0 + kk]; }
        tl[kk * 65 + nn] = v;
    }
    __syncthreads();
#pragma unroll
    for (int i = 0; i < 4; ++i) {
        int e = tid + i * 512, nn = e >> 5, kp = (e & 31) * 2;
        unsigned w = cvt_pk_bf16(tl[kp * 65 + nn], tl[(kp + 1) * 65 + nn]);
        *(unsigned*)(dst + (size_t)(n_dst0 + nn) * ld_dst + k0 + kp) = w;
    }
}

DI void xprep_tokens(const float* xsrc  , bf16_t* xb, float* ss, int tok_begin, int tok_end) {
    const int lane = ltid() & 63, wid = ltid() >> 6;
    for (int t = tok_begin + wid; t < tok_end; t += 8) {
        const float* xr = xsrc + (size_t)t * DM;
        float sum = 0.f;
#pragma unroll
        for (int i = 0; i < 4; ++i) {
            f32x4 v = *(const f32x4*)(xr + i * 256 + lane * 4);
            sum += v[0] * v[0] + v[1] * v[1] + v[2] * v[2] + v[3] * v[3];
            u32x2 w; w[0] = cvt_pk_bf16(v[0], v[1]); w[1] = cvt_pk_bf16(v[2], v[3]);
            *(u32x2*)(xb + (size_t)t * DM + i * 256 + lane * 4) = w;
        }
        sum = wave_sum(sum);
        if (lane < 8) ss[(size_t)t * 8 + lane] = lane == 0 ? sum : 0.f;
    }
}

DI void convert_win_tile(const Params& p, int l, int it, float* tl) {
    const int hg = it / 16, kt = it % 16;
    const int nvalid = hg <= 200 ? 64 : (hg == 201 ? 8 : 0);
    convert_tile(p.w_in + (size_t)l * DM * NIN, NIN, kt * 64, src_col_of_group(hg), nvalid, p.norm_g + l * DM, (bf16_t*)(p.ws + OFF_WTIN), DM, hg * 64, tl);
}
DI void phase_prep(const Params& p, char* shm) {
    char* ws = p.ws;
    const int G = gridDim.x, bid = blockIdx.x, tid = ltid();
    float2* cs = (float2*)(ws + OFF_CS);
    for (int e = bid * NTHREADS + tid; e < NB * S * 8; e += G * NTHREADS) {
        int i = e & 7, t = e >> 3;
        float inv = powf(500000.0f, -(float)(2 * i) / 16.0f);
        float ang = (float)p.pos[t] * inv;
        double rev = (double)ang * 0.15915494309189535;
        rev -= floor(rev);
        float rf = (float)rev;
        cs[e] = make_float2(__builtin_amdgcn_cosf(rf), __builtin_amdgcn_sinf(rf));
    }
    float* tl = (float*)shm;
    const int n_in_tiles = 16 * 204, n_br_tiles = DEPTH * 3 * 8 * 16, n_out_tiles = DEPTH * 16 * 16;
    for (int it = bid; it < n_in_tiles + n_br_tiles + n_out_tiles; it += G) {
        if (it < n_in_tiles) {
            convert_win_tile(p, 0, it, tl);
        } else if (it < n_in_tiles + n_br_tiles) {
            int r = it - n_in_tiles; int ln = r / 128, q = r % 128, kt = q / 16, nt = q % 16;
            convert_tile(p.w_br + (size_t)ln * 512 * DM, DM, kt * 64, nt * 64, 64, nullptr, (bf16_t*)(ws + OFF_WTBR) + (size_t)ln * DM * 512, 512, nt * 64, tl);
        } else {
            int r = it - n_in_tiles - n_br_tiles; int l = r / 256, q = r % 256, kt = q / 16, nt = q % 16;
            convert_tile(p.w_out + (size_t)l * DM * DM, DM, kt * 64, nt * 64, 64, nullptr, (bf16_t*)(ws + OFF_WTOUT) + (size_t)l * DM * DM, DM, nt * 64, tl);
        }
    }
    int per = (TG + G - 1) / G;
    int tb = bid * per, te = tb + per < TG ? tb + per : TG;
    xprep_tokens(p.x, (bf16_t*)(ws + OFF_XB), (float*)(ws + OFF_SS), tb, te);
}

constexpr int BM = 256, BK = 64, HALF = 128, NXCD = 8, WGM = 8, HT = HALF * BK;
DI int lds_byte(int r, int c) { int st = (r >> 4) * 2 + (c >> 5), rr = r & 15, cc = c & 31, ob = rr * 64 + cc * 2; return st * 1024 + (ob ^ (((ob >> 9) & 1) << 5)); }
DI void stage_rc(int b, int& R, int& C) { int st = b / 1024, sb = b % 1024, swz = sb ^ (((sb >> 9) & 1) << 5); R = (st >> 1) * 16 + swz / 64; C = (st & 1) * 32 + (swz % 64) / 2; }

#define SA(b, h) (shm + ((b) * 2 + (h)) * HT)
#define SB(b, h) (shm + (4 + (b) * 2 + (h)) * HT)
DI void glds16(const void* sbase, unsigned voff, unsigned lds_dst) {
    unsigned keep;
    asm volatile("s_mov_b32 %0, m0\n\ts_mov_b32 m0, %3\n\ts_nop 0\n\tglobal_load_lds_dwordx4 %1, %2\n\ts_mov_b32 m0, %0"
                 : "=&s"(keep) : "v"(voff), "s"(sbase), "s"(lds_dst) : "memory");
}
#define STAGE(P, BASE, LD, br, kt, VOFF) do { const bf16_t* _gp = (BASE) + (size_t)(br) * (LD) + (size_t)(kt) * BK; \
    const unsigned _l0 = (unsigned)(size_t)(P) + wbase16; \
    glds16(_gp, VOFF[0], _l0); glds16(_gp, VOFF[1], _l0 + 8192u); } while (0)
#define LDA(dst, b, h) _Pragma("unroll") for (int m = 0; m < 4; ++m) _Pragma("unroll") for (int k = 0; k < 2; ++k) \
    dst[m][k] = *reinterpret_cast<const bf16x8*>((char*)SA(b, h) + lds_byte(wr * 64 + m * 16 + fr, k * 32 + fq * 8))
#define LDB(dst, b, h) _Pragma("unroll") for (int n = 0; n < 2; ++n) _Pragma("unroll") for (int k = 0; k < 2; ++k) \
    dst[n][k] = *reinterpret_cast<const bf16x8*>((char*)SB(b, h) + lds_byte(wc * 32 + n * 16 + fr, k * 32 + fq * 8))
#define MMA(ai, bj, At, Bt_) do { __builtin_amdgcn_s_setprio(1); \
    _Pragma("unroll") for (int m = 0; m < 4; ++m) _Pragma("unroll") for (int n = 0; n < 2; ++n) _Pragma("unroll") for (int k = 0; k < 2; ++k) \
      acc[ai][bj][m][n] = MFMA16(At[m][k], Bt_[n][k], acc[ai][bj][m][n]); \
    __builtin_amdgcn_s_setprio(0); } while (0)
#define WAIT_V(n) asm volatile("s_waitcnt vmcnt(" #n ")" ::: "memory")
#define WAIT_L(n) asm volatile("s_waitcnt lgkmcnt(" #n ")" ::: "memory")
#define BAR __builtin_amdgcn_s_barrier()
#define SCHED __builtin_amdgcn_sched_barrier(0)

DI int fold_tok(int rho, int sh) { const int b = rho >> 12, rb = rho & (S - 1); return (b << 12) + (((rb & ((S >> sh) - 1)) << sh) + (rb >> (12 - sh))); }
DI void gemm_tile_of(int L, int nM, int nN, int& pm, int& pn) {
    const int nwg = nM * nN; int wgid = L;
    { int q = nwg / NXCD, r = nwg % NXCD, xcd = wgid % NXCD, off = wgid / NXCD; wgid = (xcd < r ? xcd * (q + 1) : r * (q + 1) + (xcd - r) * q) + off; }
    const int nig = WGM * nN, gid = wgid / nig, fm = gid * WGM, gsz = min(nM - fm, WGM);
    pm = fm + ((wgid % nig) % gsz); pn = (wgid % nig) / gsz;
}
template <bool FOLD, class Epi>
DI void gemm_phase(const bf16_t* __restrict__ Abase, int lda, size_t a_sub, int M, const bf16_t* __restrict__ Bbase, int ldb, size_t b_sub, int N, int K, int nsub,
                   Epi& epi, __attribute__((address_space(3))) bf16_t* shm) {
    const int nM = M / BM, nN = N / BM, nwg = nM * nN;
    const int wid = ltid() >> 6, lane = ltid() & 63, wr = wid >> 2, wc = wid & 3, fr = lane & 15, fq = lane >> 4;
    const int nt = K / BK;
    unsigned voffA[2], voffB0[2], voffB1[2];
    const unsigned wbase16 = __builtin_amdgcn_readfirstlane((ltid() & ~63u) * 16u);
#pragma unroll
    for (int i = 0; i < 2; ++i) {
        int r_, c_; stage_rc(ltid() * 16 + i * 8192, r_, c_);
        const int x_ = r_ & 63, pr_ = (r_ & 64) + ((x_ & 15) >> 2) * 16 + (x_ >> 4) * 4 + (x_ & 3);
        voffA[i] = (unsigned)(pr_ * lda + c_) * 2u;
    }
    int L = blockIdx.x, sub = 0, brow = 0, bcol = 0;
    bool have = L < nwg, prefetched = false;
    const bf16_t* A = Abase; const bf16_t* Bt = Bbase;
    auto setup = [&](int L_, int sub_) {
        int wgid = L_;
        { int q = nwg / NXCD, r = nwg % NXCD, xcd = wgid % NXCD, off = wgid / NXCD; wgid = (xcd < r ? xcd * (q + 1) : r * (q + 1) + (xcd - r) * q) + off; }
        const int nig = WGM * nN, gid = wgid / nig, fm = gid * WGM, gsz = min(nM - fm, WGM);
        const int pm = fm + ((wgid % nig) % gsz), pn = (wgid % nig) / gsz;
        brow = pm * BM; bcol = pn * BM;
        const int sh = (FOLD && pm < 18) ? 2 * ((pm % 6) >> 1) : 0;
        const int t_ = ltid();
#pragma unroll
        for (int i = 0; i < 2; ++i) {
            int r_, c_; stage_rc(t_ * 16 + i * 8192, r_, c_);
            voffB0[i] = (unsigned)(fold_tok(bcol + r_, sh) * ldb + c_) * 2u;
            voffB1[i] = (unsigned)(fold_tok(bcol + HALF + r_, sh) * ldb + c_) * 2u;
        }
        A = Abase + (size_t)sub_ * a_sub; Bt = Bbase + (size_t)sub_ * b_sub;
    };
    while (have) {
        {
            setup(L, sub);
            f32x4 acc[2][2][4][2] = {};
            bf16x8 At[4][2], B0[2][2], B1[2][2];
            if (!prefetched) {
                STAGE(SB(0, 0), Bt, ldb, 0, 0, voffB0); STAGE(SA(0, 0), A, lda, brow, 0, voffA);
                STAGE(SB(0, 1), Bt, ldb, 0, 0, voffB1); STAGE(SA(0, 1), A, lda, brow + HALF, 0, voffA);
            }
            if (wr == 1) BAR;
            if (prefetched) WAIT_V(0); else WAIT_V(4);
            BAR;
            STAGE(SB(1, 0), Bt, ldb, 0, 1, voffB0); STAGE(SA(1, 0), A, lda, brow, 1, voffA); STAGE(SB(1, 1), Bt, ldb, 0, 1, voffB1);
            WAIT_V(6); BAR;
            for (int t = 0; t < nt - 2; t += 2) {
                LDB(B0, 0, 0); SCHED; LDA(At, 0, 0); STAGE(SA(1, 1), A, lda, brow + HALF, t + 1, voffA);
                WAIT_L(8); BAR; WAIT_L(0); MMA(0, 0, At, B0); BAR; SCHED;
                LDB(B1, 0, 1); STAGE(SB(0, 0), Bt, ldb, 0, t + 2, voffB0);
                BAR; WAIT_L(0); MMA(0, 1, At, B1); BAR;
                LDA(At, 0, 1); STAGE(SA(0, 0), A, lda, brow, t + 2, voffA);
                BAR; WAIT_L(0); MMA(1, 0, At, B0); BAR; SCHED;
                STAGE(SB(0, 1), Bt, ldb, 0, t + 2, voffB1);
                WAIT_V(6); BAR; MMA(1, 1, At, B1); BAR;
                LDB(B0, 1, 0); SCHED; LDA(At, 1, 0); STAGE(SA(0, 1), A, lda, brow + HALF, t + 2, voffA);
                WAIT_L(8); BAR; WAIT_L(0); MMA(0, 0, At, B0); BAR; SCHED;
                LDB(B1, 1, 1); STAGE(SB(1, 0), Bt, ldb, 0, t + 3, voffB0);
                BAR; WAIT_L(0); MMA(0, 1, At, B1); BAR;
                LDA(At, 1, 1); STAGE(SA(1, 0), A, lda, brow, t + 3, voffA);
                BAR; WAIT_L(0); MMA(1, 0, At, B0); BAR; SCHED;
                STAGE(SB(1, 1), Bt, ldb, 0, t + 3, voffB1);
                WAIT_V(6); BAR; MMA(1, 1, At, B1); BAR;
            }
            { LDB(B0, 0, 0); LDA(At, 0, 0); STAGE(SA(1, 1), A, lda, brow + HALF, nt - 1, voffA);
              BAR; WAIT_L(0); MMA(0, 0, At, B0); BAR;
              LDB(B1, 0, 1); BAR; WAIT_L(0); MMA(0, 1, At, B1); BAR;
              LDA(At, 0, 1); WAIT_V(4); BAR; WAIT_L(0); MMA(1, 0, At, B0); MMA(1, 1, At, B1); BAR; }
            { LDB(B0, 1, 0); LDA(At, 1, 0); WAIT_V(2); BAR; WAIT_L(0); MMA(0, 0, At, B0); BAR;
              LDB(B1, 1, 1); WAIT_V(0); BAR; WAIT_L(0); MMA(0, 1, At, B1); BAR;
              LDA(At, 1, 1); BAR; WAIT_L(0); MMA(1, 0, At, B0); MMA(1, 1, At, B1); BAR; }
            if (wr == 0) BAR;
            const int e_brow = brow, e_bcol = bcol, e_sub = sub;
            if (++sub == nsub) { sub = 0; L += gridDim.x; }
            have = L < nwg;
            if (have) {
                setup(L, sub);
                STAGE(SB(0, 0), Bt, ldb, 0, 0, voffB0); STAGE(SA(0, 0), A, lda, brow, 0, voffA);
                STAGE(SB(0, 1), Bt, ldb, 0, 0, voffB1); STAGE(SA(0, 1), A, lda, brow + HALF, 0, voffA);
                prefetched = true;
            }
            { int t2 = ltid();
              const int wid2 = t2 >> 6, lane2 = t2 & 63;
              epi(acc, e_brow, e_bcol, e_sub, wid2 >> 2, wid2 & 3, lane2 & 15, lane2 >> 4); }
        }
    }
}

struct EpiIn {
    const Params* p; int layer; int gtok0;
    DI void operator()(const f32x4 (&acc)[2][2][4][2], int brow, int bcol, int sub, int wr, int wc, int fr, int fq) const {
        char* ws = p->ws;
        const float* ss = (const float*)(ws + OFF_SS);
        const float2* cs = (const float2*)(ws + OFF_CS);
        const int lane = ltid() & 63;
#pragma unroll
        for (int bj = 0; bj < 2; ++bj)
#pragma unroll
            for (int n = 0; n < 2; ++n) {
                const int rho = bcol + bj * 128 + wc * 32 + n * 16 + fr;
                const int pm_ = brow >> 8;
                const int shf = pm_ < 18 ? 2 * ((pm_ % 6) >> 1) : 0;
                const int tl = fold_tok(rho, shf);
                const f32x4 s0 = *(const f32x4*)(ss + (size_t)tl * 8), s1 = *(const f32x4*)(ss + (size_t)tl * 8 + 4);
                const float rstd = rsqrtf((s0[0] + s0[1] + s0[2] + s0[3] + s1[0] + s1[1] + s1[2] + s1[3]) * (1.0f / DM) + 1e-6f);
                const int bl = tl >> 12, s = tl & (S - 1), rb = rho & (S - 1);
                const int tg = gtok0 + tl;
#pragma unroll
                for (int ai = 0; ai < 2; ++ai) {
                    const int hg = (brow + ai * 128 + wr * 64) >> 6;
                    float v[16];
#pragma unroll
                    for (int m = 0; m < 4; ++m)
#pragma unroll
                        for (int j = 0; j < 4; ++j) v[m * 4 + j] = acc[ai][bj][m][n][j] * rstd;
                    int kind;
                    int mixer = 0, isk = 0, hh = 0, H = 8; size_t qoff = 0, koff = 0, voff = 0;
                    if (hg < 72) { mixer = 0; H = 24; qoff = OFF_QA; koff = OFF_KA; voff = OFF_VA; kind = hg < 48 ? 0 : 1; isk = hg >= 24; hh = hg % 24; }
                    else if (hg < 96) { mixer = 1; qoff = OFF_QB; koff = OFF_KB; voff = OFF_VB; kind = hg < 88 ? 0 : 1; isk = hg >= 80; hh = (hg - 72) & 7; }
                    else if (hg < 105) { kind = 2; isk = hg == 104; hh = hg - 96; }
                    else if (hg < 129) { mixer = 2; qoff = OFF_QC; koff = OFF_KC; voff = OFF_VC; kind = hg < 121 ? 0 : 1; isk = hg >= 113; hh = (hg - 105) & 7; }
                    else if (hg < 153) kind = 3;
                    else if (hg < 201) kind = 4;
                    else kind = hg == 201 ? 5 : 6;

                    if (kind == 0 || kind == 2) {
                        if (kind == 0) {
                            float sq = 0.f;
#pragma unroll
                            for (int i = 0; i < 16; ++i) sq += v[i] * v[i];
                            sq += shx(sq, 16); sq += shx(sq, 32);
                            const float rn = rsqrtf(sq * (1.0f / 64) + 1e-6f) * (isk ? 1.0f : QSCALE);
                            const float* gq = p->qk_g + ((size_t)(layer * 3 + mixer) * 2 + isk) * 64 + fq * 16;
#pragma unroll
                            for (int m = 0; m < 4; ++m) {
                                const f32x4 g4 = *(const f32x4*)(gq + m * 4);
#pragma unroll
                                for (int j = 0; j < 4; ++j) v[m * 4 + j] *= rn * g4[j];
                            }
                        }
                        if (fq == 0) {
                            const f32x4* cp = (const f32x4*)(cs + (size_t)tg * 8);
#pragma unroll
                            for (int i2 = 0; i2 < 4; ++i2) {
                                const f32x4 c2 = cp[i2];
                                const float x1a = v[2 * i2], x2a = v[8 + 2 * i2], x1b = v[2 * i2 + 1], x2b = v[8 + 2 * i2 + 1];
                                v[2 * i2] = x1a * c2[0] - x2a * c2[1]; v[8 + 2 * i2] = x2a * c2[0] + x1a * c2[1];
                                v[2 * i2 + 1] = x1b * c2[2] - x2b * c2[3]; v[8 + 2 * i2 + 1] = x2b * c2[2] + x1b * c2[3];
                            }
                        }
                        u32x4 w0, w1;
#pragma unroll
                        for (int i = 0; i < 4; ++i) { w0[i] = cvt_pk_bf16(v[2 * i], v[2 * i + 1]); w1[i] = cvt_pk_bf16(v[8 + 2 * i], v[8 + 2 * i + 1]); }
                        if (kind == 0 && isk) {
                            bf16_t* dst = (bf16_t*)(ws + koff) + ((size_t)(bl * H + hh) * 128 + (rb >> 5)) * 2048 + (size_t)(fq * 64 + (rb & 31)) * 8;
                            *(u32x4*)dst = w0; *(u32x4*)(dst + 32 * 8) = w1;
                        } else {
                            bf16_t* dst;
                            if (kind == 0) dst = (bf16_t*)(ws + qoff) + ((size_t)(bl * H + hh) * S + rb) * 64;
                            else dst = isk ? (bf16_t*)(ws + OFF_IK) + (size_t)tl * 64 : (bf16_t*)(ws + OFF_IQ) + ((size_t)(bl * 8 + hh) * S + s) * 64;
                            *(u32x4*)(dst + fq * 16) = w0; *(u32x4*)(dst + fq * 16 + 8) = w1;
                        }
                    } else if (kind == 1) {
                        const int k5 = rb & 31;
                        bf16_t* dst = (bf16_t*)(ws + voff) + ((size_t)(bl * H + hh) * 128 + (rb >> 5)) * 2048 + ((k5 >> 4) * 64 + ((k5 >> 2) & 1) * 32) * 8 + ((k5 >> 3) & 1) * 4 + (k5 & 3)
                                      + ((fq >> 1) * 128 + (fq & 1) * 16) * 8;
#pragma unroll
                        for (int i = 0; i < 16; ++i) dst[i * 8] = f2bf(v[i]);
                    } else if (kind == 3 || kind == 4) {
                        bf16_t* dst = (kind == 3 ? (bf16_t*)(ws + OFF_SZ) + (size_t)tl * 1536 + (hg - 129) * 64 : (bf16_t*)(ws + OFF_SG) + (size_t)tl * 3072 + (hg - 153) * 64) + fq * 16;
#pragma unroll
                        for (int i = 0; i < 16; ++i) { const float sg = __builtin_amdgcn_rcpf(1.0f + __expf(-v[i])); v[i] = kind == 3 ? v[i] * sg : sg; }
                        u32x4 w0, w1;
#pragma unroll
                        for (int i = 0; i < 4; ++i) { w0[i] = cvt_pk_bf16(v[2 * i], v[2 * i + 1]); w1[i] = cvt_pk_bf16(v[8 + 2 * i], v[8 + 2 * i + 1]); }
                        *(u32x4*)dst = w0; *(u32x4*)(dst + 8) = w1;
                    } else if (kind == 5) {
                        if (fq == 0) { f32x4 o0 = {v[0], v[1], v[2], v[3]}, o1 = {v[4], v[5], v[6], v[7]}; float* d = (float*)(ws + OFF_IW) + (size_t)tl * 8; *(f32x4*)d = o0; *(f32x4*)(d + 4) = o1; }
                    }
                }
            }
        (void)lane; (void)sub;
    }
};

struct EpiBr {
    const Params* p;
    DI void operator()(const f32x4 (&acc)[2][2][4][2], int brow, int bcol, int sub, int wr, int wc, int fr, int fq) const {
        char* ws = p->ws;
        const bf16_t* sg = (const bf16_t*)(ws + OFF_SG);
        float* mf = (float*)(ws + OFF_MF);
        bf16_t* mb = (bf16_t*)(ws + OFF_MB);
#pragma unroll
        for (int bj = 0; bj < 2; ++bj)
#pragma unroll
            for (int n = 0; n < 2; ++n) {
                const int tl = bcol + bj * 128 + wc * 32 + n * 16 + fr;
#pragma unroll
                for (int ai = 0; ai < 2; ++ai)
#pragma unroll
                    for (int m2 = 0; m2 < 2; ++m2) {
                        const int e = brow + ai * 128 + wr * 64 + fq * 16 + m2 * 8;
                        const u32x4 gw = *(const u32x4*)(sg + (size_t)tl * 3072 + sub * 1024 + e);
                        bf16_t* mp = mb + (size_t)tl * DM + e;
                        u32x4 pw = {0u, 0u, 0u, 0u};
                        if (sub > 0) pw = *(const u32x4*)mp;
                        u32x4 ow;
#pragma unroll
                        for (int hh2 = 0; hh2 < 2; ++hh2) {
                            const f32x4 g4 = {__uint_as_float(gw[2 * hh2] << 16), __uint_as_float(gw[2 * hh2] & 0xffff0000u), __uint_as_float(gw[2 * hh2 + 1] << 16), __uint_as_float(gw[2 * hh2 + 1] & 0xffff0000u)};
                            f32x4 r = acc[ai][bj][m2 * 2 + hh2][n] * g4;
                            if (sub > 0) r += (f32x4){__uint_as_float(pw[2 * hh2] << 16), __uint_as_float(pw[2 * hh2] & 0xffff0000u), __uint_as_float(pw[2 * hh2 + 1] << 16), __uint_as_float(pw[2 * hh2 + 1] & 0xffff0000u)};
                            ow[2 * hh2] = cvt_pk_bf16(r[0], r[1]); ow[2 * hh2 + 1] = cvt_pk_bf16(r[2], r[3]);
                        }
                        *(u32x4*)mp = ow;
                    }
                asm volatile("" ::: "memory");
            }
    }
};

struct EpiOut {
    const Params* p; int layer; int gtok0; bool st;
    DI void operator()(const f32x4 (&acc)[2][2][4][2], int brow, int bcol, int sub, int wr, int wc, int fr, int fq) const {
        char* ws = p->ws;
        const float* xin = layer == 0 ? p->x : p->out;
        bf16_t* xb = (bf16_t*)(ws + OFF_XB);
        float* ss = (float*)(ws + OFF_SS);
#pragma unroll
        for (int bj = 0; bj < 2; ++bj)
#pragma unroll
            for (int n = 0; n < 2; ++n) {
                const int tl = bcol + bj * 128 + wc * 32 + n * 16 + fr;
                const size_t tg = (size_t)gtok0 + tl;
                float sq = 0.f;
#pragma unroll
                for (int ai = 0; ai < 2; ++ai)
#pragma unroll
                    for (int m = 0; m < 4; ++m) {
                        const int e = brow + ai * 128 + wr * 64 + fq * 16 + m * 4;
                        f32x4 r = *(const f32x4*)(xin + tg * DM + e) + acc[ai][bj][m][n];
                        if (st) *(f32x4*)(p->out + tg * DM + e) = r;
                    }
            }
        (void)sub;
    }
};

DI void select_chunk(const Params& p, int bl, int c, char* shm) {
    char* ws = p.ws;
    const bf16_t* IQ = (const bf16_t*)(ws + OFF_IQ);
    const bf16_t* IK = (const bf16_t*)(ws + OFF_IK);
    const float* IW = (const float*)(ws + OFF_IW);
    unsigned* hist = (unsigned*)shm; unsigned* bits = (unsigned*)(shm + 16384);
    int* ctl = (int*)(shm + 24576); int* cnt = ctl, *mn = ctl + 16, *mx = ctl + 32, *bsel = ctl + 48, *needp = ctl + 64;
    u32x2* list = (u32x2*)(shm + 32768);
    const int tid = ltid(), lane = tid & 63, w = __builtin_amdgcn_readfirstlane(tid >> 6), q = lane & 15, g = lane >> 4;
    const int t0 = c * 16, tq = t0 + q;
    __syncthreads();
    for (int i = tid; i < 16 * 256 + 16 * 128; i += NTHREADS) hist[i] = 0;
    if (tid < 16) { cnt[tid] = 0; mn[tid] = 0x7fffffff; mx[tid] = (int)0x80000000; }
    bf16x8 qf[8][2]; float wq[8];
#pragma unroll
    for (int hd = 0; hd < 8; ++hd) {
        const bf16_t* qp = IQ + ((size_t)(bl * 8 + hd) * S + tq) * 64 + g * 8;
        qf[hd][0] = *(const bf16x8*)qp; qf[hd][1] = *(const bf16x8*)(qp + 32);
        wq[hd] = IW[(size_t)(bl * S + tq) * 8 + hd];
    }
    auto loadk = [&](int kt, bf16x8& k0, bf16x8& k1) {
        const bf16_t* kp = IK + ((size_t)bl * S + kt * 16 + q) * 64 + g * 8;
        k0 = *(const bf16x8*)kp; k1 = *(const bf16x8*)(kp + 32);
    };
    auto compute = [&](const bf16x8& k0, const bf16x8& k1) -> f32x4 {
        f32x4 sc = {0.f, 0.f, 0.f, 0.f};
#pragma unroll
        for (int hd = 0; hd < 8; ++hd) {
            f32x4 a = {0.f, 0.f, 0.f, 0.f};
            a = MFMA16(k0, qf[hd][0], a); a = MFMA16(k1, qf[hd][1], a);
#pragma unroll
            for (int j = 0; j < 4; ++j) sc[j] += wq[hd] * fmaxf(a[j], 0.f);
        }
        return sc;
    };
#define SEL_PASS(BODY) do { \
        const int cl = c - 1;     \
        bf16x8 ka0, ka1, kb0, kb1; int kt = w; \
        if (kt <= cl) loadk(kt, ka0, ka1); \
        if (kt + 8 <= cl) loadk(kt + 8, kb0, kb1); \
        for (; kt <= cl; kt += 16) { \
            { const f32x4 sc = compute(ka0, ka1); if (kt + 16 <= cl) loadk(kt + 16, ka0, ka1); const int ktc = kt; const bool diag = false; BODY } \
            if (kt + 8 <= cl) { const f32x4 sc = compute(kb0, kb1); if (kt + 24 <= cl) loadk(kt + 24, kb0, kb1); const int ktc = kt + 8; const bool diag = false; BODY } \
        } \
        if (w == (c & 7)) { loadk(c, ka0, ka1); const f32x4 sc = compute(ka0, ka1); const int ktc = c; const bool diag = true; BODY } \
    } while (0)
#define SEL_OK(j) (!diag || 4 * g + (j) <= q)
    __syncthreads();
    {
        float lo = 3.0e38f, hi = -3.0e38f;
        SEL_PASS({
            _Pragma("unroll") for (int j = 0; j < 4; ++j) if (SEL_OK(j)) { lo = fminf(lo, sc[j]); hi = fmaxf(hi, sc[j]); }
        });
        lo = fminf(lo, shx(lo, 16)); lo = fminf(lo, shx(lo, 32));
        hi = fmaxf(hi, shx(hi, 16)); hi = fmaxf(hi, shx(hi, 32));
        if (g == 0) { atomicMin(&mn[q], f2sort(lo)); atomicMax(&mx[q], f2sort(hi)); }
    }
    __syncthreads();
    const float rlo = sort2f(mn[q]), rhi = sort2f(mx[q]);
    const float rscale = rhi > rlo ? 256.0f / (rhi - rlo) : 0.f;
    SEL_PASS({
        _Pragma("unroll") for (int j = 0; j < 4; ++j) if (SEL_OK(j)) {
            int b = (int)((sc[j] - rlo) * rscale); b = b > 255 ? 255 : (b < 0 ? 0 : b);
            atomicAdd(&hist[q * 256 + b], 1u);
        }
    });
    __syncthreads();
    {
        const int row = tid >> 5, i = tid & 31;
        unsigned c8[8]; unsigned tot = 0;
#pragma unroll
        for (int k = 0; k < 8; ++k) { c8[k] = hist[row * 256 + i * 8 + k]; tot += c8[k]; }
        unsigned above = 0;
        {
            unsigned run = tot;
#pragma unroll
            for (int o = 1; o < 32; o <<= 1) { const int l_ = tid & 63; unsigned v = (unsigned)__builtin_amdgcn_ds_bpermute(((l_ + o) & 63) << 2, (int)run); if (i + o < 32) run += v; }
            above = run - tot;
        }
        const int trow = t0 + row; const unsigned need = trow + 1 < 256 ? trow + 1 : 256;
        if (above < need && above + tot >= need) {
            unsigned a = above;
#pragma unroll
            for (int k = 7; k >= 0; --k) { if (a < need && a + c8[k] >= need) { bsel[row] = i * 8 + k; needp[row] = (int)(need - a); } a += c8[k]; }
        }
    }
    __syncthreads();
    const int bstar = bsel[q];
    SEL_PASS({
        unsigned nib = 0;
        _Pragma("unroll") for (int j = 0; j < 4; ++j) if (SEL_OK(j)) {
            int b = (int)((sc[j] - rlo) * rscale); b = b > 255 ? 255 : (b < 0 ? 0 : b);
            if (b > bstar) nib |= 1u << j;
            else if (b == bstar) { int pos = atomicAdd(&cnt[q], 1); if (pos < SEL_CAP) { u32x2 e; e[0] = (unsigned)f2sort(sc[j]) ^ 0x80000000u; e[1] = ktc * 16 + 4 * g + j; list[q * SEL_CAP + pos] = e; } }
        }
        if (nib) atomicOr(&bits[q * 128 + (ktc >> 1)], nib << ((ktc & 1) * 16 + 4 * g));
    });
    __syncthreads();
    {
        const int row = tid >> 5, i = tid & 31;
        int n = cnt[row]; n = n < SEL_CAP ? n : SEL_CAP;
        const int need = needp[row];
        for (int a = i; a < n; a += 32) {
            const u32x2 ea = list[row * SEL_CAP + a];
            int rank = 0;
            for (int b = 0; b < n; ++b) { const u32x2 eb = list[row * SEL_CAP + b]; rank += (eb[0] > ea[0]) || (eb[0] == ea[0] && eb[1] < ea[1]); }
            if (rank < need) atomicOr(&bits[row * 128 + (ea[1] >> 5)], 1u << (ea[1] & 31));
        }
    }
    __syncthreads();
    unsigned* mask = (unsigned*)(ws + OFF_MASK) + ((size_t)bl * S + t0) * 128;
    for (int i = tid; i < 16 * 128; i += NTHREADS) mask[i] = bits[i];
}

DI void kmean_item(const Params& p, int bl, int h, int n, char* shm) {
    char* ws = p.ws;
    const bf16_t* K = (const bf16_t*)(ws + OFF_KC) + ((size_t)(bl * 8 + h) * 128 + n * 8) * 2048;
    float* red = (float*)shm;
    const int tid = ltid(), c = tid & 255, par = tid >> 8;
    float acc[8] = {0.f, 0.f, 0.f, 0.f, 0.f, 0.f, 0.f, 0.f};
#pragma unroll
    for (int it = 0; it < 4; ++it) {
        const u32x4 v = *(const u32x4*)(K + (size_t)(it * 2 + par) * 2048 + c * 8);
#pragma unroll
        for (int e = 0; e < 4; ++e) { acc[2 * e] += __uint_as_float(v[e] << 16); acc[2 * e + 1] += __uint_as_float(v[e] & 0xffff0000u); }
    }
    __syncthreads();
#pragma unroll
    for (int e = 0; e < 8; ++e) red[(par * 256 + c) * 8 + e] = acc[e];
    __syncthreads();
    if (tid < 64) {
        const int grp = tid >> 3, e = tid & 7;
        float t = 0.f;
        for (int pr = 0; pr < 2; ++pr) for (int r = 0; r < 32; ++r) t += red[(pr * 256 + grp * 32 + r) * 8 + e];
        t *= (1.0f / 256);
        bf16_t hi = f2bf(t); bf16_t lo = f2bf(t - bf2f(hi));
        bf16_t* km = (bf16_t*)(ws + OFF_KM) + (((size_t)(bl * 8 + h) * 16 + n) * 2) * 64;
        km[tid] = hi; km[64 + tid] = lo;
    }
}

struct AttnAcc { f32x16 o0, o1; float nb, l; bool shifted; };
DI void attn_init(AttnAcc& a, float nb) {
    float z = 0.f; asm volatile("" : "+v"(z));
#pragma unroll
    for (int i = 0; i < 16; ++i) { a.o0[i] = z; a.o1[i] = z; }
    a.shifted = __ballot(nb > 90.f) != 0ull;
    a.nb = a.shifted ? nb + z : z; a.l = z;
}
DI float attn_bound(const bf16x8 (&qf)[4], const float* gk) {
    float qs = 0.f;
#pragma unroll
    for (int kk = 0; kk < 4; ++kk)
#pragma unroll
        for (int e = 0; e < 8; ++e) { const float v = bf2f((bf16_t)qf[kk][e]); qs += v * v; }
    qs += shx(qs, 32);
    float gm = fabsf(gk[ltid() & 63]);
    for (int o = 32; o > 0; o >>= 1) gm = fmaxf(gm, shx(gm, o));
    return sqrtf(qs) * gm * 8.1f;
}
struct KVFrag { bf16x8 k[4]; bf16x8 v[2][2]; };
DI void kv_load(KVFrag& f, const bf16_t* Kt, const bf16_t* Vt, int lane) {
#pragma unroll
    for (int kk = 0; kk < 4; ++kk) f.k[kk] = *(const bf16x8*)(Kt + (kk * 64 + lane) * 8);
#pragma unroll
    for (int db = 0; db < 2; ++db)
#pragma unroll
        for (int u = 0; u < 2; ++u) f.v[db][u] = *(const bf16x8*)(Vt + ((db * 2 + u) * 64 + lane) * 8);
}
DI void attn_step(AttnAcc& a, const KVFrag& f, const bf16x8 (&qf)[4], unsigned vm) {
    f32x16 st;
    if (a.shifted) {
#pragma unroll
        for (int i = 0; i < 16; ++i) st[i] = -a.nb;
        st = MFMA32(f.k[0], qf[0], st);
    } else {
        st = MFMA32(f.k[0], qf[0], ((f32x16){0.f, 0.f, 0.f, 0.f, 0.f, 0.f, 0.f, 0.f, 0.f, 0.f, 0.f, 0.f, 0.f, 0.f, 0.f, 0.f}));
    }
#pragma unroll
    for (int kk = 1; kk < 4; ++kk) st = MFMA32(f.k[kk], qf[kk], st);
    float pv[16];
#pragma unroll
    for (int i = 0; i < 16; ++i) pv[i] = fexp2(st[i]);
    if (__ballot(vm != 0xffffu) != 0ull) {
#pragma unroll
        for (int i = 0; i < 16; ++i) pv[i] = __int_as_float(__float_as_int(pv[i]) & __builtin_amdgcn_sbfe((int)vm, i, 1));
    }
    a.l += ((pv[0] + pv[1]) + (pv[2] + pv[3])) + ((pv[4] + pv[5]) + (pv[6] + pv[7])) + (((pv[8] + pv[9]) + (pv[10] + pv[11])) + ((pv[12] + pv[13]) + (pv[14] + pv[15])));
    u32x4 p0, p1;
#pragma unroll
    for (int i = 0; i < 4; ++i) { p0[i] = cvt_pk_bf16(pv[2 * i], pv[2 * i + 1]); p1[i] = cvt_pk_bf16(pv[8 + 2 * i], pv[8 + 2 * i + 1]); }
    const bf16x8 pf0 = __builtin_bit_cast(bf16x8, p0), pf1 = __builtin_bit_cast(bf16x8, p1);
    a.o0 = MFMA32(f.v[0][0], pf0, a.o0); a.o0 = MFMA32(f.v[0][1], pf1, a.o0);
    a.o1 = MFMA32(f.v[1][0], pf0, a.o1); a.o1 = MFMA32(f.v[1][1], pf1, a.o1);
}
DI void load_q(bf16x8 (&qf)[4], const bf16_t* Qrow, int h) {
#pragma unroll
    for (int kk = 0; kk < 4; ++kk) qf[kk] = *(const bf16x8*)(Qrow + kk * 16 + h * 8);
}
DI int koff(int i, int h) { return 8 * (i >> 2) + 4 * h + (i & 3); }

DI void attn_a_item(const Params& p, int layer, int bl, int hh, int rb) {
    char* ws = p.ws;
    const int lane = ltid() & 63, w = __builtin_amdgcn_readfirstlane(ltid() >> 6), r = lane & 31, h = lane >> 5;
    const int g = hh >> 3, sh = 2 * g, n = S >> sh;
    const int row0 = rb * 256 + w * 32;
    const int rr = row0 / n, m0 = row0 % n;
    const bf16_t* Q = (const bf16_t*)(ws + OFF_QA) + (size_t)(bl * 24 + hh) * S * 64;
    const bf16_t* K = (const bf16_t*)(ws + OFF_KA) + (size_t)(bl * 24 + hh) * S * 64;
    const bf16_t* Vt = (const bf16_t*)(ws + OFF_VA) + (size_t)(bl * 24 + hh) * 64 * S;
    bf16x8 qf[4]; load_q(qf, Q + (size_t)(row0 + r) * 64, h);
    AttnAcc a; attn_init(a, attn_bound(qf, p.qk_g + ((size_t)(layer * 3 + 0) * 2 + 1) * 64));
    const int kfirst = m0 >= 128 ? 0 : (128 - m0) / 32;
    const int tile0 = (rr * n + m0 - 128) / 32 + 0;
    auto amask = [&](int k) -> unsigned {
        if (k != 0 && k != 4) return 0xffffu;
        const int mk0 = m0 - 128 + 32 * k; unsigned vm = 0;
#pragma unroll
        for (int i = 0; i < 16; ++i) { const int d = (m0 + r) - (mk0 + koff(i, h)); if (d >= 0 && d <= 128) vm |= 1u << i; }
        return vm;
    };
    KVFrag f0, f1; kv_load(f0, K + (size_t)(tile0 + kfirst) * 2048, Vt + (size_t)(tile0 + kfirst) * 2048, lane);
    for (int k = kfirst; k < 5; k += 2) {
        { const int kn = k + 1 < 5 ? k + 1 : k; kv_load(f1, K + (size_t)(tile0 + kn) * 2048, Vt + (size_t)(tile0 + kn) * 2048, lane); }
        attn_step(a, f0, qf, amask(k));
        if (k + 1 < 5) {
            { const int kn = k + 2 < 5 ? k + 2 : k + 1; kv_load(f0, K + (size_t)(tile0 + kn) * 2048, Vt + (size_t)(tile0 + kn) * 2048, lane); }
            attn_step(a, f1, qf, amask(k + 1));
        }
    }
    const float l = a.l + shx(a.l, 32);
    const float inv = 1.0f / l;
    const int s = ((m0 + r) << sh) + rr;
    const size_t tl = (size_t)bl * S + s;
    bf16_t* o = (bf16_t*)(ws + OFF_OA) + ((size_t)g * TG + tl) * 512 + (hh & 7) * 64;
#pragma unroll
    for (int q4 = 0; q4 < 4; ++q4) {
        u32x2 w0, w1;
        w0[0] = cvt_pk_bf16(a.o0[q4 * 4] * inv, a.o0[q4 * 4 + 1] * inv); w0[1] = cvt_pk_bf16(a.o0[q4 * 4 + 2] * inv, a.o0[q4 * 4 + 3] * inv);
        w1[0] = cvt_pk_bf16(a.o1[q4 * 4] * inv, a.o1[q4 * 4 + 1] * inv); w1[1] = cvt_pk_bf16(a.o1[q4 * 4 + 2] * inv, a.o1[q4 * 4 + 3] * inv);
        *(u32x2*)(o + 8 * q4 + 4 * h) = w0; *(u32x2*)(o + 32 + 8 * q4 + 4 * h) = w1;
    }
    if (h == 0) ((float*)(ws + OFF_LSE))[((size_t)g * TG + tl) * 8 + (hh & 7)] = (a.nb + __log2f(l)) * LN2F;
}

DI void attn_store_gated(const Params& p, const AttnAcc& a, size_t tl, int col0, int h, bool st) {
    const float l = a.l + shx(a.l, 32);
    const float inv = 1.0f / l;
    bf16_t* z = (bf16_t*)(p.ws + OFF_SZ) + tl * 1536 + col0;
#pragma unroll
    for (int q4 = 0; q4 < 4; ++q4) {
#pragma unroll
        for (int db = 0; db < 2; ++db) {
            bf16_t* zp = z + db * 32 + 8 * q4 + 4 * h;
            const u32x2 zw = *(const u32x2*)zp;
            const float z0 = __uint_as_float(zw[0] << 16), z1 = __uint_as_float(zw[0] & 0xffff0000u), z2 = __uint_as_float(zw[1] << 16), z3 = __uint_as_float(zw[1] & 0xffff0000u);
            const f32x16& o = db ? a.o1 : a.o0;
            u32x2 wv; wv[0] = cvt_pk_bf16(o[q4 * 4] * inv * z0, o[q4 * 4 + 1] * inv * z1); wv[1] = cvt_pk_bf16(o[q4 * 4 + 2] * inv * z2, o[q4 * 4 + 3] * inv * z3);
            if (st) *(u32x2*)zp = wv;
        }
    }
}

DI void attn_b_item(const Params& p, int layer, int bl, int hd, int qb, bool st, int var) {
    char* ws = p.ws;
    const int lane = ltid() & 63, w = __builtin_amdgcn_readfirstlane(ltid() >> 6), r = lane & 31, h = lane >> 5;
    const int q0 = qb * 256 + w * 32;
    const bf16_t* Q = (const bf16_t*)(ws + OFF_QB) + (size_t)(bl * 8 + hd) * S * 64;
    const bf16_t* K = (const bf16_t*)(ws + OFF_KB) + (size_t)(bl * 8 + hd) * S * 64;
    const bf16_t* Vt = (const bf16_t*)(ws + OFF_VB) + (size_t)(bl * 8 + hd) * 64 * S;
    const unsigned* mrow = (const unsigned*)(ws + OFF_MASK) + ((size_t)bl * S + q0 + r) * 128;
    bf16x8 qf[4]; load_q(qf, Q + (size_t)(q0 + r) * 64, h);
    AttnAcc a; attn_init(a, attn_bound(qf, p.qk_g + ((size_t)(layer * 3 + 1) * 2 + 1) * 64));
    const int nkt = q0 / 32 + 1;
    auto bmask = [&](unsigned mw) -> unsigned {
        const unsigned ws4 = mw >> (4 * h);
        return (ws4 & 0xfu) | ((ws4 >> 4) & 0xf0u) | ((ws4 >> 8) & 0xf00u) | ((ws4 >> 12) & 0xf000u);
    };
    KVFrag f0, f1; kv_load(f0, K, Vt, lane);
    unsigned mw0 = mrow[0], mw1 = 0;
    const int tmul = var == 1 ? 0 : 1;
    for (int kt = 0; kt < nkt; kt += 2) {
        { const int kn = (kt + 1 < nkt ? kt + 1 : kt) * tmul; kv_load(f1, K + (size_t)kn * 2048, Vt + (size_t)kn * 2048, lane); mw1 = mrow[kn]; }
        if (var == 2) a.l += __int_as_float((int)f0.k[0][0] + (int)f0.k[3][7] + (int)f0.v[0][0][0] + (int)f0.v[1][1][7] + (int)mw0); else
        attn_step(a, f0, qf, bmask(mw0));
        if (kt + 1 < nkt) {
            { const int kn = (kt + 2 < nkt ? kt + 2 : kt + 1) * tmul; kv_load(f0, K + (size_t)kn * 2048, Vt + (size_t)kn * 2048, lane); mw0 = mrow[kn]; }
            if (var == 2) a.l += __int_as_float((int)f1.k[0][0] + (int)f1.k[3][7] + (int)f1.v[0][0][0] + (int)f1.v[1][1][7] + (int)mw1); else
            attn_step(a, f1, qf, bmask(mw1));
        }
    }
    attn_store_gated(p, a, (size_t)bl * S + q0 + r, 512 + hd * 64, h, st);
}

DI void attn_c_item(const Params& p, int layer, int bl, int hd, int qb, bool st) {
    char* ws = p.ws;
    const int lane = ltid() & 63, w = __builtin_amdgcn_readfirstlane(ltid() >> 6), r = lane & 31, h = lane >> 5;
    const int q0 = qb * 256 + w * 32, own = qb;
    const bf16_t* Q = (const bf16_t*)(ws + OFF_QC) + (size_t)(bl * 8 + hd) * S * 64;
    const bf16_t* K = (const bf16_t*)(ws + OFF_KC) + (size_t)(bl * 8 + hd) * S * 64;
    const bf16_t* Vt = (const bf16_t*)(ws + OFF_VC) + (size_t)(bl * 8 + hd) * 64 * S;
    bf16x8 qf[4]; load_q(qf, Q + (size_t)(q0 + r) * 64, h);
    unsigned sel = 0;
    if (own > 0) {
        const bf16_t* km = (const bf16_t*)(ws + OFF_KM) + (((size_t)(bl * 8 + hd) * 16 + (r & 15)) * 2) * 64;
        f32x16 gt;
#pragma unroll
        for (int i = 0; i < 16; ++i) gt[i] = 0.f;
#pragma unroll
        for (int kk = 0; kk < 4; ++kk) {
            bf16x8 ahi = *(const bf16x8*)(km + kk * 16 + h * 8), alo = *(const bf16x8*)(km + 64 + kk * 16 + h * 8);
            if (r >= 16) { ahi = (bf16x8){0, 0, 0, 0, 0, 0, 0, 0}; alo = ahi; }
            gt = MFMA32(ahi, qf[kk], gt); gt = MFMA32(alo, qf[kk], gt);
        }
        float gl[16];
#pragma unroll
        for (int i = 0; i < 8; ++i) {
            const float mine = gt[i], oth = shx(mine, 32);
            const int blk_mine = 8 * (i >> 2) + 4 * h + (i & 3), blk_oth = 8 * (i >> 2) + 4 * (1 - h) + (i & 3);
            (void)blk_mine; (void)blk_oth;
            gl[8 * (i >> 2) + (i & 3)] = h == 0 ? mine : oth;
            gl[8 * (i >> 2) + 4 + (i & 3)] = h == 0 ? oth : mine;
        }
#pragma unroll
        for (int pick = 0; pick < 3; ++pick) {
            float best = -3.0e38f; int bi = -1;
#pragma unroll
            for (int nb = 0; nb < 16; ++nb) { const bool ok = nb < own && !((sel >> nb) & 1u); if (ok && gl[nb] > best) { best = gl[nb]; bi = nb; } }
            if (bi >= 0) sel |= 1u << bi;
        }
    }
    AttnAcc a; attn_init(a, attn_bound(qf, p.qk_g + ((size_t)(layer * 3 + 2) * 2 + 1) * 64));
    unsigned vis = 0;
    for (int nb = 0; nb < own; ++nb) if (__ballot((sel >> nb) & 1u) != 0ull) vis |= 1u << nb;
    const int ndiag = q0 / 32;
    unsigned long long tm0 = 0ull, tm1 = 0ull;
    for (int nb = 0; nb < own; ++nb) if ((vis >> nb) & 1u) { if (nb < 8) tm0 |= 0xffull << (8 * nb); else tm1 |= 0xffull << (8 * (nb - 8)); }
    for (int t = own * 8; t <= ndiag; ++t) { if (t < 64) tm0 |= 1ull << t; else tm1 |= 1ull << (t - 64); }
    int ntl = __builtin_popcountll(tm0) + __builtin_popcountll(tm1);
    auto pop = [&]() -> int { int t; if (tm0) { t = __builtin_ctzll(tm0); tm0 &= tm0 - 1; } else if (tm1) { t = 64 + __builtin_ctzll(tm1); tm1 &= tm1 - 1; } else t = ndiag; return t; };
    auto cmask = [&](int t) -> unsigned {
        const int cb = t >> 3;
        if (cb < own) return ((sel >> cb) & 1u) ? 0xffffu : 0u;
        if (t != ndiag) return 0xffffu;
        unsigned vm = 0;
#pragma unroll
        for (int i = 0; i < 16; ++i) if (koff(i, h) <= r) vm |= 1u << i;
        return vm;
    };
    KVFrag f0, f1; int t0 = pop(), t1 = 0;
    kv_load(f0, K + (size_t)t0 * 2048, Vt + (size_t)t0 * 2048, lane);
    for (int it = 0; it < ntl; it += 2) {
        t1 = pop(); kv_load(f1, K + (size_t)t1 * 2048, Vt + (size_t)t1 * 2048, lane);
        attn_step(a, f0, qf, cmask(t0));
        if (it + 1 < ntl) {
            t0 = pop(); kv_load(f0, K + (size_t)t0 * 2048, Vt + (size_t)t0 * 2048, lane);
            attn_step(a, f1, qf, cmask(t1));
        }
    }
    attn_store_gated(p, a, (size_t)bl * S + q0 + r, 1024 + hd * 64, h, st);
}

DI void attn_bc_item(const Params& p, int layer, int typ, int bl, int hd, int qb, bool st, char* shm) {
    char* ws = p.ws;
    const int tid = ltid(), lane = tid & 63, w = tid >> 6, r = lane & 31, h = lane >> 5;
    const int q0 = qb * 256 + w * 32, own = qb, ndiag = q0 / 32;
    const bf16_t* Q = (const bf16_t*)(ws + (typ ? OFF_QC : OFF_QB)) + (size_t)(bl * 8 + hd) * S * 64;
    const bf16_t* K = (const bf16_t*)(ws + (typ ? OFF_KC : OFF_KB)) + (size_t)(bl * 8 + hd) * S * 64;
    const bf16_t* Vt = (const bf16_t*)(ws + (typ ? OFF_VC : OFF_VB)) + (size_t)(bl * 8 + hd) * 64 * S;
    const unsigned* mrow = (const unsigned*)(ws + OFF_MASK) + ((size_t)bl * S + q0 + r) * 128;
    unsigned short* seq = (unsigned short*)(shm + 16384);
    unsigned* wvis = (unsigned*)(shm + 16896);
    bf16x8 qf[4]; load_q(qf, Q + (size_t)(q0 + r) * 64, h);
    unsigned sel = 0, vis = 0;
    if (typ == 1 && own > 0) {
        const bf16_t* km = (const bf16_t*)(ws + OFF_KM) + (((size_t)(bl * 8 + hd) * 16 + (r & 15)) * 2) * 64;
        f32x16 gt;
#pragma unroll
        for (int i = 0; i < 16; ++i) gt[i] = 0.f;
#pragma unroll
        for (int kk = 0; kk < 4; ++kk) {
            bf16x8 ahi = *(const bf16x8*)(km + kk * 16 + h * 8), alo = *(const bf16x8*)(km + 64 + kk * 16 + h * 8);
            if (r >= 16) { ahi = (bf16x8){0, 0, 0, 0, 0, 0, 0, 0}; alo = ahi; }
            gt = MFMA32(ahi, qf[kk], gt); gt = MFMA32(alo, qf[kk], gt);
        }
        float gl[16];
#pragma unroll
        for (int i = 0; i < 8; ++i) {
            const float mine = gt[i], oth = shx(mine, 32);
            gl[8 * (i >> 2) + (i & 3)] = h == 0 ? mine : oth;
            gl[8 * (i >> 2) + 4 + (i & 3)] = h == 0 ? oth : mine;
        }
#pragma unroll
        for (int pick = 0; pick < 3; ++pick) {
            float best = -3.0e38f; int bi = -1;
#pragma unroll
            for (int nb = 0; nb < 16; ++nb) { const bool ok = nb < own && !((sel >> nb) & 1u); if (ok && gl[nb] > best) { best = gl[nb]; bi = nb; } }
            if (bi >= 0) sel |= 1u << bi;
        }
        for (int nb = 0; nb < own; ++nb) if (__ballot((sel >> nb) & 1u) != 0ull) vis |= 1u << nb;
    }
    if (typ == 0) vis = (1u << own) - 1u;
    __syncthreads();
    if (lane == 0) wvis[w] = vis;
    __syncthreads();
    if (tid == 0) {
        unsigned bv = 0;
        for (int i = 0; i < 8; ++i) bv |= wvis[i];
        int n = 0;
        for (int nb = 0; nb < own; ++nb) if ((bv >> nb) & 1u) for (int k = 0; k < 8; ++k) seq[n++] = (unsigned short)(nb * 8 + k);
        for (int k = 0; k < 8; ++k) seq[n++] = (unsigned short)(own * 8 + k);
        seq[255] = (unsigned short)n;
    }
    __syncthreads();
    const int ntl = seq[255];
    const bf16_t* gsrc = (tid < 256 ? K : Vt) + (size_t)(tid & 255) * 8;
    char* lds_dst = shm + tid * 16;
    u32x4 R = *(const u32x4*)(gsrc + (size_t)seq[0] * 2048);
    *(u32x4*)lds_dst = R;
    if (ntl > 1) R = *(const u32x4*)(gsrc + (size_t)seq[1] * 2048);
    AttnAcc a; attn_init(a, attn_bound(qf, p.qk_g + ((size_t)(layer * 3 + 1 + typ) * 2 + 1) * 64));
    unsigned mw = typ == 0 ? mrow[seq[0]] : 0u;
    __syncthreads();
    for (int t = 0; t < ntl; ++t) {
        const int ct = seq[t], cb = ct >> 3;
        unsigned mwn = 0;
        if (typ == 0 && t + 1 < ntl) mwn = mrow[seq[t + 1]];
        const bool need = cb < own ? ((vis >> cb) & 1u) != 0u : ct <= ndiag;
        if (need) {
            const char* buf = shm + (t & 1) * 8192;
            KVFrag f;
#pragma unroll
            for (int kk = 0; kk < 4; ++kk) f.k[kk] = *(const bf16x8*)(buf + (kk * 64 + lane) * 16);
#pragma unroll
            for (int db = 0; db < 2; ++db)
#pragma unroll
                for (int u = 0; u < 2; ++u) f.v[db][u] = *(const bf16x8*)(buf + 4096 + ((db * 2 + u) * 64 + lane) * 16);
            unsigned vm;
            if (typ == 0) {
                const unsigned ws4 = mw >> (4 * h);
                vm = (ws4 & 0xfu) | ((ws4 >> 4) & 0xf0u) | ((ws4 >> 8) & 0xf00u) | ((ws4 >> 12) & 0xf000u);
            } else if (cb < own) vm = ((sel >> cb) & 1u) ? 0xffffu : 0u;
            else if (ct == ndiag) {
                vm = 0;
#pragma unroll
                for (int i = 0; i < 16; ++i) if (koff(i, h) <= r) vm |= 1u << i;
            } else vm = 0xffffu;
            attn_step(a, f, qf, vm);
        }
        if (t + 1 < ntl) {
            *(u32x4*)(lds_dst + ((t + 1) & 1) * 8192) = R;
            if (t + 2 < ntl) R = *(const u32x4*)(gsrc + (size_t)seq[t + 2] * 2048);
        }
        mw = mwn;
        __syncthreads();
    }
    attn_store_gated(p, a, (size_t)bl * S + q0 + r, (typ ? 1024 : 512) + hd * 64, h, st);
}

template <int TYP>
DI void attn_step2(AttnAcc& a0, AttnAcc& a1, KVFrag& f, const bf16x8 (&qa)[4], const bf16x8 (&qb)[4], unsigned vm0, unsigned vm1, bool shifted, const bf16_t* Kn, const bf16_t* Vn, int lane) {
    f32x16 s0, s1;
    __builtin_amdgcn_s_setprio(1);
    if (shifted) {
#pragma unroll
        for (int i = 0; i < 16; ++i) { s0[i] = -a0.nb; s1[i] = -a1.nb; }
        s0 = MFMA32(f.k[0], qa[0], s0); s1 = MFMA32(f.k[0], qb[0], s1);
    } else {
        const f32x16 z = {0.f, 0.f, 0.f, 0.f, 0.f, 0.f, 0.f, 0.f, 0.f, 0.f, 0.f, 0.f, 0.f, 0.f, 0.f, 0.f};
        s0 = MFMA32(f.k[0], qa[0], z); s1 = MFMA32(f.k[0], qb[0], z);
    }
#pragma unroll
    for (int kk = 1; kk < 4; ++kk) { s0 = MFMA32(f.k[kk], qa[kk], s0); s1 = MFMA32(f.k[kk], qb[kk], s1); }
    __builtin_amdgcn_s_setprio(0);
#pragma unroll
    for (int kk = 0; kk < 4; ++kk) f.k[kk] = *(const bf16x8*)(Kn + (kk * 64 + lane) * 8);
    float p0[16], p1[16];
#pragma unroll
    for (int i = 0; i < 16; ++i) { p0[i] = fexp2(s0[i]); p1[i] = fexp2(s1[i]); }
    if (TYP == 0 || __ballot((vm0 & vm1) != 0xffffu) != 0ull) {
#pragma unroll
        for (int i = 0; i < 16; ++i) {
            p0[i] = __int_as_float(__float_as_int(p0[i]) & __builtin_amdgcn_sbfe((int)vm0, i, 1));
            p1[i] = __int_as_float(__float_as_int(p1[i]) & __builtin_amdgcn_sbfe((int)vm1, i, 1));
        }
    }
    a0.l += ((p0[0] + p0[1]) + (p0[2] + p0[3])) + ((p0[4] + p0[5]) + (p0[6] + p0[7])) + (((p0[8] + p0[9]) + (p0[10] + p0[11])) + ((p0[12] + p0[13]) + (p0[14] + p0[15])));
    a1.l += ((p1[0] + p1[1]) + (p1[2] + p1[3])) + ((p1[4] + p1[5]) + (p1[6] + p1[7])) + (((p1[8] + p1[9]) + (p1[10] + p1[11])) + ((p1[12] + p1[13]) + (p1[14] + p1[15])));
    u32x4 w00, w01, w10, w11;
#pragma unroll
    for (int i = 0; i < 4; ++i) {
        w00[i] = cvt_pk_bf16(p0[2 * i], p0[2 * i + 1]); w01[i] = cvt_pk_bf16(p0[8 + 2 * i], p0[8 + 2 * i + 1]);
        w10[i] = cvt_pk_bf16(p1[2 * i], p1[2 * i + 1]); w11[i] = cvt_pk_bf16(p1[8 + 2 * i], p1[8 + 2 * i + 1]);
    }
    const bf16x8 f00 = __builtin_bit_cast(bf16x8, w00), f01 = __builtin_bit_cast(bf16x8, w01), f10 = __builtin_bit_cast(bf16x8, w10), f11 = __builtin_bit_cast(bf16x8, w11);
    __builtin_amdgcn_s_setprio(1);
    a0.o0 = MFMA32(f.v[0][0], f00, a0.o0); a1.o0 = MFMA32(f.v[0][0], f10, a1.o0);
    a0.o0 = MFMA32(f.v[0][1], f01, a0.o0); a1.o0 = MFMA32(f.v[0][1], f11, a1.o0);
    a0.o1 = MFMA32(f.v[1][0], f00, a0.o1); a1.o1 = MFMA32(f.v[1][0], f10, a1.o1);
    a0.o1 = MFMA32(f.v[1][1], f01, a0.o1); a1.o1 = MFMA32(f.v[1][1], f11, a1.o1);
    __builtin_amdgcn_s_setprio(0);
#pragma unroll
    for (int db = 0; db < 2; ++db)
#pragma unroll
        for (int u = 0; u < 2; ++u) f.v[db][u] = *(const bf16x8*)(Vn + ((db * 2 + u) * 64 + lane) * 8);
}
template <int TYP>
DI void attn_bc2_chunk(const Params& p, int layer, int bl, int hd, int cidx  , bool st) {
    char* ws = p.ws;
    const int lane = ltid() & 63, w = __builtin_amdgcn_readfirstlane(ltid() >> 6), r = lane & 31, h = lane >> 5;
    const int own = cidx >> 2, q0 = cidx * 64;
    const bf16_t* Q = (const bf16_t*)(ws + (TYP ? OFF_QC : OFF_QB)) + (size_t)(bl * 8 + hd) * S * 64;
    const bf16_t* K = (const bf16_t*)(ws + (TYP ? OFF_KC : OFF_KB)) + (size_t)(bl * 8 + hd) * S * 64;
    const bf16_t* Vt = (const bf16_t*)(ws + (TYP ? OFF_VC : OFF_VB)) + (size_t)(bl * 8 + hd) * 64 * S;
    const unsigned* mrow0 = (const unsigned*)(ws + OFF_MASK) + ((size_t)bl * S + q0 + r) * 128;
    const unsigned* mrow1 = mrow0 + 32 * 128;
    bf16x8 qa[4], qb[4];
    load_q(qa, Q + (size_t)(q0 + r) * 64, h); load_q(qb, Q + (size_t)(q0 + 32 + r) * 64, h);
    const float* gk = p.qk_g + ((size_t)(layer * 3 + 1 + TYP) * 2 + 1) * 64;
    AttnAcc a0, a1; attn_init(a0, attn_bound(qa, gk)); attn_init(a1, attn_bound(qb, gk));
    const bool shifted = a0.shifted || a1.shifted;
    if (shifted && !a0.shifted) a0.nb = 0.f;
    if (shifted && !a1.shifted) a1.nb = 0.f;
    const int d0 = q0 / 32, d1 = d0 + 1;
    unsigned sel0 = 0, sel1 = 0;
    unsigned long long tm0 = 0ull, tm1 = 0ull;
    if (TYP == 1) {
        if (own > 0) {
            const bf16_t* km = (const bf16_t*)(ws + OFF_KM) + (((size_t)(bl * 8 + hd) * 16 + (r & 15)) * 2) * 64;
            f32x16 g0, g1;
#pragma unroll
            for (int i = 0; i < 16; ++i) { g0[i] = 0.f; g1[i] = 0.f; }
#pragma unroll
            for (int kk = 0; kk < 4; ++kk) {
                bf16x8 ahi = *(const bf16x8*)(km + kk * 16 + h * 8), alo = *(const bf16x8*)(km + 64 + kk * 16 + h * 8);
                if (r >= 16) { ahi = (bf16x8){0, 0, 0, 0, 0, 0, 0, 0}; alo = ahi; }
                g0 = MFMA32(ahi, qa[kk], g0); g0 = MFMA32(alo, qa[kk], g0);
                g1 = MFMA32(ahi, qb[kk], g1); g1 = MFMA32(alo, qb[kk], g1);
            }
            auto top3 = [&](const f32x16& gt) -> unsigned {
                float gl[16];
#pragma unroll
                for (int i = 0; i < 8; ++i) {
                    const float mine = gt[i], oth = shx(mine, 32);
                    gl[8 * (i >> 2) + (i & 3)] = h == 0 ? mine : oth;
                    gl[8 * (i >> 2) + 4 + (i & 3)] = h == 0 ? oth : mine;
                }
                unsigned sel = 0;
#pragma unroll
                for (int pick = 0; pick < 3; ++pick) {
                    float best = -3.0e38f; int bi = -1;
#pragma unroll
                    for (int nb = 0; nb < 16; ++nb) { const bool ok = nb < own && !((sel >> nb) & 1u); if (ok && gl[nb] > best) { best = gl[nb]; bi = nb; } }
                    if (bi >= 0) sel |= 1u << bi;
                }
                return sel;
            };
            sel0 = top3(g0); sel1 = top3(g1);
        }
        for (int nb = 0; nb < own; ++nb) if (__ballot(((sel0 | sel1) >> nb) & 1u) != 0ull) { if (nb < 8) tm0 |= 0xffull << (8 * nb); else tm1 |= 0xffull << (8 * (nb - 8)); }
        for (int t = own * 8; t <= d1; ++t) { if (t < 64) tm0 |= 1ull << t; else tm1 |= 1ull << (t - 64); }
    } else {
        for (int t = 0; t <= d1; ++t) { if (t < 64) tm0 |= 1ull << t; else tm1 |= 1ull << (t - 64); }
    }
    const int ntl = __builtin_popcountll(tm0) + __builtin_popcountll(tm1);
    auto pop = [&]() -> int { int t; if (tm0) { t = __builtin_ctzll(tm0); tm0 &= tm0 - 1; } else if (tm1) { t = 64 + __builtin_ctzll(tm1); tm1 &= tm1 - 1; } else t = d1; return t; };
    auto cmask = [&](int t, unsigned sel, int dg) -> unsigned {
        const int cb = t >> 3;
        if (cb < own) return ((sel >> cb) & 1u) ? 0xffffu : 0u;
        if (t < dg) return 0xffffu;
        if (t > dg) return 0u;
        unsigned vm = 0;
#pragma unroll
        for (int i = 0; i < 16; ++i) if (koff(i, h) <= r) vm |= 1u << i;
        return vm;
    };
    auto bmask = [&](unsigned mw) -> unsigned {
        const unsigned ws4 = mw >> (4 * h);
        return (ws4 & 0xfu) | ((ws4 >> 4) & 0xf0u) | ((ws4 >> 8) & 0xf00u) | ((ws4 >> 12) & 0xf000u);
    };
    KVFrag f; int tc = pop(), tn = 0;
    kv_load(f, K + (size_t)tc * 2048, Vt + (size_t)tc * 2048, lane);
    unsigned mwa = 0, mwb = 0, mwan = 0, mwbn = 0;
    if (TYP == 0) { mwa = mrow0[tc]; mwb = mrow1[tc]; }
    for (int it = 0; it < ntl; ++it) {
        tn = pop();
        if (TYP == 0) { mwan = mrow0[tn]; mwbn = mrow1[tn]; }
        unsigned vm0, vm1;
        if (TYP == 0) { vm0 = bmask(mwa); vm1 = bmask(mwb); } else { vm0 = cmask(tc, sel0, d0); vm1 = cmask(tc, sel1, d1); }
        attn_step2<TYP>(a0, a1, f, qa, qb, vm0, vm1, shifted, K + (size_t)tn * 2048, Vt + (size_t)tn * 2048, lane);
        tc = tn; mwa = mwan; mwb = mwbn;
    }
    attn_store_gated(p, a0, (size_t)bl * S + q0 + r, (TYP ? 1024 : 512) + hd * 64, h, st);
    attn_store_gated(p, a1, (size_t)bl * S + q0 + 32 + r, (TYP ? 1024 : 512) + hd * 64, h, st);
}

DI void attn_a2_item(const Params& p, int layer, int bl, int hh, int rb2) {
    char* ws = p.ws;
    const int lane = ltid() & 63, w = __builtin_amdgcn_readfirstlane(ltid() >> 6), r = lane & 31, h = lane >> 5;
    const int g = hh >> 3, sh = 2 * g, n = S >> sh;
    const int row0 = rb2 * 512 + w * 64;
    const int rr = row0 / n, m0 = row0 % n;
    const bf16_t* Q = (const bf16_t*)(ws + OFF_QA) + (size_t)(bl * 24 + hh) * S * 64;
    const bf16_t* K = (const bf16_t*)(ws + OFF_KA) + (size_t)(bl * 24 + hh) * S * 64;
    const bf16_t* Vt = (const bf16_t*)(ws + OFF_VA) + (size_t)(bl * 24 + hh) * 64 * S;
    bf16x8 qa[4], qb[4];
    load_q(qa, Q + (size_t)(row0 + r) * 64, h); load_q(qb, Q + (size_t)(row0 + 32 + r) * 64, h);
    const float* gk = p.qk_g + ((size_t)(layer * 3 + 0) * 2 + 1) * 64;
    AttnAcc a0, a1; attn_init(a0, attn_bound(qa, gk)); attn_init(a1, attn_bound(qb, gk));
    const bool shifted = a0.shifted || a1.shifted;
    if (shifted && !a0.shifted) a0.nb = 0.f;
    if (shifted && !a1.shifted) a1.nb = 0.f;
    const int kfirst = m0 >= 128 ? 0 : (128 - m0) / 32;
    const int tile0 = (rr * n + m0 - 128) / 32;
    auto amask = [&](int k, int sb) -> unsigned {
        const int base = 128 + 32 * sb - 32 * k + r;
        if (base - 31 >= 0 && base <= 128) return 0xffffu;
        if (base < 0 || base - 31 > 128) return 0u;
        unsigned vm = 0;
#pragma unroll
        for (int i = 0; i < 16; ++i) { const int d = base - koff(i, h); if (d >= 0 && d <= 128) vm |= 1u << i; }
        return vm;
    };
    KVFrag f; kv_load(f, K + (size_t)(tile0 + kfirst) * 2048, Vt + (size_t)(tile0 + kfirst) * 2048, lane);
    for (int k = kfirst; k < 6; ++k) {
        const int kn = k + 1 < 6 ? k + 1 : k;
        attn_step2<1>(a0, a1, f, qa, qb, amask(k, 0), amask(k, 1), shifted, K + (size_t)(tile0 + kn) * 2048, Vt + (size_t)(tile0 + kn) * 2048, lane);
    }
#pragma unroll
    for (int sb = 0; sb < 2; ++sb) {
        const AttnAcc& a = sb ? a1 : a0;
        const float l = a.l + shx(a.l, 32);
        const float inv = 1.0f / l;
        const int s_ = ((m0 + 32 * sb + r) << sh) + rr;
        const size_t tl = (size_t)bl * S + s_;
        bf16_t* o = (bf16_t*)(ws + OFF_OA) + ((size_t)g * TG + tl) * 512 + (hh & 7) * 64;
#pragma unroll
        for (int q4 = 0; q4 < 4; ++q4) {
            u32x2 w0, w1;
            w0[0] = cvt_pk_bf16(a.o0[q4 * 4] * inv, a.o0[q4 * 4 + 1] * inv); w0[1] = cvt_pk_bf16(a.o0[q4 * 4 + 2] * inv, a.o0[q4 * 4 + 3] * inv);
            w1[0] = cvt_pk_bf16(a.o1[q4 * 4] * inv, a.o1[q4 * 4 + 1] * inv); w1[1] = cvt_pk_bf16(a.o1[q4 * 4 + 2] * inv, a.o1[q4 * 4 + 3] * inv);
            *(u32x2*)(o + 8 * q4 + 4 * h) = w0; *(u32x2*)(o + 32 + 8 * q4 + 4 * h) = w1;
        }
        if (h == 0) ((float*)(ws + OFF_LSE))[((size_t)g * TG + tl) * 8 + (hh & 7)] = (a.nb + __log2f(l)) * LN2F;
    }
}

DI void merge_a_item(const Params& p, int item, bool st) {
    char* ws = p.ws;
    const int tid = ltid();
    const bf16_t* oa = (const bf16_t*)(ws + OFF_OA);
    const float* lse = (const float*)(ws + OFF_LSE);
    bf16_t* sz = (bf16_t*)(ws + OFF_SZ);
    for (int it = 0; it < 8; ++it) {
        const size_t tl = (size_t)item * 64 + it * 8 + (tid >> 6);
        const int c8 = (tid & 63) * 8, hd = c8 >> 6;
        const float l0 = lse[(0 * (size_t)TG + tl) * 8 + hd], l1 = lse[(1 * (size_t)TG + tl) * 8 + hd], l2 = lse[(2 * (size_t)TG + tl) * 8 + hd];
        const float mx = fmaxf(l0, fmaxf(l1, l2));
        float w0 = __expf(l0 - mx), w1 = __expf(l1 - mx), w2 = __expf(l2 - mx);
        const float inv = 1.0f / (w0 + w1 + w2); w0 *= inv; w1 *= inv; w2 *= inv;
        const u32x4 a0 = *(const u32x4*)(oa + (0 * (size_t)TG + tl) * 512 + c8), a1 = *(const u32x4*)(oa + (1 * (size_t)TG + tl) * 512 + c8), a2 = *(const u32x4*)(oa + (2 * (size_t)TG + tl) * 512 + c8);
        const u32x4 zz = *(const u32x4*)(sz + tl * 1536 + c8);
        u32x4 res;
#pragma unroll
        for (int k = 0; k < 4; ++k) {
            const float lo = (w0 * __uint_as_float(a0[k] << 16) + w1 * __uint_as_float(a1[k] << 16) + w2 * __uint_as_float(a2[k] << 16)) * __uint_as_float(zz[k] << 16);
            const float hi = (w0 * __uint_as_float(a0[k] & 0xffff0000u) + w1 * __uint_as_float(a1[k] & 0xffff0000u) + w2 * __uint_as_float(a2[k] & 0xffff0000u)) * __uint_as_float(zz[k] & 0xffff0000u);
            res[k] = cvt_pk_bf16(lo, hi);
        }
        if (st) *(u32x4*)(sz + tl * 1536 + c8) = res;
    }
}

DI int snake_item(int round, int G, int bid) { return (round & 1) ? round * G + (G - 1 - bid) : round * G + bid; }

__global__ void __launch_bounds__(NTHREADS) fwd_megakernel(Params p) {
    __shared__ __attribute__((aligned(16))) char shm_raw[SHM_BYTES];
    cg::grid_group grid = cg::this_grid();
    char* ws = p.ws;
    const int G = gridDim.x, bid = blockIdx.x;
    __attribute__((address_space(3))) bf16_t* shm_g = (__attribute__((address_space(3))) bf16_t*)shm_raw;

    unsigned* barcnt = (unsigned*)(ws + OFF_BAR2);
    unsigned bartarget = 0;
    if (bid == 0 && threadIdx.x < 9) __hip_atomic_store(barcnt + 32 * threadIdx.x, 0u, __ATOMIC_RELAXED, __HIP_MEMORY_SCOPE_AGENT);
    if (bid == 0 && threadIdx.x < DEPTH * NGRP * 64) ((unsigned*)(ws + OFF_FLAG))[threadIdx.x] = 0u;
    phase_prep(p, shm_raw);
    if (DUPMASK & 64) { __syncthreads(); phase_prep(p, shm_raw); }
    grid.sync();

#define LAUNDER() do { } while (0)
    unsigned long long tspan = 0ull, tprev = SPINSEL ? wall_clock64() : 0ull;
#define PHASE_END(k) do { if (SPINSEL) { const unsigned long long tn_ = wall_clock64(); if (SPINSEL == (k)) tspan += tn_ - tprev; tprev = tn_; } } while (0)
    for (int layer = 0; layer < DEPTH; ++layer) {
        for (int grp = 0; grp < NGRP; ++grp) {
            const int gtok0 = grp * TG;
            LAUNDER();
            for (int rep = 0; rep <= (DUPMASK & 1); ++rep) {
                EpiIn epi{&p, layer, gtok0};
                gemm_phase<true>((const bf16_t*)(ws + OFF_WTIN), DM, 0, NPAD, (const bf16_t*)(ws + OFF_XB), DM, 0, TG, DM, 1, epi, shm_g);
            }
            grid_barrier(barcnt, bartarget, (unsigned)G);
            if (DUPMASK & 32) grid_barrier(barcnt, bartarget, (unsigned)G);
            PHASE_END(1);
            LAUNDER();
            for (int rep = 0; rep <= ((DUPMASK >> 1) & 1); ++rep) {
                const int nsel = BG * 256;
                const int nA = BG * 24 * 8, nK = BG * 8 * 16;
                const int rS = (nsel + G - 1) / G, rA = (nA + G - 1) / G, rK = (nK + G - 1) / G, rT = rS + rA + rK;
                const int off = (bid & 1) ? rS : 0;
                for (int st_ = 0; st_ < rT; ++st_) {
                    int s2 = st_ + off; if (s2 >= rT) s2 -= rT;
                    if (s2 < rS) {
                        const int it = snake_item(s2, G, bid);
                        if (it < nsel) select_chunk(p, it % BG, 255 - it / BG, shm_raw);
                    } else if (s2 < rS + rA) {
                        const int it = (s2 - rS) * G + bid;
                        if (it < nA) attn_a2_item(p, layer, it / (24 * 8), (it / 8) % 24, it % 8);
                    } else {
                        const int it = (s2 - rS - rA) * G + bid;
                        if (it < nK) kmean_item(p, it / 128, (it / 16) & 7, it & 15, shm_raw);
                    }
                }
            }
            grid_barrier(barcnt, bartarget, (unsigned)G);
            if (DUPMASK & 32) grid_barrier(barcnt, bartarget, (unsigned)G);
            PHASE_END(2);
            LAUNDER();
            for (int rep = ((DUPMASK >> 2) & 1); rep >= 0; --rep) {
                const bool st = rep == 0 || p.dupmask == 0x7fffffff;
#if ATTN64
                const int nbc = 2 * BG * 8 * 4;
                const int wv = __builtin_amdgcn_readfirstlane(ltid() >> 6);
                for (int it = bid; it < nbc; it += G) {
                    const int j = it & 3, sub = it >> 2, typ = sub / (BG * 8), bl = (sub / 8) % BG, hd = sub & 7;
                    const int c0 = j * 8 + wv, c1 = 63 - c0;
                    if (typ == 0) { attn_bc2_chunk<0>(p, layer, bl, hd, c1, st); attn_bc2_chunk<0>(p, layer, bl, hd, c0, st); }
                    else { attn_bc2_chunk<1>(p, layer, bl, hd, c1, st); attn_bc2_chunk<1>(p, layer, bl, hd, c0, st); }
                }
#else
                const int nbc = 2 * BG * 8 * 16;
                for (int rnd = 0;; ++rnd) {
                    const int it = snake_item(rnd, G, bid);
                    if (rnd * G >= nbc) break;
                    if (it < nbc) {
                        const int qb = 15 - it / (2 * BG * 8), sub = it % (2 * BG * 8), typ = sub / (BG * 8), bl = (sub / 8) % BG, hd = sub & 7;
                        {
#if ATTN_LDS
                            attn_bc_item(p, layer, typ, bl, hd, qb, st, shm_raw);
#else
                            if (typ == 0) attn_b_item(p, layer, bl, hd, qb, st, st ? 0 : ((p.dupmask >> 8) & 3)); else if (st || ((p.dupmask >> 10) & 1) == 0) attn_c_item(p, layer, bl, hd, qb, st);
#endif
                        }
                    }
                }
#endif
                for (int it = bid; it < TG / 64; it += G) merge_a_item(p, it, st);
            }
            grid_barrier(barcnt, bartarget, (unsigned)G);
            if (DUPMASK & 32) grid_barrier(barcnt, bartarget, (unsigned)G);
            PHASE_END(3);
            LAUNDER();
            for (int rep = 0; rep <= ((DUPMASK >> 3) & 1); ++rep) {
                EpiBr epi{&p};
                gemm_phase<false>((const bf16_t*)(ws + OFF_WTBR) + (size_t)layer * 3 * DM * 512, 512, (size_t)DM * 512, DM, (const bf16_t*)(ws + OFF_SZ), 1536, 512, TG, 512, 3, epi, shm_g);
            }
            {
                const bool handoff = (DUPMASK == 0) && G == (DM / BM) * (TG / BM);
                if (handoff) {
                    int pm_, pn_; gemm_tile_of(bid, DM / BM, TG / BM, pm_, pn_);
                    unsigned* fl = (unsigned*)(ws + OFF_FLAG) + (layer * NGRP + grp) * 64 + pn_;
                    __syncthreads();
                    if (threadIdx.x == 0) {
                        __builtin_amdgcn_fence(__ATOMIC_RELEASE, "agent");
                        __hip_atomic_fetch_add(fl, 1u, __ATOMIC_RELAXED, __HIP_MEMORY_SCOPE_AGENT);
                        while (__hip_atomic_load(fl, __ATOMIC_RELAXED, __HIP_MEMORY_SCOPE_AGENT) < (unsigned)(DM / BM)) __builtin_amdgcn_s_sleep(1);
                        __builtin_amdgcn_fence(__ATOMIC_ACQUIRE, "agent");
                    }
                    __syncthreads();
                } else {
                    grid_barrier(barcnt, bartarget, (unsigned)G);
                    if (DUPMASK & 32) grid_barrier(barcnt, bartarget, (unsigned)G);
                }
            }
            PHASE_END(4);
            LAUNDER();
            for (int rep = ((DUPMASK >> 4) & 1); rep >= 0; --rep) {
                EpiOut epi{&p, layer, gtok0, rep == 0 || p.dupmask == 0x7fffffff};
                gemm_phase<false>((const bf16_t*)(ws + OFF_WTOUT) + (size_t)layer * DM * DM, DM, 0, DM, (const bf16_t*)(ws + OFF_MB), DM, 0, TG, DM, 1, epi, shm_g);
                if (rep == 0) {
                    const int nl = grp + 1 < NGRP ? layer : layer + 1, ng = grp + 1 < NGRP ? grp + 1 : 0;
                    if (nl < DEPTH) {
                        __syncthreads();
                        const float* xsrc = (nl == 0 ? p.x : (const float*)p.out) + (size_t)ng * TG * DM;
                        int per = (TG + G - 1) / G; int tb = bid * per, te = tb + per < TG ? tb + per : TG;
                        xprep_tokens(xsrc, (bf16_t*)(ws + OFF_XB), (float*)(ws + OFF_SS), tb, te);
                        if (nl != layer) for (int it = bid; it < 16 * 204; it += G) convert_win_tile(p, nl, it, (float*)shm_raw);
                    }
                }
            }
            grid_barrier(barcnt, bartarget, (unsigned)G);
            if (DUPMASK & 32) grid_barrier(barcnt, bartarget, (unsigned)G);
            PHASE_END(5);
        }
    }
    if (SPINSEL) { const unsigned long long t0_ = wall_clock64(); while (wall_clock64() - t0_ < tspan) __builtin_amdgcn_s_sleep(8); }
}

extern "C" void kernel_launch(void* const* d_in, const int* in_sizes, int n_in, void* d_out, int out_size, void* d_ws, size_t ws_size, hipStream_t stream) {
    static int grid_blocks = 0;
    if (!grid_blocks) {
        int dev = 0, cus = 0, per_cu = 0;
        hipGetDevice(&dev);
        hipDeviceGetAttribute(&cus, hipDeviceAttributeMultiprocessorCount, dev);
        hipOccupancyMaxActiveBlocksPerMultiprocessor(&per_cu, fwd_megakernel, NTHREADS, 0);
        if (per_cu > 1) per_cu = 1;
        grid_blocks = cus * per_cu;
    }
    if (ws_size < WS_NEED) { fprintf(stderr, "workspace too small: %zu < %zu\n", ws_size, (size_t)WS_NEED); return; }
    Params p{};
    p.dupmask = DUPMASK; p.pad_ = 0;
    p.x = (const float*)d_in[0]; p.pos = (const int*)d_in[1]; p.norm_g = (const float*)d_in[2]; p.w_in = (const float*)d_in[3];
    p.qk_g = (const float*)d_in[4]; p.w_br = (const float*)d_in[5]; p.w_out = (const float*)d_in[6];
    p.out = (float*)d_out; p.ws = (char*)d_ws;
    void* args[] = {&p};
    hipError_t e = hipLaunchCooperativeKernel((void*)fwd_megakernel, dim3(grid_blocks), dim3(NTHREADS), args, 0, stream);
    if (e != hipSuccess) fprintf(stderr, "cooperative launch failed: %s (grid %d)\n", hipGetErrorString(e), grid_blocks);
}
```

```cpp
#include <hip/hip_runtime.h>
#include <hip/hip_cooperative_groups.h>
#include <cstdio>
#include <cstdint>
namespace cg = cooperative_groups;
#define ATTN_LDS 0
#define ATTN64 1
#define SPINSEL 0
#define DUPMASK 0

typedef unsigned short bf16_t;
typedef short bf16x8 __attribute__((ext_vector_type(8)));
typedef short s16x4 __attribute__((ext_vector_type(4)));
typedef float f32x4 __attribute__((ext_vector_type(4)));
typedef float f32x16 __attribute__((ext_vector_type(16)));
typedef unsigned u32x4 __attribute__((ext_vector_type(4)));
typedef unsigned u32x2 __attribute__((ext_vector_type(2)));
#define DI __device__ __forceinline__

constexpr int S = 4096, DM = 1024, NB = 8, DEPTH = 2;
constexpr int NIN = 12872, NPAD = 13056;
constexpr int BG = 4, TG = BG * S, NGRP = NB / BG;
constexpr int NTHREADS = 512;
constexpr int SHM_BYTES = 131072;
constexpr float QSCALE = 0.125f * 1.4426950408889634f;
constexpr float LN2F = 0.6931471805599453f;
constexpr int SEL_CAP = 768;

constexpr size_t al256(size_t x) { return (x + 255) & ~(size_t)255; }
constexpr size_t OFF_WTIN = 0;
constexpr size_t OFF_WTBR = OFF_WTIN + al256((size_t)NPAD * DM * 2);
constexpr size_t OFF_WTOUT = OFF_WTBR + al256((size_t)DEPTH * 3 * DM * 512 * 2);
constexpr size_t OFF_CS = OFF_WTOUT + al256((size_t)DEPTH * DM * DM * 2);
constexpr size_t OFF_XB = OFF_CS + al256((size_t)NB * S * 8 * 8);
constexpr size_t OFF_OA = OFF_XB;
constexpr size_t OFF_SS = OFF_XB + al256((size_t)3 * TG * 512 * 2);
constexpr size_t OFF_QA = OFF_SS + al256((size_t)TG * 8 * 4);
constexpr size_t OFF_KA = OFF_QA + al256((size_t)TG * 1536 * 2);
constexpr size_t OFF_VA = OFF_KA + al256((size_t)TG * 1536 * 2);
constexpr size_t OFF_MF = OFF_QA;
constexpr size_t OFF_MB = OFF_VA;
constexpr size_t OFF_QB = OFF_VA + al256((size_t)TG * 1536 * 2);
constexpr size_t OFF_KB = OFF_QB + al256((size_t)TG * 512 * 2);
constexpr size_t OFF_VB = OFF_KB + al256((size_t)TG * 512 * 2);
constexpr size_t OFF_QC = OFF_VB + al256((size_t)TG * 512 * 2);
constexpr size_t OFF_KC = OFF_QC + al256((size_t)TG * 512 * 2);
constexpr size_t OFF_VC = OFF_KC + al256((size_t)TG * 512 * 2);
constexpr size_t OFF_IQ = OFF_VC + al256((size_t)TG * 512 * 2);
constexpr size_t OFF_IK = OFF_IQ + al256((size_t)TG * 512 * 2);
constexpr size_t OFF_IW = OFF_IK + al256((size_t)TG * 64 * 2);
constexpr size_t OFF_SZ = OFF_IW + al256((size_t)TG * 8 * 4);
constexpr size_t OFF_SG = OFF_SZ + al256((size_t)TG * 1536 * 2);
constexpr size_t OFF_LSE = OFF_SG + al256((size_t)TG * 3072 * 2);
constexpr size_t OFF_MASK = OFF_LSE + al256((size_t)3 * TG * 8 * 4);
constexpr size_t OFF_KM = OFF_MASK + al256((size_t)BG * S * (S / 8));
static_assert((size_t)TG * DM * 4 <= (size_t)2 * TG * 1536 * 2 && (size_t)TG * DM * 2 <= (size_t)TG * 1536 * 2, "overlay sizes");
constexpr size_t OFF_BAR = OFF_KM + al256((size_t)BG * 8 * 16 * 64 * 2 * 2);
constexpr size_t OFF_FLAG = OFF_BAR + 256;
constexpr size_t OFF_BAR2 = OFF_FLAG + (size_t)DEPTH * NGRP * 64 * 4;
constexpr size_t WS_NEED = OFF_BAR2 + 9 * 128;

struct Params {
    const float* x; const int* pos; const float* norm_g; const float* w_in; const float* qk_g; const float* w_br; const float* w_out;
    float* out; char* ws; int dupmask; int pad_;
};

DI int ltid() { int t = threadIdx.x; asm volatile("" : "+v"(t)); return t; }
DI unsigned cvt_pk_bf16(float lo, float hi) { unsigned r; asm volatile("v_cvt_pk_bf16_f32 %0, %1, %2" : "=v"(r) : "v"(lo), "v"(hi)); return r; }
DI bf16_t f2bf(float x) { return (bf16_t)(cvt_pk_bf16(x, 0.f) & 0xffffu); }
DI float bf2f(bf16_t v) { return __uint_as_float(((unsigned)v) << 16); }
DI float fexp2(float x) { return __builtin_amdgcn_exp2f(x); }
DI float shx(float v, int mask) { const int l = ltid() & 63; return __int_as_float(__builtin_amdgcn_ds_bpermute((l ^ mask) << 2, __float_as_int(v))); }
DI float wave_sum(float v) { for (int o = 32; o > 0; o >>= 1) v += shx(v, o); return v; }
DI int f2sort(float f) { int i = __float_as_int(f); return i ^ ((i >> 31) & 0x7fffffff); }
DI float sort2f(int i) { return __int_as_float(i ^ ((i >> 31) & 0x7fffffff)); }
#define MFMA32(a, b, c) __builtin_amdgcn_mfma_f32_32x32x16_bf16((a), (b), (c), 0, 0, 0)
#define MFMA16(a, b, c) __builtin_amdgcn_mfma_f32_16x16x32_bf16((a), (b), (c), 0, 0, 0)

DI void grid_barrier(unsigned* bar, unsigned& gen, unsigned G) {
    __syncthreads();
    gen += 1;
    if (threadIdx.x == 0) {
        __builtin_amdgcn_fence(__ATOMIC_RELEASE, "agent");
        const unsigned sh = blockIdx.x & 7u, per = (G + 7u - sh) >> 3, nsh = G < 8u ? G : 8u;
        const unsigned old = __hip_atomic_fetch_add(bar + 32 * (1 + sh), 1u, __ATOMIC_RELAXED, __HIP_MEMORY_SCOPE_AGENT);
        if (old + 1u == per * gen) __hip_atomic_fetch_add(bar, 1u, __ATOMIC_RELAXED, __HIP_MEMORY_SCOPE_AGENT);
        while (__hip_atomic_load(bar, __ATOMIC_RELAXED, __HIP_MEMORY_SCOPE_AGENT) < nsh * gen) __builtin_amdgcn_s_sleep(2);
        __builtin_amdgcn_fence(__ATOMIC_ACQUIRE, "agent");
    }
    __syncthreads();
}

DI int src_col_of_group(int hg) { return hg <= 104 ? hg * 64 : (hg <= 200 ? 6728 + (hg - 105) * 64 : 6720); }

DI void convert_tile(const float* src, int ld_src, int k0, int n_src0, int n_valid, const float* kscale, bf16_t* dst, int ld_dst, int n_dst0, float* tl  ) {
    const int tid = ltid();
    __syncthreads();
#pragma unroll
    for (int i = 0; i < 8; ++i) {
        int e = tid + i * 512, kk = e >> 6, nn = e & 63;
        float v = 0.f;
        if (nn < n_valid) { v = src[(size_t)(k0 + kk) * ld_src + n_src0 + nn]; if (kscale) v *= kscale[k0 + kk]; }
        tl[kk * 65 + nn] = v;
    }
    __syncthreads();
#pragma unroll
    for (int i = 0; i < 4; ++i) {
        int e = tid + i * 512, nn = e >> 5, kp = (e & 31) * 2;
        unsigned w = cvt_pk_bf16(tl[kp * 65 + nn], tl[(kp + 1) * 65 + nn]);
        *(unsigned*)(dst + (size_t)(n_dst0 + nn) * ld_dst + k0 + kp) = w;
    }
}

DI void xprep_tokens(const float* xsrc  , bf16_t* xb, float* ss, int tok_begin, int tok_end) {
    const int lane = ltid() & 63, wid = ltid() >> 6;
    for (int t = tok_begin + wid; t < tok_end; t += 8) {
        const float* xr = xsrc + (size_t)t * DM;
        float sum = 0.f;
#pragma unroll
        for (int i = 0; i < 4; ++i) {
            f32x4 v = *(const f32x4*)(xr + i * 256 + lane * 4);
            sum += v[0] * v[0] + v[1] * v[1] + v[2] * v[2] + v[3] * v[3];
            u32x2 w; w[0] = cvt_pk_bf16(v[0], v[1]); w[1] = cvt_pk_bf16(v[2], v[3]);
            *(u32x2*)(xb + (size_t)t * DM + i * 256 + lane * 4) = w;
        }
        sum = wave_sum(sum);
        if (lane < 8) ss[(size_t)t * 8 + lane] = lane == 0 ? sum : 0.f;
    }
}

DI void convert_win_tile(const Params& p, int l, int it, float* tl) {
    const int hg = it / 16, kt = it % 16;
    const int nvalid = hg <= 200 ? 64 : (hg == 201 ? 8 : 0);
    convert_tile(p.w_in + (size_t)l * DM * NIN, NIN, kt * 64, src_col_of_group(hg), nvalid, p.norm_g + l * DM, (bf16_t*)(p.ws + OFF_WTIN), DM, hg * 64, tl);
}
DI void phase_prep(const Params& p, char* shm) {
    char* ws = p.ws;
    const int G = gridDim.x, bid = blockIdx.x, tid = ltid();
    float2* cs = (float2*)(ws + OFF_CS);
    for (int e = bid * NTHREADS + tid; e < NB * S * 8; e += G * NTHREADS) {
        int i = e & 7, t = e >> 3;
        float inv = powf(500000.0f, -(float)(2 * i) / 16.0f);
        float ang = (float)p.pos[t] * inv;
        double rev = (double)ang * 0.15915494309189535;
        rev -= floor(rev);
        float rf = (float)rev;
        cs[e] = make_float2(__builtin_amdgcn_cosf(rf), __builtin_amdgcn_sinf(rf));
    }
    float* tl = (float*)shm;
    const int n_in_tiles = 16 * 204, n_br_tiles = DEPTH * 3 * 8 * 16, n_out_tiles = DEPTH * 16 * 16;
    for (int it = bid; it < n_in_tiles + n_br_tiles + n_out_tiles; it += G) {
        if (it < n_in_tiles) {
            convert_win_tile(p, 0, it, tl);
        } else if (it < n_in_tiles + n_br_tiles) {
            int r = it - n_in_tiles; int ln = r / 128, q = r % 128, kt = q / 16, nt = q % 16;
            convert_tile(p.w_br + (size_t)ln * 512 * DM, DM, kt * 64, nt * 64, 64, nullptr, (bf16_t*)(ws + OFF_WTBR) + (size_t)ln * DM * 512, 512, nt * 64, tl);
        } else {
            int r = it - n_in_tiles - n_br_tiles; int l = r / 256, q = r % 256, kt = q / 16, nt = q % 16;
            convert_tile(p.w_out + (size_t)l * DM * DM, DM, kt * 64, nt * 64, 64, nullptr, (bf16_t*)(ws + OFF_WTOUT) + (size_t)l * DM * DM, DM, nt * 64, tl);
        }
    }
    int per = (TG + G - 1) / G;
    int tb = bid * per, te = tb + per < TG ? tb + per : TG;
    xprep_tokens(p.x, (bf16_t*)(ws + OFF_XB), (float*)(ws + OFF_SS), tb, te);
}

constexpr int BM = 256, BK = 64, HALF = 128, NXCD = 8, WGM = 8, HT = HALF * BK;
DI int lds_byte(int r, int c) { int st = (r >> 4) * 2 + (c >> 5), rr = r & 15, cc = c & 31, ob = rr * 64 + cc * 2; return st * 1024 + (ob ^ (((ob >> 9) & 1) << 5)); }
DI void stage_rc(int b, int& R, int& C) { int st = b / 1024, sb = b % 1024, swz = sb ^ (((sb >> 9) & 1) << 5); R = (st >> 1) * 16 + swz / 64; C = (st & 1) * 32 + (swz % 64) / 2; }

#define SA(b, h) (shm + ((b) * 2 + (h)) * HT)
#define SB(b, h) (shm + (4 + (b) * 2 + (h)) * HT)
DI void glds16(const void* sbase, unsigned voff, unsigned lds_dst) {
    unsigned keep;
    asm volatile("s_mov_b32 %0, m0\n\ts_mov_b32 m0, %3\n\ts_nop 0\n\tglobal_load_lds_dwordx4 %1, %2\n\ts_mov_b32 m0, %0"
                 : "=&s"(keep) : "v"(voff), "s"(sbase), "s"(lds_dst) : "memory");
}
#define STAGE(P, BASE, LD, br, kt, VOFF) do { const bf16_t* _gp = (BASE) + (size_t)(br) * (LD) + (size_t)(kt) * BK; \
    const unsigned _l0 = (unsigned)(size_t)(P) + wbase16; \
    glds16(_gp, VOFF[0], _l0); glds16(_gp, VOFF[1], _l0 + 8192u); } while (0)
#define LDA(dst, b, h) _Pragma("unroll") for (int m = 0; m < 4; ++m) _Pragma("unroll") for (int k = 0; k < 2; ++k) \
    dst[m][k] = *reinterpret_cast<const bf16x8*>((char*)SA(b, h) + lds_byte(wr * 64 + m * 16 + fr, k * 32 + fq * 8))
#define LDB(dst, b, h) _Pragma("unroll") for (int n = 0; n < 2; ++n) _Pragma("unroll") for (int k = 0; k < 2; ++k) \
    dst[n][k] = *reinterpret_cast<const bf16x8*>((char*)SB(b, h) + lds_byte(wc * 32 + n * 16 + fr, k * 32 + fq * 8))
#define MMA(ai, bj, At, Bt_) do { __builtin_amdgcn_s_setprio(1); \
    _Pragma("unroll") for (int m = 0; m < 4; ++m) _Pragma("unroll") for (int n = 0; n < 2; ++n) _Pragma("unroll") for (int k = 0; k < 2; ++k) \
      acc[ai][bj][m][n] = MFMA16(At[m][k], Bt_[n][k], acc[ai][bj][m][n]); \
    __builtin_amdgcn_s_setprio(0); } while (0)
#define WAIT_V(n) asm volatile("s_waitcnt vmcnt(" #n ")" ::: "memory")
#define WAIT_L(n) asm volatile("s_waitcnt lgkmcnt(" #n ")" ::: "memory")
#define BAR __builtin_amdgcn_s_barrier()
#define SCHED __builtin_amdgcn_sched_barrier(0)

DI int fold_tok(int rho, int sh) { const int b = rho >> 12, rb = rho & (S - 1); return (b << 12) + (((rb & ((S >> sh) - 1)) << sh) + (rb >> (12 - sh))); }
DI void gemm_tile_of(int L, int nM, int nN, int& pm, int& pn) {
    const int nwg = nM * nN; int wgid = L;
    { int q = nwg / NXCD, r = nwg % NXCD, xcd = wgid % NXCD, off = wgid / NXCD; wgid = (xcd < r ? xcd * (q + 1) : r * (q + 1) + (xcd - r) * q) + off; }
    const int nig = WGM * nN, gid = wgid / nig, fm = gid * WGM, gsz = min(nM - fm, WGM);
    pm = fm + ((wgid % nig) % gsz); pn = (wgid % nig) / gsz;
}
template <bool FOLD, class Epi>
DI void gemm_phase(const bf16_t* __restrict__ Abase, int lda, size_t a_sub, int M, const bf16_t* __restrict__ Bbase, int ldb, size_t b_sub, int N, int K, int nsub,
                   Epi& epi, __attribute__((address_space(3))) bf16_t* shm) {
    const int nM = M / BM, nN = N / BM, nwg = nM * nN;
    const int wid = ltid() >> 6, lane = ltid() & 63, wr = wid >> 2, wc = wid & 3, fr = lane & 15, fq = lane >> 4;
    const int nt = K / BK;
    unsigned voffA[2], voffB0[2], voffB1[2];
    const unsigned wbase16 = __builtin_amdgcn_readfirstlane((ltid() & ~63u) * 16u);
#pragma unroll
    for (int i = 0; i < 2; ++i) {
        int r_, c_; stage_rc(ltid() * 16 + i * 8192, r_, c_);
        const int x_ = r_ & 63, pr_ = (r_ & 64) + ((x_ & 15) >> 2) * 16 + (x_ >> 4) * 4 + (x_ & 3);
        voffA[i] = (unsigned)(pr_ * lda + c_) * 2u;
    }
    int L = blockIdx.x, sub = 0, brow = 0, bcol = 0;
    bool have = L < nwg, prefetched = false;
    const bf16_t* A = Abase; const bf16_t* Bt = Bbase;
    auto setup = [&](int L_, int sub_) {
        int wgid = L_;
        { int q = nwg / NXCD, r = nwg % NXCD, xcd = wgid % NXCD, off = wgid / NXCD; wgid = (xcd < r ? xcd * (q + 1) : r * (q + 1) + (xcd - r) * q) + off; }
        const int nig = WGM * nN, gid = wgid / nig, fm = gid * WGM, gsz = min(nM - fm, WGM);
        const int pm = fm + ((wgid % nig) % gsz), pn = (wgid % nig) / gsz;
        brow = pm * BM; bcol = pn * BM;
        const int sh = (FOLD && pm < 18) ? 2 * ((pm % 6) >> 1) : 0;
        const int t_ = ltid();
#pragma unroll
        for (int i = 0; i < 2; ++i) {
            int r_, c_; stage_rc(t_ * 16 + i * 8192, r_, c_);
            voffB0[i] = (unsigned)(fold_tok(bcol + r_, sh) * ldb + c_) * 2u;
            voffB1[i] = (unsigned)(fold_tok(bcol + HALF + r_, sh) * ldb + c_) * 2u;
        }
        A = Abase + (size_t)sub_ * a_sub; Bt = Bbase + (size_t)sub_ * b_sub;
    };
    while (have) {
        {
            setup(L, sub);
            f32x4 acc[2][2][4][2] = {};
            bf16x8 At[4][2], B0[2][2], B1[2][2];
            if (!prefetched) {
                STAGE(SB(0, 0), Bt, ldb, 0, 0, voffB0); STAGE(SA(0, 0), A, lda, brow, 0, voffA);
                STAGE(SB(0, 1), Bt, ldb, 0, 0, voffB1); STAGE(SA(0, 1), A, lda, brow + HALF, 0, voffA);
            }
            if (wr == 1) BAR;
            if (prefetched) WAIT_V(0); else WAIT_V(4);
            BAR;
            STAGE(SB(1, 0), Bt, ldb, 0, 1, voffB0); STAGE(SA(1, 0), A, lda, brow, 1, voffA); STAGE(SB(1, 1), Bt, ldb, 0, 1, voffB1);
            WAIT_V(6); BAR;
            for (int t = 0; t < nt - 2; t += 2) {
                LDB(B0, 0, 0); SCHED; LDA(At, 0, 0); STAGE(SA(1, 1), A, lda, brow + HALF, t + 1, voffA);
                WAIT_L(8); BAR; WAIT_L(0); MMA(0, 0, At, B0); BAR; SCHED;
                LDB(B1, 0, 1); STAGE(SB(0, 0), Bt, ldb, 0, t + 2, voffB0);
                BAR; WAIT_L(0); MMA(0, 1, At, B1); BAR;
                LDA(At, 0, 1); STAGE(SA(0, 0), A, lda, brow, t + 2, voffA);
                BAR; WAIT_L(0); MMA(1, 0, At, B0); BAR; SCHED;
                STAGE(SB(0, 1), Bt, ldb, 0, t + 2, voffB1);
                WAIT_V(6); BAR; MMA(1, 1, At, B1); BAR;
                LDB(B0, 1, 0); SCHED; LDA(At, 1, 0); STAGE(SA(0, 1), A, lda, brow + HALF, t + 2, voffA);
                WAIT_L(8); BAR; WAIT_L(0); MMA(0, 0, At, B0); BAR; SCHED;
                LDB(B1, 1, 1); STAGE(SB(1, 0), Bt, ldb, 0, t + 3, voffB0);
                BAR; WAIT_L(0); MMA(0, 1, At, B1); BAR;
                LDA(At, 1, 1); STAGE(SA(1, 0), A, lda, brow, t + 3, voffA);
                BAR; WAIT_L(0); MMA(1, 0, At, B0); BAR; SCHED;
                STAGE(SB(1, 1), Bt, ldb, 0, t + 3, voffB1);
                WAIT_V(6); BAR; MMA(1, 1, At, B1); BAR;
            }
            { LDB(B0, 0, 0); LDA(At, 0, 0); STAGE(SA(1, 1), A, lda, brow + HALF, nt - 1, voffA);
              BAR; WAIT_L(0); MMA(0, 0, At, B0); BAR;
              LDB(B1, 0, 1); BAR; WAIT_L(0); MMA(0, 1, At, B1); BAR;
              LDA(At, 0, 1); WAIT_V(4); BAR; WAIT_L(0); MMA(1, 0, At, B0); MMA(1, 1, At, B1); BAR; }
            { LDB(B0, 1, 0); LDA(At, 1, 0); WAIT_V(2); BAR; WAIT_L(0); MMA(0, 0, At, B0); BAR;
              LDB(B1, 1, 1); WAIT_V(0); BAR; WAIT_L(0); MMA(0, 1, At, B1); BAR;
              LDA(At, 1, 1); BAR; WAIT_L(0); MMA(1, 0, At, B0); MMA(1, 1, At, B1); BAR; }
            if (wr == 0) BAR;
            const int e_brow = brow, e_bcol = bcol, e_sub = sub;
            if (++sub == nsub) { sub = 0; L += gridDim.x; }
            have = L < nwg;
            if (have) {
                setup(L, sub);
                STAGE(SB(0, 0), Bt, ldb, 0, 0, voffB0); STAGE(SA(0, 0), A, lda, brow, 0, voffA);
                STAGE(SB(0, 1), Bt, ldb, 0, 0, voffB1); STAGE(SA(0, 1), A, lda, brow + HALF, 0, voffA);
                prefetched = true;
            }
            { int t2 = ltid();
              const int wid2 = t2 >> 6, lane2 = t2 & 63;
              epi(acc, e_brow, e_bcol, e_sub, wid2 >> 2, wid2 & 3, lane2 & 15, lane2 >> 4); }
        }
    }
}

struct EpiIn {
    const Params* p; int layer; int gtok0;
    DI void operator()(const f32x4 (&acc)[2][2][4][2], int brow, int bcol, int sub, int wr, int wc, int fr, int fq) const {
        char* ws = p->ws;
        const float* ss = (const float*)(ws + OFF_SS);
        const float2* cs = (const float2*)(ws + OFF_CS);
        const int lane = ltid() & 63;
#pragma unroll
        for (int bj = 0; bj < 2; ++bj)
#pragma unroll
            for (int n = 0; n < 2; ++n) {
                const int rho = bcol + bj * 128 + wc * 32 + n * 16 + fr;
                const int pm_ = brow >> 8;
                const int shf = pm_ < 18 ? 2 * ((pm_ % 6) >> 1) : 0;
                const int tl = fold_tok(rho, shf);
                const f32x4 s0 = *(const f32x4*)(ss + (size_t)tl * 8), s1 = *(const f32x4*)(ss + (size_t)tl * 8 + 4);
                const float rstd = rsqrtf((s0[0] + s0[1] + s0[2] + s0[3] + s1[0] + s1[1] + s1[2] + s1[3]) * (1.0f / DM) + 1e-6f);
                const int bl = tl >> 12, s = tl & (S - 1), rb = rho & (S - 1);
                const int tg = gtok0 + tl;
#pragma unroll
                for (int ai = 0; ai < 2; ++ai) {
                    const int hg = (brow + ai * 128 + wr * 64) >> 6;
                    float v[16];
#pragma unroll
                    for (int m = 0; m < 4; ++m)
#pragma unroll
                        for (int j = 0; j < 4; ++j) v[m * 4 + j] = acc[ai][bj][m][n][j] * rstd;
                    int kind;
                    int mixer = 0, isk = 0, hh = 0, H = 8; size_t qoff = 0, koff = 0, voff = 0;
                    if (hg < 72) { mixer = 0; H = 24; qoff = OFF_QA; koff = OFF_KA; voff = OFF_VA; kind = hg < 48 ? 0 : 1; isk = hg >= 24; hh = hg % 24; }
                    else if (hg < 96) { mixer = 1; qoff = OFF_QB; koff = OFF_KB; voff = OFF_VB; kind = hg < 88 ? 0 : 1; isk = hg >= 80; hh = (hg - 72) & 7; }
                    else if (hg < 105) { kind = 2; isk = hg == 104; hh = hg - 96; }
                    else if (hg < 129) { mixer = 2; qoff = OFF_QC; koff = OFF_KC; voff = OFF_VC; kind = hg < 121 ? 0 : 1; isk = hg >= 113; hh = (hg - 105) & 7; }
                    else if (hg < 153) kind = 3;
                    else if (hg < 201) kind = 4;
                    else kind = hg == 201 ? 5 : 6;

                    if (kind == 0 || kind == 2) {
                        if (kind == 0) {
                            float sq = 0.f;
#pragma unroll
                            for (int i = 0; i < 16; ++i) sq += v[i] * v[i];
                            sq += shx(sq, 16); sq += shx(sq, 32);
                            const float rn = rsqrtf(sq * (1.0f / 64) + 1e-6f) * (isk ? 1.0f : QSCALE);
                            const float* gq = p->qk_g + ((size_t)(layer * 3 + mixer) * 2 + isk) * 64 + fq * 16;
#pragma unroll
                            for (int m = 0; m < 4; ++m) {
                                const f32x4 g4 = *(const f32x4*)(gq + m * 4);
#pragma unroll
                                for (int j = 0; j < 4; ++j) v[m * 4 + j] *= rn * g4[j];
                            }
                        }
                        if (fq == 0) {
                            const f32x4* cp = (const f32x4*)(cs + (size_t)tg * 8);
#pragma unroll
                            for (int i2 = 0; i2 < 4; ++i2) {
                                const f32x4 c2 = cp[i2];
                                const float x1a = v[2 * i2], x2a = v[8 + 2 * i2], x1b = v[2 * i2 + 1], x2b = v[8 + 2 * i2 + 1];
                                v[2 * i2] = x1a * c2[0] - x2a * c2[1]; v[8 + 2 * i2] = x2a * c2[0] + x1a * c2[1];
                                v[2 * i2 + 1] = x1b * c2[2] - x2b * c2[3]; v[8 + 2 * i2 + 1] = x2b * c2[2] + x1b * c2[3];
                            }
                        }
                        u32x4 w0, w1;
#pragma unroll
                        for (int i = 0; i < 4; ++i) { w0[i] = cvt_pk_bf16(v[2 * i], v[2 * i + 1]); w1[i] = cvt_pk_bf16(v[8 + 2 * i], v[8 + 2 * i + 1]); }
                        if (kind == 0 && isk) {
                            bf16_t* dst = (bf16_t*)(ws + koff) + ((size_t)(bl * H + hh) * 128 + (rb >> 5)) * 2048 + (size_t)(fq * 64 + (rb & 31)) * 8;
                            *(u32x4*)dst = w0; *(u32x4*)(dst + 32 * 8) = w1;
                        } else {
                            bf16_t* dst;
                            if (kind == 0) dst = (bf16_t*)(ws + qoff) + ((size_t)(bl * H + hh) * S + rb) * 64;
                            else dst = isk ? (bf16_t*)(ws + OFF_IK) + (size_t)tl * 64 : (bf16_t*)(ws + OFF_IQ) + ((size_t)(bl * 8 + hh) * S + s) * 64;
                            *(u32x4*)(dst + fq * 16) = w0; *(u32x4*)(dst + fq * 16 + 8) = w1;
                        }
                    } else if (kind == 1) {
                        const int k5 = rb & 31;
                        bf16_t* dst = (bf16_t*)(ws + voff) + ((size_t)(bl * H + hh) * 128 + (rb >> 5)) * 2048 + ((k5 >> 4) * 64 + ((k5 >> 2) & 1) * 32) * 8 + ((k5 >> 3) & 1) * 4 + (k5 & 3)
                                      + ((fq >> 1) * 128 + (fq & 1) * 16) * 8;
#pragma unroll
                        for (int i = 0; i < 16; ++i) dst[i * 8] = f2bf(v[i]);
                    } else if (kind == 3 || kind == 4) {
                        bf16_t* dst = (kind == 3 ? (bf16_t*)(ws + OFF_SZ) + (size_t)tl * 1536 + (hg - 129) * 64 : (bf16_t*)(ws + OFF_SG) + (size_t)tl * 3072 + (hg - 153) * 64) + fq * 16;
#pragma unroll
                        for (int i = 0; i < 16; ++i) { const float sg = __builtin_amdgcn_rcpf(1.0f + __expf(-v[i])); v[i] = kind == 3 ? v[i] * sg : sg; }
                        u32x4 w0, w1;
#pragma unroll
                        for (int i = 0; i < 4; ++i) { w0[i] = cvt_pk_bf16(v[2 * i], v[2 * i + 1]); w1[i] = cvt_pk_bf16(v[8 + 2 * i], v[8 + 2 * i + 1]); }
                        *(u32x4*)dst = w0; *(u32x4*)(dst + 8) = w1;
                    } else if (kind == 5) {
                        if (fq == 0) { f32x4 o0 = {v[0], v[1], v[2], v[3]}, o1 = {v[4], v[5], v[6], v[7]}; float* d = (float*)(ws + OFF_IW) + (size_t)tl * 8; *(f32x4*)d = o0; *(f32x4*)(d + 4) = o1; }
                    }
                }
            }
        (void)lane; (void)sub;
    }
};

struct EpiBr {
    const Params* p;
    DI void operator()(const f32x4 (&acc)[2][2][4][2], int brow, int bcol, int sub, int wr, int wc, int fr, int fq) const {
        char* ws = p->ws;
        const bf16_t* sg = (const bf16_t*)(ws + OFF_SG);
        float* mf = (float*)(ws + OFF_MF);
        bf16_t* mb = (bf16_t*)(ws + OFF_MB);
#pragma unroll
        for (int bj = 0; bj < 2; ++bj)
#pragma unroll
            for (int n = 0; n < 2; ++n) {
                const int tl = bcol + bj * 128 + wc * 32 + n * 16 + fr;
#pragma unroll
                for (int ai = 0; ai < 2; ++ai)
#pragma unroll
                    for (int m2 = 0; m2 < 2; ++m2) {
                        const int e = brow + ai * 128 + wr * 64 + fq * 16 + m2 * 8;
                        const u32x4 gw = *(const u32x4*)(sg + (size_t)tl * 3072 + sub * 1024 + e);
                        bf16_t* mp = mb + (size_t)tl * DM + e;
                        u32x4 pw = {0u, 0u, 0u, 0u};
                        if (sub > 0) pw = *(const u32x4*)mp;
                        u32x4 ow;
#pragma unroll
                        for (int hh2 = 0; hh2 < 2; ++hh2) {
                            const f32x4 g4 = {__uint_as_float(gw[2 * hh2] << 16), __uint_as_float(gw[2 * hh2] & 0xffff0000u), __uint_as_float(gw[2 * hh2 + 1] << 16), __uint_as_float(gw[2 * hh2 + 1] & 0xffff0000u)};
                            f32x4 r = acc[ai][bj][m2 * 2 + hh2][n] * g4;
                            if (sub > 0) r += (f32x4){__uint_as_float(pw[2 * hh2] << 16), __uint_as_float(pw[2 * hh2] & 0xffff0000u), __uint_as_float(pw[2 * hh2 + 1] << 16), __uint_as_float(pw[2 * hh2 + 1] & 0xffff0000u)};
                            ow[2 * hh2] = cvt_pk_bf16(r[0], r[1]); ow[2 * hh2 + 1] = cvt_pk_bf16(r[2], r[3]);
                        }
                        *(u32x4*)mp = ow;
                    }
                asm volatile("" ::: "memory");
            }
    }
};

struct EpiOut {
    const Params* p; int layer; int gtok0; bool st;
    DI void operator()(const f32x4 (&acc)[2][2][4][2], int brow, int bcol, int sub, int wr, int wc, int fr, int fq) const {
        char* ws = p->ws;
        const float* xin = layer == 0 ? p->x : p->out;
        bf16_t* xb = (bf16_t*)(ws + OFF_XB);
        float* ss = (float*)(ws + OFF_SS);
#pragma unroll
        for (int bj = 0; bj < 2; ++bj)
#pragma unroll
            for (int n = 0; n < 2; ++n) {
                const int tl = bcol + bj * 128 + wc * 32 + n * 16 + fr;
                const size_t tg = (size_t)gtok0 + tl;
                float sq = 0.f;
#pragma unroll
                for (int ai = 0; ai < 2; ++ai)
#pragma unroll
                    for (int m = 0; m < 4; ++m) {
                        const int e = brow + ai * 128 + wr * 64 + fq * 16 + m * 4;
                        f32x4 r = *(const f32x4*)(xin + tg * DM + e) + acc[ai][bj][m][n];
                        if (st) *(f32x4*)(p->out + tg * DM + e) = r;
                    }
            }
        (void)sub;
    }
};

DI void select_chunk(const Params& p, int bl, int c, char* shm) {
    char* ws = p.ws;
    const bf16_t* IQ = (const bf16_t*)(ws + OFF_IQ);
    const bf16_t* IK = (const bf16_t*)(ws + OFF_IK);
    const float* IW = (const float*)(ws + OFF_IW);
    unsigned* hist = (unsigned*)shm; unsigned* bits = (unsigned*)(shm + 16384);
    int* ctl = (int*)(shm + 24576); int* cnt = ctl, *mn = ctl + 16, *mx = ctl + 32, *bsel = ctl + 48, *needp = ctl + 64;
    u32x2* list = (u32x2*)(shm + 32768);
    const int tid = ltid(), lane = tid & 63, w = __builtin_amdgcn_readfirstlane(tid >> 6), q = lane & 15, g = lane >> 4;
    const int t0 = c * 16, tq = t0 + q;
    __syncthreads();
    for (int i = tid; i < 16 * 256 + 16 * 128; i += NTHREADS) hist[i] = 0;
    if (tid < 16) { cnt[tid] = 0; mn[tid] = 0x7fffffff; mx[tid] = (int)0x80000000; }
    bf16x8 qf[8][2]; float wq[8];
#pragma unroll
    for (int hd = 0; hd < 8; ++hd) {
        const bf16_t* qp = IQ + ((size_t)(bl * 8 + hd) * S + tq) * 64 + g * 8;
        qf[hd][0] = *(const bf16x8*)qp; qf[hd][1] = *(const bf16x8*)(qp + 32);
        wq[hd] = IW[(size_t)(bl * S + tq) * 8 + hd];
    }
    auto loadk = [&](int kt, bf16x8& k0, bf16x8& k1) {
        const bf16_t* kp = IK + ((size_t)bl * S + kt * 16 + q) * 64 + g * 8;
        k0 = *(const bf16x8*)kp; k1 = *(const bf16x8*)(kp + 32);
    };
    auto compute = [&](const bf16x8& k0, const bf16x8& k1) -> f32x4 {
        f32x4 sc = {0.f, 0.f, 0.f, 0.f};
#pragma unroll
        for (int hd = 0; hd < 8; ++hd) {
            f32x4 a = {0.f, 0.f, 0.f, 0.f};
            a = MFMA16(k0, qf[hd][0], a); a = MFMA16(k1, qf[hd][1], a);
#pragma unroll
            for (int j = 0; j < 4; ++j) sc[j] += wq[hd] * fmaxf(a[j], 0.f);
        }
        return sc;
    };
#define SEL_PASS(BODY) do { \
        const int cl = c - 1;     \
        bf16x8 ka0, ka1, kb0, kb1; int kt = w; \
        if (kt <= cl) loadk(kt, ka0, ka1); \
        if (kt + 8 <= cl) loadk(kt + 8, kb0, kb1); \
        for (; kt <= cl; kt += 16) { \
            { const f32x4 sc = compute(ka0, ka1); if (kt + 16 <= cl) loadk(kt + 16, ka0, ka1); const int ktc = kt; const bool diag = false; BODY } \
            if (kt + 8 <= cl) { const f32x4 sc = compute(kb0, kb1); if (kt + 24 <= cl) loadk(kt + 24, kb0, kb1); const int ktc = kt + 8; const bool diag = false; BODY } \
        } \
        if (w == (c & 7)) { loadk(c, ka0, ka1); const f32x4 sc = compute(ka0, ka1); const int ktc = c; const bool diag = true; BODY } \
    } while (0)
#define SEL_OK(j) (!diag || 4 * g + (j) <= q)
    __syncthreads();
    {
        float lo = 3.0e38f, hi = -3.0e38f;
        SEL_PASS({
            _Pragma("unroll") for (int j = 0; j < 4; ++j) if (SEL_OK(j)) { lo = fminf(lo, sc[j]); hi = fmaxf(hi, sc[j]); }
        });
        lo = fminf(lo, shx(lo, 16)); lo = fminf(lo, shx(lo, 32));
        hi = fmaxf(hi, shx(hi, 16)); hi = fmaxf(hi, shx(hi, 32));
        if (g == 0) { atomicMin(&mn[q], f2sort(lo)); atomicMax(&mx[q], f2sort(hi)); }
    }
    __syncthreads();
    const float rlo = sort2f(mn[q]), rhi = sort2f(mx[q]);
    const float rscale = rhi > rlo ? 256.0f / (rhi - rlo) : 0.f;
    SEL_PASS({
        _Pragma("unroll") for (int j = 0; j < 4; ++j) if (SEL_OK(j)) {
            int b = (int)((sc[j] - rlo) * rscale); b = b > 255 ? 255 : (b < 0 ? 0 : b);
            atomicAdd(&hist[q * 256 + b], 1u);
        }
    });
    __syncthreads();
    {
        const int row = tid >> 5, i = tid & 31;
        unsigned c8[8]; unsigned tot = 0;
#pragma unroll
        for (int k = 0; k < 8; ++k) { c8[k] = hist[row * 256 + i * 8 + k]; tot += c8[k]; }
        unsigned above = 0;
        {
            unsigned run = tot;
#pragma unroll
            for (int o = 1; o < 32; o <<= 1) { const int l_ = tid & 63; unsigned v = (unsigned)__builtin_amdgcn_ds_bpermute(((l_ + o) & 63) << 2, (int)run); if (i + o < 32) run += v; }
            above = run - tot;
        }
        const int trow = t0 + row; const unsigned need = trow + 1 < 256 ? trow + 1 : 256;
        if (above < need && above + tot >= need) {
            unsigned a = above;
#pragma unroll
            for (int k = 7; k >= 0; --k) { if (a < need && a + c8[k] >= need) { bsel[row] = i * 8 + k; needp[row] = (int)(need - a); } a += c8[k]; }
        }
    }
    __syncthreads();
    const int bstar = bsel[q];
    SEL_PASS({
        unsigned nib = 0;
        _Pragma("unroll") for (int j = 0; j < 4; ++j) if (SEL_OK(j)) {
            int b = (int)((sc[j] - rlo) * rscale); b = b > 255 ? 255 : (b < 0 ? 0 : b);
            if (b > bstar) nib |= 1u << j;
            else if (b == bstar) { int pos = atomicAdd(&cnt[q], 1); if (pos < SEL_CAP) { u32x2 e; e[0] = (unsigned)f2sort(sc[j]) ^ 0x80000000u; e[1] = ktc * 16 + 4 * g + j; list[q * SEL_CAP + pos] = e; } }
        }
        if (nib) atomicOr(&bits[q * 128 + (ktc >> 1)], nib << ((ktc & 1) * 16 + 4 * g));
    });
    __syncthreads();
    {
        const int row = tid >> 5, i = tid & 31;
        int n = cnt[row]; n = n < SEL_CAP ? n : SEL_CAP;
        const int need = needp[row];
        for (int a = i; a < n; a += 32) {
            const u32x2 ea = list[row * SEL_CAP + a];
            int rank = 0;
            for (int b = 0; b < n; ++b) { const u32x2 eb = list[row * SEL_CAP + b]; rank += (eb[0] > ea[0]) || (eb[0] == ea[0] && eb[1] < ea[1]); }
            if (rank < need) atomicOr(&bits[row * 128 + (ea[1] >> 5)], 1u << (ea[1] & 31));
        }
    }
    __syncthreads();
    unsigned* mask = (unsigned*)(ws + OFF_MASK) + ((size_t)bl * S + t0) * 128;
    for (int i = tid; i < 16 * 128; i += NTHREADS) mask[i] = bits[i];
}

DI void kmean_item(const Params& p, int bl, int h, int n, char* shm) {
    char* ws = p.ws;
    const bf16_t* K = (const bf16_t*)(ws + OFF_KC) + ((size_t)(bl * 8 + h) * 128 + n * 8) * 2048;
    float* red = (float*)shm;
    const int tid = ltid(), c = tid & 255, par = tid >> 8;
    float acc[8] = {0.f, 0.f, 0.f, 0.f, 0.f, 0.f, 0.f, 0.f};
#pragma unroll
    for (int it = 0; it < 4; ++it) {
        const u32x4 v = *(const u32x4*)(K + (size_t)(it * 2 + par) * 2048 + c * 8);
#pragma unroll
        for (int e = 0; e < 4; ++e) { acc[2 * e] += __uint_as_float(v[e] << 16); acc[2 * e + 1] += __uint_as_float(v[e] & 0xffff0000u); }
    }
    __syncthreads();
#pragma unroll
    for (int e = 0; e < 8; ++e) red[(par * 256 + c) * 8 + e] = acc[e];
    __syncthreads();
    if (tid < 64) {
        const int grp = tid >> 3, e = tid & 7;
        float t = 0.f;
        for (int pr = 0; pr < 2; ++pr) for (int r = 0; r < 32; ++r) t += red[(pr * 256 + grp * 32 + r) * 8 + e];
        t *= (1.0f / 256);
        bf16_t hi = f2bf(t); bf16_t lo = f2bf(t - bf2f(hi));
        bf16_t* km = (bf16_t*)(ws + OFF_KM) + (((size_t)(bl * 8 + h) * 16 + n) * 2) * 64;
        km[tid] = hi; km[64 + tid] = lo;
    }
}

struct AttnAcc { f32x16 o0, o1; float nb, l; bool shifted; };
DI void attn_init(AttnAcc& a, float nb) {
    float z = 0.f; asm volatile("" : "+v"(z));
#pragma unroll
    for (int i = 0; i < 16; ++i) { a.o0[i] = z; a.o1[i] = z; }
    a.shifted = __ballot(nb > 90.f) != 0ull;
    a.nb = a.shifted ? nb + z : z; a.l = z;
}
DI float attn_bound(const bf16x8 (&qf)[4], const float* gk) {
    float qs = 0.f;
#pragma unroll
    for (int kk = 0; kk < 4; ++kk)
#pragma unroll
        for (int e = 0; e < 8; ++e) { const float v = bf2f((bf16_t)qf[kk][e]); qs += v * v; }
    qs += shx(qs, 32);
    float gm = fabsf(gk[ltid() & 63]);
    for (int o = 32; o > 0; o >>= 1) gm = fmaxf(gm, shx(gm, o));
    return sqrtf(qs) * gm * 8.1f;
}
struct KVFrag { bf16x8 k[4]; bf16x8 v[2][2]; };
DI void kv_load(KVFrag& f, const bf16_t* Kt, const bf16_t* Vt, int lane) {
#pragma unroll
    for (int kk = 0; kk < 4; ++kk) f.k[kk] = *(const bf16x8*)(Kt + (kk * 64 + lane) * 8);
#pragma unroll
    for (int db = 0; db < 2; ++db)
#pragma unroll
        for (int u = 0; u < 2; ++u) f.v[db][u] = *(const bf16x8*)(Vt + ((db * 2 + u) * 64 + lane) * 8);
}
DI void attn_step(AttnAcc& a, const KVFrag& f, const bf16x8 (&qf)[4], unsigned vm) {
    f32x16 st;
    if (a.shifted) {
#pragma unroll
        for (int i = 0; i < 16; ++i) st[i] = -a.nb;
        st = MFMA32(f.k[0], qf[0], st);
    } else {
        st = MFMA32(f.k[0], qf[0], ((f32x16){0.f, 0.f, 0.f, 0.f, 0.f, 0.f, 0.f, 0.f, 0.f, 0.f, 0.f, 0.f, 0.f, 0.f, 0.f, 0.f}));
    }
#pragma unroll
    for (int kk = 1; kk < 4; ++kk) st = MFMA32(f.k[kk], qf[kk], st);
    float pv[16];
#pragma unroll
    for (int i = 0; i < 16; ++i) pv[i] = fexp2(st[i]);
    if (__ballot(vm != 0xffffu) != 0ull) {
#pragma unroll
        for (int i = 0; i < 16; ++i) pv[i] = __int_as_float(__float_as_int(pv[i]) & __builtin_amdgcn_sbfe((int)vm, i, 1));
    }
    a.l += ((pv[0] + pv[1]) + (pv[2] + pv[3])) + ((pv[4] + pv[5]) + (pv[6] + pv[7])) + (((pv[8] + pv[9]) + (pv[10] + pv[11])) + ((pv[12] + pv[13]) + (pv[14] + pv[15])));
    u32x4 p0, p1;
#pragma unroll
    for (int i = 0; i < 4; ++i) { p0[i] = cvt_pk_bf16(pv[2 * i], pv[2 * i + 1]); p1[i] = cvt_pk_bf16(pv[8 + 2 * i], pv[8 + 2 * i + 1]); }
    const bf16x8 pf0 = __builtin_bit_cast(bf16x8, p0), pf1 = __builtin_bit_cast(bf16x8, p1);
    a.o0 = MFMA32(f.v[0][0], pf0, a.o0); a.o0 = MFMA32(f.v[0][1], pf1, a.o0);
    a.o1 = MFMA32(f.v[1][0], pf0, a.o1); a.o1 = MFMA32(f.v[1][1], pf1, a.o1);
}
DI void load_q(bf16x8 (&qf)[4], const bf16_t* Qrow, int h) {
#pragma unroll
    for (int kk = 0; kk < 4; ++kk) qf[kk] = *(const bf16x8*)(Qrow + kk * 16 + h * 8);
}
DI int koff(int i, int h) { return 8 * (i >> 2) + 4 * h + (i & 3); }

DI void attn_a_item(const Params& p, int layer, int bl, int hh, int rb) {
    char* ws = p.ws;
    const int lane = ltid() & 63, w = __builtin_amdgcn_readfirstlane(ltid() >> 6), r = lane & 31, h = lane >> 5;
    const int g = hh >> 3, sh = 2 * g, n = S >> sh;
    const int row0 = rb * 256 + w * 32;
    const int rr = row0 / n, m0 = row0 % n;
    const bf16_t* Q = (const bf16_t*)(ws + OFF_QA) + (size_t)(bl * 24 + hh) * S * 64;
    const bf16_t* K = (const bf16_t*)(ws + OFF_KA) + (size_t)(bl * 24 + hh) * S * 64;
    const bf16_t* Vt = (const bf16_t*)(ws + OFF_VA) + (size_t)(bl * 24 + hh) * 64 * S;
    bf16x8 qf[4]; load_q(qf, Q + (size_t)(row0 + r) * 64, h);
    AttnAcc a; attn_init(a, attn_bound(qf, p.qk_g + ((size_t)(layer * 3 + 0) * 2 + 1) * 64));
    const int kfirst = m0 >= 128 ? 0 : (128 - m0) / 32;
    const int tile0 = (rr * n + m0 - 128) / 32 + 0;
    auto amask = [&](int k) -> unsigned {
        if (k != 0 && k != 4) return 0xffffu;
        const int mk0 = m0 - 128 + 32 * k; unsigned vm = 0;
#pragma unroll
        for (int i = 0; i < 16; ++i) { const int d = (m0 + r) - (mk0 + koff(i, h)); if (d >= 0 && d <= 128) vm |= 1u << i; }
        return vm;
    };
    KVFrag f0, f1; kv_load(f0, K + (size_t)(tile0 + kfirst) * 2048, Vt + (size_t)(tile0 + kfirst) * 2048, lane);
    for (int k = kfirst; k < 5; k += 2) {
        { const int kn = k + 1 < 5 ? k + 1 : k; kv_load(f1, K + (size_t)(tile0 + kn) * 2048, Vt + (size_t)(tile0 + kn) * 2048, lane); }
        attn_step(a, f0, qf, amask(k));
        if (k + 1 < 5) {
            { const int kn = k + 2 < 5 ? k + 2 : k + 1; kv_load(f0, K + (size_t)(tile0 + kn) * 2048, Vt + (size_t)(tile0 + kn) * 2048, lane); }
            attn_step(a, f1, qf, amask(k + 1));
        }
    }
    const float l = a.l + shx(a.l, 32);
    const float inv = 1.0f / l;
    const int s = ((m0 + r) << sh) + rr;
    const size_t tl = (size_t)bl * S + s;
    bf16_t* o = (bf16_t*)(ws + OFF_OA) + ((size_t)g * TG + tl) * 512 + (hh & 7) * 64;
#pragma unroll
    for (int q4 = 0; q4 < 4; ++q4) {
        u32x2 w0, w1;
        w0[0] = cvt_pk_bf16(a.o0[q4 * 4] * inv, a.o0[q4 * 4 + 1] * inv); w0[1] = cvt_pk_bf16(a.o0[q4 * 4 + 2] * inv, a.o0[q4 * 4 + 3] * inv);
        w1[0] = cvt_pk_bf16(a.o1[q4 * 4] * inv, a.o1[q4 * 4 + 1] * inv); w1[1] = cvt_pk_bf16(a.o1[q4 * 4 + 2] * inv, a.o1[q4 * 4 + 3] * inv);
        *(u32x2*)(o + 8 * q4 + 4 * h) = w0; *(u32x2*)(o + 32 + 8 * q4 + 4 * h) = w1;
    }
    if (h == 0) ((float*)(ws + OFF_LSE))[((size_t)g * TG + tl) * 8 + (hh & 7)] = (a.nb + __log2f(l)) * LN2F;
}

DI void attn_store_gated(const Params& p, const AttnAcc& a, size_t tl, int col0, int h, bool st) {
    const float l = a.l + shx(a.l, 32);
    const float inv = 1.0f / l;
    bf16_t* z = (bf16_t*)(p.ws + OFF_SZ) + tl * 1536 + col0;
#pragma unroll
    for (int q4 = 0; q4 < 4; ++q4) {
#pragma unroll
        for (int db = 0; db < 2; ++db) {
            bf16_t* zp = z + db * 32 + 8 * q4 + 4 * h;
            const u32x2 zw = *(const u32x2*)zp;
            const float z0 = __uint_as_float(zw[0] << 16), z1 = __uint_as_float(zw[0] & 0xffff0000u), z2 = __uint_as_float(zw[1] << 16), z3 = __uint_as_float(zw[1] & 0xffff0000u);
            const f32x16& o = db ? a.o1 : a.o0;
            u32x2 wv; wv[0] = cvt_pk_bf16(o[q4 * 4] * inv * z0, o[q4 * 4 + 1] * inv * z1); wv[1] = cvt_pk_bf16(o[q4 * 4 + 2] * inv * z2, o[q4 * 4 + 3] * inv * z3);
            if (st) *(u32x2*)zp = wv;
        }
    }
}

DI void attn_b_item(const Params& p, int layer, int bl, int hd, int qb, bool st, int var) {
    char* ws = p.ws;
    const int lane = ltid() & 63, w = __builtin_amdgcn_readfirstlane(ltid() >> 6), r = lane & 31, h = lane >> 5;
    const int q0 = qb * 256 + w * 32;
    const bf16_t* Q = (const bf16_t*)(ws + OFF_QB) + (size_t)(bl * 8 + hd) * S * 64;
    const bf16_t* K = (const bf16_t*)(ws + OFF_KB) + (size_t)(bl * 8 + hd) * S * 64;
    const bf16_t* Vt = (const bf16_t*)(ws + OFF_VB) + (size_t)(bl * 8 + hd) * 64 * S;
    const unsigned* mrow = (const unsigned*)(ws + OFF_MASK) + ((size_t)bl * S + q0 + r) * 128;
    bf16x8 qf[4]; load_q(qf, Q + (size_t)(q0 + r) * 64, h);
    AttnAcc a; attn_init(a, attn_bound(qf, p.qk_g + ((size_t)(layer * 3 + 1) * 2 + 1) * 64));
    const int nkt = q0 / 32 + 1;
    auto bmask = [&](unsigned mw) -> unsigned {
        const unsigned ws4 = mw >> (4 * h);
        return (ws4 & 0xfu) | ((ws4 >> 4) & 0xf0u) | ((ws4 >> 8) & 0xf00u) | ((ws4 >> 12) & 0xf000u);
    };
    KVFrag f0, f1; kv_load(f0, K, Vt, lane);
    unsigned mw0 = mrow[0], mw1 = 0;
    const int tmul = var == 1 ? 0 : 1;
    for (int kt = 0; kt < nkt; kt += 2) {
        { const int kn = (kt + 1 < nkt ? kt + 1 : kt) * tmul; kv_load(f1, K + (size_t)kn * 2048, Vt + (size_t)kn * 2048, lane); mw1 = mrow[kn]; }
        if (var == 2) a.l += __int_as_float((int)f0.k[0][0] + (int)f0.k[3][7] + (int)f0.v[0][0][0] + (int)f0.v[1][1][7] + (int)mw0); else
        attn_step(a, f0, qf, bmask(mw0));
        if (kt + 1 < nkt) {
            { const int kn = (kt + 2 < nkt ? kt + 2 : kt + 1) * tmul; kv_load(f0, K + (size_t)kn * 2048, Vt + (size_t)kn * 2048, lane); mw0 = mrow[kn]; }
            if (var == 2) a.l += __int_as_float((int)f1.k[0][0] + (int)f1.k[3][7] + (int)f1.v[0][0][0] + (int)f1.v[1][1][7] + (int)mw1); else
            attn_step(a, f1, qf, bmask(mw1));
        }
    }
    attn_store_gated(p, a, (size_t)bl * S + q0 + r, 512 + hd * 64, h, st);
}

DI void attn_c_item(const Params& p, int layer, int bl, int hd, int qb, bool st) {
    char* ws = p.ws;
    const int lane = ltid() & 63, w = __builtin_amdgcn_readfirstlane(ltid() >> 6), r = lane & 31, h = lane >> 5;
    const int q0 = qb * 256 + w * 32, own = qb;
    const bf16_t* Q = (const bf16_t*)(ws + OFF_QC) + (size_t)(bl * 8 + hd) * S * 64;
    const bf16_t* K = (const bf16_t*)(ws + OFF_KC) + (size_t)(bl * 8 + hd) * S * 64;
    const bf16_t* Vt = (const bf16_t*)(ws + OFF_VC) + (size_t)(bl * 8 + hd) * 64 * S;
    bf16x8 qf[4]; load_q(qf, Q + (size_t)(q0 + r) * 64, h);
    unsigned sel = 0;
    if (own > 0) {
        const bf16_t* km = (const bf16_t*)(ws + OFF_KM) + (((size_t)(bl * 8 + hd) * 16 + (r & 15)) * 2) * 64;
        f32x16 gt;
#pragma unroll
        for (int i = 0; i < 16; ++i) gt[i] = 0.f;
#pragma unroll
        for (int kk = 0; kk < 4; ++kk) {
            bf16x8 ahi = *(const bf16x8*)(km + kk * 16 + h * 8), alo = *(const bf16x8*)(km + 64 + kk * 16 + h * 8);
            if (r >= 16) { ahi = (bf16x8){0, 0, 0, 0, 0, 0, 0, 0}; alo = ahi; }
            gt = MFMA32(ahi, qf[kk], gt); gt = MFMA32(alo, qf[kk], gt);
        }
        float gl[16];
#pragma unroll
        for (int i = 0; i < 8; ++i) {
            const float mine = gt[i], oth = shx(mine, 32);
            const int blk_mine = 8 * (i >> 2) + 4 * h + (i & 3), blk_oth = 8 * (i >> 2) + 4 * (1 - h) + (i & 3);
            (void)blk_mine; (void)blk_oth;
            gl[8 * (i >> 2) + (i & 3)] = h == 0 ? mine : oth;
            gl[8 * (i >> 2) + 4 + (i & 3)] = h == 0 ? oth : mine;
        }
#pragma unroll
        for (int pick = 0; pick < 3; ++pick) {
            float best = -3.0e38f; int bi = -1;
#pragma unroll
            for (int nb = 0; nb < 16; ++nb) { const bool ok = nb < own && !((sel >> nb) & 1u); if (ok && gl[nb] > best) { best = gl[nb]; bi = nb; } }
            if (bi >= 0) sel |= 1u << bi;
        }
    }
    AttnAcc a; attn_init(a, attn_bound(qf, p.qk_g + ((size_t)(layer * 3 + 2) * 2 + 1) * 64));
    unsigned vis = 0;
    for (int nb = 0; nb < own; ++nb) if (__ballot((sel >> nb) & 1u) != 0ull) vis |= 1u << nb;
    const int ndiag = q0 / 32;
    unsigned long long tm0 = 0ull, tm1 = 0ull;
    for (int nb = 0; nb < own; ++nb) if ((vis >> nb) & 1u) { if (nb < 8) tm0 |= 0xffull << (8 * nb); else tm1 |= 0xffull << (8 * (nb - 8)); }
    for (int t = own * 8; t <= ndiag; ++t) { if (t < 64) tm0 |= 1ull << t; else tm1 |= 1ull << (t - 64); }
    int ntl = __builtin_popcountll(tm0) + __builtin_popcountll(tm1);
    auto pop = [&]() -> int { int t; if (tm0) { t = __builtin_ctzll(tm0); tm0 &= tm0 - 1; } else if (tm1) { t = 64 + __builtin_ctzll(tm1); tm1 &= tm1 - 1; } else t = ndiag; return t; };
    auto cmask = [&](int t) -> unsigned {
        const int cb = t >> 3;
        if (cb < own) return ((sel >> cb) & 1u) ? 0xffffu : 0u;
        if (t != ndiag) return 0xffffu;
        unsigned vm = 0;
#pragma unroll
        for (int i = 0; i < 16; ++i) if (koff(i, h) <= r) vm |= 1u << i;
        return vm;
    };
    KVFrag f0, f1; int t0 = pop(), t1 = 0;
    kv_load(f0, K + (size_t)t0 * 2048, Vt + (size_t)t0 * 2048, lane);
    for (int it = 0; it < ntl; it += 2) {
        t1 = pop(); kv_load(f1, K + (size_t)t1 * 2048, Vt + (size_t)t1 * 2048, lane);
        attn_step(a, f0, qf, cmask(t0));
        if (it + 1 < ntl) {
            t0 = pop(); kv_load(f0, K + (size_t)t0 * 2048, Vt + (size_t)t0 * 2048, lane);
            attn_step(a, f1, qf, cmask(t1));
        }
    }
    attn_store_gated(p, a, (size_t)bl * S + q0 + r, 1024 + hd * 64, h, st);
}

DI void attn_bc_item(const Params& p, int layer, int typ, int bl, int hd, int qb, bool st, char* shm) {
    char* ws = p.ws;
    const int tid = ltid(), lane = tid & 63, w = tid >> 6, r = lane & 31, h = lane >> 5;
    const int q0 = qb * 256 + w * 32, own = qb, ndiag = q0 / 32;
    const bf16_t* Q = (const bf16_t*)(ws + (typ ? OFF_QC : OFF_QB)) + (size_t)(bl * 8 + hd) * S * 64;
    const bf16_t* K = (const bf16_t*)(ws + (typ ? OFF_KC : OFF_KB)) + (size_t)(bl * 8 + hd) * S * 64;
    const bf16_t* Vt = (const bf16_t*)(ws + (typ ? OFF_VC : OFF_VB)) + (size_t)(bl * 8 + hd) * 64 * S;
    const unsigned* mrow = (const unsigned*)(ws + OFF_MASK) + ((size_t)bl * S + q0 + r) * 128;
    unsigned short* seq = (unsigned short*)(shm + 16384);
    unsigned* wvis = (unsigned*)(shm + 16896);
    bf16x8 qf[4]; load_q(qf, Q + (size_t)(q0 + r) * 64, h);
    unsigned sel = 0, vis = 0;
    if (typ == 1 && own > 0) {
        const bf16_t* km = (const bf16_t*)(ws + OFF_KM) + (((size_t)(bl * 8 + hd) * 16 + (r & 15)) * 2) * 64;
        f32x16 gt;
#pragma unroll
        for (int i = 0; i < 16; ++i) gt[i] = 0.f;
#pragma unroll
        for (int kk = 0; kk < 4; ++kk) {
            bf16x8 ahi = *(const bf16x8*)(km + kk * 16 + h * 8), alo = *(const bf16x8*)(km + 64 + kk * 16 + h * 8);
            if (r >= 16) { ahi = (bf16x8){0, 0, 0, 0, 0, 0, 0, 0}; alo = ahi; }
            gt = MFMA32(ahi, qf[kk], gt); gt = MFMA32(alo, qf[kk], gt);
        }
        float gl[16];
#pragma unroll
        for (int i = 0; i < 8; ++i) {
            const float mine = gt[i], oth = shx(mine, 32);
            gl[8 * (i >> 2) + (i & 3)] = h == 0 ? mine : oth;
            gl[8 * (i >> 2) + 4 + (i & 3)] = h == 0 ? oth : mine;
        }
#pragma unroll
        for (int pick = 0; pick < 3; ++pick) {
            float best = -3.0e38f; int bi = -1;
#pragma unroll
            for (int nb = 0; nb < 16; ++nb) { const bool ok = nb < own && !((sel >> nb) & 1u); if (ok && gl[nb] > best) { best = gl[nb]; bi = nb; } }
            if (bi >= 0) sel |= 1u << bi;
        }
        for (int nb = 0; nb < own; ++nb) if (__ballot((sel >> nb) & 1u) != 0ull) vis |= 1u << nb;
    }
    if (typ == 0) vis = (1u << own) - 1u;
    __syncthreads();
    if (lane == 0) wvis[w] = vis;
    __syncthreads();
    if (tid == 0) {
        unsigned bv = 0;
        for (int i = 0; i < 8; ++i) bv |= wvis[i];
        int n = 0;
        for (int nb = 0; nb < own; ++nb) if ((bv >> nb) & 1u) for (int k = 0; k < 8; ++k) seq[n++] = (unsigned short)(nb * 8 + k);
        for (int k = 0; k < 8; ++k) seq[n++] = (unsigned short)(own * 8 + k);
        seq[255] = (unsigned short)n;
    }
    __syncthreads();
    const int ntl = seq[255];
    const bf16_t* gsrc = (tid < 256 ? K : Vt) + (size_t)(tid & 255) * 8;
    char* lds_dst = shm + tid * 16;
    u32x4 R = *(const u32x4*)(gsrc + (size_t)seq[0] * 2048);
    *(u32x4*)lds_dst = R;
    if (ntl > 1) R = *(const u32x4*)(gsrc + (size_t)seq[1] * 2048);
    AttnAcc a; attn_init(a, attn_bound(qf, p.qk_g + ((size_t)(layer * 3 + 1 + typ) * 2 + 1) * 64));
    unsigned mw = typ == 0 ? mrow[seq[0]] : 0u;
    __syncthreads();
    for (int t = 0; t < ntl; ++t) {
        const int ct = seq[t], cb = ct >> 3;
        unsigned mwn = 0;
        if (typ == 0 && t + 1 < ntl) mwn = mrow[seq[t + 1]];
        const bool need = cb < own ? ((vis >> cb) & 1u) != 0u : ct <= ndiag;
        if (need) {
            const char* buf = shm + (t & 1) * 8192;
            KVFrag f;
#pragma unroll
            for (int kk = 0; kk < 4; ++kk) f.k[kk] = *(const bf16x8*)(buf + (kk * 64 + lane) * 16);
#pragma unroll
            for (int db = 0; db < 2; ++db)
#pragma unroll
                for (int u = 0; u < 2; ++u) f.v[db][u] = *(const bf16x8*)(buf + 4096 + ((db * 2 + u) * 64 + lane) * 16);
            unsigned vm;
            if (typ == 0) {
                const unsigned ws4 = mw >> (4 * h);
                vm = (ws4 & 0xfu) | ((ws4 >> 4) & 0xf0u) | ((ws4 >> 8) & 0xf00u) | ((ws4 >> 12) & 0xf000u);
            } else if (cb < own) vm = ((sel >> cb) & 1u) ? 0xffffu : 0u;
            else if (ct == ndiag) {
                vm = 0;
#pragma unroll
                for (int i = 0; i < 16; ++i) if (koff(i, h) <= r) vm |= 1u << i;
            } else vm = 0xffffu;
            attn_step(a, f, qf, vm);
        }
        if (t + 1 < ntl) {
            *(u32x4*)(lds_dst + ((t + 1) & 1) * 8192) = R;
            if (t + 2 < ntl) R = *(const u32x4*)(gsrc + (size_t)seq[t + 2] * 2048);
        }
        mw = mwn;
        __syncthreads();
    }
    attn_store_gated(p, a, (size_t)bl * S + q0 + r, (typ ? 1024 : 512) + hd * 64, h, st);
}

template <int TYP>
DI void attn_step2(AttnAcc& a0, AttnAcc& a1, KVFrag& f, const bf16x8 (&qa)[4], const bf16x8 (&qb)[4], unsigned vm0, unsigned vm1, bool shifted, const bf16_t* Kn, const bf16_t* Vn, int lane) {
    f32x16 s0, s1;
    __builtin_amdgcn_s_setprio(1);
    if (shifted) {
#pragma unroll
        for (int i = 0; i < 16; ++i) { s0[i] = -a0.nb; s1[i] = -a1.nb; }
        s0 = MFMA32(f.k[0], qa[0], s0); s1 = MFMA32(f.k[0], qb[0], s1);
    } else {
        const f32x16 z = {0.f, 0.f, 0.f, 0.f, 0.f, 0.f, 0.f, 0.f, 0.f, 0.f, 0.f, 0.f, 0.f, 0.f, 0.f, 0.f};
        s0 = MFMA32(f.k[0], qa[0], z); s1 = MFMA32(f.k[0], qb[0], z);
    }
#pragma unroll
    for (int kk = 1; kk < 4; ++kk) { s0 = MFMA32(f.k[kk], qa[kk], s0); s1 = MFMA32(f.k[kk], qb[kk], s1); }
    __builtin_amdgcn_s_setprio(0);
#pragma unroll
    for (int kk = 0; kk < 4; ++kk) f.k[kk] = *(const bf16x8*)(Kn + (kk * 64 + lane) * 8);
    float p0[16], p1[16];
#pragma unroll
    for (int i = 0; i < 16; ++i) { p0[i] = fexp2(s0[i]); p1[i] = fexp2(s1[i]); }
    if (TYP == 0 || __ballot((vm0 & vm1) != 0xffffu) != 0ull) {
#pragma unroll
        for (int i = 0; i < 16; ++i) {
            p0[i] = __int_as_float(__float_as_int(p0[i]) & __builtin_amdgcn_sbfe((int)vm0, i, 1));
            p1[i] = __int_as_float(__float_as_int(p1[i]) & __builtin_amdgcn_sbfe((int)vm1, i, 1));
        }
    }
    a0.l += ((p0[0] + p0[1]) + (p0[2] + p0[3])) + ((p0[4] + p0[5]) + (p0[6] + p0[7])) + (((p0[8] + p0[9]) + (p0[10] + p0[11])) + ((p0[12] + p0[13]) + (p0[14] + p0[15])));
    a1.l += ((p1[0] + p1[1]) + (p1[2] + p1[3])) + ((p1[4] + p1[5]) + (p1[6] + p1[7])) + (((p1[8] + p1[9]) + (p1[10] + p1[11])) + ((p1[12] + p1[13]) + (p1[14] + p1[15])));
    u32x4 w00, w01, w10, w11;
#pragma unroll
    for (int i = 0; i < 4; ++i) {
        w00[i] = cvt_pk_bf16(p0[2 * i], p0[2 * i + 1]); w01[i] = cvt_pk_bf16(p0[8 + 2 * i], p0[8 + 2 * i + 1]);
        w10[i] = cvt_pk_bf16(p1[2 * i], p1[2 * i + 1]); w11[i] = cvt_pk_bf16(p1[8 + 2 * i], p1[8 + 2 * i + 1]);
    }
    const bf16x8 f00 = __builtin_bit_cast(bf16x8, w00), f01 = __builtin_bit_cast(bf16x8, w01), f10 = __builtin_bit_cast(bf16x8, w10), f11 = __builtin_bit_cast(bf16x8, w11);
    __builtin_amdgcn_s_setprio(1);
    a0.o0 = MFMA32(f.v[0][0], f00, a0.o0); a1.o0 = MFMA32(f.v[0][0], f10, a1.o0);
    a0.o0 = MFMA32(f.v[0][1], f01, a0.o0); a1.o0 = MFMA32(f.v[0][1], f11, a1.o0);
    a0.o1 = MFMA32(f.v[1][0], f00, a0.o1); a1.o1 = MFMA32(f.v[1][0], f10, a1.o1);
    a0.o1 = MFMA32(f.v[1][1], f01, a0.o1); a1.o1 = MFMA32(f.v[1][1], f11, a1.o1);
    __builtin_amdgcn_s_setprio(0);
#pragma unroll
    for (int db = 0; db < 2; ++db)
#pragma unroll
        for (int u = 0; u < 2; ++u) f.v[db][u] = *(const bf16x8*)(Vn + ((db * 2 + u) * 64 + lane) * 8);
}
template <int TYP>
DI void attn_bc2_chunk(const Params& p, int layer, int bl, int hd, int cidx  , bool st) {
    char* ws = p.ws;
    const int lane = ltid() & 63, w = __builtin_amdgcn_readfirstlane(ltid() >> 6), r = lane & 31, h = lane >> 5;
    const int own = cidx >> 2, q0 = cidx * 64;
    const bf16_t* Q = (const bf16_t*)(ws + (TYP ? OFF_QC : OFF_QB)) + (size_t)(bl * 8 + hd) * S * 64;
    const bf16_t* K = (const bf16_t*)(ws + (TYP ? OFF_KC : OFF_KB)) + (size_t)(bl * 8 + hd) * S * 64;
    const bf16_t* Vt = (const bf16_t*)(ws + (TYP ? OFF_VC : OFF_VB)) + (size_t)(bl * 8 + hd) * 64 * S;
    const unsigned* mrow0 = (const unsigned*)(ws + OFF_MASK) + ((size_t)bl * S + q0 + r) * 128;
    const unsigned* mrow1 = mrow0 + 32 * 128;
    bf16x8 qa[4], qb[4];
    load_q(qa, Q + (size_t)(q0 + r) * 64, h); load_q(qb, Q + (size_t)(q0 + 32 + r) * 64, h);
    const float* gk = p.qk_g + ((size_t)(layer * 3 + 1 + TYP) * 2 + 1) * 64;
    AttnAcc a0, a1; attn_init(a0, attn_bound(qa, gk)); attn_init(a1, attn_bound(qb, gk));
    const bool shifted = a0.shifted || a1.shifted;
    if (shifted && !a0.shifted) a0.nb = 0.f;
    if (shifted && !a1.shifted) a1.nb = 0.f;
    const int d0 = q0 / 32, d1 = d0 + 1;
    unsigned sel0 = 0, sel1 = 0;
    unsigned long long tm0 = 0ull, tm1 = 0ull;
    if (TYP == 1) {
        if (own > 0) {
            const bf16_t* km = (const bf16_t*)(ws + OFF_KM) + (((size_t)(bl * 8 + hd) * 16 + (r & 15)) * 2) * 64;
            f32x16 g0, g1;
#pragma unroll
            for (int i = 0; i < 16; ++i) { g0[i] = 0.f; g1[i] = 0.f; }
#pragma unroll
            for (int kk = 0; kk < 4; ++kk) {
                bf16x8 ahi = *(const bf16x8*)(km + kk * 16 + h * 8), alo = *(const bf16x8*)(km + 64 + kk * 16 + h * 8);
                if (r >= 16) { ahi = (bf16x8){0, 0, 0, 0, 0, 0, 0, 0}; alo = ahi; }
                g0 = MFMA32(ahi, qa[kk], g0); g0 = MFMA32(alo, qa[kk], g0);
                g1 = MFMA32(ahi, qb[kk], g1); g1 = MFMA32(alo, qb[kk], g1);
            }
            auto top3 = [&](const f32x16& gt) -> unsigned {
                float gl[16];
#pragma unroll
                for (int i = 0; i < 8; ++i) {
                    const float mine = gt[i], oth = shx(mine, 32);
                    gl[8 * (i >> 2) + (i & 3)] = h == 0 ? mine : oth;
                    gl[8 * (i >> 2) + 4 + (i & 3)] = h == 0 ? oth : mine;
                }
                unsigned sel = 0;
#pragma unroll
                for (int pick = 0; pick < 3; ++pick) {
                    float best = -3.0e38f; int bi = -1;
#pragma unroll
                    for (int nb = 0; nb < 16; ++nb) { const bool ok = nb < own && !((sel >> nb) & 1u); if (ok && gl[nb] > best) { best = gl[nb]; bi = nb; } }
                    if (bi >= 0) sel |= 1u << bi;
                }
                return sel;
            };
            sel0 = top3(g0); sel1 = top3(g1);
        }
        for (int nb = 0; nb < own; ++nb) if (__ballot(((sel0 | sel1) >> nb) & 1u) != 0ull) { if (nb < 8) tm0 |= 0xffull << (8 * nb); else tm1 |= 0xffull << (8 * (nb - 8)); }
        for (int t = own * 8; t <= d1; ++t) { if (t < 64) tm0 |= 1ull << t; else tm1 |= 1ull << (t - 64); }
    } else {
        for (int t = 0; t <= d1; ++t) { if (t < 64) tm0 |= 1ull << t; else tm1 |= 1ull << (t - 64); }
    }
    const int ntl = __builtin_popcountll(tm0) + __builtin_popcountll(tm1);
    auto pop = [&]() -> int { int t; if (tm0) { t = __builtin_ctzll(tm0); tm0 &= tm0 - 1; } else if (tm1) { t = 64 + __builtin_ctzll(tm1); tm1 &= tm1 - 1; } else t = d1; return t; };
    auto cmask = [&](int t, unsigned sel, int dg) -> unsigned {
        const int cb = t >> 3;
        if (cb < own) return ((sel >> cb) & 1u) ? 0xffffu : 0u;
        if (t < dg) return 0xffffu;
        if (t > dg) return 0u;
        unsigned vm = 0;
#pragma unroll
        for (int i = 0; i < 16; ++i) if (koff(i, h) <= r) vm |= 1u << i;
        return vm;
    };
    auto bmask = [&](unsigned mw) -> unsigned {
        const unsigned ws4 = mw >> (4 * h);
        return (ws4 & 0xfu) | ((ws4 >> 4) & 0xf0u) | ((ws4 >> 8) & 0xf00u) | ((ws4 >> 12) & 0xf000u);
    };
    KVFrag f; int tc = pop(), tn = 0;
    kv_load(f, K + (size_t)tc * 2048, Vt + (size_t)tc * 2048, lane);
    unsigned mwa = 0, mwb = 0, mwan = 0, mwbn = 0;
    if (TYP == 0) { mwa = mrow0[tc]; mwb = mrow1[tc]; }
    for (int it = 0; it < ntl; ++it) {
        tn = pop();
        if (TYP == 0) { mwan = mrow0[tn]; mwbn = mrow1[tn]; }
        unsigned vm0, vm1;
        if (TYP == 0) { vm0 = bmask(mwa); vm1 = bmask(mwb); } else { vm0 = cmask(tc, sel0, d0); vm1 = cmask(tc, sel1, d1); }
        attn_step2<TYP>(a0, a1, f, qa, qb, vm0, vm1, shifted, K + (size_t)tn * 2048, Vt + (size_t)tn * 2048, lane);
        tc = tn; mwa = mwan; mwb = mwbn;
    }
    attn_store_gated(p, a0, (size_t)bl * S + q0 + r, (TYP ? 1024 : 512) + hd * 64, h, st);
    attn_store_gated(p, a1, (size_t)bl * S + q0 + 32 + r, (TYP ? 1024 : 512) + hd * 64, h, st);
}

DI void attn_a2_item(const Params& p, int layer, int bl, int hh, int rb2) {
    char* ws = p.ws;
    const int lane = ltid() & 63, w = __builtin_amdgcn_readfirstlane(ltid() >> 6), r = lane & 31, h = lane >> 5;
    const int g = hh >> 3, sh = 2 * g, n = S >> sh;
    const int row0 = rb2 * 512 + w * 64;
    const int rr = row0 / n, m0 = row0 % n;
    const bf16_t* Q = (const bf16_t*)(ws + OFF_QA) + (size_t)(bl * 24 + hh) * S * 64;
    const bf16_t* K = (const bf16_t*)(ws + OFF_KA) + (size_t)(bl * 24 + hh) * S * 64;
    const bf16_t* Vt = (const bf16_t*)(ws + OFF_VA) + (size_t)(bl * 24 + hh) * 64 * S;
    bf16x8 qa[4], qb[4];
    load_q(qa, Q + (size_t)(row0 + r) * 64, h); load_q(qb, Q + (size_t)(row0 + 32 + r) * 64, h);
    const float* gk = p.qk_g + ((size_t)(layer * 3 + 0) * 2 + 1) * 64;
    AttnAcc a0, a1; attn_init(a0, attn_bound(qa, gk)); attn_init(a1, attn_bound(qb, gk));
    const bool shifted = a0.shifted || a1.shifted;
    if (shifted && !a0.shifted) a0.nb = 0.f;
    if (shifted && !a1.shifted) a1.nb = 0.f;
    const int kfirst = m0 >= 128 ? 0 : (128 - m0) / 32;
    const int tile0 = (rr * n + m0 - 128) / 32;
    auto amask = [&](int k, int sb) -> unsigned {
        const int base = 128 + 32 * sb - 32 * k + r;
        if (base - 31 >= 0 && base <= 128) return 0xffffu;
        if (base < 0 || base - 31 > 128) return 0u;
        unsigned vm = 0;
#pragma unroll
        for (int i = 0; i < 16; ++i) { const int d = base - koff(i, h); if (d >= 0 && d <= 128) vm |= 1u << i; }
        return vm;
    };
    KVFrag f; kv_load(f, K + (size_t)(tile0 + kfirst) * 2048, Vt + (size_t)(tile0 + kfirst) * 2048, lane);
    for (int k = kfirst; k < 6; ++k) {
        const int kn = k + 1 < 6 ? k + 1 : k;
        attn_step2<1>(a0, a1, f, qa, qb, amask(k, 0), amask(k, 1), shifted, K + (size_t)(tile0 + kn) * 2048, Vt + (size_t)(tile0 + kn) * 2048, lane);
    }
#pragma unroll
    for (int sb = 0; sb < 2; ++sb) {
        const AttnAcc& a = sb ? a1 : a0;
        const float l = a.l + shx(a.l, 32);
        const float inv = 1.0f / l;
        const int s_ = ((m0 + 32 * sb + r) << sh) + rr;
        const size_t tl = (size_t)bl * S + s_;
        bf16_t* o = (bf16_t*)(ws + OFF_OA) + ((size_t)g * TG + tl) * 512 + (hh & 7) * 64;
#pragma unroll
        for (int q4 = 0; q4 < 4; ++q4) {
            u32x2 w0, w1;
            w0[0] = cvt_pk_bf16(a.o0[q4 * 4] * inv, a.o0[q4 * 4 + 1] * inv); w0[1] = cvt_pk_bf16(a.o0[q4 * 4 + 2] * inv, a.o0[q4 * 4 + 3] * inv);
            w1[0] = cvt_pk_bf16(a.o1[q4 * 4] * inv, a.o1[q4 * 4 + 1] * inv); w1[1] = cvt_pk_bf16(a.o1[q4 * 4 + 2] * inv, a.o1[q4 * 4 + 3] * inv);
            *(u32x2*)(o + 8 * q4 + 4 * h) = w0; *(u32x2*)(o + 32 + 8 * q4 + 4 * h) = w1;
        }
        if (h == 0) ((float*)(ws + OFF_LSE))[((size_t)g * TG + tl) * 8 + (hh & 7)] = (a.nb + __log2f(l)) * LN2F;
    }
}

DI void merge_a_item(const Params& p, int item, bool st) {
    char* ws = p.ws;
    const int tid = ltid();
    const bf16_t* oa = (const bf16_t*)(ws + OFF_OA);
    const float* lse = (const float*)(ws + OFF_LSE);
    bf16_t* sz = (bf16_t*)(ws + OFF_SZ);
    const int c8 = (tid & 63) * 8, hd = c8 >> 6;
    for (int it = 0; it < 8; it += 4) {
        float l0[4], l1[4], l2[4]; u32x4 a0[4], a1[4], a2[4], zz[4];
#pragma unroll
        for (int u = 0; u < 4; ++u) {
            const size_t tl = (size_t)item * 64 + (it + u) * 8 + (tid >> 6);
            l0[u] = lse[(0 * (size_t)TG + tl) * 8 + hd]; l1[u] = lse[(1 * (size_t)TG + tl) * 8 + hd]; l2[u] = lse[(2 * (size_t)TG + tl) * 8 + hd];
            a0[u] = *(const u32x4*)(oa + (0 * (size_t)TG + tl) * 512 + c8); a1[u] = *(const u32x4*)(oa + (1 * (size_t)TG + tl) * 512 + c8); a2[u] = *(const u32x4*)(oa + (2 * (size_t)TG + tl) * 512 + c8);
            zz[u] = *(const u32x4*)(sz + tl * 1536 + c8);
        }
#pragma unroll
        for (int u = 0; u < 4; ++u) {
            const size_t tl = (size_t)item * 64 + (it + u) * 8 + (tid >> 6);
            const float mx = fmaxf(l0[u], fmaxf(l1[u], l2[u]));
            float w0 = __expf(l0[u] - mx), w1 = __expf(l1[u] - mx), w2 = __expf(l2[u] - mx);
            const float inv = 1.0f / (w0 + w1 + w2); w0 *= inv; w1 *= inv; w2 *= inv;
            u32x4 res;
#pragma unroll
            for (int k = 0; k < 4; ++k) {
                const float lo = (w0 * __uint_as_float(a0[u][k] << 16) + w1 * __uint_as_float(a1[u][k] << 16) + w2 * __uint_as_float(a2[u][k] << 16)) * __uint_as_float(zz[u][k] << 16);
                const float hi = (w0 * __uint_as_float(a0[u][k] & 0xffff0000u) + w1 * __uint_as_float(a1[u][k] & 0xffff0000u) + w2 * __uint_as_float(a2[u][k] & 0xffff0000u)) * __uint_as_float(zz[u][k] & 0xffff0000u);
                res[k] = cvt_pk_bf16(lo, hi);
            }
            if (st) *(u32x4*)(sz + tl * 1536 + c8) = res;
        }
    }
}

DI int snake_item(int round, int G, int bid) { return (round & 1) ? round * G + (G - 1 - bid) : round * G + bid; }

__global__ void __launch_bounds__(NTHREADS) fwd_megakernel(Params p) {
    __shared__ __attribute__((aligned(16))) char shm_raw[SHM_BYTES];
    cg::grid_group grid = cg::this_grid();
    char* ws = p.ws;
    const int G = gridDim.x, bid = blockIdx.x;
    __attribute__((address_space(3))) bf16_t* shm_g = (__attribute__((address_space(3))) bf16_t*)shm_raw;

    unsigned* barcnt = (unsigned*)(ws + OFF_BAR2);
    unsigned bartarget = 0;
    if (bid == 0 && threadIdx.x < 9) __hip_atomic_store(barcnt + 32 * threadIdx.x, 0u, __ATOMIC_RELAXED, __HIP_MEMORY_SCOPE_AGENT);
    if (bid == 0 && threadIdx.x < DEPTH * NGRP * 64) ((unsigned*)(ws + OFF_FLAG))[threadIdx.x] = 0u;
    phase_prep(p, shm_raw);
    if (DUPMASK & 64) { __syncthreads(); phase_prep(p, shm_raw); }
    grid.sync();

#define LAUNDER() do { } while (0)
    unsigned long long tspan = 0ull, tprev = SPINSEL ? wall_clock64() : 0ull;
#define PHASE_END(k) do { if (SPINSEL) { const unsigned long long tn_ = wall_clock64(); if (SPINSEL == (k)) tspan += tn_ - tprev; tprev = tn_; } } while (0)
    for (int layer = 0; layer < DEPTH; ++layer) {
        for (int grp = 0; grp < NGRP; ++grp) {
            const int gtok0 = grp * TG;
            LAUNDER();
            for (int rep = 0; rep <= (DUPMASK & 1); ++rep) {
                EpiIn epi{&p, layer, gtok0};
                gemm_phase<true>((const bf16_t*)(ws + OFF_WTIN), DM, 0, NPAD, (const bf16_t*)(ws + OFF_XB), DM, 0, TG, DM, 1, epi, shm_g);
            }
            grid_barrier(barcnt, bartarget, (unsigned)G);
            if (DUPMASK & 32) grid_barrier(barcnt, bartarget, (unsigned)G);
            PHASE_END(1);
            LAUNDER();
            for (int rep = 0; rep <= ((DUPMASK >> 1) & 1); ++rep) {
                const int nsel = BG * 256;
                const int nA = BG * 24 * 8, nK = BG * 8 * 16;
                const int rS = (nsel + G - 1) / G, rA = (nA + G - 1) / G, rK = (nK + G - 1) / G, rT = rS + rA + rK;
                const int off = (bid & 1) ? rS : 0;
                for (int st_ = 0; st_ < rT; ++st_) {
                    int s2 = st_ + off; if (s2 >= rT) s2 -= rT;
                    if (s2 < rS) {
                        const int it = snake_item(s2, G, bid);
                        if (it < nsel) select_chunk(p, it % BG, 255 - it / BG, shm_raw);
                    } else if (s2 < rS + rA) {
                        const int it = (s2 - rS) * G + bid;
                        if (it < nA) attn_a2_item(p, layer, it / (24 * 8), (it / 8) % 24, it % 8);
                    } else {
                        const int it = (s2 - rS - rA) * G + bid;
                        if (it < nK) kmean_item(p, it / 128, (it / 16) & 7, it & 15, shm_raw);
                    }
                }
            }
            grid_barrier(barcnt, bartarget, (unsigned)G);
            if (DUPMASK & 32) grid_barrier(barcnt, bartarget, (unsigned)G);
            PHASE_END(2);
            LAUNDER();
            for (int rep = ((DUPMASK >> 2) & 1); rep >= 0; --rep) {
                const bool st = rep == 0 || p.dupmask == 0x7fffffff;
#if ATTN64
                const int nbc = 2 * BG * 8 * 4;
                const int wv = __builtin_amdgcn_readfirstlane(ltid() >> 6);
                for (int it = bid; it < nbc; it += G) {
                    const int j = it & 3, sub = it >> 2, typ = sub / (BG * 8), bl = (sub / 8) % BG, hd = sub & 7;
                    const int c0 = j * 8 + wv, c1 = 63 - c0;
                    if (typ == 0) { attn_bc2_chunk<0>(p, layer, bl, hd, c1, st); attn_bc2_chunk<0>(p, layer, bl, hd, c0, st); }
                    else { attn_bc2_chunk<1>(p, layer, bl, hd, c1, st); attn_bc2_chunk<1>(p, layer, bl, hd, c0, st); }
                }
#else
                const int nbc = 2 * BG * 8 * 16;
                for (int rnd = 0;; ++rnd) {
                    const int it = snake_item(rnd, G, bid);
                    if (rnd * G >= nbc) break;
                    if (it < nbc) {
                        const int qb = 15 - it / (2 * BG * 8), sub = it % (2 * BG * 8), typ = sub / (BG * 8), bl = (sub / 8) % BG, hd = sub & 7;
                        {
#if ATTN_LDS
                            attn_bc_item(p, layer, typ, bl, hd, qb, st, shm_raw);
#else
                            if (typ == 0) attn_b_item(p, layer, bl, hd, qb, st, st ? 0 : ((p.dupmask >> 8) & 3)); else if (st || ((p.dupmask >> 10) & 1) == 0) attn_c_item(p, layer, bl, hd, qb, st);
#endif
                        }
                    }
                }
#endif
                for (int it = bid; it < TG / 64; it += G) merge_a_item(p, it, st);
            }
            grid_barrier(barcnt, bartarget, (unsigned)G);
            if (DUPMASK & 32) grid_barrier(barcnt, bartarget, (unsigned)G);
            PHASE_END(3);
            LAUNDER();
            for (int rep = 0; rep <= ((DUPMASK >> 3) & 1); ++rep) {
                EpiBr epi{&p};
                gemm_phase<false>((const bf16_t*)(ws + OFF_WTBR) + (size_t)layer * 3 * DM * 512, 512, (size_t)DM * 512, DM, (const bf16_t*)(ws + OFF_SZ), 1536, 512, TG, 512, 3, epi, shm_g);
            }
            {
                const bool handoff = (DUPMASK == 0) && G == (DM / BM) * (TG / BM);
                if (handoff) {
                    int pm_, pn_; gemm_tile_of(bid, DM / BM, TG / BM, pm_, pn_);
                    unsigned* fl = (unsigned*)(ws + OFF_FLAG) + (layer * NGRP + grp) * 64 + pn_;
                    __syncthreads();
                    if (threadIdx.x == 0) {
                        __builtin_amdgcn_fence(__ATOMIC_RELEASE, "agent");
                        __hip_atomic_fetch_add(fl, 1u, __ATOMIC_RELAXED, __HIP_MEMORY_SCOPE_AGENT);
                        while (__hip_atomic_load(fl, __ATOMIC_RELAXED, __HIP_MEMORY_SCOPE_AGENT) < (unsigned)(DM / BM)) __builtin_amdgcn_s_sleep(1);
                        __builtin_amdgcn_fence(__ATOMIC_ACQUIRE, "agent");
                    }
                    __syncthreads();
                } else {
                    grid_barrier(barcnt, bartarget, (unsigned)G);
                    if (DUPMASK & 32) grid_barrier(barcnt, bartarget, (unsigned)G);
                }
            }
            PHASE_END(4);
            LAUNDER();
            for (int rep = ((DUPMASK >> 4) & 1); rep >= 0; --rep) {
                EpiOut epi{&p, layer, gtok0, rep == 0 || p.dupmask == 0x7fffffff};
                gemm_phase<false>((const bf16_t*)(ws + OFF_WTOUT) + (size_t)layer * DM * DM, DM, 0, DM, (const bf16_t*)(ws + OFF_MB), DM, 0, TG, DM, 1, epi, shm_g);
                if (rep == 0) {
                    const int nl = grp + 1 < NGRP ? layer : layer + 1, ng = grp + 1 < NGRP ? grp + 1 : 0;
                    if (nl < DEPTH) {
                        __syncthreads();
                        const float* xsrc = (nl == 0 ? p.x : (const float*)p.out) + (size_t)ng * TG * DM;
                        int per = (TG + G - 1) / G; int tb = bid * per, te = tb + per < TG ? tb + per : TG;
                        xprep_tokens(xsrc, (bf16_t*)(ws + OFF_XB), (float*)(ws + OFF_SS), tb, te);
                        if (nl != layer) for (int it = bid; it < 16 * 204; it += G) convert_win_tile(p, nl, it, (float*)shm_raw);
                    }
                }
            }
            grid_barrier(barcnt, bartarget, (unsigned)G);
            if (DUPMASK & 32) grid_barrier(barcnt, bartarget, (unsigned)G);
            PHASE_END(5);
        }
    }
    if (SPINSEL) { const unsigned long long t0_ = wall_clock64(); while (wall_clock64() - t0_ < tspan) __builtin_amdgcn_s_sleep(8); }
}

extern "C" void kernel_launch(void* const* d_in, const int* in_sizes, int n_in, void* d_out, int out_size, void* d_ws, size_t ws_size, hipStream_t stream) {
    static int grid_blocks = 0;
    if (!grid_blocks) {
        int dev = 0, cus = 0, per_cu = 0;
        hipGetDevice(&dev);
        hipDeviceGetAttribute(&cus, hipDeviceAttributeMultiprocessorCount, dev);
        hipOccupancyMaxActiveBlocksPerMultiprocessor(&per_cu, fwd_megakernel, NTHREADS, 0);
        if (per_cu > 1) per_cu = 1;
        grid_blocks = cus * per_cu;
    }
    if (ws_size < WS_NEED) { fprintf(stderr, "workspace too small: %zu < %zu\n", ws_size, (size_t)WS_NEED); return; }
    Params p{};
    p.dupmask = DUPMASK; p.pad_ = 0;
    p.x = (const float*)d_in[0]; p.pos = (const int*)d_in[1]; p.norm_g = (const float*)d_in[2]; p.w_in = (const float*)d_in[3];
    p.qk_g = (const float*)d_in[4]; p.w_br = (const float*)d_in[5]; p.w_out = (const float*)d_in[6];
    p.out = (float*)d_out; p.ws = (char*)d_ws;
    void* args[] = {&p};
    hipError_t e = hipLaunchCooperativeKernel((void*)fwd_megakernel, dim3(grid_blocks), dim3(NTHREADS), args, 0, stream);
    if (e != hipSuccess) fprintf(stderr, "cooperative launch failed: %s (grid %d)\n", hipGetErrorString(e), grid_blocks);
}
```

```cpp
#include <hip/hip_runtime.h>
#include <hip/hip_cooperative_groups.h>
#include <cstdio>
#include <cstdint>
namespace cg = cooperative_groups;
#define ATTN_LDS 0
#define ATTN64 1
#define SPINSEL 0
#define DUPMASK 0

typedef unsigned short bf16_t;
typedef short bf16x8 __attribute__((ext_vector_type(8)));
typedef short s16x4 __attribute__((ext_vector_type(4)));
typedef float f32x4 __attribute__((ext_vector_type(4)));
typedef float f32x16 __attribute__((ext_vector_type(16)));
typedef unsigned u32x4 __attribute__((ext_vector_type(4)));
typedef unsigned u32x2 __attribute__((ext_vector_type(2)));
#define DI __device__ __forceinline__

constexpr int S = 4096, DM = 1024, NB = 8, DEPTH = 2;
constexpr int NIN = 12872, NPAD = 13056;
constexpr int BG = 4, TG = BG * S, NGRP = NB / BG;
constexpr int NTHREADS = 512;
constexpr int SHM_BYTES = 131072;
constexpr float QSCALE = 0.125f * 1.4426950408889634f;
constexpr float LN2F = 0.6931471805599453f;
constexpr int SEL_CAP = 768;

constexpr size_t al256(size_t x) { return (x + 255) & ~(size_t)255; }
constexpr size_t OFF_WTIN = 0;
constexpr size_t OFF_WTBR = OFF_WTIN + al256((size_t)NPAD * DM * 2);
constexpr size_t OFF_WTOUT = OFF_WTBR + al256((size_t)DEPTH * 3 * DM * 512 * 2);
constexpr size_t OFF_CS = OFF_WTOUT + al256((size_t)DEPTH * DM * DM * 2);
constexpr size_t OFF_XB = OFF_CS + al256((size_t)NB * S * 8 * 8);
constexpr size_t OFF_OA = OFF_XB;
constexpr size_t OFF_SS = OFF_XB + al256((size_t)3 * TG * 512 * 2);
constexpr size_t OFF_QA = OFF_SS + al256((size_t)TG * 8 * 4);
constexpr size_t OFF_KA = OFF_QA + al256((size_t)TG * 1536 * 2);
constexpr size_t OFF_VA = OFF_KA + al256((size_t)TG * 1536 * 2);
constexpr size_t OFF_MF = OFF_QA;
constexpr size_t OFF_MB = OFF_VA;
constexpr size_t OFF_QB = OFF_VA + al256((size_t)TG * 1536 * 2);
constexpr size_t OFF_KB = OFF_QB + al256((size_t)TG * 512 * 2);
constexpr size_t OFF_VB = OFF_KB + al256((size_t)TG * 512 * 2);
constexpr size_t OFF_QC = OFF_VB + al256((size_t)TG * 512 * 2);
constexpr size_t OFF_KC = OFF_QC + al256((size_t)TG * 512 * 2);
constexpr size_t OFF_VC = OFF_KC + al256((size_t)TG * 512 * 2);
constexpr size_t OFF_IQ = OFF_VC + al256((size_t)TG * 512 * 2);
constexpr size_t OFF_IK = OFF_IQ + al256((size_t)TG * 512 * 2);
constexpr size_t OFF_IW = OFF_IK + al256((size_t)TG * 64 * 2);
constexpr size_t OFF_SZ = OFF_IW + al256((size_t)TG * 8 * 4);
constexpr size_t OFF_SG = OFF_SZ + al256((size_t)TG * 1536 * 2);
constexpr size_t OFF_LSE = OFF_SG + al256((size_t)TG * 3072 * 2);
constexpr size_t OFF_MASK = OFF_LSE + al256((size_t)3 * TG * 8 * 4);
constexpr size_t OFF_KM = OFF_MASK + al256((size_t)BG * S * (S / 8));
static_assert((size_t)TG * DM * 4 <= (size_t)2 * TG * 1536 * 2 && (size_t)TG * DM * 2 <= (size_t)TG * 1536 * 2, "overlay sizes");
constexpr size_t OFF_BAR = OFF_KM + al256((size_t)BG * 8 * 16 * 64 * 2 * 2);
constexpr size_t OFF_FLAG = OFF_BAR + 256;
constexpr size_t OFF_BAR2 = OFF_FLAG + (size_t)DEPTH * NGRP * 64 * 4;
constexpr size_t WS_NEED = OFF_BAR2 + 9 * 128;

struct Params {
    const float* x; const int* pos; const float* norm_g; const float* w_in; const float* qk_g; const float* w_br; const float* w_out;
    float* out; char* ws; int dupmask; int pad_;
};

DI int ltid() { int t = threadIdx.x; asm volatile("" : "+v"(t)); return t; }
DI unsigned cvt_pk_bf16(float lo, float hi) { unsigned r; asm volatile("v_cvt_pk_bf16_f32 %0, %1, %2" : "=v"(r) : "v"(lo), "v"(hi)); return r; }
DI bf16_t f2bf(float x) { return (bf16_t)(cvt_pk_bf16(x, 0.f) & 0xffffu); }
DI float bf2f(bf16_t v) { return __uint_as_float(((unsigned)v) << 16); }
DI float fexp2(float x) { return __builtin_amdgcn_exp2f(x); }
DI float shx(float v, int mask) { const int l = ltid() & 63; return __int_as_float(__builtin_amdgcn_ds_bpermute((l ^ mask) << 2, __float_as_int(v))); }
DI float wave_sum(float v) { for (int o = 32; o > 0; o >>= 1) v += shx(v, o); return v; }
DI int f2sort(float f) { int i = __float_as_int(f); return i ^ ((i >> 31) & 0x7fffffff); }
DI float sort2f(int i) { return __int_as_float(i ^ ((i >> 31) & 0x7fffffff)); }
#define MFMA32(a, b, c) __builtin_amdgcn_mfma_f32_32x32x16_bf16((a), (b), (c), 0, 0, 0)
#define MFMA16(a, b, c) __builtin_amdgcn_mfma_f32_16x16x32_bf16((a), (b), (c), 0, 0, 0)

DI void grid_barrier(unsigned* bar, unsigned& gen, unsigned G) {
    __syncthreads();
    gen += 1;
    if (threadIdx.x == 0) {
        __builtin_amdgcn_fence(__ATOMIC_RELEASE, "agent");
        const unsigned sh = blockIdx.x & 7u, per = (G + 7u - sh) >> 3, nsh = G < 8u ? G : 8u;
        const unsigned old = __hip_atomic_fetch_add(bar + 32 * (1 + sh), 1u, __ATOMIC_RELAXED, __HIP_MEMORY_SCOPE_AGENT);
        if (old + 1u == per * gen) __hip_atomic_fetch_add(bar, 1u, __ATOMIC_RELAXED, __HIP_MEMORY_SCOPE_AGENT);
        while (__hip_atomic_load(bar, __ATOMIC_RELAXED, __HIP_MEMORY_SCOPE_AGENT) < nsh * gen) __builtin_amdgcn_s_sleep(2);
        __builtin_amdgcn_fence(__ATOMIC_ACQUIRE, "agent");
    }
    __syncthreads();
}

DI int src_col_of_group(int hg) { return hg <= 104 ? hg * 64 : (hg <= 200 ? 6728 + (hg - 105) * 64 : 6720); }

DI void convert_tile(const float* src, int ld_src, int k0, int n_src0, int n_valid, const float* kscale, bf16_t* dst, int ld_dst, int n_dst0, float* tl  ) {
    const int tid = ltid();
    __syncthreads();
#pragma unroll
    for (int i = 0; i < 8; ++i) {
        int e = tid + i * 512, kk = e >> 6, nn = e & 63;
        float v = 0.f;
        if (nn < n_valid) { v = src[(size_t)(k0 + kk) * ld_src + n_src0 + nn]; if (kscale) v *= kscale[k0 + kk]; }
        tl[kk * 65 + nn] = v;
    }
    __syncthreads();
#pragma unroll
    for (int i = 0; i < 4; ++i) {
        int e = tid + i * 512, nn = e >> 5, kp = (e & 31) * 2;
        unsigned w = cvt_pk_bf16(tl[kp * 65 + nn], tl[(kp + 1) * 65 + nn]);
        *(unsigned*)(dst + (size_t)(n_dst0 + nn) * ld_dst + k0 + kp) = w;
    }
}

DI void xprep_tokens(const float* xsrc  , bf16_t* xb, float* ss, int tok_begin, int tok_end) {
    const int lane = ltid() & 63, wid = ltid() >> 6;
    for (int t = tok_begin + wid; t < tok_end; t += 8) {
        const float* xr = xsrc + (size_t)t * DM;
        float sum = 0.f;
#pragma unroll
        for (int i = 0; i < 4; ++i) {
            f32x4 v = *(const f32x4*)(xr + i * 256 + lane * 4);
            sum += v[0] * v[0] + v[1] * v[1] + v[2] * v[2] + v[3] * v[3];
            u32x2 w; w[0] = cvt_pk_bf16(v[0], v[1]); w[1] = cvt_pk_bf16(v[2], v[3]);
            *(u32x2*)(xb + (size_t)t * DM + i * 256 + lane * 4) = w;
        }
        sum = wave_sum(sum);
        if (lane < 8) ss[(size_t)t * 8 + lane] = lane == 0 ? sum : 0.f;
    }
}

DI void convert_win_tile(const Params& p, int l, int it, float* tl) {
    const int hg = it / 16, kt = it % 16;
    const int nvalid = hg <= 200 ? 64 : (hg == 201 ? 8 : 0);
    convert_tile(p.w_in + (size_t)l * DM * NIN, NIN, kt * 64, src_col_of_group(hg), nvalid, p.norm_g + l * DM, (bf16_t*)(p.ws + OFF_WTIN), DM, hg * 64, tl);
}
DI void phase_prep(const Params& p, char* shm) {
    char* ws = p.ws;
    const int G = gridDim.x, bid = blockIdx.x, tid = ltid();
    float2* cs = (float2*)(ws + OFF_CS);
    for (int e = bid * NTHREADS + tid; e < NB * S * 8; e += G * NTHREADS) {
        int i = e & 7, t = e >> 3;
        float inv = powf(500000.0f, -(float)(2 * i) / 16.0f);
        float ang = (float)p.pos[t] * inv;
        double rev = (double)ang * 0.15915494309189535;
        rev -= floor(rev);
        float rf = (float)rev;
        cs[e] = make_float2(__builtin_amdgcn_cosf(rf), __builtin_amdgcn_sinf(rf));
    }
    float* tl = (float*)shm;
    const int n_in_tiles = 16 * 204, n_br_tiles = DEPTH * 3 * 8 * 16, n_out_tiles = DEPTH * 16 * 16;
    for (int it = bid; it < n_in_tiles + n_br_tiles + n_out_tiles; it += G) {
        if (it < n_in_tiles) {
            convert_win_tile(p, 0, it, tl);
        } else if (it < n_in_tiles + n_br_tiles) {
            int r = it - n_in_tiles; int ln = r / 128, q = r % 128, kt = q / 16, nt = q % 16;
            convert_tile(p.w_br + (size_t)ln * 512 * DM, DM, kt * 64, nt * 64, 64, nullptr, (bf16_t*)(ws + OFF_WTBR) + (size_t)ln * DM * 512, 512, nt * 64, tl);
        } else {
            int r = it - n_in_tiles - n_br_tiles; int l = r / 256, q = r % 256, kt = q / 16, nt = q % 16;
            convert_tile(p.w_out + (size_t)l * DM * DM, DM, kt * 64, nt * 64, 64, nullptr, (bf16_t*)(ws + OFF_WTOUT) + (size_t)l * DM * DM, DM, nt * 64, tl);
        }
    }
    int per = (TG + G - 1) / G;
    int tb = bid * per, te = tb + per < TG ? tb + per : TG;
    xprep_tokens(p.x, (bf16_t*)(ws + OFF_XB), (float*)(ws + OFF_SS), tb, te);
}

constexpr int BM = 256, BK = 64, HALF = 128, NXCD = 8, WGM = 8, HT = HALF * BK;
DI int lds_byte(int r, int c) { int st = (r >> 4) * 2 + (c >> 5), rr = r & 15, cc = c & 31, ob = rr * 64 + cc * 2; return st * 1024 + (ob ^ (((ob >> 9) & 1) << 5)); }
DI void stage_rc(int b, int& R, int& C) { int st = b / 1024, sb = b % 1024, swz = sb ^ (((sb >> 9) & 1) << 5); R = (st >> 1) * 16 + swz / 64; C = (st & 1) * 32 + (swz % 64) / 2; }

#define SA(b, h) (shm + ((b) * 2 + (h)) * HT)
#define SB(b, h) (shm + (4 + (b) * 2 + (h)) * HT)
DI void glds16(const void* sbase, unsigned voff, unsigned lds_dst) {
    unsigned keep;
    asm volatile("s_mov_b32 %0, m0\n\ts_mov_b32 m0, %3\n\ts_nop 0\n\tglobal_load_lds_dwordx4 %1, %2\n\ts_mov_b32 m0, %0"
                 : "=&s"(keep) : "v"(voff), "s"(sbase), "s"(lds_dst) : "memory");
}
#define STAGE(P, BASE, LD, br, kt, VOFF) do { const bf16_t* _gp = (BASE) + (size_t)(br) * (LD) + (size_t)(kt) * BK; \
    const unsigned _l0 = (unsigned)(size_t)(P) + wbase16; \
    glds16(_gp, VOFF[0], _l0); glds16(_gp, VOFF[1], _l0 + 8192u); } while (0)
#define LDA(dst, b, h) _Pragma("unroll") for (int m = 0; m < 4; ++m) _Pragma("unroll") for (int k = 0; k < 2; ++k) \
    dst[m][k] = *reinterpret_cast<const bf16x8*>((char*)SA(b, h) + lds_byte(wr * 64 + m * 16 + fr, k * 32 + fq * 8))
#define LDB(dst, b, h) _Pragma("unroll") for (int n = 0; n < 2; ++n) _Pragma("unroll") for (int k = 0; k < 2; ++k) \
    dst[n][k] = *reinterpret_cast<const bf16x8*>((char*)SB(b, h) + lds_byte(wc * 32 + n * 16 + fr, k * 32 + fq * 8))
#define MMA(ai, bj, At, Bt_) do { __builtin_amdgcn_s_setprio(1); \
    _Pragma("unroll") for (int m = 0; m < 4; ++m) _Pragma("unroll") for (int n = 0; n < 2; ++n) _Pragma("unroll") for (int k = 0; k < 2; ++k) \
      acc[ai][bj][m][n] = MFMA16(At[m][k], Bt_[n][k], acc[ai][bj][m][n]); \
    __builtin_amdgcn_s_setprio(0); } while (0)
#define WAIT_V(n) asm volatile("s_waitcnt vmcnt(" #n ")" ::: "memory")
#define WAIT_L(n) asm volatile("s_waitcnt lgkmcnt(" #n ")" ::: "memory")
#define BAR __builtin_amdgcn_s_barrier()
#define SCHED __builtin_amdgcn_sched_barrier(0)

DI int fold_tok(int rho, int sh) { const int b = rho >> 12, rb = rho & (S - 1); return (b << 12) + (((rb & ((S >> sh) - 1)) << sh) + (rb >> (12 - sh))); }
DI void gemm_tile_of(int L, int nM, int nN, int& pm, int& pn) {
    const int nwg = nM * nN; int wgid = L;
    { int q = nwg / NXCD, r = nwg % NXCD, xcd = wgid % NXCD, off = wgid / NXCD; wgid = (xcd < r ? xcd * (q + 1) : r * (q + 1) + (xcd - r) * q) + off; }
    const int nig = WGM * nN, gid = wgid / nig, fm = gid * WGM, gsz = min(nM - fm, WGM);
    pm = fm + ((wgid % nig) % gsz); pn = (wgid % nig) / gsz;
}
template <bool FOLD, class Epi>
DI void gemm_phase(const bf16_t* __restrict__ Abase, int lda, size_t a_sub, int M, const bf16_t* __restrict__ Bbase, int ldb, size_t b_sub, int N, int K, int nsub,
                   Epi& epi, __attribute__((address_space(3))) bf16_t* shm) {
    const int nM = M / BM, nN = N / BM, nwg = nM * nN;
    const int wid = ltid() >> 6, lane = ltid() & 63, wr = wid >> 2, wc = wid & 3, fr = lane & 15, fq = lane >> 4;
    const int nt = K / BK;
    unsigned voffA[2], voffB0[2], voffB1[2];
    const unsigned wbase16 = __builtin_amdgcn_readfirstlane((ltid() & ~63u) * 16u);
#pragma unroll
    for (int i = 0; i < 2; ++i) {
        int r_, c_; stage_rc(ltid() * 16 + i * 8192, r_, c_);
        const int x_ = r_ & 63, pr_ = (r_ & 64) + ((x_ & 15) >> 2) * 16 + (x_ >> 4) * 4 + (x_ & 3);
        voffA[i] = (unsigned)(pr_ * lda + c_) * 2u;
    }
    int L = blockIdx.x, sub = 0, brow = 0, bcol = 0;
    bool have = L < nwg, prefetched = false;
    const bf16_t* A = Abase; const bf16_t* Bt = Bbase;
    auto setup = [&](int L_, int sub_) {
        int wgid = L_;
        { int q = nwg / NXCD, r = nwg % NXCD, xcd = wgid % NXCD, off = wgid / NXCD; wgid = (xcd < r ? xcd * (q + 1) : r * (q + 1) + (xcd - r) * q) + off; }
        const int nig = WGM * nN, gid = wgid / nig, fm = gid * WGM, gsz = min(nM - fm, WGM);
        const int pm = fm + ((wgid % nig) % gsz), pn = (wgid % nig) / gsz;
        brow = pm * BM; bcol = pn * BM;
        const int sh = (FOLD && pm < 18) ? 2 * ((pm % 6) >> 1) : 0;
        const int t_ = ltid();
#pragma unroll
        for (int i = 0; i < 2; ++i) {
            int r_, c_; stage_rc(t_ * 16 + i * 8192, r_, c_);
            voffB0[i] = (unsigned)(fold_tok(bcol + r_, sh) * ldb + c_) * 2u;
            voffB1[i] = (unsigned)(fold_tok(bcol + HALF + r_, sh) * ldb + c_) * 2u;
        }
        A = Abase + (size_t)sub_ * a_sub; Bt = Bbase + (size_t)sub_ * b_sub;
    };
    while (have) {
        {
            setup(L, sub);
            f32x4 acc[2][2][4][2] = {};
            bf16x8 At[4][2], B0[2][2], B1[2][2];
            if (!prefetched) {
                STAGE(SB(0, 0), Bt, ldb, 0, 0, voffB0); STAGE(SA(0, 0), A, lda, brow, 0, voffA);
                STAGE(SB(0, 1), Bt, ldb, 0, 0, voffB1); STAGE(SA(0, 1), A, lda, brow + HALF, 0, voffA);
            }
            if (wr == 1) BAR;
            if (prefetched) WAIT_V(0); else WAIT_V(4);
            BAR;
            STAGE(SB(1, 0), Bt, ldb, 0, 1, voffB0); STAGE(SA(1, 0), A, lda, brow, 1, voffA); STAGE(SB(1, 1), Bt, ldb, 0, 1, voffB1);
            WAIT_V(6); BAR;
            for (int t = 0; t < nt - 2; t += 2) {
                LDB(B0, 0, 0); SCHED; LDA(At, 0, 0); STAGE(SA(1, 1), A, lda, brow + HALF, t + 1, voffA);
                WAIT_L(8); BAR; WAIT_L(0); MMA(0, 0, At, B0); BAR; SCHED;
                LDB(B1, 0, 1); STAGE(SB(0, 0), Bt, ldb, 0, t + 2, voffB0);
                BAR; WAIT_L(0); MMA(0, 1, At, B1); BAR;
                LDA(At, 0, 1); STAGE(SA(0, 0), A, lda, brow, t + 2, voffA);
                BAR; WAIT_L(0); MMA(1, 0, At, B0); BAR; SCHED;
                STAGE(SB(0, 1), Bt, ldb, 0, t + 2, voffB1);
                WAIT_V(6); BAR; MMA(1, 1, At, B1); BAR;
                LDB(B0, 1, 0); SCHED; LDA(At, 1, 0); STAGE(SA(0, 1), A, lda, brow + HALF, t + 2, voffA);
                WAIT_L(8); BAR; WAIT_L(0); MMA(0, 0, At, B0); BAR; SCHED;
                LDB(B1, 1, 1); STAGE(SB(1, 0), Bt, ldb, 0, t + 3, voffB0);
                BAR; WAIT_L(0); MMA(0, 1, At, B1); BAR;
                LDA(At, 1, 1); STAGE(SA(1, 0), A, lda, brow, t + 3, voffA);
                BAR; WAIT_L(0); MMA(1, 0, At, B0); BAR; SCHED;
                STAGE(SB(1, 1), Bt, ldb, 0, t + 3, voffB1);
                WAIT_V(6); BAR; MMA(1, 1, At, B1); BAR;
            }
            { LDB(B0, 0, 0); LDA(At, 0, 0); STAGE(SA(1, 1), A, lda, brow + HALF, nt - 1, voffA);
              BAR; WAIT_L(0); MMA(0, 0, At, B0); BAR;
              LDB(B1, 0, 1); BAR; WAIT_L(0); MMA(0, 1, At, B1); BAR;
              LDA(At, 0, 1); WAIT_V(4); BAR; WAIT_L(0); MMA(1, 0, At, B0); MMA(1, 1, At, B1); BAR; }
            { LDB(B0, 1, 0); LDA(At, 1, 0); WAIT_V(2); BAR; WAIT_L(0); MMA(0, 0, At, B0); BAR;
              LDB(B1, 1, 1); WAIT_V(0); BAR; WAIT_L(0); MMA(0, 1, At, B1); BAR;
              LDA(At, 1, 1); BAR; WAIT_L(0); MMA(1, 0, At, B0); MMA(1, 1, At, B1); BAR; }
            if (wr == 0) BAR;
            const int e_brow = brow, e_bcol = bcol, e_sub = sub;
            if (++sub == nsub) { sub = 0; L += gridDim.x; }
            have = L < nwg;
            if (have) {
                setup(L, sub);
                STAGE(SB(0, 0), Bt, ldb, 0, 0, voffB0); STAGE(SA(0, 0), A, lda, brow, 0, voffA);
                STAGE(SB(0, 1), Bt, ldb, 0, 0, voffB1); STAGE(SA(0, 1), A, lda, brow + HALF, 0, voffA);
                prefetched = true;
            }
            { int t2 = ltid();
              const int wid2 = t2 >> 6, lane2 = t2 & 63;
              epi(acc, e_brow, e_bcol, e_sub, wid2 >> 2, wid2 & 3, lane2 & 15, lane2 >> 4); }
        }
    }
}

struct EpiIn {
    const Params* p; int layer; int gtok0;
    DI void operator()(const f32x4 (&acc)[2][2][4][2], int brow, int bcol, int sub, int wr, int wc, int fr, int fq) const {
        char* ws = p->ws;
        const float* ss = (const float*)(ws + OFF_SS);
        const float2* cs = (const float2*)(ws + OFF_CS);
        const int lane = ltid() & 63; const int tg_unused = 0;
        const int pm_ = brow >> 8;
        const int shf = pm_ < 18 ? 2 * ((pm_ % 6) >> 1) : 0;
        float rstd4[2][2];
        {
            f32x4 sA[2][2], sB[2][2];
#pragma unroll
            for (int bj = 0; bj < 2; ++bj)
#pragma unroll
                for (int n = 0; n < 2; ++n) {
                    const int tl_ = fold_tok(bcol + bj * 128 + wc * 32 + n * 16 + fr, shf);
                    sA[bj][n] = *(const f32x4*)(ss + (size_t)tl_ * 8); sB[bj][n] = *(const f32x4*)(ss + (size_t)tl_ * 8 + 4);
                }
#pragma unroll
            for (int bj = 0; bj < 2; ++bj)
#pragma unroll
                for (int n = 0; n < 2; ++n) {
                    const f32x4 s0 = sA[bj][n], s1 = sB[bj][n];
                    rstd4[bj][n] = rsqrtf((s0[0] + s0[1] + s0[2] + s0[3] + s1[0] + s1[1] + s1[2] + s1[3]) * (1.0f / DM) + 1e-6f);
                }
        }
#pragma unroll
        for (int ai = 0; ai < 2; ++ai) {
            const int hg = (brow + ai * 128 + wr * 64) >> 6;
            int kind;
            int mixer = 0, isk = 0, hh = 0, H = 8; size_t qoff = 0, koff = 0, voff = 0;
            if (hg < 72) { mixer = 0; H = 24; qoff = OFF_QA; koff = OFF_KA; voff = OFF_VA; kind = hg < 48 ? 0 : 1; isk = hg >= 24; hh = hg % 24; }
            else if (hg < 96) { mixer = 1; qoff = OFF_QB; koff = OFF_KB; voff = OFF_VB; kind = hg < 88 ? 0 : 1; isk = hg >= 80; hh = (hg - 72) & 7; }
            else if (hg < 105) { kind = 2; isk = hg == 104; hh = hg - 96; }
            else if (hg < 129) { mixer = 2; qoff = OFF_QC; koff = OFF_KC; voff = OFF_VC; kind = hg < 121 ? 0 : 1; isk = hg >= 113; hh = (hg - 105) & 7; }
            else if (hg < 153) kind = 3;
            else if (hg < 201) kind = 4;
            else kind = hg == 201 ? 5 : 6;
            f32x4 gq4[4] = {};
            if (kind == 0) {
                const float* gq = p->qk_g + ((size_t)(layer * 3 + mixer) * 2 + isk) * 64 + fq * 16;
#pragma unroll
                for (int m = 0; m < 4; ++m) gq4[m] = *(const f32x4*)(gq + m * 4);
            }
#pragma unroll
            for (int bj = 0; bj < 2; ++bj) {
#pragma unroll
                for (int n = 0; n < 2; ++n) {
                    const int rho = bcol + bj * 128 + wc * 32 + n * 16 + fr;
                    const int tl = fold_tok(rho, shf);
                    const float rstd = rstd4[bj][n];
                    const int bl = tl >> 12, s = tl & (S - 1), rb = rho & (S - 1);
                    const int tg = gtok0 + tl;
                    float v[16];
#pragma unroll
                    for (int m = 0; m < 4; ++m)
#pragma unroll
                        for (int j = 0; j < 4; ++j) v[m * 4 + j] = acc[ai][bj][m][n][j] * rstd;

                    if (kind == 0 || kind == 2) {
                        if (kind == 0) {
                            float sq = 0.f;
#pragma unroll
                            for (int i = 0; i < 16; ++i) sq += v[i] * v[i];
                            sq += shx(sq, 16); sq += shx(sq, 32);
                            const float rn = rsqrtf(sq * (1.0f / 64) + 1e-6f) * (isk ? 1.0f : QSCALE);
#pragma unroll
                            for (int m = 0; m < 4; ++m) {
                                const f32x4 g4 = gq4[m];
#pragma unroll
                                for (int j = 0; j < 4; ++j) v[m * 4 + j] *= rn * g4[j];
                            }
                        }
                        if (fq == 0) {
                            const f32x4* cp = (const f32x4*)(cs + (size_t)tg * 8);
#pragma unroll
                            for (int i2 = 0; i2 < 4; ++i2) {
                                const f32x4 c2 = cp[i2];
                                const float x1a = v[2 * i2], x2a = v[8 + 2 * i2], x1b = v[2 * i2 + 1], x2b = v[8 + 2 * i2 + 1];
                                v[2 * i2] = x1a * c2[0] - x2a * c2[1]; v[8 + 2 * i2] = x2a * c2[0] + x1a * c2[1];
                                v[2 * i2 + 1] = x1b * c2[2] - x2b * c2[3]; v[8 + 2 * i2 + 1] = x2b * c2[2] + x1b * c2[3];
                            }
                        }
                        u32x4 w0, w1;
#pragma unroll
                        for (int i = 0; i < 4; ++i) { w0[i] = cvt_pk_bf16(v[2 * i], v[2 * i + 1]); w1[i] = cvt_pk_bf16(v[8 + 2 * i], v[8 + 2 * i + 1]); }
                        if (kind == 0 && isk) {
                            bf16_t* dst = (bf16_t*)(ws + koff) + ((size_t)(bl * H + hh) * 128 + (rb >> 5)) * 2048 + (size_t)(fq * 64 + (rb & 31)) * 8;
                            *(u32x4*)dst = w0; *(u32x4*)(dst + 32 * 8) = w1;
                        } else {
                            bf16_t* dst;
                            if (kind == 0) dst = (bf16_t*)(ws + qoff) + ((size_t)(bl * H + hh) * S + rb) * 64;
                            else dst = isk ? (bf16_t*)(ws + OFF_IK) + (size_t)tl * 64 : (bf16_t*)(ws + OFF_IQ) + ((size_t)(bl * 8 + hh) * S + s) * 64;
                            *(u32x4*)(dst + fq * 16) = w0; *(u32x4*)(dst + fq * 16 + 8) = w1;
                        }
                    } else if (kind == 1) {
                        const int k5 = rb & 31;
                        bf16_t* dst = (bf16_t*)(ws + voff) + ((size_t)(bl * H + hh) * 128 + (rb >> 5)) * 2048 + ((k5 >> 4) * 64 + ((k5 >> 2) & 1) * 32) * 8 + ((k5 >> 3) & 1) * 4 + (k5 & 3)
                                      + ((fq >> 1) * 128 + (fq & 1) * 16) * 8;
#pragma unroll
                        for (int i = 0; i < 16; ++i) dst[i * 8] = f2bf(v[i]);
                    } else if (kind == 3 || kind == 4) {
                        bf16_t* dst = (kind == 3 ? (bf16_t*)(ws + OFF_SZ) + (size_t)tl * 1536 + (hg - 129) * 64 : (bf16_t*)(ws + OFF_SG) + (size_t)tl * 3072 + (hg - 153) * 64) + fq * 16;
#pragma unroll
                        for (int i = 0; i < 16; ++i) { const float sg = __builtin_amdgcn_rcpf(1.0f + __expf(-v[i])); v[i] = kind == 3 ? v[i] * sg : sg; }
                        u32x4 w0, w1;
#pragma unroll
                        for (int i = 0; i < 4; ++i) { w0[i] = cvt_pk_bf16(v[2 * i], v[2 * i + 1]); w1[i] = cvt_pk_bf16(v[8 + 2 * i], v[8 + 2 * i + 1]); }
                        *(u32x4*)dst = w0; *(u32x4*)(dst + 8) = w1;
                    } else if (kind == 5) {
                        if (fq == 0) { f32x4 o0 = {v[0], v[1], v[2], v[3]}, o1 = {v[4], v[5], v[6], v[7]}; float* d = (float*)(ws + OFF_IW) + (size_t)tl * 8; *(f32x4*)d = o0; *(f32x4*)(d + 4) = o1; }
                    }
                }
            }
        }
        (void)lane; (void)sub; (void)tg_unused;
    }
};

struct EpiBr {
    const Params* p;
    DI void operator()(const f32x4 (&acc)[2][2][4][2], int brow, int bcol, int sub, int wr, int wc, int fr, int fq) const {
        char* ws = p->ws;
        const bf16_t* sg = (const bf16_t*)(ws + OFF_SG);
        float* mf = (float*)(ws + OFF_MF);
        bf16_t* mb = (bf16_t*)(ws + OFF_MB);
#pragma unroll
        for (int bj = 0; bj < 2; ++bj)
#pragma unroll
            for (int n = 0; n < 2; ++n) {
                const int tl = bcol + bj * 128 + wc * 32 + n * 16 + fr;
#pragma unroll
                for (int ai = 0; ai < 2; ++ai)
#pragma unroll
                    for (int m2 = 0; m2 < 2; ++m2) {
                        const int e = brow + ai * 128 + wr * 64 + fq * 16 + m2 * 8;
                        const u32x4 gw = *(const u32x4*)(sg + (size_t)tl * 3072 + sub * 1024 + e);
                        bf16_t* mp = mb + (size_t)tl * DM + e;
                        u32x4 pw = {0u, 0u, 0u, 0u};
                        if (sub > 0) pw = *(const u32x4*)mp;
                        u32x4 ow;
#pragma unroll
                        for (int hh2 = 0; hh2 < 2; ++hh2) {
                            const f32x4 g4 = {__uint_as_float(gw[2 * hh2] << 16), __uint_as_float(gw[2 * hh2] & 0xffff0000u), __uint_as_float(gw[2 * hh2 + 1] << 16), __uint_as_float(gw[2 * hh2 + 1] & 0xffff0000u)};
                            f32x4 r = acc[ai][bj][m2 * 2 + hh2][n] * g4;
                            if (sub > 0) r += (f32x4){__uint_as_float(pw[2 * hh2] << 16), __uint_as_float(pw[2 * hh2] & 0xffff0000u), __uint_as_float(pw[2 * hh2 + 1] << 16), __uint_as_float(pw[2 * hh2 + 1] & 0xffff0000u)};
                            ow[2 * hh2] = cvt_pk_bf16(r[0], r[1]); ow[2 * hh2 + 1] = cvt_pk_bf16(r[2], r[3]);
                        }
                        *(u32x4*)mp = ow;
                    }
                asm volatile("" ::: "memory");
            }
    }
};

struct EpiOut {
    const Params* p; int layer; int gtok0; bool st;
    DI void operator()(const f32x4 (&acc)[2][2][4][2], int brow, int bcol, int sub, int wr, int wc, int fr, int fq) const {
        char* ws = p->ws;
        const float* xin = layer == 0 ? p->x : p->out;
        bf16_t* xb = (bf16_t*)(ws + OFF_XB);
        float* ss = (float*)(ws + OFF_SS);
#pragma unroll
        for (int bj = 0; bj < 2; ++bj)
#pragma unroll
            for (int n = 0; n < 2; ++n) {
                const int tl = bcol + bj * 128 + wc * 32 + n * 16 + fr;
                const size_t tg = (size_t)gtok0 + tl;
                float sq = 0.f;
#pragma unroll
                for (int ai = 0; ai < 2; ++ai)
#pragma unroll
                    for (int m = 0; m < 4; ++m) {
                        const int e = brow + ai * 128 + wr * 64 + fq * 16 + m * 4;
                        f32x4 r = *(const f32x4*)(xin + tg * DM + e) + acc[ai][bj][m][n];
                        if (st) *(f32x4*)(p->out + tg * DM + e) = r;
                    }
            }
        (void)sub;
    }
};

DI void select_chunk(const Params& p, int bl, int c, char* shm) {
    char* ws = p.ws;
    const bf16_t* IQ = (const bf16_t*)(ws + OFF_IQ);
    const bf16_t* IK = (const bf16_t*)(ws + OFF_IK);
    const float* IW = (const float*)(ws + OFF_IW);
    unsigned* hist = (unsigned*)shm; unsigned* bits = (unsigned*)(shm + 16384);
    int* ctl = (int*)(shm + 24576); int* cnt = ctl, *mn = ctl + 16, *mx = ctl + 32, *bsel = ctl + 48, *needp = ctl + 64;
    u32x2* list = (u32x2*)(shm + 32768);
    const int tid = ltid(), lane = tid & 63, w = __builtin_amdgcn_readfirstlane(tid >> 6), q = lane & 15, g = lane >> 4;
    const int t0 = c * 16, tq = t0 + q;
    __syncthreads();
    for (int i = tid; i < 16 * 256 + 16 * 128; i += NTHREADS) hist[i] = 0;
    if (tid < 16) { cnt[tid] = 0; mn[tid] = 0x7fffffff; mx[tid] = (int)0x80000000; }
    bf16x8 qf[8][2]; float wq[8];
#pragma unroll
    for (int hd = 0; hd < 8; ++hd) {
        const bf16_t* qp = IQ + ((size_t)(bl * 8 + hd) * S + tq) * 64 + g * 8;
        qf[hd][0] = *(const bf16x8*)qp; qf[hd][1] = *(const bf16x8*)(qp + 32);
        wq[hd] = IW[(size_t)(bl * S + tq) * 8 + hd];
    }
    auto loadk = [&](int kt, bf16x8& k0, bf16x8& k1) {
        const bf16_t* kp = IK + ((size_t)bl * S + kt * 16 + q) * 64 + g * 8;
        k0 = *(const bf16x8*)kp; k1 = *(const bf16x8*)(kp + 32);
    };
    auto compute = [&](const bf16x8& k0, const bf16x8& k1) -> f32x4 {
        f32x4 sc = {0.f, 0.f, 0.f, 0.f};
#pragma unroll
        for (int hd = 0; hd < 8; ++hd) {
            f32x4 a = {0.f, 0.f, 0.f, 0.f};
            a = MFMA16(k0, qf[hd][0], a); a = MFMA16(k1, qf[hd][1], a);
#pragma unroll
            for (int j = 0; j < 4; ++j) sc[j] += wq[hd] * fmaxf(a[j], 0.f);
        }
        return sc;
    };
#define SEL_PASS(BODY) do { \
        const int cl = c - 1;     \
        bf16x8 ka0, ka1, kb0, kb1; int kt = w; \
        if (kt <= cl) loadk(kt, ka0, ka1); \
        if (kt + 8 <= cl) loadk(kt + 8, kb0, kb1); \
        for (; kt <= cl; kt += 16) { \
            { const f32x4 sc = compute(ka0, ka1); if (kt + 16 <= cl) loadk(kt + 16, ka0, ka1); const int ktc = kt; const bool diag = false; BODY } \
            if (kt + 8 <= cl) { const f32x4 sc = compute(kb0, kb1); if (kt + 24 <= cl) loadk(kt + 24, kb0, kb1); const int ktc = kt + 8; const bool diag = false; BODY } \
        } \
        if (w == (c & 7)) { loadk(c, ka0, ka1); const f32x4 sc = compute(ka0, ka1); const int ktc = c; const bool diag = true; BODY } \
    } while (0)
#define SEL_OK(j) (!diag || 4 * g + (j) <= q)
    __syncthreads();
    {
        float lo = 3.0e38f, hi = -3.0e38f;
        SEL_PASS({
            _Pragma("unroll") for (int j = 0; j < 4; ++j) if (SEL_OK(j)) { lo = fminf(lo, sc[j]); hi = fmaxf(hi, sc[j]); }
        });
        lo = fminf(lo, shx(lo, 16)); lo = fminf(lo, shx(lo, 32));
        hi = fmaxf(hi, shx(hi, 16)); hi = fmaxf(hi, shx(hi, 32));
        if (g == 0) { atomicMin(&mn[q], f2sort(lo)); atomicMax(&mx[q], f2sort(hi)); }
    }
    __syncthreads();
    const float rlo = sort2f(mn[q]), rhi = sort2f(mx[q]);
    const float rscale = rhi > rlo ? 256.0f / (rhi - rlo) : 0.f;
    SEL_PASS({
        _Pragma("unroll") for (int j = 0; j < 4; ++j) if (SEL_OK(j)) {
            int b = (int)((sc[j] - rlo) * rscale); b = b > 255 ? 255 : (b < 0 ? 0 : b);
            atomicAdd(&hist[q * 256 + b], 1u);
        }
    });
    __syncthreads();
    {
        const int row = tid >> 5, i = tid & 31;
        unsigned c8[8]; unsigned tot = 0;
#pragma unroll
        for (int k = 0; k < 8; ++k) { c8[k] = hist[row * 256 + i * 8 + k]; tot += c8[k]; }
        unsigned above = 0;
        {
            unsigned run = tot;
#pragma unroll
            for (int o = 1; o < 32; o <<= 1) { const int l_ = tid & 63; unsigned v = (unsigned)__builtin_amdgcn_ds_bpermute(((l_ + o) & 63) << 2, (int)run); if (i + o < 32) run += v; }
            above = run - tot;
        }
        const int trow = t0 + row; const unsigned need = trow + 1 < 256 ? trow + 1 : 256;
        if (above < need && above + tot >= need) {
            unsigned a = above;
#pragma unroll
            for (int k = 7; k >= 0; --k) { if (a < need && a + c8[k] >= need) { bsel[row] = i * 8 + k; needp[row] = (int)(need - a); } a += c8[k]; }
        }
    }
    __syncthreads();
    const int bstar = bsel[q];
    SEL_PASS({
        unsigned nib = 0;
        _Pragma("unroll") for (int j = 0; j < 4; ++j) if (SEL_OK(j)) {
            int b = (int)((sc[j] - rlo) * rscale); b = b > 255 ? 255 : (b < 0 ? 0 : b);
            if (b > bstar) nib |= 1u << j;
            else if (b == bstar) { int pos = atomicAdd(&cnt[q], 1); if (pos < SEL_CAP) { u32x2 e; e[0] = (unsigned)f2sort(sc[j]) ^ 0x80000000u; e[1] = ktc * 16 + 4 * g + j; list[q * SEL_CAP + pos] = e; } }
        }
        if (nib) atomicOr(&bits[q * 128 + (ktc >> 1)], nib << ((ktc & 1) * 16 + 4 * g));
    });
    __syncthreads();
    {
        const int row = tid >> 5, i = tid & 31;
        int n = cnt[row]; n = n < SEL_CAP ? n : SEL_CAP;
        const int need = needp[row];
        for (int a = i; a < n; a += 32) {
            const u32x2 ea = list[row * SEL_CAP + a];
            int rank = 0;
            for (int b = 0; b < n; ++b) { const u32x2 eb = list[row * SEL_CAP + b]; rank += (eb[0] > ea[0]) || (eb[0] == ea[0] && eb[1] < ea[1]); }
            if (rank < need) atomicOr(&bits[row * 128 + (ea[1] >> 5)], 1u << (ea[1] & 31));
        }
    }
    __syncthreads();
    unsigned* mask = (unsigned*)(ws + OFF_MASK) + ((size_t)bl * S + t0) * 128;
    for (int i = tid; i < 16 * 128; i += NTHREADS) mask[i] = bits[i];
}

DI void kmean_item(const Params& p, int bl, int h, int n, char* shm) {
    char* ws = p.ws;
    const bf16_t* K = (const bf16_t*)(ws + OFF_KC) + ((size_t)(bl * 8 + h) * 128 + n * 8) * 2048;
    float* red = (float*)shm;
    const int tid = ltid(), c = tid & 255, par = tid >> 8;
    float acc[8] = {0.f, 0.f, 0.f, 0.f, 0.f, 0.f, 0.f, 0.f};
#pragma unroll
    for (int it = 0; it < 4; ++it) {
        const u32x4 v = *(const u32x4*)(K + (size_t)(it * 2 + par) * 2048 + c * 8);
#pragma unroll
        for (int e = 0; e < 4; ++e) { acc[2 * e] += __uint_as_float(v[e] << 16); acc[2 * e + 1] += __uint_as_float(v[e] & 0xffff0000u); }
    }
    __syncthreads();
#pragma unroll
    for (int e = 0; e < 8; ++e) red[(par * 256 + c) * 8 + e] = acc[e];
    __syncthreads();
    if (tid < 64) {
        const int grp = tid >> 3, e = tid & 7;
        float t = 0.f;
        for (int pr = 0; pr < 2; ++pr) for (int r = 0; r < 32; ++r) t += red[(pr * 256 + grp * 32 + r) * 8 + e];
        t *= (1.0f / 256);
        bf16_t hi = f2bf(t); bf16_t lo = f2bf(t - bf2f(hi));
        bf16_t* km = (bf16_t*)(ws + OFF_KM) + (((size_t)(bl * 8 + h) * 16 + n) * 2) * 64;
        km[tid] = hi; km[64 + tid] = lo;
    }
}

struct AttnAcc { f32x16 o0, o1; float nb, l; bool shifted; };
DI void attn_init(AttnAcc& a, float nb) {
    float z = 0.f; asm volatile("" : "+v"(z));
#pragma unroll
    for (int i = 0; i < 16; ++i) { a.o0[i] = z; a.o1[i] = z; }
    a.shifted = __ballot(nb > 90.f) != 0ull;
    a.nb = a.shifted ? nb + z : z; a.l = z;
}
DI float attn_bound(const bf16x8 (&qf)[4], const float* gk) {
    float qs = 0.f;
#pragma unroll
    for (int kk = 0; kk < 4; ++kk)
#pragma unroll
        for (int e = 0; e < 8; ++e) { const float v = bf2f((bf16_t)qf[kk][e]); qs += v * v; }
    qs += shx(qs, 32);
    float gm = fabsf(gk[ltid() & 63]);
    for (int o = 32; o > 0; o >>= 1) gm = fmaxf(gm, shx(gm, o));
    return sqrtf(qs) * gm * 8.1f;
}
struct KVFrag { bf16x8 k[4]; bf16x8 v[2][2]; };
DI void kv_load(KVFrag& f, const bf16_t* Kt, const bf16_t* Vt, int lane) {
#pragma unroll
    for (int kk = 0; kk < 4; ++kk) f.k[kk] = *(const bf16x8*)(Kt + (kk * 64 + lane) * 8);
#pragma unroll
    for (int db = 0; db < 2; ++db)
#pragma unroll
        for (int u = 0; u < 2; ++u) f.v[db][u] = *(const bf16x8*)(Vt + ((db * 2 + u) * 64 + lane) * 8);
}
DI void attn_step(AttnAcc& a, const KVFrag& f, const bf16x8 (&qf)[4], unsigned vm) {
    f32x16 st;
    if (a.shifted) {
#pragma unroll
        for (int i = 0; i < 16; ++i) st[i] = -a.nb;
        st = MFMA32(f.k[0], qf[0], st);
    } else {
        st = MFMA32(f.k[0], qf[0], ((f32x16){0.f, 0.f, 0.f, 0.f, 0.f, 0.f, 0.f, 0.f, 0.f, 0.f, 0.f, 0.f, 0.f, 0.f, 0.f, 0.f}));
    }
#pragma unroll
    for (int kk = 1; kk < 4; ++kk) st = MFMA32(f.k[kk], qf[kk], st);
    float pv[16];
#pragma unroll
    for (int i = 0; i < 16; ++i) pv[i] = fexp2(st[i]);
    if (__ballot(vm != 0xffffu) != 0ull) {
#pragma unroll
        for (int i = 0; i < 16; ++i) pv[i] = __int_as_float(__float_as_int(pv[i]) & __builtin_amdgcn_sbfe((int)vm, i, 1));
    }
    a.l += ((pv[0] + pv[1]) + (pv[2] + pv[3])) + ((pv[4] + pv[5]) + (pv[6] + pv[7])) + (((pv[8] + pv[9]) + (pv[10] + pv[11])) + ((pv[12] + pv[13]) + (pv[14] + pv[15])));
    u32x4 p0, p1;
#pragma unroll
    for (int i = 0; i < 4; ++i) { p0[i] = cvt_pk_bf16(pv[2 * i], pv[2 * i + 1]); p1[i] = cvt_pk_bf16(pv[8 + 2 * i], pv[8 + 2 * i + 1]); }
    const bf16x8 pf0 = __builtin_bit_cast(bf16x8, p0), pf1 = __builtin_bit_cast(bf16x8, p1);
    a.o0 = MFMA32(f.v[0][0], pf0, a.o0); a.o0 = MFMA32(f.v[0][1], pf1, a.o0);
    a.o1 = MFMA32(f.v[1][0], pf0, a.o1); a.o1 = MFMA32(f.v[1][1], pf1, a.o1);
}
DI void load_q(bf16x8 (&qf)[4], const bf16_t* Qrow, int h) {
#pragma unroll
    for (int kk = 0; kk < 4; ++kk) qf[kk] = *(const bf16x8*)(Qrow + kk * 16 + h * 8);
}
DI int koff(int i, int h) { return 8 * (i >> 2) + 4 * h + (i & 3); }

DI void attn_a_item(const Params& p, int layer, int bl, int hh, int rb) {
    char* ws = p.ws;
    const int lane = ltid() & 63, w = __builtin_amdgcn_readfirstlane(ltid() >> 6), r = lane & 31, h = lane >> 5;
    const int g = hh >> 3, sh = 2 * g, n = S >> sh;
    const int row0 = rb * 256 + w * 32;
    const int rr = row0 / n, m0 = row0 % n;
    const bf16_t* Q = (const bf16_t*)(ws + OFF_QA) + (size_t)(bl * 24 + hh) * S * 64;
    const bf16_t* K = (const bf16_t*)(ws + OFF_KA) + (size_t)(bl * 24 + hh) * S * 64;
    const bf16_t* Vt = (const bf16_t*)(ws + OFF_VA) + (size_t)(bl * 24 + hh) * 64 * S;
    bf16x8 qf[4]; load_q(qf, Q + (size_t)(row0 + r) * 64, h);
    AttnAcc a; attn_init(a, attn_bound(qf, p.qk_g + ((size_t)(layer * 3 + 0) * 2 + 1) * 64));
    const int kfirst = m0 >= 128 ? 0 : (128 - m0) / 32;
    const int tile0 = (rr * n + m0 - 128) / 32 + 0;
    auto amask = [&](int k) -> unsigned {
        if (k != 0 && k != 4) return 0xffffu;
        const int mk0 = m0 - 128 + 32 * k; unsigned vm = 0;
#pragma unroll
        for (int i = 0; i < 16; ++i) { const int d = (m0 + r) - (mk0 + koff(i, h)); if (d >= 0 && d <= 128) vm |= 1u << i; }
        return vm;
    };
    KVFrag f0, f1; kv_load(f0, K + (size_t)(tile0 + kfirst) * 2048, Vt + (size_t)(tile0 + kfirst) * 2048, lane);
    for (int k = kfirst; k < 5; k += 2) {
        { const int kn = k + 1 < 5 ? k + 1 : k; kv_load(f1, K + (size_t)(tile0 + kn) * 2048, Vt + (size_t)(tile0 + kn) * 2048, lane); }
        attn_step(a, f0, qf, amask(k));
        if (k + 1 < 5) {
            { const int kn = k + 2 < 5 ? k + 2 : k + 1; kv_load(f0, K + (size_t)(tile0 + kn) * 2048, Vt + (size_t)(tile0 + kn) * 2048, lane); }
            attn_step(a, f1, qf, amask(k + 1));
        }
    }
    const float l = a.l + shx(a.l, 32);
    const float inv = 1.0f / l;
    const int s = ((m0 + r) << sh) + rr;
    const size_t tl = (size_t)bl * S + s;
    bf16_t* o = (bf16_t*)(ws + OFF_OA) + ((size_t)g * TG + tl) * 512 + (hh & 7) * 64;
#pragma unroll
    for (int q4 = 0; q4 < 4; ++q4) {
        u32x2 w0, w1;
        w0[0] = cvt_pk_bf16(a.o0[q4 * 4] * inv, a.o0[q4 * 4 + 1] * inv); w0[1] = cvt_pk_bf16(a.o0[q4 * 4 + 2] * inv, a.o0[q4 * 4 + 3] * inv);
        w1[0] = cvt_pk_bf16(a.o1[q4 * 4] * inv, a.o1[q4 * 4 + 1] * inv); w1[1] = cvt_pk_bf16(a.o1[q4 * 4 + 2] * inv, a.o1[q4 * 4 + 3] * inv);
        *(u32x2*)(o + 8 * q4 + 4 * h) = w0; *(u32x2*)(o + 32 + 8 * q4 + 4 * h) = w1;
    }
    if (h == 0) ((float*)(ws + OFF_LSE))[((size_t)g * TG + tl) * 8 + (hh & 7)] = (a.nb + __log2f(l)) * LN2F;
}

DI void attn_store_gated(const Params& p, const AttnAcc& a, size_t tl, int col0, int h, bool st) {
    const float l = a.l + shx(a.l, 32);
    const float inv = 1.0f / l;
    bf16_t* z = (bf16_t*)(p.ws + OFF_SZ) + tl * 1536 + col0;
#pragma unroll
    for (int q4 = 0; q4 < 4; ++q4) {
#pragma unroll
        for (int db = 0; db < 2; ++db) {
            bf16_t* zp = z + db * 32 + 8 * q4 + 4 * h;
            const u32x2 zw = *(const u32x2*)zp;
            const float z0 = __uint_as_float(zw[0] << 16), z1 = __uint_as_float(zw[0] & 0xffff0000u), z2 = __uint_as_float(zw[1] << 16), z3 = __uint_as_float(zw[1] & 0xffff0000u);
            const f32x16& o = db ? a.o1 : a.o0;
            u32x2 wv; wv[0] = cvt_pk_bf16(o[q4 * 4] * inv * z0, o[q4 * 4 + 1] * inv * z1); wv[1] = cvt_pk_bf16(o[q4 * 4 + 2] * inv * z2, o[q4 * 4 + 3] * inv * z3);
            if (st) *(u32x2*)zp = wv;
        }
    }
}

DI void attn_b_item(const Params& p, int layer, int bl, int hd, int qb, bool st, int var) {
    char* ws = p.ws;
    const int lane = ltid() & 63, w = __builtin_amdgcn_readfirstlane(ltid() >> 6), r = lane & 31, h = lane >> 5;
    const int q0 = qb * 256 + w * 32;
    const bf16_t* Q = (const bf16_t*)(ws + OFF_QB) + (size_t)(bl * 8 + hd) * S * 64;
    const bf16_t* K = (const bf16_t*)(ws + OFF_KB) + (size_t)(bl * 8 + hd) * S * 64;
    const bf16_t* Vt = (const bf16_t*)(ws + OFF_VB) + (size_t)(bl * 8 + hd) * 64 * S;
    const unsigned* mrow = (const unsigned*)(ws + OFF_MASK) + ((size_t)bl * S + q0 + r) * 128;
    bf16x8 qf[4]; load_q(qf, Q + (size_t)(q0 + r) * 64, h);
    AttnAcc a; attn_init(a, attn_bound(qf, p.qk_g + ((size_t)(layer * 3 + 1) * 2 + 1) * 64));
    const int nkt = q0 / 32 + 1;
    auto bmask = [&](unsigned mw) -> unsigned {
        const unsigned ws4 = mw >> (4 * h);
        return (ws4 & 0xfu) | ((ws4 >> 4) & 0xf0u) | ((ws4 >> 8) & 0xf00u) | ((ws4 >> 12) & 0xf000u);
    };
    KVFrag f0, f1; kv_load(f0, K, Vt, lane);
    unsigned mw0 = mrow[0], mw1 = 0;
    const int tmul = var == 1 ? 0 : 1;
    for (int kt = 0; kt < nkt; kt += 2) {
        { const int kn = (kt + 1 < nkt ? kt + 1 : kt) * tmul; kv_load(f1, K + (size_t)kn * 2048, Vt + (size_t)kn * 2048, lane); mw1 = mrow[kn]; }
        if (var == 2) a.l += __int_as_float((int)f0.k[0][0] + (int)f0.k[3][7] + (int)f0.v[0][0][0] + (int)f0.v[1][1][7] + (int)mw0); else
        attn_step(a, f0, qf, bmask(mw0));
        if (kt + 1 < nkt) {
            { const int kn = (kt + 2 < nkt ? kt + 2 : kt + 1) * tmul; kv_load(f0, K + (size_t)kn * 2048, Vt + (size_t)kn * 2048, lane); mw0 = mrow[kn]; }
            if (var == 2) a.l += __int_as_float((int)f1.k[0][0] + (int)f1.k[3][7] + (int)f1.v[0][0][0] + (int)f1.v[1][1][7] + (int)mw1); else
            attn_step(a, f1, qf, bmask(mw1));
        }
    }
    attn_store_gated(p, a, (size_t)bl * S + q0 + r, 512 + hd * 64, h, st);
}

DI void attn_c_item(const Params& p, int layer, int bl, int hd, int qb, bool st) {
    char* ws = p.ws;
    const int lane = ltid() & 63, w = __builtin_amdgcn_readfirstlane(ltid() >> 6), r = lane & 31, h = lane >> 5;
    const int q0 = qb * 256 + w * 32, own = qb;
    const bf16_t* Q = (const bf16_t*)(ws + OFF_QC) + (size_t)(bl * 8 + hd) * S * 64;
    const bf16_t* K = (const bf16_t*)(ws + OFF_KC) + (size_t)(bl * 8 + hd) * S * 64;
    const bf16_t* Vt = (const bf16_t*)(ws + OFF_VC) + (size_t)(bl * 8 + hd) * 64 * S;
    bf16x8 qf[4]; load_q(qf, Q + (size_t)(q0 + r) * 64, h);
    unsigned sel = 0;
    if (own > 0) {
        const bf16_t* km = (const bf16_t*)(ws + OFF_KM) + (((size_t)(bl * 8 + hd) * 16 + (r & 15)) * 2) * 64;
        f32x16 gt;
#pragma unroll
        for (int i = 0; i < 16; ++i) gt[i] = 0.f;
#pragma unroll
        for (int kk = 0; kk < 4; ++kk) {
            bf16x8 ahi = *(const bf16x8*)(km + kk * 16 + h * 8), alo = *(const bf16x8*)(km + 64 + kk * 16 + h * 8);
            if (r >= 16) { ahi = (bf16x8){0, 0, 0, 0, 0, 0, 0, 0}; alo = ahi; }
            gt = MFMA32(ahi, qf[kk], gt); gt = MFMA32(alo, qf[kk], gt);
        }
        float gl[16];
#pragma unroll
        for (int i = 0; i < 8; ++i) {
            const float mine = gt[i], oth = shx(mine, 32);
            const int blk_mine = 8 * (i >> 2) + 4 * h + (i & 3), blk_oth = 8 * (i >> 2) + 4 * (1 - h) + (i & 3);
            (void)blk_mine; (void)blk_oth;
            gl[8 * (i >> 2) + (i & 3)] = h == 0 ? mine : oth;
            gl[8 * (i >> 2) + 4 + (i & 3)] = h == 0 ? oth : mine;
        }
#pragma unroll
        for (int pick = 0; pick < 3; ++pick) {
            float best = -3.0e38f; int bi = -1;
#pragma unroll
            for (int nb = 0; nb < 16; ++nb) { const bool ok = nb < own && !((sel >> nb) & 1u); if (ok && gl[nb] > best) { best = gl[nb]; bi = nb; } }
            if (bi >= 0) sel |= 1u << bi;
        }
    }
    AttnAcc a; attn_init(a, attn_bound(qf, p.qk_g + ((size_t)(layer * 3 + 2) * 2 + 1) * 64));
    unsigned vis = 0;
    for (int nb = 0; nb < own; ++nb) if (__ballot((sel >> nb) & 1u) != 0ull) vis |= 1u << nb;
    const int ndiag = q0 / 32;
    unsigned long long tm0 = 0ull, tm1 = 0ull;
    for (int nb = 0; nb < own; ++nb) if ((vis >> nb) & 1u) { if (nb < 8) tm0 |= 0xffull << (8 * nb); else tm1 |= 0xffull << (8 * (nb - 8)); }
    for (int t = own * 8; t <= ndiag; ++t) { if (t < 64) tm0 |= 1ull << t; else tm1 |= 1ull << (t - 64); }
    int ntl = __builtin_popcountll(tm0) + __builtin_popcountll(tm1);
    auto pop = [&]() -> int { int t; if (tm0) { t = __builtin_ctzll(tm0); tm0 &= tm0 - 1; } else if (tm1) { t = 64 + __builtin_ctzll(tm1); tm1 &= tm1 - 1; } else t = ndiag; return t; };
    auto cmask = [&](int t) -> unsigned {
        const int cb = t >> 3;
        if (cb < own) return ((sel >> cb) & 1u) ? 0xffffu : 0u;
        if (t != ndiag) return 0xffffu;
        unsigned vm = 0;
#pragma unroll
        for (int i = 0; i < 16; ++i) if (koff(i, h) <= r) vm |= 1u << i;
        return vm;
    };
    KVFrag f0, f1; int t0 = pop(), t1 = 0;
    kv_load(f0, K + (size_t)t0 * 2048, Vt + (size_t)t0 * 2048, lane);
    for (int it = 0; it < ntl; it += 2) {
        t1 = pop(); kv_load(f1, K + (size_t)t1 * 2048, Vt + (size_t)t1 * 2048, lane);
        attn_step(a, f0, qf, cmask(t0));
        if (it + 1 < ntl) {
            t0 = pop(); kv_load(f0, K + (size_t)t0 * 2048, Vt + (size_t)t0 * 2048, lane);
            attn_step(a, f1, qf, cmask(t1));
        }
    }
    attn_store_gated(p, a, (size_t)bl * S + q0 + r, 1024 + hd * 64, h, st);
}

DI void attn_bc_item(const Params& p, int layer, int typ, int bl, int hd, int qb, bool st, char* shm) {
    char* ws = p.ws;
    const int tid = ltid(), lane = tid & 63, w = tid >> 6, r = lane & 31, h = lane >> 5;
    const int q0 = qb * 256 + w * 32, own = qb, ndiag = q0 / 32;
    const bf16_t* Q = (const bf16_t*)(ws + (typ ? OFF_QC : OFF_QB)) + (size_t)(bl * 8 + hd) * S * 64;
    const bf16_t* K = (const bf16_t*)(ws + (typ ? OFF_KC : OFF_KB)) + (size_t)(bl * 8 + hd) * S * 64;
    const bf16_t* Vt = (const bf16_t*)(ws + (typ ? OFF_VC : OFF_VB)) + (size_t)(bl * 8 + hd) * 64 * S;
    const unsigned* mrow = (const unsigned*)(ws + OFF_MASK) + ((size_t)bl * S + q0 + r) * 128;
    unsigned short* seq = (unsigned short*)(shm + 16384);
    unsigned* wvis = (unsigned*)(shm + 16896);
    bf16x8 qf[4]; load_q(qf, Q + (size_t)(q0 + r) * 64, h);
    unsigned sel = 0, vis = 0;
    if (typ == 1 && own > 0) {
        const bf16_t* km = (const bf16_t*)(ws + OFF_KM) + (((size_t)(bl * 8 + hd) * 16 + (r & 15)) * 2) * 64;
        f32x16 gt;
#pragma unroll
        for (int i = 0; i < 16; ++i) gt[i] = 0.f;
#pragma unroll
        for (int kk = 0; kk < 4; ++kk) {
            bf16x8 ahi = *(const bf16x8*)(km + kk * 16 + h * 8), alo = *(const bf16x8*)(km + 64 + kk * 16 + h * 8);
            if (r >= 16) { ahi = (bf16x8){0, 0, 0, 0, 0, 0, 0, 0}; alo = ahi; }
            gt = MFMA32(ahi, qf[kk], gt); gt = MFMA32(alo, qf[kk], gt);
        }
        float gl[16];
#pragma unroll
        for (int i = 0; i < 8; ++i) {
            const float mine = gt[i], oth = shx(mine, 32);
            gl[8 * (i >> 2) + (i & 3)] = h == 0 ? mine : oth;
            gl[8 * (i >> 2) + 4 + (i & 3)] = h == 0 ? oth : mine;
        }
#pragma unroll
        for (int pick = 0; pick < 3; ++pick) {
            float best = -3.0e38f; int bi = -1;
#pragma unroll
            for (int nb = 0; nb < 16; ++nb) { const bool ok = nb < own && !((sel >> nb) & 1u); if (ok && gl[nb] > best) { best = gl[nb]; bi = nb; } }
            if (bi >= 0) sel |= 1u << bi;
        }
        for (int nb = 0; nb < own; ++nb) if (__ballot((sel >> nb) & 1u) != 0ull) vis |= 1u << nb;
    }
    if (typ == 0) vis = (1u << own) - 1u;
    __syncthreads();
    if (lane == 0) wvis[w] = vis;
    __syncthreads();
    if (tid == 0) {
        unsigned bv = 0;
        for (int i = 0; i < 8; ++i) bv |= wvis[i];
        int n = 0;
        for (int nb = 0; nb < own; ++nb) if ((bv >> nb) & 1u) for (int k = 0; k < 8; ++k) seq[n++] = (unsigned short)(nb * 8 + k);
        for (int k = 0; k < 8; ++k) seq[n++] = (unsigned short)(own * 8 + k);
        seq[255] = (unsigned short)n;
    }
    __syncthreads();
    const int ntl = seq[255];
    const bf16_t* gsrc = (tid < 256 ? K : Vt) + (size_t)(tid & 255) * 8;
    char* lds_dst = shm + tid * 16;
    u32x4 R = *(const u32x4*)(gsrc + (size_t)seq[0] * 2048);
    *(u32x4*)lds_dst = R;
    if (ntl > 1) R = *(const u32x4*)(gsrc + (size_t)seq[1] * 2048);
    AttnAcc a; attn_init(a, attn_bound(qf, p.qk_g + ((size_t)(layer * 3 + 1 + typ) * 2 + 1) * 64));
    unsigned mw = typ == 0 ? mrow[seq[0]] : 0u;
    __syncthreads();
    for (int t = 0; t < ntl; ++t) {
        const int ct = seq[t], cb = ct >> 3;
        unsigned mwn = 0;
        if (typ == 0 && t + 1 < ntl) mwn = mrow[seq[t + 1]];
        const bool need = cb < own ? ((vis >> cb) & 1u) != 0u : ct <= ndiag;
        if (need) {
            const char* buf = shm + (t & 1) * 8192;
            KVFrag f;
#pragma unroll
            for (int kk = 0; kk < 4; ++kk) f.k[kk] = *(const bf16x8*)(buf + (kk * 64 + lane) * 16);
#pragma unroll
            for (int db = 0; db < 2; ++db)
#pragma unroll
                for (int u = 0; u < 2; ++u) f.v[db][u] = *(const bf16x8*)(buf + 4096 + ((db * 2 + u) * 64 + lane) * 16);
            unsigned vm;
            if (typ == 0) {
                const unsigned ws4 = mw >> (4 * h);
                vm = (ws4 & 0xfu) | ((ws4 >> 4) & 0xf0u) | ((ws4 >> 8) & 0xf00u) | ((ws4 >> 12) & 0xf000u);
            } else if (cb < own) vm = ((sel >> cb) & 1u) ? 0xffffu : 0u;
            else if (ct == ndiag) {
                vm = 0;
#pragma unroll
                for (int i = 0; i < 16; ++i) if (koff(i, h) <= r) vm |= 1u << i;
            } else vm = 0xffffu;
            attn_step(a, f, qf, vm);
        }
        if (t + 1 < ntl) {
            *(u32x4*)(lds_dst + ((t + 1) & 1) * 8192) = R;
            if (t + 2 < ntl) R = *(const u32x4*)(gsrc + (size_t)seq[t + 2] * 2048);
        }
        mw = mwn;
        __syncthreads();
    }
    attn_store_gated(p, a, (size_t)bl * S + q0 + r, (typ ? 1024 : 512) + hd * 64, h, st);
}

template <int TYP>
DI void attn_step2(AttnAcc& a0, AttnAcc& a1, KVFrag& f, const bf16x8 (&qa)[4], const bf16x8 (&qb)[4], unsigned vm0, unsigned vm1, bool shifted, const bf16_t* Kn, const bf16_t* Vn, int lane) {
    f32x16 s0, s1;
    __builtin_amdgcn_s_setprio(1);
    if (shifted) {
#pragma unroll
        for (int i = 0; i < 16; ++i) { s0[i] = -a0.nb; s1[i] = -a1.nb; }
        s0 = MFMA32(f.k[0], qa[0], s0); s1 = MFMA32(f.k[0], qb[0], s1);
    } else {
        const f32x16 z = {0.f, 0.f, 0.f, 0.f, 0.f, 0.f, 0.f, 0.f, 0.f, 0.f, 0.f, 0.f, 0.f, 0.f, 0.f, 0.f};
        s0 = MFMA32(f.k[0], qa[0], z); s1 = MFMA32(f.k[0], qb[0], z);
    }
#pragma unroll
    for (int kk = 1; kk < 4; ++kk) { s0 = MFMA32(f.k[kk], qa[kk], s0); s1 = MFMA32(f.k[kk], qb[kk], s1); }
    __builtin_amdgcn_s_setprio(0);
#pragma unroll
    for (int kk = 0; kk < 4; ++kk) f.k[kk] = *(const bf16x8*)(Kn + (kk * 64 + lane) * 8);
    float p0[16], p1[16];
#pragma unroll
    for (int i = 0; i < 16; ++i) { p0[i] = fexp2(s0[i]); p1[i] = fexp2(s1[i]); }
    if (TYP == 0 || __ballot((vm0 & vm1) != 0xffffu) != 0ull) {
#pragma unroll
        for (int i = 0; i < 16; ++i) {
            p0[i] = __int_as_float(__float_as_int(p0[i]) & __builtin_amdgcn_sbfe((int)vm0, i, 1));
            p1[i] = __int_as_float(__float_as_int(p1[i]) & __builtin_amdgcn_sbfe((int)vm1, i, 1));
        }
    }
    a0.l += ((p0[0] + p0[1]) + (p0[2] + p0[3])) + ((p0[4] + p0[5]) + (p0[6] + p0[7])) + (((p0[8] + p0[9]) + (p0[10] + p0[11])) + ((p0[12] + p0[13]) + (p0[14] + p0[15])));
    a1.l += ((p1[0] + p1[1]) + (p1[2] + p1[3])) + ((p1[4] + p1[5]) + (p1[6] + p1[7])) + (((p1[8] + p1[9]) + (p1[10] + p1[11])) + ((p1[12] + p1[13]) + (p1[14] + p1[15])));
    u32x4 w00, w01, w10, w11;
#pragma unroll
    for (int i = 0; i < 4; ++i) {
        w00[i] = cvt_pk_bf16(p0[2 * i], p0[2 * i + 1]); w01[i] = cvt_pk_bf16(p0[8 + 2 * i], p0[8 + 2 * i + 1]);
        w10[i] = cvt_pk_bf16(p1[2 * i], p1[2 * i + 1]); w11[i] = cvt_pk_bf16(p1[8 + 2 * i], p1[8 + 2 * i + 1]);
    }
    const bf16x8 f00 = __builtin_bit_cast(bf16x8, w00), f01 = __builtin_bit_cast(bf16x8, w01), f10 = __builtin_bit_cast(bf16x8, w10), f11 = __builtin_bit_cast(bf16x8, w11);
    __builtin_amdgcn_s_setprio(1);
    a0.o0 = MFMA32(f.v[0][0], f00, a0.o0); a1.o0 = MFMA32(f.v[0][0], f10, a1.o0);
    a0.o0 = MFMA32(f.v[0][1], f01, a0.o0); a1.o0 = MFMA32(f.v[0][1], f11, a1.o0);
    a0.o1 = MFMA32(f.v[1][0], f00, a0.o1); a1.o1 = MFMA32(f.v[1][0], f10, a1.o1);
    a0.o1 = MFMA32(f.v[1][1], f01, a0.o1); a1.o1 = MFMA32(f.v[1][1], f11, a1.o1);
    __builtin_amdgcn_s_setprio(0);
#pragma unroll
    for (int db = 0; db < 2; ++db)
#pragma unroll
        for (int u = 0; u < 2; ++u) f.v[db][u] = *(const bf16x8*)(Vn + ((db * 2 + u) * 64 + lane) * 8);
}
template <int TYP>
DI void attn_bc2_chunk(const Params& p, int layer, int bl, int hd, int cidx  , bool st) {
    char* ws = p.ws;
    const int lane = ltid() & 63, w = __builtin_amdgcn_readfirstlane(ltid() >> 6), r = lane & 31, h = lane >> 5;
    const int own = cidx >> 2, q0 = cidx * 64;
    const bf16_t* Q = (const bf16_t*)(ws + (TYP ? OFF_QC : OFF_QB)) + (size_t)(bl * 8 + hd) * S * 64;
    const bf16_t* K = (const bf16_t*)(ws + (TYP ? OFF_KC : OFF_KB)) + (size_t)(bl * 8 + hd) * S * 64;
    const bf16_t* Vt = (const bf16_t*)(ws + (TYP ? OFF_VC : OFF_VB)) + (size_t)(bl * 8 + hd) * 64 * S;
    const unsigned* mrow0 = (const unsigned*)(ws + OFF_MASK) + ((size_t)bl * S + q0 + r) * 128;
    const unsigned* mrow1 = mrow0 + 32 * 128;
    bf16x8 qa[4], qb[4];
    load_q(qa, Q + (size_t)(q0 + r) * 64, h); load_q(qb, Q + (size_t)(q0 + 32 + r) * 64, h);
    const float* gk = p.qk_g + ((size_t)(layer * 3 + 1 + TYP) * 2 + 1) * 64;
    AttnAcc a0, a1; attn_init(a0, attn_bound(qa, gk)); attn_init(a1, attn_bound(qb, gk));
    const bool shifted = a0.shifted || a1.shifted;
    if (shifted && !a0.shifted) a0.nb = 0.f;
    if (shifted && !a1.shifted) a1.nb = 0.f;
    const int d0 = q0 / 32, d1 = d0 + 1;
    unsigned sel0 = 0, sel1 = 0;
    unsigned long long tm0 = 0ull, tm1 = 0ull;
    if (TYP == 1) {
        if (own > 0) {
            const bf16_t* km = (const bf16_t*)(ws + OFF_KM) + (((size_t)(bl * 8 + hd) * 16 + (r & 15)) * 2) * 64;
            f32x16 g0, g1;
#pragma unroll
            for (int i = 0; i < 16; ++i) { g0[i] = 0.f; g1[i] = 0.f; }
#pragma unroll
            for (int kk = 0; kk < 4; ++kk) {
                bf16x8 ahi = *(const bf16x8*)(km + kk * 16 + h * 8), alo = *(const bf16x8*)(km + 64 + kk * 16 + h * 8);
                if (r >= 16) { ahi = (bf16x8){0, 0, 0, 0, 0, 0, 0, 0}; alo = ahi; }
                g0 = MFMA32(ahi, qa[kk], g0); g0 = MFMA32(alo, qa[kk], g0);
                g1 = MFMA32(ahi, qb[kk], g1); g1 = MFMA32(alo, qb[kk], g1);
            }
            auto top3 = [&](const f32x16& gt) -> unsigned {
                float gl[16];
#pragma unroll
                for (int i = 0; i < 8; ++i) {
                    const float mine = gt[i], oth = shx(mine, 32);
                    gl[8 * (i >> 2) + (i & 3)] = h == 0 ? mine : oth;
                    gl[8 * (i >> 2) + 4 + (i & 3)] = h == 0 ? oth : mine;
                }
                unsigned sel = 0;
#pragma unroll
                for (int pick = 0; pick < 3; ++pick) {
                    float best = -3.0e38f; int bi = -1;
#pragma unroll
                    for (int nb = 0; nb < 16; ++nb) { const bool ok = nb < own && !((sel >> nb) & 1u); if (ok && gl[nb] > best) { best = gl[nb]; bi = nb; } }
                    if (bi >= 0) sel |= 1u << bi;
                }
                return sel;
            };
            sel0 = top3(g0); sel1 = top3(g1);
        }
        for (int nb = 0; nb < own; ++nb) if (__ballot(((sel0 | sel1) >> nb) & 1u) != 0ull) { if (nb < 8) tm0 |= 0xffull << (8 * nb); else tm1 |= 0xffull << (8 * (nb - 8)); }
        for (int t = own * 8; t <= d1; ++t) { if (t < 64) tm0 |= 1ull << t; else tm1 |= 1ull << (t - 64); }
    } else {
        for (int t = 0; t <= d1; ++t) { if (t < 64) tm0 |= 1ull << t; else tm1 |= 1ull << (t - 64); }
    }
    const int ntl = __builtin_popcountll(tm0) + __builtin_popcountll(tm1);
    auto pop = [&]() -> int { int t; if (tm0) { t = __builtin_ctzll(tm0); tm0 &= tm0 - 1; } else if (tm1) { t = 64 + __builtin_ctzll(tm1); tm1 &= tm1 - 1; } else t = d1; return t; };
    auto cmask = [&](int t, unsigned sel, int dg) -> unsigned {
        const int cb = t >> 3;
        if (cb < own) return ((sel >> cb) & 1u) ? 0xffffu : 0u;
        if (t < dg) return 0xffffu;
        if (t > dg) return 0u;
        unsigned vm = 0;
#pragma unroll
        for (int i = 0; i < 16; ++i) if (koff(i, h) <= r) vm |= 1u << i;
        return vm;
    };
    auto bmask = [&](unsigned mw) -> unsigned {
        const unsigned ws4 = mw >> (4 * h);
        return (ws4 & 0xfu) | ((ws4 >> 4) & 0xf0u) | ((ws4 >> 8) & 0xf00u) | ((ws4 >> 12) & 0xf000u);
    };
    KVFrag f; int tc = pop(), tn = 0;
    kv_load(f, K + (size_t)tc * 2048, Vt + (size_t)tc * 2048, lane);
    unsigned mwa = 0, mwb = 0, mwan = 0, mwbn = 0;
    if (TYP == 0) { mwa = mrow0[tc]; mwb = mrow1[tc]; }
    for (int it = 0; it < ntl; ++it) {
        tn = pop();
        if (TYP == 0) { mwan = mrow0[tn]; mwbn = mrow1[tn]; }
        unsigned vm0, vm1;
        if (TYP == 0) { vm0 = bmask(mwa); vm1 = bmask(mwb); } else { vm0 = cmask(tc, sel0, d0); vm1 = cmask(tc, sel1, d1); }
        attn_step2<TYP>(a0, a1, f, qa, qb, vm0, vm1, shifted, K + (size_t)tn * 2048, Vt + (size_t)tn * 2048, lane);
        tc = tn; mwa = mwan; mwb = mwbn;
    }
    attn_store_gated(p, a0, (size_t)bl * S + q0 + r, (TYP ? 1024 : 512) + hd * 64, h, st);
    attn_store_gated(p, a1, (size_t)bl * S + q0 + 32 + r, (TYP ? 1024 : 512) + hd * 64, h, st);
}

DI void attn_a2_item(const Params& p, int layer, int bl, int hh, int rb2) {
    char* ws = p.ws;
    const int lane = ltid() & 63, w = __builtin_amdgcn_readfirstlane(ltid() >> 6), r = lane & 31, h = lane >> 5;
    const int g = hh >> 3, sh = 2 * g, n = S >> sh;
    const int row0 = rb2 * 512 + w * 64;
    const int rr = row0 / n, m0 = row0 % n;
    const bf16_t* Q = (const bf16_t*)(ws + OFF_QA) + (size_t)(bl * 24 + hh) * S * 64;
    const bf16_t* K = (const bf16_t*)(ws + OFF_KA) + (size_t)(bl * 24 + hh) * S * 64;
    const bf16_t* Vt = (const bf16_t*)(ws + OFF_VA) + (size_t)(bl * 24 + hh) * 64 * S;
    bf16x8 qa[4], qb[4];
    load_q(qa, Q + (size_t)(row0 + r) * 64, h); load_q(qb, Q + (size_t)(row0 + 32 + r) * 64, h);
    const float* gk = p.qk_g + ((size_t)(layer * 3 + 0) * 2 + 1) * 64;
    AttnAcc a0, a1; attn_init(a0, attn_bound(qa, gk)); attn_init(a1, attn_bound(qb, gk));
    const bool shifted = a0.shifted || a1.shifted;
    if (shifted && !a0.shifted) a0.nb = 0.f;
    if (shifted && !a1.shifted) a1.nb = 0.f;
    const int kfirst = m0 >= 128 ? 0 : (128 - m0) / 32;
    const int tile0 = (rr * n + m0 - 128) / 32;
    auto amask = [&](int k, int sb) -> unsigned {
        const int base = 128 + 32 * sb - 32 * k + r;
        if (base - 31 >= 0 && base <= 128) return 0xffffu;
        if (base < 0 || base - 31 > 128) return 0u;
        unsigned vm = 0;
#pragma unroll
        for (int i = 0; i < 16; ++i) { const int d = base - koff(i, h); if (d >= 0 && d <= 128) vm |= 1u << i; }
        return vm;
    };
    KVFrag f; kv_load(f, K + (size_t)(tile0 + kfirst) * 2048, Vt + (size_t)(tile0 + kfirst) * 2048, lane);
    for (int k = kfirst; k < 6; ++k) {
        const int kn = k + 1 < 6 ? k + 1 : k;
        attn_step2<1>(a0, a1, f, qa, qb, amask(k, 0), amask(k, 1), shifted, K + (size_t)(tile0 + kn) * 2048, Vt + (size_t)(tile0 + kn) * 2048, lane);
    }
#pragma unroll
    for (int sb = 0; sb < 2; ++sb) {
        const AttnAcc& a = sb ? a1 : a0;
        const float l = a.l + shx(a.l, 32);
        const float inv = 1.0f / l;
        const int s_ = ((m0 + 32 * sb + r) << sh) + rr;
        const size_t tl = (size_t)bl * S + s_;
        bf16_t* o = (bf16_t*)(ws + OFF_OA) + ((size_t)g * TG + tl) * 512 + (hh & 7) * 64;
#pragma unroll
        for (int q4 = 0; q4 < 4; ++q4) {
            u32x2 w0, w1;
            w0[0] = cvt_pk_bf16(a.o0[q4 * 4] * inv, a.o0[q4 * 4 + 1] * inv); w0[1] = cvt_pk_bf16(a.o0[q4 * 4 + 2] * inv, a.o0[q4 * 4 + 3] * inv);
            w1[0] = cvt_pk_bf16(a.o1[q4 * 4] * inv, a.o1[q4 * 4 + 1] * inv); w1[1] = cvt_pk_bf16(a.o1[q4 * 4 + 2] * inv, a.o1[q4 * 4 + 3] * inv);
            *(u32x2*)(o + 8 * q4 + 4 * h) = w0; *(u32x2*)(o + 32 + 8 * q4 + 4 * h) = w1;
        }
        if (h == 0) ((float*)(ws + OFF_LSE))[((size_t)g * TG + tl) * 8 + (hh & 7)] = (a.nb + __log2f(l)) * LN2F;
    }
}

DI void merge_a_item(const Params& p, int item, bool st) {
    char* ws = p.ws;
    const int tid = ltid();
    const bf16_t* oa = (const bf16_t*)(ws + OFF_OA);
    const float* lse = (const float*)(ws + OFF_LSE);
    bf16_t* sz = (bf16_t*)(ws + OFF_SZ);
    const int c8 = (tid & 63) * 8, hd = c8 >> 6;
    for (int it = 0; it < 8; it += 4) {
        float l0[4], l1[4], l2[4]; u32x4 a0[4], a1[4], a2[4], zz[4];
#pragma unroll
        for (int u = 0; u < 4; ++u) {
            const size_t tl = (size_t)item * 64 + (it + u) * 8 + (tid >> 6);
            l0[u] = lse[(0 * (size_t)TG + tl) * 8 + hd]; l1[u] = lse[(1 * (size_t)TG + tl) * 8 + hd]; l2[u] = lse[(2 * (size_t)TG + tl) * 8 + hd];
            a0[u] = *(const u32x4*)(oa + (0 * (size_t)TG + tl) * 512 + c8); a1[u] = *(const u32x4*)(oa + (1 * (size_t)TG + tl) * 512 + c8); a2[u] = *(const u32x4*)(oa + (2 * (size_t)TG + tl) * 512 + c8);
            zz[u] = *(const u32x4*)(sz + tl * 1536 + c8);
        }
#pragma unroll
        for (int u = 0; u < 4; ++u) {
            const size_t tl = (size_t)item * 64 + (it + u) * 8 + (tid >> 6);
            const float mx = fmaxf(l0[u], fmaxf(l1[u], l2[u]));
            float w0 = __expf(l0[u] - mx), w1 = __expf(l1[u] - mx), w2 = __expf(l2[u] - mx);
            const float inv = 1.0f / (w0 + w1 + w2); w0 *= inv; w1 *= inv; w2 *= inv;
            u32x4 res;
#pragma unroll
            for (int k = 0; k < 4; ++k) {
                const float lo = (w0 * __uint_as_float(a0[u][k] << 16) + w1 * __uint_as_float(a1[u][k] << 16) + w2 * __uint_as_float(a2[u][k] << 16)) * __uint_as_float(zz[u][k] << 16);
                const float hi = (w0 * __uint_as_float(a0[u][k] & 0xffff0000u) + w1 * __uint_as_float(a1[u][k] & 0xffff0000u) + w2 * __uint_as_float(a2[u][k] & 0xffff0000u)) * __uint_as_float(zz[u][k] & 0xffff0000u);
                res[k] = cvt_pk_bf16(lo, hi);
            }
            if (st) *(u32x4*)(sz + tl * 1536 + c8) = res;
        }
    }
}

DI int snake_item(int round, int G, int bid) { return (round & 1) ? round * G + (G - 1 - bid) : round * G + bid; }

__global__ void __launch_bounds__(NTHREADS) fwd_megakernel(Params p) {
    __shared__ __attribute__((aligned(16))) char shm_raw[SHM_BYTES];
    cg::grid_group grid = cg::this_grid();
    char* ws = p.ws;
    const int G = gridDim.x, bid = blockIdx.x;
    __attribute__((address_space(3))) bf16_t* shm_g = (__attribute__((address_space(3))) bf16_t*)shm_raw;

    unsigned* barcnt = (unsigned*)(ws + OFF_BAR2);
    unsigned bartarget = 0;
    if (bid == 0 && threadIdx.x < 9) __hip_atomic_store(barcnt + 32 * threadIdx.x, 0u, __ATOMIC_RELAXED, __HIP_MEMORY_SCOPE_AGENT);
    if (bid == 0 && threadIdx.x < DEPTH * NGRP * 64) ((unsigned*)(ws + OFF_FLAG))[threadIdx.x] = 0u;
    phase_prep(p, shm_raw);
    if (DUPMASK & 64) { __syncthreads(); phase_prep(p, shm_raw); }
    grid.sync();

#define LAUNDER() do { } while (0)
    unsigned long long tspan = 0ull, tprev = SPINSEL ? wall_clock64() : 0ull;
#define PHASE_END(k) do { if (SPINSEL) { const unsigned long long tn_ = wall_clock64(); if (SPINSEL == (k)) tspan += tn_ - tprev; tprev = tn_; } } while (0)
    for (int layer = 0; layer < DEPTH; ++layer) {
        for (int grp = 0; grp < NGRP; ++grp) {
            const int gtok0 = grp * TG;
            LAUNDER();
            for (int rep = 0; rep <= (DUPMASK & 1); ++rep) {
                EpiIn epi{&p, layer, gtok0};
                gemm_phase<true>((const bf16_t*)(ws + OFF_WTIN), DM, 0, NPAD, (const bf16_t*)(ws + OFF_XB), DM, 0, TG, DM, 1, epi, shm_g);
            }
            grid_barrier(barcnt, bartarget, (unsigned)G);
            if (DUPMASK & 32) grid_barrier(barcnt, bartarget, (unsigned)G);
            PHASE_END(1);
            LAUNDER();
            for (int rep = 0; rep <= ((DUPMASK >> 1) & 1); ++rep) {
                const int nsel = BG * 256;
                const int nA = BG * 24 * 8, nK = BG * 8 * 16;
                const int rS = (nsel + G - 1) / G, rA = (nA + G - 1) / G, rK = (nK + G - 1) / G, rT = rS + rA + rK;
                const int off = (bid & 1) ? rS : 0;
                for (int st_ = 0; st_ < rT; ++st_) {
                    int s2 = st_ + off; if (s2 >= rT) s2 -= rT;
                    if (s2 < rS) {
                        const int it = snake_item(s2, G, bid);
                        if (it < nsel) select_chunk(p, it % BG, 255 - it / BG, shm_raw);
                    } else if (s2 < rS + rA) {
                        const int it = (s2 - rS) * G + bid;
                        if (it < nA) attn_a2_item(p, layer, it / (24 * 8), (it / 8) % 24, it % 8);
                    } else {
                        const int it = (s2 - rS - rA) * G + bid;
                        if (it < nK) kmean_item(p, it / 128, (it / 16) & 7, it & 15, shm_raw);
                    }
                }
            }
            grid_barrier(barcnt, bartarget, (unsigned)G);
            if (DUPMASK & 32) grid_barrier(barcnt, bartarget, (unsigned)G);
            PHASE_END(2);
            LAUNDER();
            for (int rep = ((DUPMASK >> 2) & 1); rep >= 0; --rep) {
                const bool st = rep == 0 || p.dupmask == 0x7fffffff;
#if ATTN64
                const int nbc = 2 * BG * 8 * 4;
                const int wv = __builtin_amdgcn_readfirstlane(ltid() >> 6);
                for (int it = bid; it < nbc; it += G) {
                    const int j = it & 3, sub = it >> 2, typ = sub / (BG * 8), bl = (sub / 8) % BG, hd = sub & 7;
                    const int c0 = j * 8 + wv, c1 = 63 - c0;
                    if (typ == 0) { attn_bc2_chunk<0>(p, layer, bl, hd, c1, st); attn_bc2_chunk<0>(p, layer, bl, hd, c0, st); }
                    else { attn_bc2_chunk<1>(p, layer, bl, hd, c1, st); attn_bc2_chunk<1>(p, layer, bl, hd, c0, st); }
                }
#else
                const int nbc = 2 * BG * 8 * 16;
                for (int rnd = 0;; ++rnd) {
                    const int it = snake_item(rnd, G, bid);
                    if (rnd * G >= nbc) break;
                    if (it < nbc) {
                        const int qb = 15 - it / (2 * BG * 8), sub = it % (2 * BG * 8), typ = sub / (BG * 8), bl = (sub / 8) % BG, hd = sub & 7;
                        {
#if ATTN_LDS
                            attn_bc_item(p, layer, typ, bl, hd, qb, st, shm_raw);
#else
                            if (typ == 0) attn_b_item(p, layer, bl, hd, qb, st, st ? 0 : ((p.dupmask >> 8) & 3)); else if (st || ((p.dupmask >> 10) & 1) == 0) attn_c_item(p, layer, bl, hd, qb, st);
#endif
                        }
                    }
                }
#endif
                for (int it = bid; it < TG / 64; it += G) merge_a_item(p, it, st);
            }
            grid_barrier(barcnt, bartarget, (unsigned)G);
            if (DUPMASK & 32) grid_barrier(barcnt, bartarget, (unsigned)G);
            PHASE_END(3);
            LAUNDER();
            for (int rep = 0; rep <= ((DUPMASK >> 3) & 1); ++rep) {
                EpiBr epi{&p};
                gemm_phase<false>((const bf16_t*)(ws + OFF_WTBR) + (size_t)layer * 3 * DM * 512, 512, (size_t)DM * 512, DM, (const bf16_t*)(ws + OFF_SZ), 1536, 512, TG, 512, 3, epi, shm_g);
            }
            {
                const bool handoff = (DUPMASK == 0) && G == (DM / BM) * (TG / BM);
                if (handoff) {
                    int pm_, pn_; gemm_tile_of(bid, DM / BM, TG / BM, pm_, pn_);
                    unsigned* fl = (unsigned*)(ws + OFF_FLAG) + (layer * NGRP + grp) * 64 + pn_;
                    __syncthreads();
                    if (threadIdx.x == 0) {
                        __builtin_amdgcn_fence(__ATOMIC_RELEASE, "agent");
                        __hip_atomic_fetch_add(fl, 1u, __ATOMIC_RELAXED, __HIP_MEMORY_SCOPE_AGENT);
                        while (__hip_atomic_load(fl, __ATOMIC_RELAXED, __HIP_MEMORY_SCOPE_AGENT) < (unsigned)(DM / BM)) __builtin_amdgcn_s_sleep(1);
                        __builtin_amdgcn_fence(__ATOMIC_ACQUIRE, "agent");
                    }
                    __syncthreads();
                } else {
                    grid_barrier(barcnt, bartarget, (unsigned)G);
                    if (DUPMASK & 32) grid_barrier(barcnt, bartarget, (unsigned)G);
                }
            }
            PHASE_END(4);
            LAUNDER();
            for (int rep = ((DUPMASK >> 4) & 1); rep >= 0; --rep) {
                EpiOut epi{&p, layer, gtok0, rep == 0 || p.dupmask == 0x7fffffff};
                gemm_phase<false>((const bf16_t*)(ws + OFF_WTOUT) + (size_t)layer * DM * DM, DM, 0, DM, (const bf16_t*)(ws + OFF_MB), DM, 0, TG, DM, 1, epi, shm_g);
                if (rep == 0) {
                    const int nl = grp + 1 < NGRP ? layer : layer + 1, ng = grp + 1 < NGRP ? grp + 1 : 0;
                    if (nl < DEPTH) {
                        __syncthreads();
                        const float* xsrc = (nl == 0 ? p.x : (const float*)p.out) + (size_t)ng * TG * DM;
                        int per = (TG + G - 1) / G; int tb = bid * per, te = tb + per < TG ? tb + per : TG;
                        xprep_tokens(xsrc, (bf16_t*)(ws + OFF_XB), (float*)(ws + OFF_SS), tb, te);
                        if (nl != layer) for (int it = bid; it < 16 * 204; it += G) convert_win_tile(p, nl, it, (float*)shm_raw);
                    }
                }
            }
            grid_barrier(barcnt, bartarget, (unsigned)G);
            if (DUPMASK & 32) grid_barrier(barcnt, bartarget, (unsigned)G);
            PHASE_END(5);
        }
    }
    if (SPINSEL) { const unsigned long long t0_ = wall_clock64(); while (wall_clock64() - t0_ < tspan) __builtin_amdgcn_s_sleep(8); }
}

extern "C" void kernel_launch(void* const* d_in, const int* in_sizes, int n_in, void* d_out, int out_size, void* d_ws, size_t ws_size, hipStream_t stream) {
    static int grid_blocks = 0;
    if (!grid_blocks) {
        int dev = 0, cus = 0, per_cu = 0;
        hipGetDevice(&dev);
        hipDeviceGetAttribute(&cus, hipDeviceAttributeMultiprocessorCount, dev);
        hipOccupancyMaxActiveBlocksPerMultiprocessor(&per_cu, fwd_megakernel, NTHREADS, 0);
        if (per_cu > 1) per_cu = 1;
        grid_blocks = cus * per_cu;
    }
    if (ws_size < WS_NEED) { fprintf(stderr, "workspace too small: %zu < %zu\n", ws_size, (size_t)WS_NEED); return; }
    Params p{};
    p.dupmask = DUPMASK; p.pad_ = 0;
    p.x = (const float*)d_in[0]; p.pos = (const int*)d_in[1]; p.norm_g = (const float*)d_in[2]; p.w_in = (const float*)d_in[3];
    p.qk_g = (const float*)d_in[4]; p.w_br = (const float*)d_in[5]; p.w_out = (const float*)d_in[6];
    p.out = (float*)d_out; p.ws = (char*)d_ws;
    void* args[] = {&p};
    hipError_t e = hipLaunchCooperativeKernel((void*)fwd_megakernel, dim3(grid_blocks), dim3(NTHREADS), args, 0, stream);
    if (e != hipSuccess) fprintf(stderr, "cooperative launch failed: %s (grid %d)\n", hipGetErrorString(e), grid_blocks);
}
```

```cpp
#include <hip/hip_runtime.h>
#include <hip/hip_cooperative_groups.h>
#include <cstdio>
#include <cstdint>
namespace cg = cooperative_groups;
#define ATTN_LDS 0
#define ATTN64 1
#define SPINSEL 0
#define DUPMASK 0

typedef unsigned short bf16_t;
typedef short bf16x8 __attribute__((ext_vector_type(8)));
typedef short s16x4 __attribute__((ext_vector_type(4)));
typedef float f32x4 __attribute__((ext_vector_type(4)));
typedef float f32x16 __attribute__((ext_vector_type(16)));
typedef unsigned u32x4 __attribute__((ext_vector_type(4)));
typedef unsigned u32x2 __attribute__((ext_vector_type(2)));
#define DI __device__ __forceinline__

constexpr int S = 4096, DM = 1024, NB = 8, DEPTH = 2;
constexpr int NIN = 12872, NPAD = 13056;
constexpr int BG = 4, TG = BG * S, NGRP = NB / BG;
constexpr int NTHREADS = 512;
constexpr int SHM_BYTES = 131072;
constexpr float QSCALE = 0.125f * 1.4426950408889634f;
constexpr float LN2F = 0.6931471805599453f;
constexpr int SEL_CAP = 768;

constexpr size_t al256(size_t x) { return (x + 255) & ~(size_t)255; }
constexpr size_t OFF_WTIN = 0;
constexpr size_t OFF_WTBR = OFF_WTIN + al256((size_t)NPAD * DM * 2);
constexpr size_t OFF_WTOUT = OFF_WTBR + al256((size_t)DEPTH * 3 * DM * 512 * 2);
constexpr size_t OFF_CS = OFF_WTOUT + al256((size_t)DEPTH * DM * DM * 2);
constexpr size_t OFF_XB = OFF_CS + al256((size_t)NB * S * 8 * 8);
constexpr size_t OFF_OA = OFF_XB;
constexpr size_t OFF_SS = OFF_XB + al256((size_t)3 * TG * 512 * 2);
constexpr size_t OFF_QA = OFF_SS + al256((size_t)TG * 8 * 4);
constexpr size_t OFF_KA = OFF_QA + al256((size_t)TG * 1536 * 2);
constexpr size_t OFF_VA = OFF_KA + al256((size_t)TG * 1536 * 2);
constexpr size_t OFF_MF = OFF_QA;
constexpr size_t OFF_MB = OFF_VA;
constexpr size_t OFF_QB = OFF_VA + al256((size_t)TG * 1536 * 2);
constexpr size_t OFF_KB = OFF_QB + al256((size_t)TG * 512 * 2);
constexpr size_t OFF_VB = OFF_KB + al256((size_t)TG * 512 * 2);
constexpr size_t OFF_QC = OFF_VB + al256((size_t)TG * 512 * 2);
constexpr size_t OFF_KC = OFF_QC + al256((size_t)TG * 512 * 2);
constexpr size_t OFF_VC = OFF_KC + al256((size_t)TG * 512 * 2);
constexpr size_t OFF_IQ = OFF_VC + al256((size_t)TG * 512 * 2);
constexpr size_t OFF_IK = OFF_IQ + al256((size_t)TG * 512 * 2);
constexpr size_t OFF_IW = OFF_IK + al256((size_t)TG * 64 * 2);
constexpr size_t OFF_SZ = OFF_IW + al256((size_t)TG * 8 * 4);
constexpr size_t OFF_SG = OFF_SZ + al256((size_t)TG * 1536 * 2);
constexpr size_t OFF_LSE = OFF_SG + al256((size_t)TG * 3072 * 2);
constexpr size_t OFF_MASK = OFF_LSE + al256((size_t)3 * TG * 8 * 4);
constexpr size_t OFF_KM = OFF_MASK + al256((size_t)BG * S * (S / 8));
static_assert((size_t)TG * DM * 4 <= (size_t)2 * TG * 1536 * 2 && (size_t)TG * DM * 2 <= (size_t)TG * 1536 * 2, "overlay sizes");
constexpr size_t OFF_BAR = OFF_KM + al256((size_t)BG * 8 * 16 * 64 * 2 * 2);
constexpr size_t OFF_FLAG = OFF_BAR + 256;
constexpr size_t OFF_BAR2 = OFF_FLAG + (size_t)DEPTH * NGRP * 64 * 4;
constexpr size_t WS_NEED = OFF_BAR2 + 9 * 128;

struct Params {
    const float* x; const int* pos; const float* norm_g; const float* w_in; const float* qk_g; const float* w_br; const float* w_out;
    float* out; char* ws; int dupmask; int pad_;
};

DI int ltid() { int t = threadIdx.x; asm volatile("" : "+v"(t)); return t; }
DI unsigned cvt_pk_bf16(float lo, float hi) { unsigned r; asm volatile("v_cvt_pk_bf16_f32 %0, %1, %2" : "=v"(r) : "v"(lo), "v"(hi)); return r; }
DI bf16_t f2bf(float x) { return (bf16_t)(cvt_pk_bf16(x, 0.f) & 0xffffu); }
DI float bf2f(bf16_t v) { return __uint_as_float(((unsigned)v) << 16); }
DI float fexp2(float x) { return __builtin_amdgcn_exp2f(x); }
DI float shx(float v, int mask) { const int l = ltid() & 63; return __int_as_float(__builtin_amdgcn_ds_bpermute((l ^ mask) << 2, __float_as_int(v))); }
DI float wave_sum(float v) { for (int o = 32; o > 0; o >>= 1) v += shx(v, o); return v; }
DI int f2sort(float f) { int i = __float_as_int(f); return i ^ ((i >> 31) & 0x7fffffff); }
DI float sort2f(int i) { return __int_as_float(i ^ ((i >> 31) & 0x7fffffff)); }
#define MFMA32(a, b, c) __builtin_amdgcn_mfma_f32_32x32x16_bf16((a), (b), (c), 0, 0, 0)
#define MFMA16(a, b, c) __builtin_amdgcn_mfma_f32_16x16x32_bf16((a), (b), (c), 0, 0, 0)

DI void grid_barrier(unsigned* bar, unsigned& gen, unsigned G) {
    __syncthreads();
    gen += 1;
    if (threadIdx.x == 0) {
        __builtin_amdgcn_fence(__ATOMIC_RELEASE, "agent");
        const unsigned sh = blockIdx.x & 7u, per = (G + 7u - sh) >> 3, nsh = G < 8u ? G : 8u;
        const unsigned old = __hip_atomic_fetch_add(bar + 32 * (1 + sh), 1u, __ATOMIC_RELAXED, __HIP_MEMORY_SCOPE_AGENT);
        if (old + 1u == per * gen) __hip_atomic_fetch_add(bar, 1u, __ATOMIC_RELAXED, __HIP_MEMORY_SCOPE_AGENT);
        while (__hip_atomic_load(bar, __ATOMIC_RELAXED, __HIP_MEMORY_SCOPE_AGENT) < nsh * gen) __builtin_amdgcn_s_sleep(2);
        __builtin_amdgcn_fence(__ATOMIC_ACQUIRE, "agent");
    }
    __syncthreads();
}

DI int src_col_of_group(int hg) { return hg <= 104 ? hg * 64 : (hg <= 200 ? 6728 + (hg - 105) * 64 : 6720); }

DI void convert_tile(const float* src, int ld_src, int k0, int n_src0, int n_valid, const float* kscale, bf16_t* dst, int ld_dst, int n_dst0, float* tl  ) {
    const int tid = ltid();
    __syncthreads();
#pragma unroll
    for (int i = 0; i < 8; ++i) {
        int e = tid + i * 512, kk = e >> 6, nn = e & 63;
        float v = 0.f;
        if (nn < n_valid) { v = src[(size_t)(k0 + kk) * ld_src + n_src0 + nn]; if (kscale) v *= kscale[k0 + kk]; }
        tl[kk * 65 + nn] = v;
    }
    __syncthreads();
#pragma unroll
    for (int i = 0; i < 4; ++i) {
        int e = tid + i * 512, nn = e >> 5, kp = (e & 31) * 2;
        unsigned w = cvt_pk_bf16(tl[kp * 65 + nn], tl[(kp + 1) * 65 + nn]);
        *(unsigned*)(dst + (size_t)(n_dst0 + nn) * ld_dst + k0 + kp) = w;
    }
}

DI void xprep_tokens(const float* xsrc  , bf16_t* xb, float* ss, int tok_begin, int tok_end) {
    const int lane = ltid() & 63, wid = ltid() >> 6;
    for (int t = tok_begin + wid; t < tok_end; t += 8) {
        const float* xr = xsrc + (size_t)t * DM;
        float sum = 0.f;
#pragma unroll
        for (int i = 0; i < 4; ++i) {
            f32x4 v = *(const f32x4*)(xr + i * 256 + lane * 4);
            sum += v[0] * v[0] + v[1] * v[1] + v[2] * v[2] + v[3] * v[3];
            u32x2 w; w[0] = cvt_pk_bf16(v[0], v[1]); w[1] = cvt_pk_bf16(v[2], v[3]);
            *(u32x2*)(xb + (size_t)t * DM + i * 256 + lane * 4) = w;
        }
        sum = wave_sum(sum);
        if (lane < 8) ss[(size_t)t * 8 + lane] = lane == 0 ? sum : 0.f;
    }
}

DI void convert_win_tile(const Params& p, int l, int it, float* tl) {
    const int hg = it / 16, kt = it % 16;
    const int nvalid = hg <= 200 ? 64 : (hg == 201 ? 8 : 0);
    convert_tile(p.w_in + (size_t)l * DM * NIN, NIN, kt * 64, src_col_of_group(hg), nvalid, p.norm_g + l * DM, (bf16_t*)(p.ws + OFF_WTIN), DM, hg * 64, tl);
}
DI void phase_prep(const Params& p, char* shm) {
    char* ws = p.ws;
    const int G = gridDim.x, bid = blockIdx.x, tid = ltid();
    float2* cs = (float2*)(ws + OFF_CS);
    for (int e = bid * NTHREADS + tid; e < NB * S * 8; e += G * NTHREADS) {
        int i = e & 7, t = e >> 3;
        float inv = powf(500000.0f, -(float)(2 * i) / 16.0f);
        float ang = (float)p.pos[t] * inv;
        double rev = (double)ang * 0.15915494309189535;
        rev -= floor(rev);
        float rf = (float)rev;
        cs[e] = make_float2(__builtin_amdgcn_cosf(rf), __builtin_amdgcn_sinf(rf));
    }
    float* tl = (float*)shm;
    const int n_in_tiles = 16 * 204, n_br_tiles = DEPTH * 3 * 8 * 16, n_out_tiles = DEPTH * 16 * 16;
    for (int it = bid; it < n_in_tiles + n_br_tiles + n_out_tiles; it += G) {
        if (it < n_in_tiles) {
            convert_win_tile(p, 0, it, tl);
        } else if (it < n_in_tiles + n_br_tiles) {
            int r = it - n_in_tiles; int ln = r / 128, q = r % 128, kt = q / 16, nt = q % 16;
            convert_tile(p.w_br + (size_t)ln * 512 * DM, DM, kt * 64, nt * 64, 64, nullptr, (bf16_t*)(ws + OFF_WTBR) + (size_t)ln * DM * 512, 512, nt * 64, tl);
        } else {
            int r = it - n_in_tiles - n_br_tiles; int l = r / 256, q = r % 256, kt = q / 16, nt = q % 16;
            convert_tile(p.w_out + (size_t)l * DM * DM, DM, kt * 64, nt * 64, 64, nullptr, (bf16_t*)(ws + OFF_WTOUT) + (size_t)l * DM * DM, DM, nt * 64, tl);
        }
    }
    int per = (TG + G - 1) / G;
    int tb = bid * per, te = tb + per < TG ? tb + per : TG;
    xprep_tokens(p.x, (bf16_t*)(ws + OFF_XB), (float*)(ws + OFF_SS), tb, te);
}

constexpr int BM = 256, BK = 64, HALF = 128, NXCD = 8, WGM = 8, HT = HALF * BK;
DI int lds_byte(int r, int c) { int st = (r >> 4) * 2 + (c >> 5), rr = r & 15, cc = c & 31, ob = rr * 64 + cc * 2; return st * 1024 + (ob ^ (((ob >> 9) & 1) << 5)); }
DI void stage_rc(int b, int& R, int& C) { int st = b / 1024, sb = b % 1024, swz = sb ^ (((sb >> 9) & 1) << 5); R = (st >> 1) * 16 + swz / 64; C = (st & 1) * 32 + (swz % 64) / 2; }

#define SA(b, h) (shm + ((b) * 2 + (h)) * HT)
#define SB(b, h) (shm + (4 + (b) * 2 + (h)) * HT)
DI void glds16(const void* sbase, unsigned voff, unsigned lds_dst) {
    unsigned keep;
    asm volatile("s_mov_b32 %0, m0\n\ts_mov_b32 m0, %3\n\ts_nop 0\n\tglobal_load_lds_dwordx4 %1, %2\n\ts_mov_b32 m0, %0"
                 : "=&s"(keep) : "v"(voff), "s"(sbase), "s"(lds_dst) : "memory");
}
#define STAGE(P, BASE, LD, br, kt, VOFF) do { const bf16_t* _gp = (BASE) + (size_t)(br) * (LD) + (size_t)(kt) * BK; \
    const unsigned _l0 = (unsigned)(size_t)(P) + wbase16; \
    glds16(_gp, VOFF[0], _l0); glds16(_gp, VOFF[1], _l0 + 8192u); } while (0)
#define LDA(dst, b, h) _Pragma("unroll") for (int m = 0; m < 4; ++m) _Pragma("unroll") for (int k = 0; k < 2; ++k) \
    dst[m][k] = *reinterpret_cast<const bf16x8*>((char*)SA(b, h) + lds_byte(wr * 64 + m * 16 + fr, k * 32 + fq * 8))
#define LDB(dst, b, h) _Pragma("unroll") for (int n = 0; n < 2; ++n) _Pragma("unroll") for (int k = 0; k < 2; ++k) \
    dst[n][k] = *reinterpret_cast<const bf16x8*>((char*)SB(b, h) + lds_byte(wc * 32 + n * 16 + fr, k * 32 + fq * 8))
#define MMA(ai, bj, At, Bt_) do { __builtin_amdgcn_s_setprio(1); \
    _Pragma("unroll") for (int m = 0; m < 4; ++m) _Pragma("unroll") for (int n = 0; n < 2; ++n) _Pragma("unroll") for (int k = 0; k < 2; ++k) \
      acc[ai][bj][m][n] = MFMA16(At[m][k], Bt_[n][k], acc[ai][bj][m][n]); \
    __builtin_amdgcn_s_setprio(0); } while (0)
#define WAIT_V(n) asm volatile("s_waitcnt vmcnt(" #n ")" ::: "memory")
#define WAIT_L(n) asm volatile("s_waitcnt lgkmcnt(" #n ")" ::: "memory")
#define BAR __builtin_amdgcn_s_barrier()
#define SCHED __builtin_amdgcn_sched_barrier(0)

DI int fold_tok(int rho, int sh) { const int b = rho >> 12, rb = rho & (S - 1); return (b << 12) + (((rb & ((S >> sh) - 1)) << sh) + (rb >> (12 - sh))); }
DI void gemm_tile_of(int L, int nM, int nN, int& pm, int& pn) {
    const int nwg = nM * nN; int wgid = L;
    { int q = nwg / NXCD, r = nwg % NXCD, xcd = wgid % NXCD, off = wgid / NXCD; wgid = (xcd < r ? xcd * (q + 1) : r * (q + 1) + (xcd - r) * q) + off; }
    const int nig = WGM * nN, gid = wgid / nig, fm = gid * WGM, gsz = min(nM - fm, WGM);
    pm = fm + ((wgid % nig) % gsz); pn = (wgid % nig) / gsz;
}
template <bool FOLD, class Epi>
DI void gemm_phase(const bf16_t* __restrict__ Abase, int lda, size_t a_sub, int M, const bf16_t* __restrict__ Bbase, int ldb, size_t b_sub, int N, int K, int nsub,
                   Epi& epi, __attribute__((address_space(3))) bf16_t* shm) {
    const int nM = M / BM, nN = N / BM, nwg = nM * nN;
    const int wid = ltid() >> 6, lane = ltid() & 63, wr = wid >> 2, wc = wid & 3, fr = lane & 15, fq = lane >> 4;
    const int nt = K / BK;
    unsigned voffA[2], voffB0[2], voffB1[2];
    const unsigned wbase16 = __builtin_amdgcn_readfirstlane((ltid() & ~63u) * 16u);
#pragma unroll
    for (int i = 0; i < 2; ++i) {
        int r_, c_; stage_rc(ltid() * 16 + i * 8192, r_, c_);
        const int x_ = r_ & 63, pr_ = (r_ & 64) + ((x_ & 15) >> 2) * 16 + (x_ >> 4) * 4 + (x_ & 3);
        voffA[i] = (unsigned)(pr_ * lda + c_) * 2u;
    }
    int L = blockIdx.x, sub = 0, brow = 0, bcol = 0;
    bool have = L < nwg, prefetched = false;
    const bf16_t* A = Abase; const bf16_t* Bt = Bbase;
    auto setup = [&](int L_, int sub_) {
        int wgid = L_;
        { int q = nwg / NXCD, r = nwg % NXCD, xcd = wgid % NXCD, off = wgid / NXCD; wgid = (xcd < r ? xcd * (q + 1) : r * (q + 1) + (xcd - r) * q) + off; }
        const int nig = WGM * nN, gid = wgid / nig, fm = gid * WGM, gsz = min(nM - fm, WGM);
        const int pm = fm + ((wgid % nig) % gsz), pn = (wgid % nig) / gsz;
        brow = pm * BM; bcol = pn * BM;
        const int sh = (FOLD && pm < 18) ? 2 * ((pm % 6) >> 1) : 0;
        const int t_ = ltid();
#pragma unroll
        for (int i = 0; i < 2; ++i) {
            int r_, c_; stage_rc(t_ * 16 + i * 8192, r_, c_);
            voffB0[i] = (unsigned)(fold_tok(bcol + r_, sh) * ldb + c_) * 2u;
            voffB1[i] = (unsigned)(fold_tok(bcol + HALF + r_, sh) * ldb + c_) * 2u;
        }
        A = Abase + (size_t)sub_ * a_sub; Bt = Bbase + (size_t)sub_ * b_sub;
    };
    while (have) {
        {
            setup(L, sub);
            f32x4 acc[2][2][4][2] = {};
            bf16x8 At[4][2], B0[2][2], B1[2][2];
            if (!prefetched) {
                STAGE(SB(0, 0), Bt, ldb, 0, 0, voffB0); STAGE(SA(0, 0), A, lda, brow, 0, voffA);
                STAGE(SB(0, 1), Bt, ldb, 0, 0, voffB1); STAGE(SA(0, 1), A, lda, brow + HALF, 0, voffA);
            }
            if (wr == 1) BAR;
            if (prefetched) WAIT_V(0); else WAIT_V(4);
            BAR;
            STAGE(SB(1, 0), Bt, ldb, 0, 1, voffB0); STAGE(SA(1, 0), A, lda, brow, 1, voffA); STAGE(SB(1, 1), Bt, ldb, 0, 1, voffB1);
            WAIT_V(6); BAR;
            for (int t = 0; t < nt - 2; t += 2) {
                LDB(B0, 0, 0); SCHED; LDA(At, 0, 0); STAGE(SA(1, 1), A, lda, brow + HALF, t + 1, voffA);
                WAIT_L(8); BAR; WAIT_L(0); MMA(0, 0, At, B0); BAR; SCHED;
                LDB(B1, 0, 1); STAGE(SB(0, 0), Bt, ldb, 0, t + 2, voffB0);
                BAR; WAIT_L(0); MMA(0, 1, At, B1); BAR;
                LDA(At, 0, 1); STAGE(SA(0, 0), A, lda, brow, t + 2, voffA);
                BAR; WAIT_L(0); MMA(1, 0, At, B0); BAR; SCHED;
                STAGE(SB(0, 1), Bt, ldb, 0, t + 2, voffB1);
                WAIT_V(6); BAR; MMA(1, 1, At, B1); BAR;
                LDB(B0, 1, 0); SCHED; LDA(At, 1, 0); STAGE(SA(0, 1), A, lda, brow + HALF, t + 2, voffA);
                WAIT_L(8); BAR; WAIT_L(0); MMA(0, 0, At, B0); BAR; SCHED;
                LDB(B1, 1, 1); STAGE(SB(1, 0), Bt, ldb, 0, t + 3, voffB0);
                BAR; WAIT_L(0); MMA(0, 1, At, B1); BAR;
                LDA(At, 1, 1); STAGE(SA(1, 0), A, lda, brow, t + 3, voffA);
                BAR; WAIT_L(0); MMA(1, 0, At, B0); BAR; SCHED;
                STAGE(SB(1, 1), Bt, ldb, 0, t + 3, voffB1);
                WAIT_V(6); BAR; MMA(1, 1, At, B1); BAR;
            }
            { LDB(B0, 0, 0); LDA(At, 0, 0); STAGE(SA(1, 1), A, lda, brow + HALF, nt - 1, voffA);
              BAR; WAIT_L(0); MMA(0, 0, At, B0); BAR;
              LDB(B1, 0, 1); BAR; WAIT_L(0); MMA(0, 1, At, B1); BAR;
              LDA(At, 0, 1); WAIT_V(4); BAR; WAIT_L(0); MMA(1, 0, At, B0); MMA(1, 1, At, B1); BAR; }
            { LDB(B0, 1, 0); LDA(At, 1, 0); WAIT_V(2); BAR; WAIT_L(0); MMA(0, 0, At, B0); BAR;
              LDB(B1, 1, 1); WAIT_V(0); BAR; WAIT_L(0); MMA(0, 1, At, B1); BAR;
              LDA(At, 1, 1); BAR; WAIT_L(0); MMA(1, 0, At, B0); MMA(1, 1, At, B1); BAR; }
            if (wr == 0) BAR;
            const int e_brow = brow, e_bcol = bcol, e_sub = sub;
            if (++sub == nsub) { sub = 0; L += gridDim.x; }
            have = L < nwg;
            if (have) {
                setup(L, sub);
                STAGE(SB(0, 0), Bt, ldb, 0, 0, voffB0); STAGE(SA(0, 0), A, lda, brow, 0, voffA);
                STAGE(SB(0, 1), Bt, ldb, 0, 0, voffB1); STAGE(SA(0, 1), A, lda, brow + HALF, 0, voffA);
                prefetched = true;
            }
            { int t2 = ltid();
              const int wid2 = t2 >> 6, lane2 = t2 & 63;
              epi(acc, e_brow, e_bcol, e_sub, wid2 >> 2, wid2 & 3, lane2 & 15, lane2 >> 4); }
        }
    }
}

struct EpiIn {
    const Params* p; int layer; int gtok0;
    DI void operator()(const f32x4 (&acc)[2][2][4][2], int brow, int bcol, int sub, int wr, int wc, int fr, int fq) const {
        char* ws = p->ws;
        const float* ss = (const float*)(ws + OFF_SS);
        const float2* cs = (const float2*)(ws + OFF_CS);
        const int lane = ltid() & 63; const int tg_unused = 0;
        const int pm_ = brow >> 8;
        const int shf = pm_ < 18 ? 2 * ((pm_ % 6) >> 1) : 0;
        float rstd4[2][2];
        {
            f32x4 sA[2][2], sB[2][2];
#pragma unroll
            for (int bj = 0; bj < 2; ++bj)
#pragma unroll
                for (int n = 0; n < 2; ++n) {
                    const int tl_ = fold_tok(bcol + bj * 128 + wc * 32 + n * 16 + fr, shf);
                    sA[bj][n] = *(const f32x4*)(ss + (size_t)tl_ * 8); sB[bj][n] = *(const f32x4*)(ss + (size_t)tl_ * 8 + 4);
                }
#pragma unroll
            for (int bj = 0; bj < 2; ++bj)
#pragma unroll
                for (int n = 0; n < 2; ++n) {
                    const f32x4 s0 = sA[bj][n], s1 = sB[bj][n];
                    rstd4[bj][n] = rsqrtf((s0[0] + s0[1] + s0[2] + s0[3] + s1[0] + s1[1] + s1[2] + s1[3]) * (1.0f / DM) + 1e-6f);
                }
        }
#pragma unroll
        for (int ai = 0; ai < 2; ++ai) {
            const int hg = (brow + ai * 128 + wr * 64) >> 6;
            int kind;
            int mixer = 0, isk = 0, hh = 0, H = 8; size_t qoff = 0, koff = 0, voff = 0;
            if (hg < 72) { mixer = 0; H = 24; qoff = OFF_QA; koff = OFF_KA; voff = OFF_VA; kind = hg < 48 ? 0 : 1; isk = hg >= 24; hh = hg % 24; }
            else if (hg < 96) { mixer = 1; qoff = OFF_QB; koff = OFF_KB; voff = OFF_VB; kind = hg < 88 ? 0 : 1; isk = hg >= 80; hh = (hg - 72) & 7; }
            else if (hg < 105) { kind = 2; isk = hg == 104; hh = hg - 96; }
            else if (hg < 129) { mixer = 2; qoff = OFF_QC; koff = OFF_KC; voff = OFF_VC; kind = hg < 121 ? 0 : 1; isk = hg >= 113; hh = (hg - 105) & 7; }
            else if (hg < 153) kind = 3;
            else if (hg < 201) kind = 4;
            else kind = hg == 201 ? 5 : 6;
            f32x4 gq4[4] = {};
            if (kind == 0) {
                const float* gq = p->qk_g + ((size_t)(layer * 3 + mixer) * 2 + isk) * 64 + fq * 16;
#pragma unroll
                for (int m = 0; m < 4; ++m) gq4[m] = *(const f32x4*)(gq + m * 4);
            }
#pragma unroll
            for (int bj = 0; bj < 2; ++bj) {
#pragma unroll
                for (int n = 0; n < 2; ++n) {
                    const int rho = bcol + bj * 128 + wc * 32 + n * 16 + fr;
                    const int tl = fold_tok(rho, shf);
                    const float rstd = rstd4[bj][n];
                    const int bl = tl >> 12, s = tl & (S - 1), rb = rho & (S - 1);
                    const int tg = gtok0 + tl;
                    float v[16];
#pragma unroll
                    for (int m = 0; m < 4; ++m)
#pragma unroll
                        for (int j = 0; j < 4; ++j) v[m * 4 + j] = acc[ai][bj][m][n][j] * rstd;

                    if (kind == 0 || kind == 2) {
                        if (kind == 0) {
                            float sq = 0.f;
#pragma unroll
                            for (int i = 0; i < 16; ++i) sq += v[i] * v[i];
                            sq += shx(sq, 16); sq += shx(sq, 32);
                            const float rn = rsqrtf(sq * (1.0f / 64) + 1e-6f) * (isk ? 1.0f : QSCALE);
#pragma unroll
                            for (int m = 0; m < 4; ++m) {
                                const f32x4 g4 = gq4[m];
#pragma unroll
                                for (int j = 0; j < 4; ++j) v[m * 4 + j] *= rn * g4[j];
                            }
                        }
                        if (fq == 0) {
                            const f32x4* cp = (const f32x4*)(cs + (size_t)tg * 8);
#pragma unroll
                            for (int i2 = 0; i2 < 4; ++i2) {
                                const f32x4 c2 = cp[i2];
                                const float x1a = v[2 * i2], x2a = v[8 + 2 * i2], x1b = v[2 * i2 + 1], x2b = v[8 + 2 * i2 + 1];
                                v[2 * i2] = x1a * c2[0] - x2a * c2[1]; v[8 + 2 * i2] = x2a * c2[0] + x1a * c2[1];
                                v[2 * i2 + 1] = x1b * c2[2] - x2b * c2[3]; v[8 + 2 * i2 + 1] = x2b * c2[2] + x1b * c2[3];
                            }
                        }
                        u32x4 w0, w1;
#pragma unroll
                        for (int i = 0; i < 4; ++i) { w0[i] = cvt_pk_bf16(v[2 * i], v[2 * i + 1]); w1[i] = cvt_pk_bf16(v[8 + 2 * i], v[8 + 2 * i + 1]); }
                        if (kind == 0 && isk) {
                            bf16_t* dst = (bf16_t*)(ws + koff) + ((size_t)(bl * H + hh) * 128 + (rb >> 5)) * 2048 + (size_t)(fq * 64 + (rb & 31)) * 8;
                            *(u32x4*)dst = w0; *(u32x4*)(dst + 32 * 8) = w1;
                        } else {
                            bf16_t* dst;
                            if (kind == 0) dst = (bf16_t*)(ws + qoff) + ((size_t)(bl * H + hh) * S + rb) * 64;
                            else dst = isk ? (bf16_t*)(ws + OFF_IK) + (size_t)tl * 64 : (bf16_t*)(ws + OFF_IQ) + ((size_t)(bl * 8 + hh) * S + s) * 64;
                            *(u32x4*)(dst + fq * 16) = w0; *(u32x4*)(dst + fq * 16 + 8) = w1;
                        }
                    } else if (kind == 1) {
                        const int k5 = rb & 31;
                        bf16_t* dst = (bf16_t*)(ws + voff) + ((size_t)(bl * H + hh) * 128 + (rb >> 5)) * 2048 + ((k5 >> 4) * 64 + ((k5 >> 2) & 1) * 32) * 8 + ((k5 >> 3) & 1) * 4 + (k5 & 3)
                                      + ((fq >> 1) * 128 + (fq & 1) * 16) * 8;
#pragma unroll
                        for (int i = 0; i < 16; ++i) dst[i * 8] = f2bf(v[i]);
                    } else if (kind == 3 || kind == 4) {
                        bf16_t* dst = (kind == 3 ? (bf16_t*)(ws + OFF_SZ) + (size_t)tl * 1536 + (hg - 129) * 64 : (bf16_t*)(ws + OFF_SG) + (size_t)tl * 3072 + (hg - 153) * 64) + fq * 16;
#pragma unroll
                        for (int i = 0; i < 16; ++i) { const float sg = __builtin_amdgcn_rcpf(1.0f + __expf(-v[i])); v[i] = kind == 3 ? v[i] * sg : sg; }
                        u32x4 w0, w1;
#pragma unroll
                        for (int i = 0; i < 4; ++i) { w0[i] = cvt_pk_bf16(v[2 * i], v[2 * i + 1]); w1[i] = cvt_pk_bf16(v[8 + 2 * i], v[8 + 2 * i + 1]); }
                        *(u32x4*)dst = w0; *(u32x4*)(dst + 8) = w1;
                    } else if (kind == 5) {
                        if (fq == 0) { f32x4 o0 = {v[0], v[1], v[2], v[3]}, o1 = {v[4], v[5], v[6], v[7]}; float* d = (float*)(ws + OFF_IW) + (size_t)tl * 8; *(f32x4*)d = o0; *(f32x4*)(d + 4) = o1; }
                    }
                }
            }
        }
        (void)lane; (void)sub; (void)tg_unused;
    }
};

struct EpiBr {
    const Params* p;
    DI void operator()(const f32x4 (&acc)[2][2][4][2], int brow, int bcol, int sub, int wr, int wc, int fr, int fq) const {
        char* ws = p->ws;
        const bf16_t* sg = (const bf16_t*)(ws + OFF_SG);
        float* mf = (float*)(ws + OFF_MF);
        bf16_t* mb = (bf16_t*)(ws + OFF_MB);
#pragma unroll
        for (int bj = 0; bj < 2; ++bj)
#pragma unroll
            for (int n = 0; n < 2; ++n) {
                const int tl = bcol + bj * 128 + wc * 32 + n * 16 + fr;
#pragma unroll
                for (int ai = 0; ai < 2; ++ai)
#pragma unroll
                    for (int m2 = 0; m2 < 2; ++m2) {
                        const int e = brow + ai * 128 + wr * 64 + fq * 16 + m2 * 8;
                        const u32x4 gw = *(const u32x4*)(sg + (size_t)tl * 3072 + sub * 1024 + e);
                        bf16_t* mp = mb + (size_t)tl * DM + e;
                        u32x4 pw = {0u, 0u, 0u, 0u};
                        if (sub > 0) pw = *(const u32x4*)mp;
                        u32x4 ow;
#pragma unroll
                        for (int hh2 = 0; hh2 < 2; ++hh2) {
                            const f32x4 g4 = {__uint_as_float(gw[2 * hh2] << 16), __uint_as_float(gw[2 * hh2] & 0xffff0000u), __uint_as_float(gw[2 * hh2 + 1] << 16), __uint_as_float(gw[2 * hh2 + 1] & 0xffff0000u)};
                            f32x4 r = acc[ai][bj][m2 * 2 + hh2][n] * g4;
                            if (sub > 0) r += (f32x4){__uint_as_float(pw[2 * hh2] << 16), __uint_as_float(pw[2 * hh2] & 0xffff0000u), __uint_as_float(pw[2 * hh2 + 1] << 16), __uint_as_float(pw[2 * hh2 + 1] & 0xffff0000u)};
                            ow[2 * hh2] = cvt_pk_bf16(r[0], r[1]); ow[2 * hh2 + 1] = cvt_pk_bf16(r[2], r[3]);
                        }
                        *(u32x4*)mp = ow;
                    }
                asm volatile("" ::: "memory");
            }
    }
};

struct EpiOut {
    const Params* p; int layer; int gtok0; bool st;
    DI void operator()(const f32x4 (&acc)[2][2][4][2], int brow, int bcol, int sub, int wr, int wc, int fr, int fq) const {
        char* ws = p->ws;
        const float* xin = layer == 0 ? p->x : p->out;
        bf16_t* xb = (bf16_t*)(ws + OFF_XB);
        float* ss = (float*)(ws + OFF_SS);
#pragma unroll
        for (int bj = 0; bj < 2; ++bj)
#pragma unroll
            for (int n = 0; n < 2; ++n) {
                const int tl = bcol + bj * 128 + wc * 32 + n * 16 + fr;
                const size_t tg = (size_t)gtok0 + tl;
                f32x4 xv[2][4];
#pragma unroll
                for (int ai = 0; ai < 2; ++ai)
#pragma unroll
                    for (int m = 0; m < 4; ++m) xv[ai][m] = *(const f32x4*)(xin + tg * DM + brow + ai * 128 + wr * 64 + fq * 16 + m * 4);
#pragma unroll
                for (int ai = 0; ai < 2; ++ai)
#pragma unroll
                    for (int m = 0; m < 4; ++m) {
                        const int e = brow + ai * 128 + wr * 64 + fq * 16 + m * 4;
                        const f32x4 r = xv[ai][m] + acc[ai][bj][m][n];
                        if (st) *(f32x4*)(p->out + tg * DM + e) = r;
                    }
            }
        (void)sub;
    }
};

DI void select_chunk(const Params& p, int bl, int c, char* shm) {
    char* ws = p.ws;
    const bf16_t* IQ = (const bf16_t*)(ws + OFF_IQ);
    const bf16_t* IK = (const bf16_t*)(ws + OFF_IK);
    const float* IW = (const float*)(ws + OFF_IW);
    unsigned* hist = (unsigned*)shm; unsigned* bits = (unsigned*)(shm + 16384);
    int* ctl = (int*)(shm + 24576); int* cnt = ctl, *mn = ctl + 16, *mx = ctl + 32, *bsel = ctl + 48, *needp = ctl + 64;
    u32x2* list = (u32x2*)(shm + 32768);
    const int tid = ltid(), lane = tid & 63, w = __builtin_amdgcn_readfirstlane(tid >> 6), q = lane & 15, g = lane >> 4;
    const int t0 = c * 16, tq = t0 + q;
    __syncthreads();
    for (int i = tid; i < 16 * 256 + 16 * 128; i += NTHREADS) hist[i] = 0;
    if (tid < 16) { cnt[tid] = 0; mn[tid] = 0x7fffffff; mx[tid] = (int)0x80000000; }
    bf16x8 qf[8][2]; float wq[8];
#pragma unroll
    for (int hd = 0; hd < 8; ++hd) {
        const bf16_t* qp = IQ + ((size_t)(bl * 8 + hd) * S + tq) * 64 + g * 8;
        qf[hd][0] = *(const bf16x8*)qp; qf[hd][1] = *(const bf16x8*)(qp + 32);
        wq[hd] = IW[(size_t)(bl * S + tq) * 8 + hd];
    }
    auto loadk = [&](int kt, bf16x8& k0, bf16x8& k1) {
        const bf16_t* kp = IK + ((size_t)bl * S + kt * 16 + q) * 64 + g * 8;
        k0 = *(const bf16x8*)kp; k1 = *(const bf16x8*)(kp + 32);
    };
    auto compute = [&](const bf16x8& k0, const bf16x8& k1) -> f32x4 {
        f32x4 sc = {0.f, 0.f, 0.f, 0.f};
#pragma unroll
        for (int hd = 0; hd < 8; ++hd) {
            f32x4 a = {0.f, 0.f, 0.f, 0.f};
            a = MFMA16(k0, qf[hd][0], a); a = MFMA16(k1, qf[hd][1], a);
#pragma unroll
            for (int j = 0; j < 4; ++j) sc[j] += wq[hd] * fmaxf(a[j], 0.f);
        }
        return sc;
    };
#define SEL_PASS(BODY) do { \
        const int cl = c - 1;     \
        bf16x8 ka0, ka1, kb0, kb1; int kt = w; \
        if (kt <= cl) loadk(kt, ka0, ka1); \
        if (kt + 8 <= cl) loadk(kt + 8, kb0, kb1); \
        for (; kt <= cl; kt += 16) { \
            { const f32x4 sc = compute(ka0, ka1); if (kt + 16 <= cl) loadk(kt + 16, ka0, ka1); const int ktc = kt; const bool diag = false; BODY } \
            if (kt + 8 <= cl) { const f32x4 sc = compute(kb0, kb1); if (kt + 24 <= cl) loadk(kt + 24, kb0, kb1); const int ktc = kt + 8; const bool diag = false; BODY } \
        } \
        if (w == (c & 7)) { loadk(c, ka0, ka1); const f32x4 sc = compute(ka0, ka1); const int ktc = c; const bool diag = true; BODY } \
    } while (0)
#define SEL_OK(j) (!diag || 4 * g + (j) <= q)
    __syncthreads();
    {
        float lo = 3.0e38f, hi = -3.0e38f;
        SEL_PASS({
            _Pragma("unroll") for (int j = 0; j < 4; ++j) if (SEL_OK(j)) { lo = fminf(lo, sc[j]); hi = fmaxf(hi, sc[j]); }
        });
        lo = fminf(lo, shx(lo, 16)); lo = fminf(lo, shx(lo, 32));
        hi = fmaxf(hi, shx(hi, 16)); hi = fmaxf(hi, shx(hi, 32));
        if (g == 0) { atomicMin(&mn[q], f2sort(lo)); atomicMax(&mx[q], f2sort(hi)); }
    }
    __syncthreads();
    const float rlo = sort2f(mn[q]), rhi = sort2f(mx[q]);
    const float rscale = rhi > rlo ? 256.0f / (rhi - rlo) : 0.f;
    SEL_PASS({
        _Pragma("unroll") for (int j = 0; j < 4; ++j) if (SEL_OK(j)) {
            int b = (int)((sc[j] - rlo) * rscale); b = b > 255 ? 255 : (b < 0 ? 0 : b);
            atomicAdd(&hist[q * 256 + b], 1u);
        }
    });
    __syncthreads();
    {
        const int row = tid >> 5, i = tid & 31;
        unsigned c8[8]; unsigned tot = 0;
#pragma unroll
        for (int k = 0; k < 8; ++k) { c8[k] = hist[row * 256 + i * 8 + k]; tot += c8[k]; }
        unsigned above = 0;
        {
            unsigned run = tot;
#pragma unroll
            for (int o = 1; o < 32; o <<= 1) { const int l_ = tid & 63; unsigned v = (unsigned)__builtin_amdgcn_ds_bpermute(((l_ + o) & 63) << 2, (int)run); if (i + o < 32) run += v; }
            above = run - tot;
        }
        const int trow = t0 + row; const unsigned need = trow + 1 < 256 ? trow + 1 : 256;
        if (above < need && above + tot >= need) {
            unsigned a = above;
#pragma unroll
            for (int k = 7; k >= 0; --k) { if (a < need && a + c8[k] >= need) { bsel[row] = i * 8 + k; needp[row] = (int)(need - a); } a += c8[k]; }
        }
    }
    __syncthreads();
    const int bstar = bsel[q];
    SEL_PASS({
        unsigned nib = 0;
        _Pragma("unroll") for (int j = 0; j < 4; ++j) if (SEL_OK(j)) {
            int b = (int)((sc[j] - rlo) * rscale); b = b > 255 ? 255 : (b < 0 ? 0 : b);
            if (b > bstar) nib |= 1u << j;
            else if (b == bstar) { int pos = atomicAdd(&cnt[q], 1); if (pos < SEL_CAP) { u32x2 e; e[0] = (unsigned)f2sort(sc[j]) ^ 0x80000000u; e[1] = ktc * 16 + 4 * g + j; list[q * SEL_CAP + pos] = e; } }
        }
        if (nib) atomicOr(&bits[q * 128 + (ktc >> 1)], nib << ((ktc & 1) * 16 + 4 * g));
    });
    __syncthreads();
    {
        const int row = tid >> 5, i = tid & 31;
        int n = cnt[row]; n = n < SEL_CAP ? n : SEL_CAP;
        const int need = needp[row];
        for (int a = i; a < n; a += 32) {
            const u32x2 ea = list[row * SEL_CAP + a];
            int rank = 0;
            for (int b = 0; b < n; ++b) { const u32x2 eb = list[row * SEL_CAP + b]; rank += (eb[0] > ea[0]) || (eb[0] == ea[0] && eb[1] < ea[1]); }
            if (rank < need) atomicOr(&bits[row * 128 + (ea[1] >> 5)], 1u << (ea[1] & 31));
        }
    }
    __syncthreads();
    unsigned* mask = (unsigned*)(ws + OFF_MASK) + ((size_t)bl * S + t0) * 128;
    for (int i = tid; i < 16 * 128; i += NTHREADS) mask[i] = bits[i];
}

DI void kmean_item(const Params& p, int bl, int h, int n, char* shm) {
    char* ws = p.ws;
    const bf16_t* K = (const bf16_t*)(ws + OFF_KC) + ((size_t)(bl * 8 + h) * 128 + n * 8) * 2048;
    float* red = (float*)shm;
    const int tid = ltid(), c = tid & 255, par = tid >> 8;
    float acc[8] = {0.f, 0.f, 0.f, 0.f, 0.f, 0.f, 0.f, 0.f};
#pragma unroll
    for (int it = 0; it < 4; ++it) {
        const u32x4 v = *(const u32x4*)(K + (size_t)(it * 2 + par) * 2048 + c * 8);
#pragma unroll
        for (int e = 0; e < 4; ++e) { acc[2 * e] += __uint_as_float(v[e] << 16); acc[2 * e + 1] += __uint_as_float(v[e] & 0xffff0000u); }
    }
    __syncthreads();
#pragma unroll
    for (int e = 0; e < 8; ++e) red[(par * 256 + c) * 8 + e] = acc[e];
    __syncthreads();
    if (tid < 64) {
        const int grp = tid >> 3, e = tid & 7;
        float t = 0.f;
        for (int pr = 0; pr < 2; ++pr) for (int r = 0; r < 32; ++r) t += red[(pr * 256 + grp * 32 + r) * 8 + e];
        t *= (1.0f / 256);
        bf16_t hi = f2bf(t); bf16_t lo = f2bf(t - bf2f(hi));
        bf16_t* km = (bf16_t*)(ws + OFF_KM) + (((size_t)(bl * 8 + h) * 16 + n) * 2) * 64;
        km[tid] = hi; km[64 + tid] = lo;
    }
}

struct AttnAcc { f32x16 o0, o1; float nb, l; bool shifted; };
DI void attn_init(AttnAcc& a, float nb) {
    float z = 0.f; asm volatile("" : "+v"(z));
#pragma unroll
    for (int i = 0; i < 16; ++i) { a.o0[i] = z; a.o1[i] = z; }
    a.shifted = __ballot(nb > 90.f) != 0ull;
    a.nb = a.shifted ? nb + z : z; a.l = z;
}
DI float attn_bound(const bf16x8 (&qf)[4], const float* gk) {
    float qs = 0.f;
#pragma unroll
    for (int kk = 0; kk < 4; ++kk)
#pragma unroll
        for (int e = 0; e < 8; ++e) { const float v = bf2f((bf16_t)qf[kk][e]); qs += v * v; }
    qs += shx(qs, 32);
    float gm = fabsf(gk[ltid() & 63]);
    for (int o = 32; o > 0; o >>= 1) gm = fmaxf(gm, shx(gm, o));
    return sqrtf(qs) * gm * 8.1f;
}
struct KVFrag { bf16x8 k[4]; bf16x8 v[2][2]; };
DI void kv_load(KVFrag& f, const bf16_t* Kt, const bf16_t* Vt, int lane) {
#pragma unroll
    for (int kk = 0; kk < 4; ++kk) f.k[kk] = *(const bf16x8*)(Kt + (kk * 64 + lane) * 8);
#pragma unroll
    for (int db = 0; db < 2; ++db)
#pragma unroll
        for (int u = 0; u < 2; ++u) f.v[db][u] = *(const bf16x8*)(Vt + ((db * 2 + u) * 64 + lane) * 8);
}
DI void attn_step(AttnAcc& a, const KVFrag& f, const bf16x8 (&qf)[4], unsigned vm) {
    f32x16 st;
    if (a.shifted) {
#pragma unroll
        for (int i = 0; i < 16; ++i) st[i] = -a.nb;
        st = MFMA32(f.k[0], qf[0], st);
    } else {
        st = MFMA32(f.k[0], qf[0], ((f32x16){0.f, 0.f, 0.f, 0.f, 0.f, 0.f, 0.f, 0.f, 0.f, 0.f, 0.f, 0.f, 0.f, 0.f, 0.f, 0.f}));
    }
#pragma unroll
    for (int kk = 1; kk < 4; ++kk) st = MFMA32(f.k[kk], qf[kk], st);
    float pv[16];
#pragma unroll
    for (int i = 0; i < 16; ++i) pv[i] = fexp2(st[i]);
    if (__ballot(vm != 0xffffu) != 0ull) {
#pragma unroll
        for (int i = 0; i < 16; ++i) pv[i] = __int_as_float(__float_as_int(pv[i]) & __builtin_amdgcn_sbfe((int)vm, i, 1));
    }
    a.l += ((pv[0] + pv[1]) + (pv[2] + pv[3])) + ((pv[4] + pv[5]) + (pv[6] + pv[7])) + (((pv[8] + pv[9]) + (pv[10] + pv[11])) + ((pv[12] + pv[13]) + (pv[14] + pv[15])));
    u32x4 p0, p1;
#pragma unroll
    for (int i = 0; i < 4; ++i) { p0[i] = cvt_pk_bf16(pv[2 * i], pv[2 * i + 1]); p1[i] = cvt_pk_bf16(pv[8 + 2 * i], pv[8 + 2 * i + 1]); }
    const bf16x8 pf0 = __builtin_bit_cast(bf16x8, p0), pf1 = __builtin_bit_cast(bf16x8, p1);
    a.o0 = MFMA32(f.v[0][0], pf0, a.o0); a.o0 = MFMA32(f.v[0][1], pf1, a.o0);
    a.o1 = MFMA32(f.v[1][0], pf0, a.o1); a.o1 = MFMA32(f.v[1][1], pf1, a.o1);
}
DI void load_q(bf16x8 (&qf)[4], const bf16_t* Qrow, int h) {
#pragma unroll
    for (int kk = 0; kk < 4; ++kk) qf[kk] = *(const bf16x8*)(Qrow + kk * 16 + h * 8);
}
DI int koff(int i, int h) { return 8 * (i >> 2) + 4 * h + (i & 3); }

DI void attn_a_item(const Params& p, int layer, int bl, int hh, int rb) {
    char* ws = p.ws;
    const int lane = ltid() & 63, w = __builtin_amdgcn_readfirstlane(ltid() >> 6), r = lane & 31, h = lane >> 5;
    const int g = hh >> 3, sh = 2 * g, n = S >> sh;
    const int row0 = rb * 256 + w * 32;
    const int rr = row0 / n, m0 = row0 % n;
    const bf16_t* Q = (const bf16_t*)(ws + OFF_QA) + (size_t)(bl * 24 + hh) * S * 64;
    const bf16_t* K = (const bf16_t*)(ws + OFF_KA) + (size_t)(bl * 24 + hh) * S * 64;
    const bf16_t* Vt = (const bf16_t*)(ws + OFF_VA) + (size_t)(bl * 24 + hh) * 64 * S;
    bf16x8 qf[4]; load_q(qf, Q + (size_t)(row0 + r) * 64, h);
    AttnAcc a; attn_init(a, attn_bound(qf, p.qk_g + ((size_t)(layer * 3 + 0) * 2 + 1) * 64));
    const int kfirst = m0 >= 128 ? 0 : (128 - m0) / 32;
    const int tile0 = (rr * n + m0 - 128) / 32 + 0;
    auto amask = [&](int k) -> unsigned {
        if (k != 0 && k != 4) return 0xffffu;
        const int mk0 = m0 - 128 + 32 * k; unsigned vm = 0;
#pragma unroll
        for (int i = 0; i < 16; ++i) { const int d = (m0 + r) - (mk0 + koff(i, h)); if (d >= 0 && d <= 128) vm |= 1u << i; }
        return vm;
    };
    KVFrag f0, f1; kv_load(f0, K + (size_t)(tile0 + kfirst) * 2048, Vt + (size_t)(tile0 + kfirst) * 2048, lane);
    for (int k = kfirst; k < 5; k += 2) {
        { const int kn = k + 1 < 5 ? k + 1 : k; kv_load(f1, K + (size_t)(tile0 + kn) * 2048, Vt + (size_t)(tile0 + kn) * 2048, lane); }
        attn_step(a, f0, qf, amask(k));
        if (k + 1 < 5) {
            { const int kn = k + 2 < 5 ? k + 2 : k + 1; kv_load(f0, K + (size_t)(tile0 + kn) * 2048, Vt + (size_t)(tile0 + kn) * 2048, lane); }
            attn_step(a, f1, qf, amask(k + 1));
        }
    }
    const float l = a.l + shx(a.l, 32);
    const float inv = 1.0f / l;
    const int s = ((m0 + r) << sh) + rr;
    const size_t tl = (size_t)bl * S + s;
    bf16_t* o = (bf16_t*)(ws + OFF_OA) + ((size_t)g * TG + tl) * 512 + (hh & 7) * 64;
#pragma unroll
    for (int q4 = 0; q4 < 4; ++q4) {
        u32x2 w0, w1;
        w0[0] = cvt_pk_bf16(a.o0[q4 * 4] * inv, a.o0[q4 * 4 + 1] * inv); w0[1] = cvt_pk_bf16(a.o0[q4 * 4 + 2] * inv, a.o0[q4 * 4 + 3] * inv);
        w1[0] = cvt_pk_bf16(a.o1[q4 * 4] * inv, a.o1[q4 * 4 + 1] * inv); w1[1] = cvt_pk_bf16(a.o1[q4 * 4 + 2] * inv, a.o1[q4 * 4 + 3] * inv);
        *(u32x2*)(o + 8 * q4 + 4 * h) = w0; *(u32x2*)(o + 32 + 8 * q4 + 4 * h) = w1;
    }
    if (h == 0) ((float*)(ws + OFF_LSE))[((size_t)g * TG + tl) * 8 + (hh & 7)] = (a.nb + __log2f(l)) * LN2F;
}

DI void attn_store_gated(const Params& p, const AttnAcc& a, size_t tl, int col0, int h, bool st) {
    const float l = a.l + shx(a.l, 32);
    const float inv = 1.0f / l;
    bf16_t* z = (bf16_t*)(p.ws + OFF_SZ) + tl * 1536 + col0;
#pragma unroll
    for (int q4 = 0; q4 < 4; ++q4) {
#pragma unroll
        for (int db = 0; db < 2; ++db) {
            bf16_t* zp = z + db * 32 + 8 * q4 + 4 * h;
            const u32x2 zw = *(const u32x2*)zp;
            const float z0 = __uint_as_float(zw[0] << 16), z1 = __uint_as_float(zw[0] & 0xffff0000u), z2 = __uint_as_float(zw[1] << 16), z3 = __uint_as_float(zw[1] & 0xffff0000u);
            const f32x16& o = db ? a.o1 : a.o0;
            u32x2 wv; wv[0] = cvt_pk_bf16(o[q4 * 4] * inv * z0, o[q4 * 4 + 1] * inv * z1); wv[1] = cvt_pk_bf16(o[q4 * 4 + 2] * inv * z2, o[q4 * 4 + 3] * inv * z3);
            if (st) *(u32x2*)zp = wv;
        }
    }
}

DI void attn_b_item(const Params& p, int layer, int bl, int hd, int qb, bool st, int var) {
    char* ws = p.ws;
    const int lane = ltid() & 63, w = __builtin_amdgcn_readfirstlane(ltid() >> 6), r = lane & 31, h = lane >> 5;
    const int q0 = qb * 256 + w * 32;
    const bf16_t* Q = (const bf16_t*)(ws + OFF_QB) + (size_t)(bl * 8 + hd) * S * 64;
    const bf16_t* K = (const bf16_t*)(ws + OFF_KB) + (size_t)(bl * 8 + hd) * S * 64;
    const bf16_t* Vt = (const bf16_t*)(ws + OFF_VB) + (size_t)(bl * 8 + hd) * 64 * S;
    const unsigned* mrow = (const unsigned*)(ws + OFF_MASK) + ((size_t)bl * S + q0 + r) * 128;
    bf16x8 qf[4]; load_q(qf, Q + (size_t)(q0 + r) * 64, h);
    AttnAcc a; attn_init(a, attn_bound(qf, p.qk_g + ((size_t)(layer * 3 + 1) * 2 + 1) * 64));
    const int nkt = q0 / 32 + 1;
    auto bmask = [&](unsigned mw) -> unsigned {
        const unsigned ws4 = mw >> (4 * h);
        return (ws4 & 0xfu) | ((ws4 >> 4) & 0xf0u) | ((ws4 >> 8) & 0xf00u) | ((ws4 >> 12) & 0xf000u);
    };
    KVFrag f0, f1; kv_load(f0, K, Vt, lane);
    unsigned mw0 = mrow[0], mw1 = 0;
    const int tmul = var == 1 ? 0 : 1;
    for (int kt = 0; kt < nkt; kt += 2) {
        { const int kn = (kt + 1 < nkt ? kt + 1 : kt) * tmul; kv_load(f1, K + (size_t)kn * 2048, Vt + (size_t)kn * 2048, lane); mw1 = mrow[kn]; }
        if (var == 2) a.l += __int_as_float((int)f0.k[0][0] + (int)f0.k[3][7] + (int)f0.v[0][0][0] + (int)f0.v[1][1][7] + (int)mw0); else
        attn_step(a, f0, qf, bmask(mw0));
        if (kt + 1 < nkt) {
            { const int kn = (kt + 2 < nkt ? kt + 2 : kt + 1) * tmul; kv_load(f0, K + (size_t)kn * 2048, Vt + (size_t)kn * 2048, lane); mw0 = mrow[kn]; }
            if (var == 2) a.l += __int_as_float((int)f1.k[0][0] + (int)f1.k[3][7] + (int)f1.v[0][0][0] + (int)f1.v[1][1][7] + (int)mw1); else
            attn_step(a, f1, qf, bmask(mw1));
        }
    }
    attn_store_gated(p, a, (size_t)bl * S + q0 + r, 512 + hd * 64, h, st);
}

DI void attn_c_item(const Params& p, int layer, int bl, int hd, int qb, bool st) {
    char* ws = p.ws;
    const int lane = ltid() & 63, w = __builtin_amdgcn_readfirstlane(ltid() >> 6), r = lane & 31, h = lane >> 5;
    const int q0 = qb * 256 + w * 32, own = qb;
    const bf16_t* Q = (const bf16_t*)(ws + OFF_QC) + (size_t)(bl * 8 + hd) * S * 64;
    const bf16_t* K = (const bf16_t*)(ws + OFF_KC) + (size_t)(bl * 8 + hd) * S * 64;
    const bf16_t* Vt = (const bf16_t*)(ws + OFF_VC) + (size_t)(bl * 8 + hd) * 64 * S;
    bf16x8 qf[4]; load_q(qf, Q + (size_t)(q0 + r) * 64, h);
    unsigned sel = 0;
    if (own > 0) {
        const bf16_t* km = (const bf16_t*)(ws + OFF_KM) + (((size_t)(bl * 8 + hd) * 16 + (r & 15)) * 2) * 64;
        f32x16 gt;
#pragma unroll
        for (int i = 0; i < 16; ++i) gt[i] = 0.f;
#pragma unroll
        for (int kk = 0; kk < 4; ++kk) {
            bf16x8 ahi = *(const bf16x8*)(km + kk * 16 + h * 8), alo = *(const bf16x8*)(km + 64 + kk * 16 + h * 8);
            if (r >= 16) { ahi = (bf16x8){0, 0, 0, 0, 0, 0, 0, 0}; alo = ahi; }
            gt = MFMA32(ahi, qf[kk], gt); gt = MFMA32(alo, qf[kk], gt);
        }
        float gl[16];
#pragma unroll
        for (int i = 0; i < 8; ++i) {
            const float mine = gt[i], oth = shx(mine, 32);
            const int blk_mine = 8 * (i >> 2) + 4 * h + (i & 3), blk_oth = 8 * (i >> 2) + 4 * (1 - h) + (i & 3);
            (void)blk_mine; (void)blk_oth;
            gl[8 * (i >> 2) + (i & 3)] = h == 0 ? mine : oth;
            gl[8 * (i >> 2) + 4 + (i & 3)] = h == 0 ? oth : mine;
        }
#pragma unroll
        for (int pick = 0; pick < 3; ++pick) {
            float best = -3.0e38f; int bi = -1;
#pragma unroll
            for (int nb = 0; nb < 16; ++nb) { const bool ok = nb < own && !((sel >> nb) & 1u); if (ok && gl[nb] > best) { best = gl[nb]; bi = nb; } }
            if (bi >= 0) sel |= 1u << bi;
        }
    }
    AttnAcc a; attn_init(a, attn_bound(qf, p.qk_g + ((size_t)(layer * 3 + 2) * 2 + 1) * 64));
    unsigned vis = 0;
    for (int nb = 0; nb < own; ++nb) if (__ballot((sel >> nb) & 1u) != 0ull) vis |= 1u << nb;
    const int ndiag = q0 / 32;
    unsigned long long tm0 = 0ull, tm1 = 0ull;
    for (int nb = 0; nb < own; ++nb) if ((vis >> nb) & 1u) { if (nb < 8) tm0 |= 0xffull << (8 * nb); else tm1 |= 0xffull << (8 * (nb - 8)); }
    for (int t = own * 8; t <= ndiag; ++t) { if (t < 64) tm0 |= 1ull << t; else tm1 |= 1ull << (t - 64); }
    int ntl = __builtin_popcountll(tm0) + __builtin_popcountll(tm1);
    auto pop = [&]() -> int { int t; if (tm0) { t = __builtin_ctzll(tm0); tm0 &= tm0 - 1; } else if (tm1) { t = 64 + __builtin_ctzll(tm1); tm1 &= tm1 - 1; } else t = ndiag; return t; };
    auto cmask = [&](int t) -> unsigned {
        const int cb = t >> 3;
        if (cb < own) return ((sel >> cb) & 1u) ? 0xffffu : 0u;
        if (t != ndiag) return 0xffffu;
        unsigned vm = 0;
#pragma unroll
        for (int i = 0; i < 16; ++i) if (koff(i, h) <= r) vm |= 1u << i;
        return vm;
    };
    KVFrag f0, f1; int t0 = pop(), t1 = 0;
    kv_load(f0, K + (size_t)t0 * 2048, Vt + (size_t)t0 * 2048, lane);
    for (int it = 0; it < ntl; it += 2) {
        t1 = pop(); kv_load(f1, K + (size_t)t1 * 2048, Vt + (size_t)t1 * 2048, lane);
        attn_step(a, f0, qf, cmask(t0));
        if (it + 1 < ntl) {
            t0 = pop(); kv_load(f0, K + (size_t)t0 * 2048, Vt + (size_t)t0 * 2048, lane);
            attn_step(a, f1, qf, cmask(t1));
        }
    }
    attn_store_gated(p, a, (size_t)bl * S + q0 + r, 1024 + hd * 64, h, st);
}

DI void attn_bc_item(const Params& p, int layer, int typ, int bl, int hd, int qb, bool st, char* shm) {
    char* ws = p.ws;
    const int tid = ltid(), lane = tid & 63, w = tid >> 6, r = lane & 31, h = lane >> 5;
    const int q0 = qb * 256 + w * 32, own = qb, ndiag = q0 / 32;
    const bf16_t* Q = (const bf16_t*)(ws + (typ ? OFF_QC : OFF_QB)) + (size_t)(bl * 8 + hd) * S * 64;
    const bf16_t* K = (const bf16_t*)(ws + (typ ? OFF_KC : OFF_KB)) + (size_t)(bl * 8 + hd) * S * 64;
    const bf16_t* Vt = (const bf16_t*)(ws + (typ ? OFF_VC : OFF_VB)) + (size_t)(bl * 8 + hd) * 64 * S;
    const unsigned* mrow = (const unsigned*)(ws + OFF_MASK) + ((size_t)bl * S + q0 + r) * 128;
    unsigned short* seq = (unsigned short*)(shm + 16384);
    unsigned* wvis = (unsigned*)(shm + 16896);
    bf16x8 qf[4]; load_q(qf, Q + (size_t)(q0 + r) * 64, h);
    unsigned sel = 0, vis = 0;
    if (typ == 1 && own > 0) {
        const bf16_t* km = (const bf16_t*)(ws + OFF_KM) + (((size_t)(bl * 8 + hd) * 16 + (r & 15)) * 2) * 64;
        f32x16 gt;
#pragma unroll
        for (int i = 0; i < 16; ++i) gt[i] = 0.f;
#pragma unroll
        for (int kk = 0; kk < 4; ++kk) {
            bf16x8 ahi = *(const bf16x8*)(km + kk * 16 + h * 8), alo = *(const bf16x8*)(km + 64 + kk * 16 + h * 8);
            if (r >= 16) { ahi = (bf16x8){0, 0, 0, 0, 0, 0, 0, 0}; alo = ahi; }
            gt = MFMA32(ahi, qf[kk], gt); gt = MFMA32(alo, qf[kk], gt);
        }
        float gl[16];
#pragma unroll
        for (int i = 0; i < 8; ++i) {
            const float mine = gt[i], oth = shx(mine, 32);
            gl[8 * (i >> 2) + (i & 3)] = h == 0 ? mine : oth;
            gl[8 * (i >> 2) + 4 + (i & 3)] = h == 0 ? oth : mine;
        }
#pragma unroll
        for (int pick = 0; pick < 3; ++pick) {
            float best = -3.0e38f; int bi = -1;
#pragma unroll
            for (int nb = 0; nb < 16; ++nb) { const bool ok = nb < own && !((sel >> nb) & 1u); if (ok && gl[nb] > best) { best = gl[nb]; bi = nb; } }
            if (bi >= 0) sel |= 1u << bi;
        }
        for (int nb = 0; nb < own; ++nb) if (__ballot((sel >> nb) & 1u) != 0ull) vis |= 1u << nb;
    }
    if (typ == 0) vis = (1u << own) - 1u;
    __syncthreads();
    if (lane == 0) wvis[w] = vis;
    __syncthreads();
    if (tid == 0) {
        unsigned bv = 0;
        for (int i = 0; i < 8; ++i) bv |= wvis[i];
        int n = 0;
        for (int nb = 0; nb < own; ++nb) if ((bv >> nb) & 1u) for (int k = 0; k < 8; ++k) seq[n++] = (unsigned short)(nb * 8 + k);
        for (int k = 0; k < 8; ++k) seq[n++] = (unsigned short)(own * 8 + k);
        seq[255] = (unsigned short)n;
    }
    __syncthreads();
    const int ntl = seq[255];
    const bf16_t* gsrc = (tid < 256 ? K : Vt) + (size_t)(tid & 255) * 8;
    char* lds_dst = shm + tid * 16;
    u32x4 R = *(const u32x4*)(gsrc + (size_t)seq[0] * 2048);
    *(u32x4*)lds_dst = R;
    if (ntl > 1) R = *(const u32x4*)(gsrc + (size_t)seq[1] * 2048);
    AttnAcc a; attn_init(a, attn_bound(qf, p.qk_g + ((size_t)(layer * 3 + 1 + typ) * 2 + 1) * 64));
    unsigned mw = typ == 0 ? mrow[seq[0]] : 0u;
    __syncthreads();
    for (int t = 0; t < ntl; ++t) {
        const int ct = seq[t], cb = ct >> 3;
        unsigned mwn = 0;
        if (typ == 0 && t + 1 < ntl) mwn = mrow[seq[t + 1]];
        const bool need = cb < own ? ((vis >> cb) & 1u) != 0u : ct <= ndiag;
        if (need) {
            const char* buf = shm + (t & 1) * 8192;
            KVFrag f;
#pragma unroll
            for (int kk = 0; kk < 4; ++kk) f.k[kk] = *(const bf16x8*)(buf + (kk * 64 + lane) * 16);
#pragma unroll
            for (int db = 0; db < 2; ++db)
#pragma unroll
                for (int u = 0; u < 2; ++u) f.v[db][u] = *(const bf16x8*)(buf + 4096 + ((db * 2 + u) * 64 + lane) * 16);
            unsigned vm;
            if (typ == 0) {
                const unsigned ws4 = mw >> (4 * h);
                vm = (ws4 & 0xfu) | ((ws4 >> 4) & 0xf0u) | ((ws4 >> 8) & 0xf00u) | ((ws4 >> 12) & 0xf000u);
            } else if (cb < own) vm = ((sel >> cb) & 1u) ? 0xffffu : 0u;
            else if (ct == ndiag) {
                vm = 0;
#pragma unroll
                for (int i = 0; i < 16; ++i) if (koff(i, h) <= r) vm |= 1u << i;
            } else vm = 0xffffu;
            attn_step(a, f, qf, vm);
        }
        if (t + 1 < ntl) {
            *(u32x4*)(lds_dst + ((t + 1) & 1) * 8192) = R;
            if (t + 2 < ntl) R = *(const u32x4*)(gsrc + (size_t)seq[t + 2] * 2048);
        }
        mw = mwn;
        __syncthreads();
    }
    attn_store_gated(p, a, (size_t)bl * S + q0 + r, (typ ? 1024 : 512) + hd * 64, h, st);
}

template <int TYP>
DI void attn_step2(AttnAcc& a0, AttnAcc& a1, KVFrag& f, const bf16x8 (&qa)[4], const bf16x8 (&qb)[4], unsigned vm0, unsigned vm1, bool shifted, const bf16_t* Kn, const bf16_t* Vn, int lane) {
    f32x16 s0, s1;
    __builtin_amdgcn_s_setprio(1);
    if (shifted) {
#pragma unroll
        for (int i = 0; i < 16; ++i) { s0[i] = -a0.nb; s1[i] = -a1.nb; }
        s0 = MFMA32(f.k[0], qa[0], s0); s1 = MFMA32(f.k[0], qb[0], s1);
    } else {
        const f32x16 z = {0.f, 0.f, 0.f, 0.f, 0.f, 0.f, 0.f, 0.f, 0.f, 0.f, 0.f, 0.f, 0.f, 0.f, 0.f, 0.f};
        s0 = MFMA32(f.k[0], qa[0], z); s1 = MFMA32(f.k[0], qb[0], z);
    }
#pragma unroll
    for (int kk = 1; kk < 4; ++kk) { s0 = MFMA32(f.k[kk], qa[kk], s0); s1 = MFMA32(f.k[kk], qb[kk], s1); }
    __builtin_amdgcn_s_setprio(0);
#pragma unroll
    for (int kk = 0; kk < 4; ++kk) f.k[kk] = *(const bf16x8*)(Kn + (kk * 64 + lane) * 8);
    float p0[16], p1[16];
#pragma unroll
    for (int i = 0; i < 16; ++i) { p0[i] = fexp2(s0[i]); p1[i] = fexp2(s1[i]); }
    if (TYP == 0 || __ballot((vm0 & vm1) != 0xffffu) != 0ull) {
#pragma unroll
        for (int i = 0; i < 16; ++i) {
            p0[i] = __int_as_float(__float_as_int(p0[i]) & __builtin_amdgcn_sbfe((int)vm0, i, 1));
            p1[i] = __int_as_float(__float_as_int(p1[i]) & __builtin_amdgcn_sbfe((int)vm1, i, 1));
        }
    }
    a0.l += ((p0[0] + p0[1]) + (p0[2] + p0[3])) + ((p0[4] + p0[5]) + (p0[6] + p0[7])) + (((p0[8] + p0[9]) + (p0[10] + p0[11])) + ((p0[12] + p0[13]) + (p0[14] + p0[15])));
    a1.l += ((p1[0] + p1[1]) + (p1[2] + p1[3])) + ((p1[4] + p1[5]) + (p1[6] + p1[7])) + (((p1[8] + p1[9]) + (p1[10] + p1[11])) + ((p1[12] + p1[13]) + (p1[14] + p1[15])));
    u32x4 w00, w01, w10, w11;
#pragma unroll
    for (int i = 0; i < 4; ++i) {
        w00[i] = cvt_pk_bf16(p0[2 * i], p0[2 * i + 1]); w01[i] = cvt_pk_bf16(p0[8 + 2 * i], p0[8 + 2 * i + 1]);
        w10[i] = cvt_pk_bf16(p1[2 * i], p1[2 * i + 1]); w11[i] = cvt_pk_bf16(p1[8 + 2 * i], p1[8 + 2 * i + 1]);
    }
    const bf16x8 f00 = __builtin_bit_cast(bf16x8, w00), f01 = __builtin_bit_cast(bf16x8, w01), f10 = __builtin_bit_cast(bf16x8, w10), f11 = __builtin_bit_cast(bf16x8, w11);
    __builtin_amdgcn_s_setprio(1);
    a0.o0 = MFMA32(f.v[0][0], f00, a0.o0); a1.o0 = MFMA32(f.v[0][0], f10, a1.o0);
    a0.o0 = MFMA32(f.v[0][1], f01, a0.o0); a1.o0 = MFMA32(f.v[0][1], f11, a1.o0);
    a0.o1 = MFMA32(f.v[1][0], f00, a0.o1); a1.o1 = MFMA32(f.v[1][0], f10, a1.o1);
    a0.o1 = MFMA32(f.v[1][1], f01, a0.o1); a1.o1 = MFMA32(f.v[1][1], f11, a1.o1);
    __builtin_amdgcn_s_setprio(0);
#pragma unroll
    for (int db = 0; db < 2; ++db)
#pragma unroll
        for (int u = 0; u < 2; ++u) f.v[db][u] = *(const bf16x8*)(Vn + ((db * 2 + u) * 64 + lane) * 8);
}
template <int TYP>
DI void attn_bc2_chunk(const Params& p, int layer, int bl, int hd, int cidx  , bool st) {
    char* ws = p.ws;
    const int lane = ltid() & 63, w = __builtin_amdgcn_readfirstlane(ltid() >> 6), r = lane & 31, h = lane >> 5;
    const int own = cidx >> 2, q0 = cidx * 64;
    const bf16_t* Q = (const bf16_t*)(ws + (TYP ? OFF_QC : OFF_QB)) + (size_t)(bl * 8 + hd) * S * 64;
    const bf16_t* K = (const bf16_t*)(ws + (TYP ? OFF_KC : OFF_KB)) + (size_t)(bl * 8 + hd) * S * 64;
    const bf16_t* Vt = (const bf16_t*)(ws + (TYP ? OFF_VC : OFF_VB)) + (size_t)(bl * 8 + hd) * 64 * S;
    const unsigned* mrow0 = (const unsigned*)(ws + OFF_MASK) + ((size_t)bl * S + q0 + r) * 128;
    const unsigned* mrow1 = mrow0 + 32 * 128;
    bf16x8 qa[4], qb[4];
    load_q(qa, Q + (size_t)(q0 + r) * 64, h); load_q(qb, Q + (size_t)(q0 + 32 + r) * 64, h);
    const float* gk = p.qk_g + ((size_t)(layer * 3 + 1 + TYP) * 2 + 1) * 64;
    AttnAcc a0, a1; attn_init(a0, attn_bound(qa, gk)); attn_init(a1, attn_bound(qb, gk));
    const bool shifted = a0.shifted || a1.shifted;
    if (shifted && !a0.shifted) a0.nb = 0.f;
    if (shifted && !a1.shifted) a1.nb = 0.f;
    const int d0 = q0 / 32, d1 = d0 + 1;
    unsigned sel0 = 0, sel1 = 0;
    unsigned long long tm0 = 0ull, tm1 = 0ull;
    if (TYP == 1) {
        if (own > 0) {
            const bf16_t* km = (const bf16_t*)(ws + OFF_KM) + (((size_t)(bl * 8 + hd) * 16 + (r & 15)) * 2) * 64;
            f32x16 g0, g1;
#pragma unroll
            for (int i = 0; i < 16; ++i) { g0[i] = 0.f; g1[i] = 0.f; }
#pragma unroll
            for (int kk = 0; kk < 4; ++kk) {
                bf16x8 ahi = *(const bf16x8*)(km + kk * 16 + h * 8), alo = *(const bf16x8*)(km + 64 + kk * 16 + h * 8);
                if (r >= 16) { ahi = (bf16x8){0, 0, 0, 0, 0, 0, 0, 0}; alo = ahi; }
                g0 = MFMA32(ahi, qa[kk], g0); g0 = MFMA32(alo, qa[kk], g0);
                g1 = MFMA32(ahi, qb[kk], g1); g1 = MFMA32(alo, qb[kk], g1);
            }
            auto top3 = [&](const f32x16& gt) -> unsigned {
                float gl[16];
#pragma unroll
                for (int i = 0; i < 8; ++i) {
                    const float mine = gt[i], oth = shx(mine, 32);
                    gl[8 * (i >> 2) + (i & 3)] = h == 0 ? mine : oth;
                    gl[8 * (i >> 2) + 4 + (i & 3)] = h == 0 ? oth : mine;
                }
                unsigned sel = 0;
#pragma unroll
                for (int pick = 0; pick < 3; ++pick) {
                    float best = -3.0e38f; int bi = -1;
#pragma unroll
                    for (int nb = 0; nb < 16; ++nb) { const bool ok = nb < own && !((sel >> nb) & 1u); if (ok && gl[nb] > best) { best = gl[nb]; bi = nb; } }
                    if (bi >= 0) sel |= 1u << bi;
                }
                return sel;
            };
            sel0 = top3(g0); sel1 = top3(g1);
        }
        for (int nb = 0; nb < own; ++nb) if (__ballot(((sel0 | sel1) >> nb) & 1u) != 0ull) { if (nb < 8) tm0 |= 0xffull << (8 * nb); else tm1 |= 0xffull << (8 * (nb - 8)); }
        for (int t = own * 8; t <= d1; ++t) { if (t < 64) tm0 |= 1ull << t; else tm1 |= 1ull << (t - 64); }
    } else {
        for (int t = 0; t <= d1; ++t) { if (t < 64) tm0 |= 1ull << t; else tm1 |= 1ull << (t - 64); }
    }
    const int ntl = __builtin_popcountll(tm0) + __builtin_popcountll(tm1);
    auto pop = [&]() -> int { int t; if (tm0) { t = __builtin_ctzll(tm0); tm0 &= tm0 - 1; } else if (tm1) { t = 64 + __builtin_ctzll(tm1); tm1 &= tm1 - 1; } else t = d1; return t; };
    auto cmask = [&](int t, unsigned sel, int dg) -> unsigned {
        const int cb = t >> 3;
        if (cb < own) return ((sel >> cb) & 1u) ? 0xffffu : 0u;
        if (t < dg) return 0xffffu;
        if (t > dg) return 0u;
        unsigned vm = 0;
#pragma unroll
        for (int i = 0; i < 16; ++i) if (koff(i, h) <= r) vm |= 1u << i;
        return vm;
    };
    auto bmask = [&](unsigned mw) -> unsigned {
        const unsigned ws4 = mw >> (4 * h);
        return (ws4 & 0xfu) | ((ws4 >> 4) & 0xf0u) | ((ws4 >> 8) & 0xf00u) | ((ws4 >> 12) & 0xf000u);
    };
    KVFrag f; int tc = pop(), tn = 0;
    kv_load(f, K + (size_t)tc * 2048, Vt + (size_t)tc * 2048, lane);
    unsigned mwa = 0, mwb = 0, mwan = 0, mwbn = 0;
    if (TYP == 0) { mwa = mrow0[tc]; mwb = mrow1[tc]; }
    for (int it = 0; it < ntl; ++it) {
        tn = pop();
        if (TYP == 0) { mwan = mrow0[tn]; mwbn = mrow1[tn]; }
        unsigned vm0, vm1;
        if (TYP == 0) { vm0 = bmask(mwa); vm1 = bmask(mwb); } else { vm0 = cmask(tc, sel0, d0); vm1 = cmask(tc, sel1, d1); }
        attn_step2<TYP>(a0, a1, f, qa, qb, vm0, vm1, shifted, K + (size_t)tn * 2048, Vt + (size_t)tn * 2048, lane);
        tc = tn; mwa = mwan; mwb = mwbn;
    }
    attn_store_gated(p, a0, (size_t)bl * S + q0 + r, (TYP ? 1024 : 512) + hd * 64, h, st);
    attn_store_gated(p, a1, (size_t)bl * S + q0 + 32 + r, (TYP ? 1024 : 512) + hd * 64, h, st);
}

DI void attn_a2_item(const Params& p, int layer, int bl, int hh, int rb2) {
    char* ws = p.ws;
    const int lane = ltid() & 63, w = __builtin_amdgcn_readfirstlane(ltid() >> 6), r = lane & 31, h = lane >> 5;
    const int g = hh >> 3, sh = 2 * g, n = S >> sh;
    const int row0 = rb2 * 512 + w * 64;
    const int rr = row0 / n, m0 = row0 % n;
    const bf16_t* Q = (const bf16_t*)(ws + OFF_QA) + (size_t)(bl * 24 + hh) * S * 64;
    const bf16_t* K = (const bf16_t*)(ws + OFF_KA) + (size_t)(bl * 24 + hh) * S * 64;
    const bf16_t* Vt = (const bf16_t*)(ws + OFF_VA) + (size_t)(bl * 24 + hh) * 64 * S;
    bf16x8 qa[4], qb[4];
    load_q(qa, Q + (size_t)(row0 + r) * 64, h); load_q(qb, Q + (size_t)(row0 + 32 + r) * 64, h);
    const float* gk = p.qk_g + ((size_t)(layer * 3 + 0) * 2 + 1) * 64;
    AttnAcc a0, a1; attn_init(a0, attn_bound(qa, gk)); attn_init(a1, attn_bound(qb, gk));
    const bool shifted = a0.shifted || a1.shifted;
    if (shifted && !a0.shifted) a0.nb = 0.f;
    if (shifted && !a1.shifted) a1.nb = 0.f;
    const int kfirst = m0 >= 128 ? 0 : (128 - m0) / 32;
    const int tile0 = (rr * n + m0 - 128) / 32;
    auto amask = [&](int k, int sb) -> unsigned {
        const int base = 128 + 32 * sb - 32 * k + r;
        if (base - 31 >= 0 && base <= 128) return 0xffffu;
        if (base < 0 || base - 31 > 128) return 0u;
        unsigned vm = 0;
#pragma unroll
        for (int i = 0; i < 16; ++i) { const int d = base - koff(i, h); if (d >= 0 && d <= 128) vm |= 1u << i; }
        return vm;
    };
    KVFrag f; kv_load(f, K + (size_t)(tile0 + kfirst) * 2048, Vt + (size_t)(tile0 + kfirst) * 2048, lane);
    for (int k = kfirst; k < 6; ++k) {
        const int kn = k + 1 < 6 ? k + 1 : k;
        attn_step2<1>(a0, a1, f, qa, qb, amask(k, 0), amask(k, 1), shifted, K + (size_t)(tile0 + kn) * 2048, Vt + (size_t)(tile0 + kn) * 2048, lane);
    }
#pragma unroll
    for (int sb = 0; sb < 2; ++sb) {
        const AttnAcc& a = sb ? a1 : a0;
        const float l = a.l + shx(a.l, 32);
        const float inv = 1.0f / l;
        const int s_ = ((m0 + 32 * sb + r) << sh) + rr;
        const size_t tl = (size_t)bl * S + s_;
        bf16_t* o = (bf16_t*)(ws + OFF_OA) + ((size_t)g * TG + tl) * 512 + (hh & 7) * 64;
#pragma unroll
        for (int q4 = 0; q4 < 4; ++q4) {
            u32x2 w0, w1;
            w0[0] = cvt_pk_bf16(a.o0[q4 * 4] * inv, a.o0[q4 * 4 + 1] * inv); w0[1] = cvt_pk_bf16(a.o0[q4 * 4 + 2] * inv, a.o0[q4 * 4 + 3] * inv);
            w1[0] = cvt_pk_bf16(a.o1[q4 * 4] * inv, a.o1[q4 * 4 + 1] * inv); w1[1] = cvt_pk_bf16(a.o1[q4 * 4 + 2] * inv, a.o1[q4 * 4 + 3] * inv);
            *(u32x2*)(o + 8 * q4 + 4 * h) = w0; *(u32x2*)(o + 32 + 8 * q4 + 4 * h) = w1;
        }
        if (h == 0) ((float*)(ws + OFF_LSE))[((size_t)g * TG + tl) * 8 + (hh & 7)] = (a.nb + __log2f(l)) * LN2F;
    }
}

DI void merge_a_item(const Params& p, int item, bool st) {
    char* ws = p.ws;
    const int tid = ltid();
    const bf16_t* oa = (const bf16_t*)(ws + OFF_OA);
    const float* lse = (const float*)(ws + OFF_LSE);
    bf16_t* sz = (bf16_t*)(ws + OFF_SZ);
    const int c8 = (tid & 63) * 8, hd = c8 >> 6;
    for (int it = 0; it < 8; it += 4) {
        float l0[4], l1[4], l2[4]; u32x4 a0[4], a1[4], a2[4], zz[4];
#pragma unroll
        for (int u = 0; u < 4; ++u) {
            const size_t tl = (size_t)item * 64 + (it + u) * 8 + (tid >> 6);
            l0[u] = lse[(0 * (size_t)TG + tl) * 8 + hd]; l1[u] = lse[(1 * (size_t)TG + tl) * 8 + hd]; l2[u] = lse[(2 * (size_t)TG + tl) * 8 + hd];
            a0[u] = *(const u32x4*)(oa + (0 * (size_t)TG + tl) * 512 + c8); a1[u] = *(const u32x4*)(oa + (1 * (size_t)TG + tl) * 512 + c8); a2[u] = *(const u32x4*)(oa + (2 * (size_t)TG + tl) * 512 + c8);
            zz[u] = *(const u32x4*)(sz + tl * 1536 + c8);
        }
#pragma unroll
        for (int u = 0; u < 4; ++u) {
            const size_t tl = (size_t)item * 64 + (it + u) * 8 + (tid >> 6);
            const float mx = fmaxf(l0[u], fmaxf(l1[u], l2[u]));
            float w0 = __expf(l0[u] - mx), w1 = __expf(l1[u] - mx), w2 = __expf(l2[u] - mx);
            const float inv = 1.0f / (w0 + w1 + w2); w0 *= inv; w1 *= inv; w2 *= inv;
            u32x4 res;
#pragma unroll
            for (int k = 0; k < 4; ++k) {
                const float lo = (w0 * __uint_as_float(a0[u][k] << 16) + w1 * __uint_as_float(a1[u][k] << 16) + w2 * __uint_as_float(a2[u][k] << 16)) * __uint_as_float(zz[u][k] << 16);
                const float hi = (w0 * __uint_as_float(a0[u][k] & 0xffff0000u) + w1 * __uint_as_float(a1[u][k] & 0xffff0000u) + w2 * __uint_as_float(a2[u][k] & 0xffff0000u)) * __uint_as_float(zz[u][k] & 0xffff0000u);
                res[k] = cvt_pk_bf16(lo, hi);
            }
            if (st) *(u32x4*)(sz + tl * 1536 + c8) = res;
        }
    }
}

DI int snake_item(int round, int G, int bid) { return (round & 1) ? round * G + (G - 1 - bid) : round * G + bid; }

__global__ void __launch_bounds__(NTHREADS) fwd_megakernel(Params p) {
    __shared__ __attribute__((aligned(16))) char shm_raw[SHM_BYTES];
    cg::grid_group grid = cg::this_grid();
    char* ws = p.ws;
    const int G = gridDim.x, bid = blockIdx.x;
    __attribute__((address_space(3))) bf16_t* shm_g = (__attribute__((address_space(3))) bf16_t*)shm_raw;

    unsigned* barcnt = (unsigned*)(ws + OFF_BAR2);
    unsigned bartarget = 0;
    if (bid == 0 && threadIdx.x < 9) __hip_atomic_store(barcnt + 32 * threadIdx.x, 0u, __ATOMIC_RELAXED, __HIP_MEMORY_SCOPE_AGENT);
    if (bid == 0 && threadIdx.x < DEPTH * NGRP * 64) ((unsigned*)(ws + OFF_FLAG))[threadIdx.x] = 0u;
    phase_prep(p, shm_raw);
    if (DUPMASK & 64) { __syncthreads(); phase_prep(p, shm_raw); }
    grid.sync();

#define LAUNDER() do { } while (0)
    unsigned long long tspan = 0ull, tprev = SPINSEL ? wall_clock64() : 0ull;
#define PHASE_END(k) do { if (SPINSEL) { const unsigned long long tn_ = wall_clock64(); if (SPINSEL == (k)) tspan += tn_ - tprev; tprev = tn_; } } while (0)
    for (int layer = 0; layer < DEPTH; ++layer) {
        for (int grp = 0; grp < NGRP; ++grp) {
            const int gtok0 = grp * TG;
            LAUNDER();
            for (int rep = 0; rep <= (DUPMASK & 1); ++rep) {
                EpiIn epi{&p, layer, gtok0};
                gemm_phase<true>((const bf16_t*)(ws + OFF_WTIN), DM, 0, NPAD, (const bf16_t*)(ws + OFF_XB), DM, 0, TG, DM, 1, epi, shm_g);
            }
            grid_barrier(barcnt, bartarget, (unsigned)G);
            if (DUPMASK & 32) grid_barrier(barcnt, bartarget, (unsigned)G);
            PHASE_END(1);
            LAUNDER();
            for (int rep = 0; rep <= ((DUPMASK >> 1) & 1); ++rep) {
                const int nsel = BG * 256;
                const int nA = BG * 24 * 8, nK = BG * 8 * 16;
                const int rS = (nsel + G - 1) / G, rA = (nA + G - 1) / G, rK = (nK + G - 1) / G, rT = rS + rA + rK;
                const int off = (bid & 1) ? rS : 0;
                for (int st_ = 0; st_ < rT; ++st_) {
                    int s2 = st_ + off; if (s2 >= rT) s2 -= rT;
                    if (s2 < rS) {
                        const int it = snake_item(s2, G, bid);
                        if (it < nsel) select_chunk(p, it % BG, 255 - it / BG, shm_raw);
                    } else if (s2 < rS + rA) {
                        const int it = (s2 - rS) * G + bid;
                        if (it < nA) attn_a2_item(p, layer, it / (24 * 8), (it / 8) % 24, it % 8);
                    } else {
                        const int it = (s2 - rS - rA) * G + bid;
                        if (it < nK) kmean_item(p, it / 128, (it / 16) & 7, it & 15, shm_raw);
                    }
                }
            }
            grid_barrier(barcnt, bartarget, (unsigned)G);
            if (DUPMASK & 32) grid_barrier(barcnt, bartarget, (unsigned)G);
            PHASE_END(2);
            LAUNDER();
            for (int rep = ((DUPMASK >> 2) & 1); rep >= 0; --rep) {
                const bool st = rep == 0 || p.dupmask == 0x7fffffff;
#if ATTN64
                const int nbc = 2 * BG * 8 * 4;
                const int wv = __builtin_amdgcn_readfirstlane(ltid() >> 6);
                for (int it = bid; it < nbc; it += G) {
                    const int j = it & 3, sub = it >> 2, typ = sub / (BG * 8), bl = (sub / 8) % BG, hd = sub & 7;
                    const int c0 = j * 8 + wv, c1 = 63 - c0;
                    if (typ == 0) { attn_bc2_chunk<0>(p, layer, bl, hd, c1, st); attn_bc2_chunk<0>(p, layer, bl, hd, c0, st); }
                    else { attn_bc2_chunk<1>(p, layer, bl, hd, c1, st); attn_bc2_chunk<1>(p, layer, bl, hd, c0, st); }
                }
#else
                const int nbc = 2 * BG * 8 * 16;
                for (int rnd = 0;; ++rnd) {
                    const int it = snake_item(rnd, G, bid);
                    if (rnd * G >= nbc) break;
                    if (it < nbc) {
                        const int qb = 15 - it / (2 * BG * 8), sub = it % (2 * BG * 8), typ = sub / (BG * 8), bl = (sub / 8) % BG, hd = sub & 7;
                        {
#if ATTN_LDS
                            attn_bc_item(p, layer, typ, bl, hd, qb, st, shm_raw);
#else
                            if (typ == 0) attn_b_item(p, layer, bl, hd, qb, st, st ? 0 : ((p.dupmask >> 8) & 3)); else if (st || ((p.dupmask >> 10) & 1) == 0) attn_c_item(p, layer, bl, hd, qb, st);
#endif
                        }
                    }
                }
#endif
                for (int it = bid; it < TG / 64; it += G) merge_a_item(p, it, st);
            }
            grid_barrier(barcnt, bartarget, (unsigned)G);
            if (DUPMASK & 32) grid_barrier(barcnt, bartarget, (unsigned)G);
            PHASE_END(3);
            LAUNDER();
            for (int rep = 0; rep <= ((DUPMASK >> 3) & 1); ++rep) {
                EpiBr epi{&p};
                gemm_phase<false>((const bf16_t*)(ws + OFF_WTBR) + (size_t)layer * 3 * DM * 512, 512, (size_t)DM * 512, DM, (const bf16_t*)(ws + OFF_SZ), 1536, 512, TG, 512, 3, epi, shm_g);
            }
            {
                const bool handoff = (DUPMASK == 0) && G == (DM / BM) * (TG / BM);
                if (handoff) {
                    int pm_, pn_; gemm_tile_of(bid, DM / BM, TG / BM, pm_, pn_);
                    unsigned* fl = (unsigned*)(ws + OFF_FLAG) + (layer * NGRP + grp) * 64 + pn_;
                    __syncthreads();
                    if (threadIdx.x == 0) {
                        __builtin_amdgcn_fence(__ATOMIC_RELEASE, "agent");
                        __hip_atomic_fetch_add(fl, 1u, __ATOMIC_RELAXED, __HIP_MEMORY_SCOPE_AGENT);
                        while (__hip_atomic_load(fl, __ATOMIC_RELAXED, __HIP_MEMORY_SCOPE_AGENT) < (unsigned)(DM / BM)) __builtin_amdgcn_s_sleep(1);
                        __builtin_amdgcn_fence(__ATOMIC_ACQUIRE, "agent");
                    }
                    __syncthreads();
                } else {
                    grid_barrier(barcnt, bartarget, (unsigned)G);
                    if (DUPMASK & 32) grid_barrier(barcnt, bartarget, (unsigned)G);
                }
            }
            PHASE_END(4);
            LAUNDER();
            for (int rep = ((DUPMASK >> 4) & 1); rep >= 0; --rep) {
                EpiOut epi{&p, layer, gtok0, rep == 0 || p.dupmask == 0x7fffffff};
                gemm_phase<false>((const bf16_t*)(ws + OFF_WTOUT) + (size_t)layer * DM * DM, DM, 0, DM, (const bf16_t*)(ws + OFF_MB), DM, 0, TG, DM, 1, epi, shm_g);
                if (rep == 0) {
                    const int nl = grp + 1 < NGRP ? layer : layer + 1, ng = grp + 1 < NGRP ? grp + 1 : 0;
                    if (nl < DEPTH) {
                        __syncthreads();
                        const float* xsrc = (nl == 0 ? p.x : (const float*)p.out) + (size_t)ng * TG * DM;
                        int per = (TG + G - 1) / G; int tb = bid * per, te = tb + per < TG ? tb + per : TG;
                        xprep_tokens(xsrc, (bf16_t*)(ws + OFF_XB), (float*)(ws + OFF_SS), tb, te);
                        if (nl != layer) for (int it = bid; it < 16 * 204; it += G) convert_win_tile(p, nl, it, (float*)shm_raw);
                    }
                }
            }
            grid_barrier(barcnt, bartarget, (unsigned)G);
            if (DUPMASK & 32) grid_barrier(barcnt, bartarget, (unsigned)G);
            PHASE_END(5);
        }
    }
    if (SPINSEL) { const unsigned long long t0_ = wall_clock64(); while (wall_clock64() - t0_ < tspan) __builtin_amdgcn_s_sleep(8); }
}

extern "C" void kernel_launch(void* const* d_in, const int* in_sizes, int n_in, void* d_out, int out_size, void* d_ws, size_t ws_size, hipStream_t stream) {
    static int grid_blocks = 0;
    if (!grid_blocks) {
        int dev = 0, cus = 0, per_cu = 0;
        hipGetDevice(&dev);
        hipDeviceGetAttribute(&cus, hipDeviceAttributeMultiprocessorCount, dev);
        hipOccupancyMaxActiveBlocksPerMultiprocessor(&per_cu, fwd_megakernel, NTHREADS, 0);
        if (per_cu > 1) per_cu = 1;
        grid_blocks = cus * per_cu;
    }
    if (ws_size < WS_NEED) { fprintf(stderr, "workspace too small: %zu < %zu\n", ws_size, (size_t)WS_NEED); return; }
    Params p{};
    p.dupmask = DUPMASK; p.pad_ = 0;
    p.x = (const float*)d_in[0]; p.pos = (const int*)d_in[1]; p.norm_g = (const float*)d_in[2]; p.w_in = (const float*)d_in[3];
    p.qk_g = (const float*)d_in[4]; p.w_br = (const float*)d_in[5]; p.w_out = (const float*)d_in[6];
    p.out = (float*)d_out; p.ws = (char*)d_ws;
    void* args[] = {&p};
    hipError_t e = hipLaunchCooperativeKernel((void*)fwd_megakernel, dim3(grid_blocks), dim3(NTHREADS), args, 0, stream);
    if (e != hipSuccess) fprintf(stderr, "cooperative launch failed: %s (grid %d)\n", hipGetErrorString(e), grid_blocks);
}
```

```cpp
#include <hip/hip_runtime.h>
#include <hip/hip_cooperative_groups.h>
#include <cstdio>
#include <cstdint>
namespace cg = cooperative_groups;
#define ATTN_LDS 0
#define ATTN64 1
#define SPINSEL 0
#define DUPMASK 0

typedef unsigned short bf16_t;
typedef short bf16x8 __attribute__((ext_vector_type(8)));
typedef short s16x4 __attribute__((ext_vector_type(4)));
typedef float f32x4 __attribute__((ext_vector_type(4)));
typedef float f32x16 __attribute__((ext_vector_type(16)));
typedef unsigned u32x4 __attribute__((ext_vector_type(4)));
typedef unsigned u32x2 __attribute__((ext_vector_type(2)));
#define DI __device__ __forceinline__

constexpr int S = 4096, DM = 1024, NB = 8, DEPTH = 2;
constexpr int NIN = 12872, NPAD = 13056;
constexpr int BG = 4, TG = BG * S, NGRP = NB / BG;
constexpr int NTHREADS = 512;
constexpr int SHM_BYTES = 131072;
constexpr float QSCALE = 0.125f * 1.4426950408889634f;
constexpr float LN2F = 0.6931471805599453f;
constexpr int SEL_CAP = 768;

constexpr size_t al256(size_t x) { return (x + 255) & ~(size_t)255; }
constexpr size_t OFF_WTIN = 0;
constexpr size_t OFF_WTBR = OFF_WTIN + al256((size_t)NPAD * DM * 2);
constexpr size_t OFF_WTOUT = OFF_WTBR + al256((size_t)DEPTH * 3 * DM * 512 * 2);
constexpr size_t OFF_CS = OFF_WTOUT + al256((size_t)DEPTH * DM * DM * 2);
constexpr size_t OFF_XB = OFF_CS + al256((size_t)NB * S * 8 * 8);
constexpr size_t OFF_OA = OFF_XB;
constexpr size_t OFF_SS = OFF_XB + al256((size_t)3 * TG * 512 * 2);
constexpr size_t OFF_QA = OFF_SS + al256((size_t)TG * 8 * 4);
constexpr size_t OFF_KA = OFF_QA + al256((size_t)TG * 1536 * 2);
constexpr size_t OFF_VA = OFF_KA + al256((size_t)TG * 1536 * 2);
constexpr size_t OFF_MF = OFF_QA;
constexpr size_t OFF_MB = OFF_VA;
constexpr size_t OFF_QB = OFF_VA + al256((size_t)TG * 1536 * 2);
constexpr size_t OFF_KB = OFF_QB + al256((size_t)TG * 512 * 2);
constexpr size_t OFF_VB = OFF_KB + al256((size_t)TG * 512 * 2);
constexpr size_t OFF_QC = OFF_VB + al256((size_t)TG * 512 * 2);
constexpr size_t OFF_KC = OFF_QC + al256((size_t)TG * 512 * 2);
constexpr size_t OFF_VC = OFF_KC + al256((size_t)TG * 512 * 2);
constexpr size_t OFF_IQ = OFF_VC + al256((size_t)TG * 512 * 2);
constexpr size_t OFF_IK = OFF_IQ + al256((size_t)TG * 512 * 2);
constexpr size_t OFF_IW = OFF_IK + al256((size_t)TG * 64 * 2);
constexpr size_t OFF_SZ = OFF_IW + al256((size_t)TG * 8 * 4);
constexpr size_t OFF_SG = OFF_SZ + al256((size_t)TG * 1536 * 2);
constexpr size_t OFF_LSE = OFF_SG + al256((size_t)TG * 3072 * 2);
constexpr size_t OFF_MASK = OFF_LSE + al256((size_t)3 * TG * 8 * 4);
constexpr size_t OFF_KM = OFF_MASK + al256((size_t)BG * S * (S / 8));
static_assert((size_t)TG * DM * 4 <= (size_t)2 * TG * 1536 * 2 && (size_t)TG * DM * 2 <= (size_t)TG * 1536 * 2, "overlay sizes");
constexpr size_t OFF_BAR = OFF_KM + al256((size_t)BG * 8 * 16 * 64 * 2 * 2);
constexpr size_t OFF_FLAG = OFF_BAR + 256;
constexpr size_t OFF_BAR2 = OFF_FLAG + (size_t)DEPTH * NGRP * 64 * 4;
constexpr size_t WS_NEED = OFF_BAR2 + 9 * 128;

struct Params {
    const float* x; const int* pos; const float* norm_g; const float* w_in; const float* qk_g; const float* w_br; const float* w_out;
    float* out; char* ws; int dupmask; int pad_;
};

DI int ltid() { int t = threadIdx.x; asm volatile("" : "+v"(t)); return t; }
DI unsigned cvt_pk_bf16(float lo, float hi) { unsigned r; asm volatile("v_cvt_pk_bf16_f32 %0, %1, %2" : "=v"(r) : "v"(lo), "v"(hi)); return r; }
DI bf16_t f2bf(float x) { return (bf16_t)(cvt_pk_bf16(x, 0.f) & 0xffffu); }
DI float bf2f(bf16_t v) { return __uint_as_float(((unsigned)v) << 16); }
DI float fexp2(float x) { return __builtin_amdgcn_exp2f(x); }
DI float shx(float v, int mask) { const int l = ltid() & 63; return __int_as_float(__builtin_amdgcn_ds_bpermute((l ^ mask) << 2, __float_as_int(v))); }
DI float wave_sum(float v) { for (int o = 32; o > 0; o >>= 1) v += shx(v, o); return v; }
DI int f2sort(float f) { int i = __float_as_int(f); return i ^ ((i >> 31) & 0x7fffffff); }
DI float sort2f(int i) { return __int_as_float(i ^ ((i >> 31) & 0x7fffffff)); }
#define MFMA32(a, b, c) __builtin_amdgcn_mfma_f32_32x32x16_bf16((a), (b), (c), 0, 0, 0)
#define MFMA16(a, b, c) __builtin_amdgcn_mfma_f32_16x16x32_bf16((a), (b), (c), 0, 0, 0)

DI void grid_barrier(unsigned* bar, unsigned& gen, unsigned G) {
    __syncthreads();
    gen += 1;
    if (threadIdx.x == 0) {
        __builtin_amdgcn_fence(__ATOMIC_RELEASE, "agent");
        const unsigned sh = blockIdx.x & 7u, per = (G + 7u - sh) >> 3, nsh = G < 8u ? G : 8u;
        const unsigned old = __hip_atomic_fetch_add(bar + 32 * (1 + sh), 1u, __ATOMIC_RELAXED, __HIP_MEMORY_SCOPE_AGENT);
        if (old + 1u == per * gen) __hip_atomic_fetch_add(bar, 1u, __ATOMIC_RELAXED, __HIP_MEMORY_SCOPE_AGENT);
        while (__hip_atomic_load(bar, __ATOMIC_RELAXED, __HIP_MEMORY_SCOPE_AGENT) < nsh * gen) __builtin_amdgcn_s_sleep(2);
        __builtin_amdgcn_fence(__ATOMIC_ACQUIRE, "agent");
    }
    __syncthreads();
}

DI int src_col_of_group(int hg) { return hg <= 104 ? hg * 64 : (hg <= 200 ? 6728 + (hg - 105) * 64 : 6720); }

DI void convert_tile(const float* src, int ld_src, int k0, int n_src0, int n_valid, const float* kscale, bf16_t* dst, int ld_dst, int n_dst0, float* tl  ) {
    const int tid = ltid();
    __syncthreads();
#pragma unroll
    for (int i = 0; i < 8; ++i) {
        int e = tid + i * 512, kk = e >> 6, nn = e & 63;
        float v = 0.f;
        if (nn < n_valid) { v = src[(size_t)(k0 + kk) * ld_src + n_src0 + nn]; if (kscale) v *= kscale[k0 + kk]; }
        tl[kk * 65 + nn] = v;
    }
    __syncthreads();
#pragma unroll
    for (int i = 0; i < 4; ++i) {
        int e = tid + i * 512, nn = e >> 5, kp = (e & 31) * 2;
        unsigned w = cvt_pk_bf16(tl[kp * 65 + nn], tl[(kp + 1) * 65 + nn]);
        *(unsigned*)(dst + (size_t)(n_dst0 + nn) * ld_dst + k0 + kp) = w;
    }
}

DI void xprep_tokens(const float* xsrc  , bf16_t* xb, float* ss, int tok_begin, int tok_end) {
    const int lane = ltid() & 63, wid = ltid() >> 6;
    for (int t = tok_begin + wid; t < tok_end; t += 8) {
        const float* xr = xsrc + (size_t)t * DM;
        float sum = 0.f;
#pragma unroll
        for (int i = 0; i < 4; ++i) {
            f32x4 v = *(const f32x4*)(xr + i * 256 + lane * 4);
            sum += v[0] * v[0] + v[1] * v[1] + v[2] * v[2] + v[3] * v[3];
            u32x2 w; w[0] = cvt_pk_bf16(v[0], v[1]); w[1] = cvt_pk_bf16(v[2], v[3]);
            *(u32x2*)(xb + (size_t)t * DM + i * 256 + lane * 4) = w;
        }
        sum = wave_sum(sum);
        if (lane < 8) ss[(size_t)t * 8 + lane] = lane == 0 ? sum : 0.f;
    }
}

DI void convert_win_tile(const Params& p, int l, int it, float* tl) {
    const int hg = it / 16, kt = it % 16;
    const int nvalid = hg <= 200 ? 64 : (hg == 201 ? 8 : 0);
    convert_tile(p.w_in + (size_t)l * DM * NIN, NIN, kt * 64, src_col_of_group(hg), nvalid, p.norm_g + l * DM, (bf16_t*)(p.ws + OFF_WTIN), DM, hg * 64, tl);
}
DI void phase_prep(const Params& p, char* shm) {
    char* ws = p.ws;
    const int G = gridDim.x, bid = blockIdx.x, tid = ltid();
    float2* cs = (float2*)(ws + OFF_CS);
    for (int e = bid * NTHREADS + tid; e < NB * S * 8; e += G * NTHREADS) {
        int i = e & 7, t = e >> 3;
        float inv = powf(500000.0f, -(float)(2 * i) / 16.0f);
        float ang = (float)p.pos[t] * inv;
        double rev = (double)ang * 0.15915494309189535;
        rev -= floor(rev);
        float rf = (float)rev;
        cs[e] = make_float2(__builtin_amdgcn_cosf(rf), __builtin_amdgcn_sinf(rf));
    }
    float* tl = (float*)shm;
    const int n_in_tiles = 16 * 204, n_br_tiles = DEPTH * 3 * 8 * 16, n_out_tiles = DEPTH * 16 * 16;
    for (int it = bid; it < n_in_tiles + n_br_tiles + n_out_tiles; it += G) {
        if (it < n_in_tiles) {
            convert_win_tile(p, 0, it, tl);
        } else if (it < n_in_tiles + n_br_tiles) {
            int r = it - n_in_tiles; int ln = r / 128, q = r % 128, kt = q / 16, nt = q % 16;
            convert_tile(p.w_br + (size_t)ln * 512 * DM, DM, kt * 64, nt * 64, 64, nullptr, (bf16_t*)(ws + OFF_WTBR) + (size_t)ln * DM * 512, 512, nt * 64, tl);
        } else {
            int r = it - n_in_tiles - n_br_tiles; int l = r / 256, q = r % 256, kt = q / 16, nt = q % 16;
            convert_tile(p.w_out + (size_t)l * DM * DM, DM, kt * 64, nt * 64, 64, nullptr, (bf16_t*)(ws + OFF_WTOUT) + (size_t)l * DM * DM, DM, nt * 64, tl);
        }
    }
    int per = (TG + G - 1) / G;
    int tb = bid * per, te = tb + per < TG ? tb + per : TG;
    xprep_tokens(p.x, (bf16_t*)(ws + OFF_XB), (float*)(ws + OFF_SS), tb, te);
}

constexpr int BM = 256, BK = 64, HALF = 128, NXCD = 8, WGM = 8, HT = HALF * BK;
DI int lds_byte(int r, int c) { int st = (r >> 4) * 2 + (c >> 5), rr = r & 15, cc = c & 31, ob = rr * 64 + cc * 2; return st * 1024 + (ob ^ (((ob >> 9) & 1) << 5)); }
DI void stage_rc(int b, int& R, int& C) { int st = b / 1024, sb = b % 1024, swz = sb ^ (((sb >> 9) & 1) << 5); R = (st >> 1) * 16 + swz / 64; C = (st & 1) * 32 + (swz % 64) / 2; }

#define SA(b, h) (shm + ((b) * 2 + (h)) * HT)
#define SB(b, h) (shm + (4 + (b) * 2 + (h)) * HT)
DI void glds16(const void* sbase, unsigned voff, unsigned lds_dst) {
    unsigned keep;
    asm volatile("s_mov_b32 %0, m0\n\ts_mov_b32 m0, %3\n\ts_nop 0\n\tglobal_load_lds_dwordx4 %1, %2\n\ts_mov_b32 m0, %0"
                 : "=&s"(keep) : "v"(voff), "s"(sbase), "s"(lds_dst) : "memory");
}
#define STAGE(P, BASE, LD, br, kt, VOFF) do { const bf16_t* _gp = (BASE) + (size_t)(br) * (LD) + (size_t)(kt) * BK; \
    const unsigned _l0 = (unsigned)(size_t)(P) + wbase16; \
    glds16(_gp, VOFF[0], _l0); glds16(_gp, VOFF[1], _l0 + 8192u); } while (0)
#define LDA(dst, b, h) _Pragma("unroll") for (int m = 0; m < 4; ++m) _Pragma("unroll") for (int k = 0; k < 2; ++k) \
    dst[m][k] = *reinterpret_cast<const bf16x8*>((char*)SA(b, h) + lds_byte(wr * 64 + m * 16 + fr, k * 32 + fq * 8))
#define LDB(dst, b, h) _Pragma("unroll") for (int n = 0; n < 2; ++n) _Pragma("unroll") for (int k = 0; k < 2; ++k) \
    dst[n][k] = *reinterpret_cast<const bf16x8*>((char*)SB(b, h) + lds_byte(wc * 32 + n * 16 + fr, k * 32 + fq * 8))
#define MMA(ai, bj, At, Bt_) do { __builtin_amdgcn_s_setprio(1); \
    _Pragma("unroll") for (int m = 0; m < 4; ++m) _Pragma("unroll") for (int n = 0; n < 2; ++n) _Pragma("unroll") for (int k = 0; k < 2; ++k) \
      acc[ai][bj][m][n] = MFMA16(At[m][k], Bt_[n][k], acc[ai][bj][m][n]); \
    __builtin_amdgcn_s_setprio(0); } while (0)
#define WAIT_V(n) asm volatile("s_waitcnt vmcnt(" #n ")" ::: "memory")
#define WAIT_L(n) asm volatile("s_waitcnt lgkmcnt(" #n ")" ::: "memory")
#define BAR __builtin_amdgcn_s_barrier()
#define SCHED __builtin_amdgcn_sched_barrier(0)

DI int fold_tok(int rho, int sh) { const int b = rho >> 12, rb = rho & (S - 1); return (b << 12) + (((rb & ((S >> sh) - 1)) << sh) + (rb >> (12 - sh))); }
DI void gemm_tile_of(int L, int nM, int nN, int& pm, int& pn) {
    const int nwg = nM * nN; int wgid = L;
    { int q = nwg / NXCD, r = nwg % NXCD, xcd = wgid % NXCD, off = wgid / NXCD; wgid = (xcd < r ? xcd * (q + 1) : r * (q + 1) + (xcd - r) * q) + off; }
    const int nig = WGM * nN, gid = wgid / nig, fm = gid * WGM, gsz = min(nM - fm, WGM);
    pm = fm + ((wgid % nig) % gsz); pn = (wgid % nig) / gsz;
}
template <bool FOLD, class Epi>
DI void gemm_phase(const bf16_t* __restrict__ Abase, int lda, size_t a_sub, int M, const bf16_t* __restrict__ Bbase, int ldb, size_t b_sub, int N, int K, int nsub,
                   Epi& epi, __attribute__((address_space(3))) bf16_t* shm) {
    const int nM = M / BM, nN = N / BM, nwg = nM * nN;
    const int wid = ltid() >> 6, lane = ltid() & 63, wr = wid >> 2, wc = wid & 3, fr = lane & 15, fq = lane >> 4;
    const int nt = K / BK;
    unsigned voffA[2], voffB0[2], voffB1[2];
    const unsigned wbase16 = __builtin_amdgcn_readfirstlane((ltid() & ~63u) * 16u);
#pragma unroll
    for (int i = 0; i < 2; ++i) {
        int r_, c_; stage_rc(ltid() * 16 + i * 8192, r_, c_);
        const int x_ = r_ & 63, pr_ = (r_ & 64) + ((x_ & 15) >> 2) * 16 + (x_ >> 4) * 4 + (x_ & 3);
        voffA[i] = (unsigned)(pr_ * lda + c_) * 2u;
    }
    int L = blockIdx.x, sub = 0, brow = 0, bcol = 0;
    bool have = L < nwg, prefetched = false;
    const bf16_t* A = Abase; const bf16_t* Bt = Bbase;
    auto setup = [&](int L_, int sub_) {
        int wgid = L_;
        { int q = nwg / NXCD, r = nwg % NXCD, xcd = wgid % NXCD, off = wgid / NXCD; wgid = (xcd < r ? xcd * (q + 1) : r * (q + 1) + (xcd - r) * q) + off; }
        const int nig = WGM * nN, gid = wgid / nig, fm = gid * WGM, gsz = min(nM - fm, WGM);
        const int pm = fm + ((wgid % nig) % gsz), pn = (wgid % nig) / gsz;
        brow = pm * BM; bcol = pn * BM;
        const int sh = (FOLD && pm < 18) ? 2 * ((pm % 6) >> 1) : 0;
        const int t_ = ltid();
#pragma unroll
        for (int i = 0; i < 2; ++i) {
            int r_, c_; stage_rc(t_ * 16 + i * 8192, r_, c_);
            voffB0[i] = (unsigned)(fold_tok(bcol + r_, sh) * ldb + c_) * 2u;
            voffB1[i] = (unsigned)(fold_tok(bcol + HALF + r_, sh) * ldb + c_) * 2u;
        }
        A = Abase + (size_t)sub_ * a_sub; Bt = Bbase + (size_t)sub_ * b_sub;
    };
    while (have) {
        {
            setup(L, sub);
            f32x4 acc[2][2][4][2] = {};
            bf16x8 At[4][2], B0[2][2], B1[2][2];
            if (!prefetched) {
                STAGE(SB(0, 0), Bt, ldb, 0, 0, voffB0); STAGE(SA(0, 0), A, lda, brow, 0, voffA);
                STAGE(SB(0, 1), Bt, ldb, 0, 0, voffB1); STAGE(SA(0, 1), A, lda, brow + HALF, 0, voffA);
            }
            if (wr == 1) BAR;
            if (prefetched) WAIT_V(0); else WAIT_V(4);
            BAR;
            STAGE(SB(1, 0), Bt, ldb, 0, 1, voffB0); STAGE(SA(1, 0), A, lda, brow, 1, voffA); STAGE(SB(1, 1), Bt, ldb, 0, 1, voffB1);
            WAIT_V(6); BAR;
            for (int t = 0; t < nt - 2; t += 2) {
                LDB(B0, 0, 0); SCHED; LDA(At, 0, 0); STAGE(SA(1, 1), A, lda, brow + HALF, t + 1, voffA);
                WAIT_L(8); BAR; WAIT_L(0); MMA(0, 0, At, B0); BAR; SCHED;
                LDB(B1, 0, 1); STAGE(SB(0, 0), Bt, ldb, 0, t + 2, voffB0);
                BAR; WAIT_L(0); MMA(0, 1, At, B1); BAR;
                LDA(At, 0, 1); STAGE(SA(0, 0), A, lda, brow, t + 2, voffA);
                BAR; WAIT_L(0); MMA(1, 0, At, B0); BAR; SCHED;
                STAGE(SB(0, 1), Bt, ldb, 0, t + 2, voffB1);
                WAIT_V(6); BAR; MMA(1, 1, At, B1); BAR;
                LDB(B0, 1, 0); SCHED; LDA(At, 1, 0); STAGE(SA(0, 1), A, lda, brow + HALF, t + 2, voffA);
                WAIT_L(8); BAR; WAIT_L(0); MMA(0, 0, At, B0); BAR; SCHED;
                LDB(B1, 1, 1); STAGE(SB(1, 0), Bt, ldb, 0, t + 3, voffB0);
                BAR; WAIT_L(0); MMA(0, 1, At, B1); BAR;
                LDA(At, 1, 1); STAGE(SA(1, 0), A, lda, brow, t + 3, voffA);
                BAR; WAIT_L(0); MMA(1, 0, At, B0); BAR; SCHED;
                STAGE(SB(1, 1), Bt, ldb, 0, t + 3, voffB1);
                WAIT_V(6); BAR; MMA(1, 1, At, B1); BAR;
            }
            { LDB(B0, 0, 0); LDA(At, 0, 0); STAGE(SA(1, 1), A, lda, brow + HALF, nt - 1, voffA);
              BAR; WAIT_L(0); MMA(0, 0, At, B0); BAR;
              LDB(B1, 0, 1); BAR; WAIT_L(0); MMA(0, 1, At, B1); BAR;
              LDA(At, 0, 1); WAIT_V(4); BAR; WAIT_L(0); MMA(1, 0, At, B0); MMA(1, 1, At, B1); BAR; }
            { LDB(B0, 1, 0); LDA(At, 1, 0); WAIT_V(2); BAR; WAIT_L(0); MMA(0, 0, At, B0); BAR;
              LDB(B1, 1, 1); WAIT_V(0); BAR; WAIT_L(0); MMA(0, 1, At, B1); BAR;
              LDA(At, 1, 1); BAR; WAIT_L(0); MMA(1, 0, At, B0); MMA(1, 1, At, B1); BAR; }
            if (wr == 0) BAR;
            const int e_brow = brow, e_bcol = bcol, e_sub = sub;
            if (++sub == nsub) { sub = 0; L += gridDim.x; }
            have = L < nwg;
            if (have) {
                setup(L, sub);
                STAGE(SB(0, 0), Bt, ldb, 0, 0, voffB0); STAGE(SA(0, 0), A, lda, brow, 0, voffA);
                STAGE(SB(0, 1), Bt, ldb, 0, 0, voffB1); STAGE(SA(0, 1), A, lda, brow + HALF, 0, voffA);
                prefetched = true;
            }
            { int t2 = ltid();
              const int wid2 = t2 >> 6, lane2 = t2 & 63;
              epi(acc, e_brow, e_bcol, e_sub, wid2 >> 2, wid2 & 3, lane2 & 15, lane2 >> 4); }
        }
    }
}

struct EpiIn {
    const Params* p; int layer; int gtok0;
    DI void operator()(const f32x4 (&acc)[2][2][4][2], int brow, int bcol, int sub, int wr, int wc, int fr, int fq) const {
        char* ws = p->ws;
        const float* ss = (const float*)(ws + OFF_SS);
        const float2* cs = (const float2*)(ws + OFF_CS);
        const int lane = ltid() & 63; const int tg_unused = 0;
        const int pm_ = brow >> 8;
        const int shf = pm_ < 18 ? 2 * ((pm_ % 6) >> 1) : 0;
        float rstd4[2][2];
        {
            f32x4 sA[2][2], sB[2][2];
#pragma unroll
            for (int bj = 0; bj < 2; ++bj)
#pragma unroll
                for (int n = 0; n < 2; ++n) {
                    const int tl_ = fold_tok(bcol + bj * 128 + wc * 32 + n * 16 + fr, shf);
                    sA[bj][n] = *(const f32x4*)(ss + (size_t)tl_ * 8); sB[bj][n] = *(const f32x4*)(ss + (size_t)tl_ * 8 + 4);
                }
#pragma unroll
            for (int bj = 0; bj < 2; ++bj)
#pragma unroll
                for (int n = 0; n < 2; ++n) {
                    const f32x4 s0 = sA[bj][n], s1 = sB[bj][n];
                    rstd4[bj][n] = rsqrtf((s0[0] + s0[1] + s0[2] + s0[3] + s1[0] + s1[1] + s1[2] + s1[3]) * (1.0f / DM) + 1e-6f);
                }
        }
#pragma unroll
        for (int ai = 0; ai < 2; ++ai) {
            const int hg = (brow + ai * 128 + wr * 64) >> 6;
            int kind;
            int mixer = 0, isk = 0, hh = 0, H = 8; size_t qoff = 0, koff = 0, voff = 0;
            if (hg < 72) { mixer = 0; H = 24; qoff = OFF_QA; koff = OFF_KA; voff = OFF_VA; kind = hg < 48 ? 0 : 1; isk = hg >= 24; hh = hg % 24; }
            else if (hg < 96) { mixer = 1; qoff = OFF_QB; koff = OFF_KB; voff = OFF_VB; kind = hg < 88 ? 0 : 1; isk = hg >= 80; hh = (hg - 72) & 7; }
            else if (hg < 105) { kind = 2; isk = hg == 104; hh = hg - 96; }
            else if (hg < 129) { mixer = 2; qoff = OFF_QC; koff = OFF_KC; voff = OFF_VC; kind = hg < 121 ? 0 : 1; isk = hg >= 113; hh = (hg - 105) & 7; }
            else if (hg < 153) kind = 3;
            else if (hg < 201) kind = 4;
            else kind = hg == 201 ? 5 : 6;
            f32x4 gq4[4] = {};
            if (kind == 0) {
                const float* gq = p->qk_g + ((size_t)(layer * 3 + mixer) * 2 + isk) * 64 + fq * 16;
#pragma unroll
                for (int m = 0; m < 4; ++m) gq4[m] = *(const f32x4*)(gq + m * 4);
            }
#pragma unroll
            for (int bj = 0; bj < 2; ++bj) {
#pragma unroll
                for (int n = 0; n < 2; ++n) {
                    const int rho = bcol + bj * 128 + wc * 32 + n * 16 + fr;
                    const int tl = fold_tok(rho, shf);
                    const float rstd = rstd4[bj][n];
                    const int bl = tl >> 12, s = tl & (S - 1), rb = rho & (S - 1);
                    const int tg = gtok0 + tl;
                    float v[16];
#pragma unroll
                    for (int m = 0; m < 4; ++m)
#pragma unroll
                        for (int j = 0; j < 4; ++j) v[m * 4 + j] = acc[ai][bj][m][n][j] * rstd;

                    if (kind == 0 || kind == 2) {
                        if (kind == 0) {
                            float sq = 0.f;
#pragma unroll
                            for (int i = 0; i < 16; ++i) sq += v[i] * v[i];
                            sq += shx(sq, 16); sq += shx(sq, 32);
                            const float rn = rsqrtf(sq * (1.0f / 64) + 1e-6f) * (isk ? 1.0f : QSCALE);
#pragma unroll
                            for (int m = 0; m < 4; ++m) {
                                const f32x4 g4 = gq4[m];
#pragma unroll
                                for (int j = 0; j < 4; ++j) v[m * 4 + j] *= rn * g4[j];
                            }
                        }
                        if (fq == 0) {
                            const f32x4* cp = (const f32x4*)(cs + (size_t)tg * 8);
#pragma unroll
                            for (int i2 = 0; i2 < 4; ++i2) {
                                const f32x4 c2 = cp[i2];
                                const float x1a = v[2 * i2], x2a = v[8 + 2 * i2], x1b = v[2 * i2 + 1], x2b = v[8 + 2 * i2 + 1];
                                v[2 * i2] = x1a * c2[0] - x2a * c2[1]; v[8 + 2 * i2] = x2a * c2[0] + x1a * c2[1];
                                v[2 * i2 + 1] = x1b * c2[2] - x2b * c2[3]; v[8 + 2 * i2 + 1] = x2b * c2[2] + x1b * c2[3];
                            }
                        }
                        u32x4 w0, w1;
#pragma unroll
                        for (int i = 0; i < 4; ++i) { w0[i] = cvt_pk_bf16(v[2 * i], v[2 * i + 1]); w1[i] = cvt_pk_bf16(v[8 + 2 * i], v[8 + 2 * i + 1]); }
                        if (kind == 0 && isk) {
                            bf16_t* dst = (bf16_t*)(ws + koff) + ((size_t)(bl * H + hh) * 128 + (rb >> 5)) * 2048 + (size_t)(fq * 64 + (rb & 31)) * 8;
                            *(u32x4*)dst = w0; *(u32x4*)(dst + 32 * 8) = w1;
                        } else {
                            bf16_t* dst;
                            if (kind == 0) dst = (bf16_t*)(ws + qoff) + ((size_t)(bl * H + hh) * S + rb) * 64;
                            else dst = isk ? (bf16_t*)(ws + OFF_IK) + (size_t)tl * 64 : (bf16_t*)(ws + OFF_IQ) + ((size_t)(bl * 8 + hh) * S + s) * 64;
                            *(u32x4*)(dst + fq * 16) = w0; *(u32x4*)(dst + fq * 16 + 8) = w1;
                        }
                    } else if (kind == 1) {
                        const int k5 = rb & 31;
                        bf16_t* dst = (bf16_t*)(ws + voff) + ((size_t)(bl * H + hh) * 128 + (rb >> 5)) * 2048 + ((k5 >> 4) * 64 + ((k5 >> 2) & 1) * 32) * 8 + ((k5 >> 3) & 1) * 4 + (k5 & 3)
                                      + ((fq >> 1) * 128 + (fq & 1) * 16) * 8;
#pragma unroll
                        for (int i = 0; i < 16; ++i) dst[i * 8] = f2bf(v[i]);
                    } else if (kind == 3 || kind == 4) {
                        bf16_t* dst = (kind == 3 ? (bf16_t*)(ws + OFF_SZ) + (size_t)tl * 1536 + (hg - 129) * 64 : (bf16_t*)(ws + OFF_SG) + (size_t)tl * 3072 + (hg - 153) * 64) + fq * 16;
#pragma unroll
                        for (int i = 0; i < 16; ++i) { const float sg = __builtin_amdgcn_rcpf(1.0f + __expf(-v[i])); v[i] = kind == 3 ? v[i] * sg : sg; }
                        u32x4 w0, w1;
#pragma unroll
                        for (int i = 0; i < 4; ++i) { w0[i] = cvt_pk_bf16(v[2 * i], v[2 * i + 1]); w1[i] = cvt_pk_bf16(v[8 + 2 * i], v[8 + 2 * i + 1]); }
                        *(u32x4*)dst = w0; *(u32x4*)(dst + 8) = w1;
                    } else if (kind == 5) {
                        if (fq == 0) { f32x4 o0 = {v[0], v[1], v[2], v[3]}, o1 = {v[4], v[5], v[6], v[7]}; float* d = (float*)(ws + OFF_IW) + (size_t)tl * 8; *(f32x4*)d = o0; *(f32x4*)(d + 4) = o1; }
                    }
                }
            }
        }
        (void)lane; (void)sub; (void)tg_unused;
    }
};

struct EpiBr {
    const Params* p;
    DI void operator()(const f32x4 (&acc)[2][2][4][2], int brow, int bcol, int sub, int wr, int wc, int fr, int fq) const {
        char* ws = p->ws;
        const bf16_t* sg = (const bf16_t*)(ws + OFF_SG);
        float* mf = (float*)(ws + OFF_MF);
        bf16_t* mb = (bf16_t*)(ws + OFF_MB);
#pragma unroll
        for (int bj = 0; bj < 2; ++bj)
#pragma unroll
            for (int n = 0; n < 2; ++n) {
                const int tl = bcol + bj * 128 + wc * 32 + n * 16 + fr;
                u32x4 gwv[2][2], pwv[2][2];
#pragma unroll
                for (int ai = 0; ai < 2; ++ai)
#pragma unroll
                    for (int m2 = 0; m2 < 2; ++m2) {
                        const int e = brow + ai * 128 + wr * 64 + fq * 16 + m2 * 8;
                        gwv[ai][m2] = *(const u32x4*)(sg + (size_t)tl * 3072 + sub * 1024 + e);
                        pwv[ai][m2] = (u32x4){0u, 0u, 0u, 0u};
                        if (sub > 0) pwv[ai][m2] = *(const u32x4*)(mb + (size_t)tl * DM + e);
                    }
#pragma unroll
                for (int ai = 0; ai < 2; ++ai)
#pragma unroll
                    for (int m2 = 0; m2 < 2; ++m2) {
                        const int e = brow + ai * 128 + wr * 64 + fq * 16 + m2 * 8;
                        const u32x4 gw = gwv[ai][m2], pw = pwv[ai][m2];
                        bf16_t* mp = mb + (size_t)tl * DM + e;
                        u32x4 ow;
#pragma unroll
                        for (int hh2 = 0; hh2 < 2; ++hh2) {
                            const f32x4 g4 = {__uint_as_float(gw[2 * hh2] << 16), __uint_as_float(gw[2 * hh2] & 0xffff0000u), __uint_as_float(gw[2 * hh2 + 1] << 16), __uint_as_float(gw[2 * hh2 + 1] & 0xffff0000u)};
                            f32x4 r = acc[ai][bj][m2 * 2 + hh2][n] * g4;
                            if (sub > 0) r += (f32x4){__uint_as_float(pw[2 * hh2] << 16), __uint_as_float(pw[2 * hh2] & 0xffff0000u), __uint_as_float(pw[2 * hh2 + 1] << 16), __uint_as_float(pw[2 * hh2 + 1] & 0xffff0000u)};
                            ow[2 * hh2] = cvt_pk_bf16(r[0], r[1]); ow[2 * hh2 + 1] = cvt_pk_bf16(r[2], r[3]);
                        }
                        *(u32x4*)mp = ow;
                    }
                asm volatile("" ::: "memory");
            }
    }
};

struct EpiOut {
    const Params* p; int layer; int gtok0; bool st;
    DI void operator()(const f32x4 (&acc)[2][2][4][2], int brow, int bcol, int sub, int wr, int wc, int fr, int fq) const {
        char* ws = p->ws;
        const float* xin = layer == 0 ? p->x : p->out;
        bf16_t* xb = (bf16_t*)(ws + OFF_XB);
        float* ss = (float*)(ws + OFF_SS);
#pragma unroll
        for (int bj = 0; bj < 2; ++bj)
#pragma unroll
            for (int n = 0; n < 2; ++n) {
                const int tl = bcol + bj * 128 + wc * 32 + n * 16 + fr;
                const size_t tg = (size_t)gtok0 + tl;
                f32x4 xv[2][4];
#pragma unroll
                for (int ai = 0; ai < 2; ++ai)
#pragma unroll
                    for (int m = 0; m < 4; ++m) xv[ai][m] = *(const f32x4*)(xin + tg * DM + brow + ai * 128 + wr * 64 + fq * 16 + m * 4);
#pragma unroll
                for (int ai = 0; ai < 2; ++ai)
#pragma unroll
                    for (int m = 0; m < 4; ++m) {
                        const int e = brow + ai * 128 + wr * 64 + fq * 16 + m * 4;
                        const f32x4 r = xv[ai][m] + acc[ai][bj][m][n];
                        if (st) *(f32x4*)(p->out + tg * DM + e) = r;
                    }
            }
        (void)sub;
    }
};

DI void select_chunk(const Params& p, int bl, int c, char* shm) {
    char* ws = p.ws;
    const bf16_t* IQ = (const bf16_t*)(ws + OFF_IQ);
    const bf16_t* IK = (const bf16_t*)(ws + OFF_IK);
    const float* IW = (const float*)(ws + OFF_IW);
    unsigned* hist = (unsigned*)shm; unsigned* bits = (unsigned*)(shm + 16384);
    int* ctl = (int*)(shm + 24576); int* cnt = ctl, *mn = ctl + 16, *mx = ctl + 32, *bsel = ctl + 48, *needp = ctl + 64;
    u32x2* list = (u32x2*)(shm + 32768);
    const int tid = ltid(), lane = tid & 63, w = __builtin_amdgcn_readfirstlane(tid >> 6), q = lane & 15, g = lane >> 4;
    const int t0 = c * 16, tq = t0 + q;
    __syncthreads();
    for (int i = tid; i < 16 * 256 + 16 * 128; i += NTHREADS) hist[i] = 0;
    if (tid < 16) { cnt[tid] = 0; mn[tid] = 0x7fffffff; mx[tid] = (int)0x80000000; }
    bf16x8 qf[8][2]; float wq[8];
#pragma unroll
    for (int hd = 0; hd < 8; ++hd) {
        const bf16_t* qp = IQ + ((size_t)(bl * 8 + hd) * S + tq) * 64 + g * 8;
        qf[hd][0] = *(const bf16x8*)qp; qf[hd][1] = *(const bf16x8*)(qp + 32);
        wq[hd] = IW[(size_t)(bl * S + tq) * 8 + hd];
    }
    auto loadk = [&](int kt, bf16x8& k0, bf16x8& k1) {
        const bf16_t* kp = IK + ((size_t)bl * S + kt * 16 + q) * 64 + g * 8;
        k0 = *(const bf16x8*)kp; k1 = *(const bf16x8*)(kp + 32);
    };
    auto compute = [&](const bf16x8& k0, const bf16x8& k1) -> f32x4 {
        f32x4 sc = {0.f, 0.f, 0.f, 0.f};
#pragma unroll
        for (int hd = 0; hd < 8; ++hd) {
            f32x4 a = {0.f, 0.f, 0.f, 0.f};
            a = MFMA16(k0, qf[hd][0], a); a = MFMA16(k1, qf[hd][1], a);
#pragma unroll
            for (int j = 0; j < 4; ++j) sc[j] += wq[hd] * fmaxf(a[j], 0.f);
        }
        return sc;
    };
#define SEL_PASS(BODY) do { \
        const int cl = c - 1;     \
        bf16x8 ka0, ka1, kb0, kb1; int kt = w; \
        if (kt <= cl) loadk(kt, ka0, ka1); \
        if (kt + 8 <= cl) loadk(kt + 8, kb0, kb1); \
        for (; kt <= cl; kt += 16) { \
            { const f32x4 sc = compute(ka0, ka1); if (kt + 16 <= cl) loadk(kt + 16, ka0, ka1); const int ktc = kt; const bool diag = false; BODY } \
            if (kt + 8 <= cl) { const f32x4 sc = compute(kb0, kb1); if (kt + 24 <= cl) loadk(kt + 24, kb0, kb1); const int ktc = kt + 8; const bool diag = false; BODY } \
        } \
        if (w == (c & 7)) { loadk(c, ka0, ka1); const f32x4 sc = compute(ka0, ka1); const int ktc = c; const bool diag = true; BODY } \
    } while (0)
#define SEL_OK(j) (!diag || 4 * g + (j) <= q)
    __syncthreads();
    {
        float lo = 3.0e38f, hi = -3.0e38f;
        SEL_PASS({
            _Pragma("unroll") for (int j = 0; j < 4; ++j) if (SEL_OK(j)) { lo = fminf(lo, sc[j]); hi = fmaxf(hi, sc[j]); }
        });
        lo = fminf(lo, shx(lo, 16)); lo = fminf(lo, shx(lo, 32));
        hi = fmaxf(hi, shx(hi, 16)); hi = fmaxf(hi, shx(hi, 32));
        if (g == 0) { atomicMin(&mn[q], f2sort(lo)); atomicMax(&mx[q], f2sort(hi)); }
    }
    __syncthreads();
    const float rlo = sort2f(mn[q]), rhi = sort2f(mx[q]);
    const float rscale = rhi > rlo ? 256.0f / (rhi - rlo) : 0.f;
    SEL_PASS({
        _Pragma("unroll") for (int j = 0; j < 4; ++j) if (SEL_OK(j)) {
            int b = (int)((sc[j] - rlo) * rscale); b = b > 255 ? 255 : (b < 0 ? 0 : b);
            atomicAdd(&hist[q * 256 + b], 1u);
        }
    });
    __syncthreads();
    {
        const int row = tid >> 5, i = tid & 31;
        unsigned c8[8]; unsigned tot = 0;
#pragma unroll
        for (int k = 0; k < 8; ++k) { c8[k] = hist[row * 256 + i * 8 + k]; tot += c8[k]; }
        unsigned above = 0;
        {
            unsigned run = tot;
#pragma unroll
            for (int o = 1; o < 32; o <<= 1) { const int l_ = tid & 63; unsigned v = (unsigned)__builtin_amdgcn_ds_bpermute(((l_ + o) & 63) << 2, (int)run); if (i + o < 32) run += v; }
            above = run - tot;
        }
        const int trow = t0 + row; const unsigned need = trow + 1 < 256 ? trow + 1 : 256;
        if (above < need && above + tot >= need) {
            unsigned a = above;
#pragma unroll
            for (int k = 7; k >= 0; --k) { if (a < need && a + c8[k] >= need) { bsel[row] = i * 8 + k; needp[row] = (int)(need - a); } a += c8[k]; }
        }
    }
    __syncthreads();
    const int bstar = bsel[q];
    SEL_PASS({
        unsigned nib = 0;
        _Pragma("unroll") for (int j = 0; j < 4; ++j) if (SEL_OK(j)) {
            int b = (int)((sc[j] - rlo) * rscale); b = b > 255 ? 255 : (b < 0 ? 0 : b);
            if (b > bstar) nib |= 1u << j;
            else if (b == bstar) { int pos = atomicAdd(&cnt[q], 1); if (pos < SEL_CAP) { u32x2 e; e[0] = (unsigned)f2sort(sc[j]) ^ 0x80000000u; e[1] = ktc * 16 + 4 * g + j; list[q * SEL_CAP + pos] = e; } }
        }
        if (nib) atomicOr(&bits[q * 128 + (ktc >> 1)], nib << ((ktc & 1) * 16 + 4 * g));
    });
    __syncthreads();
    {
        const int row = tid >> 5, i = tid & 31;
        int n = cnt[row]; n = n < SEL_CAP ? n : SEL_CAP;
        const int need = needp[row];
        for (int a = i; a < n; a += 32) {
            const u32x2 ea = list[row * SEL_CAP + a];
            int rank = 0;
            for (int b = 0; b < n; ++b) { const u32x2 eb = list[row * SEL_CAP + b]; rank += (eb[0] > ea[0]) || (eb[0] == ea[0] && eb[1] < ea[1]); }
            if (rank < need) atomicOr(&bits[row * 128 + (ea[1] >> 5)], 1u << (ea[1] & 31));
        }
    }
    __syncthreads();
    unsigned* mask = (unsigned*)(ws + OFF_MASK) + ((size_t)bl * S + t0) * 128;
    for (int i = tid; i < 16 * 128; i += NTHREADS) mask[i] = bits[i];
}

DI void kmean_item(const Params& p, int bl, int h, int n, char* shm) {
    char* ws = p.ws;
    const bf16_t* K = (const bf16_t*)(ws + OFF_KC) + ((size_t)(bl * 8 + h) * 128 + n * 8) * 2048;
    float* red = (float*)shm;
    const int tid = ltid(), c = tid & 255, par = tid >> 8;
    float acc[8] = {0.f, 0.f, 0.f, 0.f, 0.f, 0.f, 0.f, 0.f};
#pragma unroll
    for (int it = 0; it < 4; ++it) {
        const u32x4 v = *(const u32x4*)(K + (size_t)(it * 2 + par) * 2048 + c * 8);
#pragma unroll
        for (int e = 0; e < 4; ++e) { acc[2 * e] += __uint_as_float(v[e] << 16); acc[2 * e + 1] += __uint_as_float(v[e] & 0xffff0000u); }
    }
    __syncthreads();
#pragma unroll
    for (int e = 0; e < 8; ++e) red[(par * 256 + c) * 8 + e] = acc[e];
    __syncthreads();
    if (tid < 64) {
        const int grp = tid >> 3, e = tid & 7;
        float t = 0.f;
        for (int pr = 0; pr < 2; ++pr) for (int r = 0; r < 32; ++r) t += red[(pr * 256 + grp * 32 + r) * 8 + e];
        t *= (1.0f / 256);
        bf16_t hi = f2bf(t); bf16_t lo = f2bf(t - bf2f(hi));
        bf16_t* km = (bf16_t*)(ws + OFF_KM) + (((size_t)(bl * 8 + h) * 16 + n) * 2) * 64;
        km[tid] = hi; km[64 + tid] = lo;
    }
}

struct AttnAcc { f32x16 o0, o1; float nb, l; bool shifted; };
DI void attn_init(AttnAcc& a, float nb) {
    float z = 0.f; asm volatile("" : "+v"(z));
#pragma unroll
    for (int i = 0; i < 16; ++i) { a.o0[i] = z; a.o1[i] = z; }
    a.shifted = __ballot(nb > 90.f) != 0ull;
    a.nb = a.shifted ? nb + z : z; a.l = z;
}
DI float attn_bound(const bf16x8 (&qf)[4], const float* gk) {
    float qs = 0.f;
#pragma unroll
    for (int kk = 0; kk < 4; ++kk)
#pragma unroll
        for (int e = 0; e < 8; ++e) { const float v = bf2f((bf16_t)qf[kk][e]); qs += v * v; }
    qs += shx(qs, 32);
    float gm = fabsf(gk[ltid() & 63]);
    for (int o = 32; o > 0; o >>= 1) gm = fmaxf(gm, shx(gm, o));
    return sqrtf(qs) * gm * 8.1f;
}
struct KVFrag { bf16x8 k[4]; bf16x8 v[2][2]; };
DI void kv_load(KVFrag& f, const bf16_t* Kt, const bf16_t* Vt, int lane) {
#pragma unroll
    for (int kk = 0; kk < 4; ++kk) f.k[kk] = *(const bf16x8*)(Kt + (kk * 64 + lane) * 8);
#pragma unroll
    for (int db = 0; db < 2; ++db)
#pragma unroll
        for (int u = 0; u < 2; ++u) f.v[db][u] = *(const bf16x8*)(Vt + ((db * 2 + u) * 64 + lane) * 8);
}
DI void attn_step(AttnAcc& a, const KVFrag& f, const bf16x8 (&qf)[4], unsigned vm) {
    f32x16 st;
    if (a.shifted) {
#pragma unroll
        for (int i = 0; i < 16; ++i) st[i] = -a.nb;
        st = MFMA32(f.k[0], qf[0], st);
    } else {
        st = MFMA32(f.k[0], qf[0], ((f32x16){0.f, 0.f, 0.f, 0.f, 0.f, 0.f, 0.f, 0.f, 0.f, 0.f, 0.f, 0.f, 0.f, 0.f, 0.f, 0.f}));
    }
#pragma unroll
    for (int kk = 1; kk < 4; ++kk) st = MFMA32(f.k[kk], qf[kk], st);
    float pv[16];
#pragma unroll
    for (int i = 0; i < 16; ++i) pv[i] = fexp2(st[i]);
    if (__ballot(vm != 0xffffu) != 0ull) {
#pragma unroll
        for (int i = 0; i < 16; ++i) pv[i] = __int_as_float(__float_as_int(pv[i]) & __builtin_amdgcn_sbfe((int)vm, i, 1));
    }
    a.l += ((pv[0] + pv[1]) + (pv[2] + pv[3])) + ((pv[4] + pv[5]) + (pv[6] + pv[7])) + (((pv[8] + pv[9]) + (pv[10] + pv[11])) + ((pv[12] + pv[13]) + (pv[14] + pv[15])));
    u32x4 p0, p1;
#pragma unroll
    for (int i = 0; i < 4; ++i) { p0[i] = cvt_pk_bf16(pv[2 * i], pv[2 * i + 1]); p1[i] = cvt_pk_bf16(pv[8 + 2 * i], pv[8 + 2 * i + 1]); }
    const bf16x8 pf0 = __builtin_bit_cast(bf16x8, p0), pf1 = __builtin_bit_cast(bf16x8, p1);
    a.o0 = MFMA32(f.v[0][0], pf0, a.o0); a.o0 = MFMA32(f.v[0][1], pf1, a.o0);
    a.o1 = MFMA32(f.v[1][0], pf0, a.o1); a.o1 = MFMA32(f.v[1][1], pf1, a.o1);
}
DI void load_q(bf16x8 (&qf)[4], const bf16_t* Qrow, int h) {
#pragma unroll
    for (int kk = 0; kk < 4; ++kk) qf[kk] = *(const bf16x8*)(Qrow + kk * 16 + h * 8);
}
DI int koff(int i, int h) { return 8 * (i >> 2) + 4 * h + (i & 3); }

DI void attn_a_item(const Params& p, int layer, int bl, int hh, int rb) {
    char* ws = p.ws;
    const int lane = ltid() & 63, w = __builtin_amdgcn_readfirstlane(ltid() >> 6), r = lane & 31, h = lane >> 5;
    const int g = hh >> 3, sh = 2 * g, n = S >> sh;
    const int row0 = rb * 256 + w * 32;
    const int rr = row0 / n, m0 = row0 % n;
    const bf16_t* Q = (const bf16_t*)(ws + OFF_QA) + (size_t)(bl * 24 + hh) * S * 64;
    const bf16_t* K = (const bf16_t*)(ws + OFF_KA) + (size_t)(bl * 24 + hh) * S * 64;
    const bf16_t* Vt = (const bf16_t*)(ws + OFF_VA) + (size_t)(bl * 24 + hh) * 64 * S;
    bf16x8 qf[4]; load_q(qf, Q + (size_t)(row0 + r) * 64, h);
    AttnAcc a; attn_init(a, attn_bound(qf, p.qk_g + ((size_t)(layer * 3 + 0) * 2 + 1) * 64));
    const int kfirst = m0 >= 128 ? 0 : (128 - m0) / 32;
    const int tile0 = (rr * n + m0 - 128) / 32 + 0;
    auto amask = [&](int k) -> unsigned {
        if (k != 0 && k != 4) return 0xffffu;
        const int mk0 = m0 - 128 + 32 * k; unsigned vm = 0;
#pragma unroll
        for (int i = 0; i < 16; ++i) { const int d = (m0 + r) - (mk0 + koff(i, h)); if (d >= 0 && d <= 128) vm |= 1u << i; }
        return vm;
    };
    KVFrag f0, f1; kv_load(f0, K + (size_t)(tile0 + kfirst) * 2048, Vt + (size_t)(tile0 + kfirst) * 2048, lane);
    for (int k = kfirst; k < 5; k += 2) {
        { const int kn = k + 1 < 5 ? k + 1 : k; kv_load(f1, K + (size_t)(tile0 + kn) * 2048, Vt + (size_t)(tile0 + kn) * 2048, lane); }
        attn_step(a, f0, qf, amask(k));
        if (k + 1 < 5) {
            { const int kn = k + 2 < 5 ? k + 2 : k + 1; kv_load(f0, K + (size_t)(tile0 + kn) * 2048, Vt + (size_t)(tile0 + kn) * 2048, lane); }
            attn_step(a, f1, qf, amask(k + 1));
        }
    }
    const float l = a.l + shx(a.l, 32);
    const float inv = 1.0f / l;
    const int s = ((m0 + r) << sh) + rr;
    const size_t tl = (size_t)bl * S + s;
    bf16_t* o = (bf16_t*)(ws + OFF_OA) + ((size_t)g * TG + tl) * 512 + (hh & 7) * 64;
#pragma unroll
    for (int q4 = 0; q4 < 4; ++q4) {
        u32x2 w0, w1;
        w0[0] = cvt_pk_bf16(a.o0[q4 * 4] * inv, a.o0[q4 * 4 + 1] * inv); w0[1] = cvt_pk_bf16(a.o0[q4 * 4 + 2] * inv, a.o0[q4 * 4 + 3] * inv);
        w1[0] = cvt_pk_bf16(a.o1[q4 * 4] * inv, a.o1[q4 * 4 + 1] * inv); w1[1] = cvt_pk_bf16(a.o1[q4 * 4 + 2] * inv, a.o1[q4 * 4 + 3] * inv);
        *(u32x2*)(o + 8 * q4 + 4 * h) = w0; *(u32x2*)(o + 32 + 8 * q4 + 4 * h) = w1;
    }
    if (h == 0) ((float*)(ws + OFF_LSE))[((size_t)g * TG + tl) * 8 + (hh & 7)] = (a.nb + __log2f(l)) * LN2F;
}

DI void attn_store_gated(const Params& p, const AttnAcc& a, size_t tl, int col0, int h, bool st) {
    const float l = a.l + shx(a.l, 32);
    const float inv = 1.0f / l;
    bf16_t* z = (bf16_t*)(p.ws + OFF_SZ) + tl * 1536 + col0;
#pragma unroll
    for (int q4 = 0; q4 < 4; ++q4) {
#pragma unroll
        for (int db = 0; db < 2; ++db) {
            bf16_t* zp = z + db * 32 + 8 * q4 + 4 * h;
            const u32x2 zw = *(const u32x2*)zp;
            const float z0 = __uint_as_float(zw[0] << 16), z1 = __uint_as_float(zw[0] & 0xffff0000u), z2 = __uint_as_float(zw[1] << 16), z3 = __uint_as_float(zw[1] & 0xffff0000u);
            const f32x16& o = db ? a.o1 : a.o0;
            u32x2 wv; wv[0] = cvt_pk_bf16(o[q4 * 4] * inv * z0, o[q4 * 4 + 1] * inv * z1); wv[1] = cvt_pk_bf16(o[q4 * 4 + 2] * inv * z2, o[q4 * 4 + 3] * inv * z3);
            if (st) *(u32x2*)zp = wv;
        }
    }
}

DI void attn_b_item(const Params& p, int layer, int bl, int hd, int qb, bool st, int var) {
    char* ws = p.ws;
    const int lane = ltid() & 63, w = __builtin_amdgcn_readfirstlane(ltid() >> 6), r = lane & 31, h = lane >> 5;
    const int q0 = qb * 256 + w * 32;
    const bf16_t* Q = (const bf16_t*)(ws + OFF_QB) + (size_t)(bl * 8 + hd) * S * 64;
    const bf16_t* K = (const bf16_t*)(ws + OFF_KB) + (size_t)(bl * 8 + hd) * S * 64;
    const bf16_t* Vt = (const bf16_t*)(ws + OFF_VB) + (size_t)(bl * 8 + hd) * 64 * S;
    const unsigned* mrow = (const unsigned*)(ws + OFF_MASK) + ((size_t)bl * S + q0 + r) * 128;
    bf16x8 qf[4]; load_q(qf, Q + (size_t)(q0 + r) * 64, h);
    AttnAcc a; attn_init(a, attn_bound(qf, p.qk_g + ((size_t)(layer * 3 + 1) * 2 + 1) * 64));
    const int nkt = q0 / 32 + 1;
    auto bmask = [&](unsigned mw) -> unsigned {
        const unsigned ws4 = mw >> (4 * h);
        return (ws4 & 0xfu) | ((ws4 >> 4) & 0xf0u) | ((ws4 >> 8) & 0xf00u) | ((ws4 >> 12) & 0xf000u);
    };
    KVFrag f0, f1; kv_load(f0, K, Vt, lane);
    unsigned mw0 = mrow[0], mw1 = 0;
    const int tmul = var == 1 ? 0 : 1;
    for (int kt = 0; kt < nkt; kt += 2) {
        { const int kn = (kt + 1 < nkt ? kt + 1 : kt) * tmul; kv_load(f1, K + (size_t)kn * 2048, Vt + (size_t)kn * 2048, lane); mw1 = mrow[kn]; }
        if (var == 2) a.l += __int_as_float((int)f0.k[0][0] + (int)f0.k[3][7] + (int)f0.v[0][0][0] + (int)f0.v[1][1][7] + (int)mw0); else
        attn_step(a, f0, qf, bmask(mw0));
        if (kt + 1 < nkt) {
            { const int kn = (kt + 2 < nkt ? kt + 2 : kt + 1) * tmul; kv_load(f0, K + (size_t)kn * 2048, Vt + (size_t)kn * 2048, lane); mw0 = mrow[kn]; }
            if (var == 2) a.l += __int_as_float((int)f1.k[0][0] + (int)f1.k[3][7] + (int)f1.v[0][0][0] + (int)f1.v[1][1][7] + (int)mw1); else
            attn_step(a, f1, qf, bmask(mw1));
        }
    }
    attn_store_gated(p, a, (size_t)bl * S + q0 + r, 512 + hd * 64, h, st);
}

DI void attn_c_item(const Params& p, int layer, int bl, int hd, int qb, bool st) {
    char* ws = p.ws;
    const int lane = ltid() & 63, w = __builtin_amdgcn_readfirstlane(ltid() >> 6), r = lane & 31, h = lane >> 5;
    const int q0 = qb * 256 + w * 32, own = qb;
    const bf16_t* Q = (const bf16_t*)(ws + OFF_QC) + (size_t)(bl * 8 + hd) * S * 64;
    const bf16_t* K = (const bf16_t*)(ws + OFF_KC) + (size_t)(bl * 8 + hd) * S * 64;
    const bf16_t* Vt = (const bf16_t*)(ws + OFF_VC) + (size_t)(bl * 8 + hd) * 64 * S;
    bf16x8 qf[4]; load_q(qf, Q + (size_t)(q0 + r) * 64, h);
    unsigned sel = 0;
    if (own > 0) {
        const bf16_t* km = (const bf16_t*)(ws + OFF_KM) + (((size_t)(bl * 8 + hd) * 16 + (r & 15)) * 2) * 64;
        f32x16 gt;
#pragma unroll
        for (int i = 0; i < 16; ++i) gt[i] = 0.f;
#pragma unroll
        for (int kk = 0; kk < 4; ++kk) {
            bf16x8 ahi = *(const bf16x8*)(km + kk * 16 + h * 8), alo = *(const bf16x8*)(km + 64 + kk * 16 + h * 8);
            if (r >= 16) { ahi = (bf16x8){0, 0, 0, 0, 0, 0, 0, 0}; alo = ahi; }
            gt = MFMA32(ahi, qf[kk], gt); gt = MFMA32(alo, qf[kk], gt);
        }
        float gl[16];
#pragma unroll
        for (int i = 0; i < 8; ++i) {
            const float mine = gt[i], oth = shx(mine, 32);
            const int blk_mine = 8 * (i >> 2) + 4 * h + (i & 3), blk_oth = 8 * (i >> 2) + 4 * (1 - h) + (i & 3);
            (void)blk_mine; (void)blk_oth;
            gl[8 * (i >> 2) + (i & 3)] = h == 0 ? mine : oth;
            gl[8 * (i >> 2) + 4 + (i & 3)] = h == 0 ? oth : mine;
        }
#pragma unroll
        for (int pick = 0; pick < 3; ++pick) {
            float best = -3.0e38f; int bi = -1;
#pragma unroll
            for (int nb = 0; nb < 16; ++nb) { const bool ok = nb < own && !((sel >> nb) & 1u); if (ok && gl[nb] > best) { best = gl[nb]; bi = nb; } }
            if (bi >= 0) sel |= 1u << bi;
        }
    }
    AttnAcc a; attn_init(a, attn_bound(qf, p.qk_g + ((size_t)(layer * 3 + 2) * 2 + 1) * 64));
    unsigned vis = 0;
    for (int nb = 0; nb < own; ++nb) if (__ballot((sel >> nb) & 1u) != 0ull) vis |= 1u << nb;
    const int ndiag = q0 / 32;
    unsigned long long tm0 = 0ull, tm1 = 0ull;
    for (int nb = 0; nb < own; ++nb) if ((vis >> nb) & 1u) { if (nb < 8) tm0 |= 0xffull << (8 * nb); else tm1 |= 0xffull << (8 * (nb - 8)); }
    for (int t = own * 8; t <= ndiag; ++t) { if (t < 64) tm0 |= 1ull << t; else tm1 |= 1ull << (t - 64); }
    int ntl = __builtin_popcountll(tm0) + __builtin_popcountll(tm1);
    auto pop = [&]() -> int { int t; if (tm0) { t = __builtin_ctzll(tm0); tm0 &= tm0 - 1; } else if (tm1) { t = 64 + __builtin_ctzll(tm1); tm1 &= tm1 - 1; } else t = ndiag; return t; };
    auto cmask = [&](int t) -> unsigned {
        const int cb = t >> 3;
        if (cb < own) return ((sel >> cb) & 1u) ? 0xffffu : 0u;
        if (t != ndiag) return 0xffffu;
        unsigned vm = 0;
#pragma unroll
        for (int i = 0; i < 16; ++i) if (koff(i, h) <= r) vm |= 1u << i;
        return vm;
    };
    KVFrag f0, f1; int t0 = pop(), t1 = 0;
    kv_load(f0, K + (size_t)t0 * 2048, Vt + (size_t)t0 * 2048, lane);
    for (int it = 0; it < ntl; it += 2) {
        t1 = pop(); kv_load(f1, K + (size_t)t1 * 2048, Vt + (size_t)t1 * 2048, lane);
        attn_step(a, f0, qf, cmask(t0));
        if (it + 1 < ntl) {
            t0 = pop(); kv_load(f0, K + (size_t)t0 * 2048, Vt + (size_t)t0 * 2048, lane);
            attn_step(a, f1, qf, cmask(t1));
        }
    }
    attn_store_gated(p, a, (size_t)bl * S + q0 + r, 1024 + hd * 64, h, st);
}

DI void attn_bc_item(const Params& p, int layer, int typ, int bl, int hd, int qb, bool st, char* shm) {
    char* ws = p.ws;
    const int tid = ltid(), lane = tid & 63, w = tid >> 6, r = lane & 31, h = lane >> 5;
    const int q0 = qb * 256 + w * 32, own = qb, ndiag = q0 / 32;
    const bf16_t* Q = (const bf16_t*)(ws + (typ ? OFF_QC : OFF_QB)) + (size_t)(bl * 8 + hd) * S * 64;
    const bf16_t* K = (const bf16_t*)(ws + (typ ? OFF_KC : OFF_KB)) + (size_t)(bl * 8 + hd) * S * 64;
    const bf16_t* Vt = (const bf16_t*)(ws + (typ ? OFF_VC : OFF_VB)) + (size_t)(bl * 8 + hd) * 64 * S;
    const unsigned* mrow = (const unsigned*)(ws + OFF_MASK) + ((size_t)bl * S + q0 + r) * 128;
    unsigned short* seq = (unsigned short*)(shm + 16384);
    unsigned* wvis = (unsigned*)(shm + 16896);
    bf16x8 qf[4]; load_q(qf, Q + (size_t)(q0 + r) * 64, h);
    unsigned sel = 0, vis = 0;
    if (typ == 1 && own > 0) {
        const bf16_t* km = (const bf16_t*)(ws + OFF_KM) + (((size_t)(bl * 8 + hd) * 16 + (r & 15)) * 2) * 64;
        f32x16 gt;
#pragma unroll
        for (int i = 0; i < 16; ++i) gt[i] = 0.f;
#pragma unroll
        for (int kk = 0; kk < 4; ++kk) {
            bf16x8 ahi = *(const bf16x8*)(km + kk * 16 + h * 8), alo = *(const bf16x8*)(km + 64 + kk * 16 + h * 8);
            if (r >= 16) { ahi = (bf16x8){0, 0, 0, 0, 0, 0, 0, 0}; alo = ahi; }
            gt = MFMA32(ahi, qf[kk], gt); gt = MFMA32(alo, qf[kk], gt);
        }
        float gl[16];
#pragma unroll
        for (int i = 0; i < 8; ++i) {
            const float mine = gt[i], oth = shx(mine, 32);
            gl[8 * (i >> 2) + (i & 3)] = h == 0 ? mine : oth;
            gl[8 * (i >> 2) + 4 + (i & 3)] = h == 0 ? oth : mine;
        }
#pragma unroll
        for (int pick = 0; pick < 3; ++pick) {
            float best = -3.0e38f; int bi = -1;
#pragma unroll
            for (int nb = 0; nb < 16; ++nb) { const bool ok = nb < own && !((sel >> nb) & 1u); if (ok && gl[nb] > best) { best = gl[nb]; bi = nb; } }
            if (bi >= 0) sel |= 1u << bi;
        }
        for (int nb = 0; nb < own; ++nb) if (__ballot((sel >> nb) & 1u) != 0ull) vis |= 1u << nb;
    }
    if (typ == 0) vis = (1u << own) - 1u;
    __syncthreads();
    if (lane == 0) wvis[w] = vis;
    __syncthreads();
    if (tid == 0) {
        unsigned bv = 0;
        for (int i = 0; i < 8; ++i) bv |= wvis[i];
        int n = 0;
        for (int nb = 0; nb < own; ++nb) if ((bv >> nb) & 1u) for (int k = 0; k < 8; ++k) seq[n++] = (unsigned short)(nb * 8 + k);
        for (int k = 0; k < 8; ++k) seq[n++] = (unsigned short)(own * 8 + k);
        seq[255] = (unsigned short)n;
    }
    __syncthreads();
    const int ntl = seq[255];
    const bf16_t* gsrc = (tid < 256 ? K : Vt) + (size_t)(tid & 255) * 8;
    char* lds_dst = shm + tid * 16;
    u32x4 R = *(const u32x4*)(gsrc + (size_t)seq[0] * 2048);
    *(u32x4*)lds_dst = R;
    if (ntl > 1) R = *(const u32x4*)(gsrc + (size_t)seq[1] * 2048);
    AttnAcc a; attn_init(a, attn_bound(qf, p.qk_g + ((size_t)(layer * 3 + 1 + typ) * 2 + 1) * 64));
    unsigned mw = typ == 0 ? mrow[seq[0]] : 0u;
    __syncthreads();
    for (int t = 0; t < ntl; ++t) {
        const int ct = seq[t], cb = ct >> 3;
        unsigned mwn = 0;
        if (typ == 0 && t + 1 < ntl) mwn = mrow[seq[t + 1]];
        const bool need = cb < own ? ((vis >> cb) & 1u) != 0u : ct <= ndiag;
        if (need) {
            const char* buf = shm + (t & 1) * 8192;
            KVFrag f;
#pragma unroll
            for (int kk = 0; kk < 4; ++kk) f.k[kk] = *(const bf16x8*)(buf + (kk * 64 + lane) * 16);
#pragma unroll
            for (int db = 0; db < 2; ++db)
#pragma unroll
                for (int u = 0; u < 2; ++u) f.v[db][u] = *(const bf16x8*)(buf + 4096 + ((db * 2 + u) * 64 + lane) * 16);
            unsigned vm;
            if (typ == 0) {
                const unsigned ws4 = mw >> (4 * h);
                vm = (ws4 & 0xfu) | ((ws4 >> 4) & 0xf0u) | ((ws4 >> 8) & 0xf00u) | ((ws4 >> 12) & 0xf000u);
            } else if (cb < own) vm = ((sel >> cb) & 1u) ? 0xffffu : 0u;
            else if (ct == ndiag) {
                vm = 0;
#pragma unroll
                for (int i = 0; i < 16; ++i) if (koff(i, h) <= r) vm |= 1u << i;
            } else vm = 0xffffu;
            attn_step(a, f, qf, vm);
        }
        if (t + 1 < ntl) {
            *(u32x4*)(lds_dst + ((t + 1) & 1) * 8192) = R;
            if (t + 2 < ntl) R = *(const u32x4*)(gsrc + (size_t)seq[t + 2] * 2048);
        }
        mw = mwn;
        __syncthreads();
    }
    attn_store_gated(p, a, (size_t)bl * S + q0 + r, (typ ? 1024 : 512) + hd * 64, h, st);
}

template <int TYP>
DI void attn_step2(AttnAcc& a0, AttnAcc& a1, KVFrag& f, const bf16x8 (&qa)[4], const bf16x8 (&qb)[4], unsigned vm0, unsigned vm1, bool shifted, const bf16_t* Kn, const bf16_t* Vn, int lane) {
    f32x16 s0, s1;
    __builtin_amdgcn_s_setprio(1);
    if (shifted) {
#pragma unroll
        for (int i = 0; i < 16; ++i) { s0[i] = -a0.nb; s1[i] = -a1.nb; }
        s0 = MFMA32(f.k[0], qa[0], s0); s1 = MFMA32(f.k[0], qb[0], s1);
    } else {
        const f32x16 z = {0.f, 0.f, 0.f, 0.f, 0.f, 0.f, 0.f, 0.f, 0.f, 0.f, 0.f, 0.f, 0.f, 0.f, 0.f, 0.f};
        s0 = MFMA32(f.k[0], qa[0], z); s1 = MFMA32(f.k[0], qb[0], z);
    }
#pragma unroll
    for (int kk = 1; kk < 4; ++kk) { s0 = MFMA32(f.k[kk], qa[kk], s0); s1 = MFMA32(f.k[kk], qb[kk], s1); }
    __builtin_amdgcn_s_setprio(0);
#pragma unroll
    for (int kk = 0; kk < 4; ++kk) f.k[kk] = *(const bf16x8*)(Kn + (kk * 64 + lane) * 8);
    float p0[16], p1[16];
#pragma unroll
    for (int i = 0; i < 16; ++i) { p0[i] = fexp2(s0[i]); p1[i] = fexp2(s1[i]); }
    if (TYP == 0 || __ballot((vm0 & vm1) != 0xffffu) != 0ull) {
#pragma unroll
        for (int i = 0; i < 16; ++i) {
            p0[i] = __int_as_float(__float_as_int(p0[i]) & __builtin_amdgcn_sbfe((int)vm0, i, 1));
            p1[i] = __int_as_float(__float_as_int(p1[i]) & __builtin_amdgcn_sbfe((int)vm1, i, 1));
        }
    }
    a0.l += ((p0[0] + p0[1]) + (p0[2] + p0[3])) + ((p0[4] + p0[5]) + (p0[6] + p0[7])) + (((p0[8] + p0[9]) + (p0[10] + p0[11])) + ((p0[12] + p0[13]) + (p0[14] + p0[15])));
    a1.l += ((p1[0] + p1[1]) + (p1[2] + p1[3])) + ((p1[4] + p1[5]) + (p1[6] + p1[7])) + (((p1[8] + p1[9]) + (p1[10] + p1[11])) + ((p1[12] + p1[13]) + (p1[14] + p1[15])));
    u32x4 w00, w01, w10, w11;
#pragma unroll
    for (int i = 0; i < 4; ++i) {
        w00[i] = cvt_pk_bf16(p0[2 * i], p0[2 * i + 1]); w01[i] = cvt_pk_bf16(p0[8 + 2 * i], p0[8 + 2 * i + 1]);
        w10[i] = cvt_pk_bf16(p1[2 * i], p1[2 * i + 1]); w11[i] = cvt_pk_bf16(p1[8 + 2 * i], p1[8 + 2 * i + 1]);
    }
    const bf16x8 f00 = __builtin_bit_cast(bf16x8, w00), f01 = __builtin_bit_cast(bf16x8, w01), f10 = __builtin_bit_cast(bf16x8, w10), f11 = __builtin_bit_cast(bf16x8, w11);
    __builtin_amdgcn_s_setprio(1);
    a0.o0 = MFMA32(f.v[0][0], f00, a0.o0); a1.o0 = MFMA32(f.v[0][0], f10, a1.o0);
    a0.o0 = MFMA32(f.v[0][1], f01, a0.o0); a1.o0 = MFMA32(f.v[0][1], f11, a1.o0);
    a0.o1 = MFMA32(f.v[1][0], f00, a0.o1); a1.o1 = MFMA32(f.v[1][0], f10, a1.o1);
    a0.o1 = MFMA32(f.v[1][1], f01, a0.o1); a1.o1 = MFMA32(f.v[1][1], f11, a1.o1);
    __builtin_amdgcn_s_setprio(0);
#pragma unroll
    for (int db = 0; db < 2; ++db)
#pragma unroll
        for (int u = 0; u < 2; ++u) f.v[db][u] = *(const bf16x8*)(Vn + ((db * 2 + u) * 64 + lane) * 8);
}
template <int TYP>
DI void attn_bc2_chunk(const Params& p, int layer, int bl, int hd, int cidx  , bool st) {
    char* ws = p.ws;
    const int lane = ltid() & 63, w = __builtin_amdgcn_readfirstlane(ltid() >> 6), r = lane & 31, h = lane >> 5;
    const int own = cidx >> 2, q0 = cidx * 64;
    const bf16_t* Q = (const bf16_t*)(ws + (TYP ? OFF_QC : OFF_QB)) + (size_t)(bl * 8 + hd) * S * 64;
    const bf16_t* K = (const bf16_t*)(ws + (TYP ? OFF_KC : OFF_KB)) + (size_t)(bl * 8 + hd) * S * 64;
    const bf16_t* Vt = (const bf16_t*)(ws + (TYP ? OFF_VC : OFF_VB)) + (size_t)(bl * 8 + hd) * 64 * S;
    const unsigned* mrow0 = (const unsigned*)(ws + OFF_MASK) + ((size_t)bl * S + q0 + r) * 128;
    const unsigned* mrow1 = mrow0 + 32 * 128;
    bf16x8 qa[4], qb[4];
    load_q(qa, Q + (size_t)(q0 + r) * 64, h); load_q(qb, Q + (size_t)(q0 + 32 + r) * 64, h);
    const float* gk = p.qk_g + ((size_t)(layer * 3 + 1 + TYP) * 2 + 1) * 64;
    AttnAcc a0, a1; attn_init(a0, attn_bound(qa, gk)); attn_init(a1, attn_bound(qb, gk));
    const bool shifted = a0.shifted || a1.shifted;
    if (shifted && !a0.shifted) a0.nb = 0.f;
    if (shifted && !a1.shifted) a1.nb = 0.f;
    const int d0 = q0 / 32, d1 = d0 + 1;
    unsigned sel0 = 0, sel1 = 0;
    unsigned long long tm0 = 0ull, tm1 = 0ull;
    if (TYP == 1) {
        if (own > 0) {
            const bf16_t* km = (const bf16_t*)(ws + OFF_KM) + (((size_t)(bl * 8 + hd) * 16 + (r & 15)) * 2) * 64;
            f32x16 g0, g1;
#pragma unroll
            for (int i = 0; i < 16; ++i) { g0[i] = 0.f; g1[i] = 0.f; }
#pragma unroll
            for (int kk = 0; kk < 4; ++kk) {
                bf16x8 ahi = *(const bf16x8*)(km + kk * 16 + h * 8), alo = *(const bf16x8*)(km + 64 + kk * 16 + h * 8);
                if (r >= 16) { ahi = (bf16x8){0, 0, 0, 0, 0, 0, 0, 0}; alo = ahi; }
                g0 = MFMA32(ahi, qa[kk], g0); g0 = MFMA32(alo, qa[kk], g0);
                g1 = MFMA32(ahi, qb[kk], g1); g1 = MFMA32(alo, qb[kk], g1);
            }
            auto top3 = [&](const f32x16& gt) -> unsigned {
                float gl[16];
#pragma unroll
                for (int i = 0; i < 8; ++i) {
                    const float mine = gt[i], oth = shx(mine, 32);
                    gl[8 * (i >> 2) + (i & 3)] = h == 0 ? mine : oth;
                    gl[8 * (i >> 2) + 4 + (i & 3)] = h == 0 ? oth : mine;
                }
                unsigned sel = 0;
#pragma unroll
                for (int pick = 0; pick < 3; ++pick) {
                    float best = -3.0e38f; int bi = -1;
#pragma unroll
                    for (int nb = 0; nb < 16; ++nb) { const bool ok = nb < own && !((sel >> nb) & 1u); if (ok && gl[nb] > best) { best = gl[nb]; bi = nb; } }
                    if (bi >= 0) sel |= 1u << bi;
                }
                return sel;
            };
            sel0 = top3(g0); sel1 = top3(g1);
        }
        for (int nb = 0; nb < own; ++nb) if (__ballot(((sel0 | sel1) >> nb) & 1u) != 0ull) { if (nb < 8) tm0 |= 0xffull << (8 * nb); else tm1 |= 0xffull << (8 * (nb - 8)); }
        for (int t = own * 8; t <= d1; ++t) { if (t < 64) tm0 |= 1ull << t; else tm1 |= 1ull << (t - 64); }
    } else {
        for (int t = 0; t <= d1; ++t) { if (t < 64) tm0 |= 1ull << t; else tm1 |= 1ull << (t - 64); }
    }
    const int ntl = __builtin_popcountll(tm0) + __builtin_popcountll(tm1);
    auto pop = [&]() -> int { int t; if (tm0) { t = __builtin_ctzll(tm0); tm0 &= tm0 - 1; } else if (tm1) { t = 64 + __builtin_ctzll(tm1); tm1 &= tm1 - 1; } else t = d1; return t; };
    auto cmask = [&](int t, unsigned sel, int dg) -> unsigned {
        const int cb = t >> 3;
        if (cb < own) return ((sel >> cb) & 1u) ? 0xffffu : 0u;
        if (t < dg) return 0xffffu;
        if (t > dg) return 0u;
        unsigned vm = 0;
#pragma unroll
        for (int i = 0; i < 16; ++i) if (koff(i, h) <= r) vm |= 1u << i;
        return vm;
    };
    auto bmask = [&](unsigned mw) -> unsigned {
        const unsigned ws4 = mw >> (4 * h);
        return (ws4 & 0xfu) | ((ws4 >> 4) & 0xf0u) | ((ws4 >> 8) & 0xf00u) | ((ws4 >> 12) & 0xf000u);
    };
    KVFrag f; int tc = pop(), tn = 0;
    kv_load(f, K + (size_t)tc * 2048, Vt + (size_t)tc * 2048, lane);
    unsigned mwa = 0, mwb = 0, mwan = 0, mwbn = 0;
    if (TYP == 0) { mwa = mrow0[tc]; mwb = mrow1[tc]; }
    for (int it = 0; it < ntl; ++it) {
        tn = pop();
        if (TYP == 0) { mwan = mrow0[tn]; mwbn = mrow1[tn]; }
        unsigned vm0, vm1;
        if (TYP == 0) { vm0 = bmask(mwa); vm1 = bmask(mwb); } else { vm0 = cmask(tc, sel0, d0); vm1 = cmask(tc, sel1, d1); }
        attn_step2<TYP>(a0, a1, f, qa, qb, vm0, vm1, shifted, K + (size_t)tn * 2048, Vt + (size_t)tn * 2048, lane);
        tc = tn; mwa = mwan; mwb = mwbn;
    }
    attn_store_gated(p, a0, (size_t)bl * S + q0 + r, (TYP ? 1024 : 512) + hd * 64, h, st);
    attn_store_gated(p, a1, (size_t)bl * S + q0 + 32 + r, (TYP ? 1024 : 512) + hd * 64, h, st);
}

DI void attn_a2_item(const Params& p, int layer, int bl, int hh, int rb2) {
    char* ws = p.ws;
    const int lane = ltid() & 63, w = __builtin_amdgcn_readfirstlane(ltid() >> 6), r = lane & 31, h = lane >> 5;
    const int g = hh >> 3, sh = 2 * g, n = S >> sh;
    const int row0 = rb2 * 512 + w * 64;
    const int rr = row0 / n, m0 = row0 % n;
    const bf16_t* Q = (const bf16_t*)(ws + OFF_QA) + (size_t)(bl * 24 + hh) * S * 64;
    const bf16_t* K = (const bf16_t*)(ws + OFF_KA) + (size_t)(bl * 24 + hh) * S * 64;
    const bf16_t* Vt = (const bf16_t*)(ws + OFF_VA) + (size_t)(bl * 24 + hh) * 64 * S;
    bf16x8 qa[4], qb[4];
    load_q(qa, Q + (size_t)(row0 + r) * 64, h); load_q(qb, Q + (size_t)(row0 + 32 + r) * 64, h);
    const float* gk = p.qk_g + ((size_t)(layer * 3 + 0) * 2 + 1) * 64;
    AttnAcc a0, a1; attn_init(a0, attn_bound(qa, gk)); attn_init(a1, attn_bound(qb, gk));
    const bool shifted = a0.shifted || a1.shifted;
    if (shifted && !a0.shifted) a0.nb = 0.f;
    if (shifted && !a1.shifted) a1.nb = 0.f;
    const int kfirst = m0 >= 128 ? 0 : (128 - m0) / 32;
    const int tile0 = (rr * n + m0 - 128) / 32;
    auto amask = [&](int k, int sb) -> unsigned {
        const int base = 128 + 32 * sb - 32 * k + r;
        if (base - 31 >= 0 && base <= 128) return 0xffffu;
        if (base < 0 || base - 31 > 128) return 0u;
        unsigned vm = 0;
#pragma unroll
        for (int i = 0; i < 16; ++i) { const int d = base - koff(i, h); if (d >= 0 && d <= 128) vm |= 1u << i; }
        return vm;
    };
    KVFrag f; kv_load(f, K + (size_t)(tile0 + kfirst) * 2048, Vt + (size_t)(tile0 + kfirst) * 2048, lane);
    for (int k = kfirst; k < 6; ++k) {
        const int kn = k + 1 < 6 ? k + 1 : k;
        attn_step2<1>(a0, a1, f, qa, qb, amask(k, 0), amask(k, 1), shifted, K + (size_t)(tile0 + kn) * 2048, Vt + (size_t)(tile0 + kn) * 2048, lane);
    }
#pragma unroll
    for (int sb = 0; sb < 2; ++sb) {
        const AttnAcc& a = sb ? a1 : a0;
        const float l = a.l + shx(a.l, 32);
        const float inv = 1.0f / l;
        const int s_ = ((m0 + 32 * sb + r) << sh) + rr;
        const size_t tl = (size_t)bl * S + s_;
        bf16_t* o = (bf16_t*)(ws + OFF_OA) + ((size_t)g * TG + tl) * 512 + (hh & 7) * 64;
#pragma unroll
        for (int q4 = 0; q4 < 4; ++q4) {
            u32x2 w0, w1;
            w0[0] = cvt_pk_bf16(a.o0[q4 * 4] * inv, a.o0[q4 * 4 + 1] * inv); w0[1] = cvt_pk_bf16(a.o0[q4 * 4 + 2] * inv, a.o0[q4 * 4 + 3] * inv);
            w1[0] = cvt_pk_bf16(a.o1[q4 * 4] * inv, a.o1[q4 * 4 + 1] * inv); w1[1] = cvt_pk_bf16(a.o1[q4 * 4 + 2] * inv, a.o1[q4 * 4 + 3] * inv);
            *(u32x2*)(o + 8 * q4 + 4 * h) = w0; *(u32x2*)(o + 32 + 8 * q4 + 4 * h) = w1;
        }
        if (h == 0) ((float*)(ws + OFF_LSE))[((size_t)g * TG + tl) * 8 + (hh & 7)] = (a.nb + __log2f(l)) * LN2F;
    }
}

DI void merge_a_item(const Params& p, int item, bool st) {
    char* ws = p.ws;
    const int tid = ltid();
    const bf16_t* oa = (const bf16_t*)(ws + OFF_OA);
    const float* lse = (const float*)(ws + OFF_LSE);
    bf16_t* sz = (bf16_t*)(ws + OFF_SZ);
    const int c8 = (tid & 63) * 8, hd = c8 >> 6;
    for (int it = 0; it < 8; it += 4) {
        float l0[4], l1[4], l2[4]; u32x4 a0[4], a1[4], a2[4], zz[4];
#pragma unroll
        for (int u = 0; u < 4; ++u) {
            const size_t tl = (size_t)item * 64 + (it + u) * 8 + (tid >> 6);
            l0[u] = lse[(0 * (size_t)TG + tl) * 8 + hd]; l1[u] = lse[(1 * (size_t)TG + tl) * 8 + hd]; l2[u] = lse[(2 * (size_t)TG + tl) * 8 + hd];
            a0[u] = *(const u32x4*)(oa + (0 * (size_t)TG + tl) * 512 + c8); a1[u] = *(const u32x4*)(oa + (1 * (size_t)TG + tl) * 512 + c8); a2[u] = *(const u32x4*)(oa + (2 * (size_t)TG + tl) * 512 + c8);
            zz[u] = *(const u32x4*)(sz + tl * 1536 + c8);
        }
#pragma unroll
        for (int u = 0; u < 4; ++u) {
            const size_t tl = (size_t)item * 64 + (it + u) * 8 + (tid >> 6);
            const float mx = fmaxf(l0[u], fmaxf(l1[u], l2[u]));
            float w0 = __expf(l0[u] - mx), w1 = __expf(l1[u] - mx), w2 = __expf(l2[u] - mx);
            const float inv = 1.0f / (w0 + w1 + w2); w0 *= inv; w1 *= inv; w2 *= inv;
            u32x4 res;
#pragma unroll
            for (int k = 0; k < 4; ++k) {
                const float lo = (w0 * __uint_as_float(a0[u][k] << 16) + w1 * __uint_as_float(a1[u][k] << 16) + w2 * __uint_as_float(a2[u][k] << 16)) * __uint_as_float(zz[u][k] << 16);
                const float hi = (w0 * __uint_as_float(a0[u][k] & 0xffff0000u) + w1 * __uint_as_float(a1[u][k] & 0xffff0000u) + w2 * __uint_as_float(a2[u][k] & 0xffff0000u)) * __uint_as_float(zz[u][k] & 0xffff0000u);
                res[k] = cvt_pk_bf16(lo, hi);
            }
            if (st) *(u32x4*)(sz + tl * 1536 + c8) = res;
        }
    }
}

DI int snake_item(int round, int G, int bid) { return (round & 1) ? round * G + (G - 1 - bid) : round * G + bid; }

__global__ void __launch_bounds__(NTHREADS) fwd_megakernel(Params p) {
    __shared__ __attribute__((aligned(16))) char shm_raw[SHM_BYTES];
    cg::grid_group grid = cg::this_grid();
    char* ws = p.ws;
    const int G = gridDim.x, bid = blockIdx.x;
    __attribute__((address_space(3))) bf16_t* shm_g = (__attribute__((address_space(3))) bf16_t*)shm_raw;

    unsigned* barcnt = (unsigned*)(ws + OFF_BAR2);
    unsigned bartarget = 0;
    if (bid == 0 && threadIdx.x < 9) __hip_atomic_store(barcnt + 32 * threadIdx.x, 0u, __ATOMIC_RELAXED, __HIP_MEMORY_SCOPE_AGENT);
    if (bid == 0 && threadIdx.x < DEPTH * NGRP * 64) ((unsigned*)(ws + OFF_FLAG))[threadIdx.x] = 0u;
    phase_prep(p, shm_raw);
    if (DUPMASK & 64) { __syncthreads(); phase_prep(p, shm_raw); }
    grid.sync();

#define LAUNDER() do { } while (0)
    unsigned long long tspan = 0ull, tprev = SPINSEL ? wall_clock64() : 0ull;
#define PHASE_END(k) do { if (SPINSEL) { const unsigned long long tn_ = wall_clock64(); if (SPINSEL == (k)) tspan += tn_ - tprev; tprev = tn_; } } while (0)
    for (int layer = 0; layer < DEPTH; ++layer) {
        for (int grp = 0; grp < NGRP; ++grp) {
            const int gtok0 = grp * TG;
            LAUNDER();
            for (int rep = 0; rep <= (DUPMASK & 1); ++rep) {
                EpiIn epi{&p, layer, gtok0};
                gemm_phase<true>((const bf16_t*)(ws + OFF_WTIN), DM, 0, NPAD, (const bf16_t*)(ws + OFF_XB), DM, 0, TG, DM, 1, epi, shm_g);
            }
            grid_barrier(barcnt, bartarget, (unsigned)G);
            if (DUPMASK & 32) grid_barrier(barcnt, bartarget, (unsigned)G);
            PHASE_END(1);
            LAUNDER();
            for (int rep = 0; rep <= ((DUPMASK >> 1) & 1); ++rep) {
                const int nsel = BG * 256;
                const int nA = BG * 24 * 8, nK = BG * 8 * 16;
                const int rS = (nsel + G - 1) / G, rA = (nA + G - 1) / G, rK = (nK + G - 1) / G, rT = rS + rA + rK;
                const int off = (bid & 1) ? rS : 0;
                for (int st_ = 0; st_ < rT; ++st_) {
                    int s2 = st_ + off; if (s2 >= rT) s2 -= rT;
                    if (s2 < rS) {
                        const int it = snake_item(s2, G, bid);
                        if (it < nsel) select_chunk(p, it % BG, 255 - it / BG, shm_raw);
                    } else if (s2 < rS + rA) {
                        const int it = (s2 - rS) * G + bid;
                        if (it < nA) attn_a2_item(p, layer, it / (24 * 8), (it / 8) % 24, it % 8);
                    } else {
                        const int it = (s2 - rS - rA) * G + bid;
                        if (it < nK) kmean_item(p, it / 128, (it / 16) & 7, it & 15, shm_raw);
                    }
                }
            }
            grid_barrier(barcnt, bartarget, (unsigned)G);
            if (DUPMASK & 32) grid_barrier(barcnt, bartarget, (unsigned)G);
            PHASE_END(2);
            LAUNDER();
            for (int rep = ((DUPMASK >> 2) & 1); rep >= 0; --rep) {
                const bool st = rep == 0 || p.dupmask == 0x7fffffff;
#if ATTN64
                const int nbc = 2 * BG * 8 * 4;
                const int wv = __builtin_amdgcn_readfirstlane(ltid() >> 6);
                for (int it = bid; it < nbc; it += G) {
                    const int j = it & 3, sub = it >> 2, typ = sub / (BG * 8), bl = (sub / 8) % BG, hd = sub & 7;
                    const int c0 = j * 8 + wv, c1 = 63 - c0;
                    if (typ == 0) { attn_bc2_chunk<0>(p, layer, bl, hd, c1, st); attn_bc2_chunk<0>(p, layer, bl, hd, c0, st); }
                    else { attn_bc2_chunk<1>(p, layer, bl, hd, c1, st); attn_bc2_chunk<1>(p, layer, bl, hd, c0, st); }
                }
#else
                const int nbc = 2 * BG * 8 * 16;
                for (int rnd = 0;; ++rnd) {
                    const int it = snake_item(rnd, G, bid);
                    if (rnd * G >= nbc) break;
                    if (it < nbc) {
                        const int qb = 15 - it / (2 * BG * 8), sub = it % (2 * BG * 8), typ = sub / (BG * 8), bl = (sub / 8) % BG, hd = sub & 7;
                        {
#if ATTN_LDS
                            attn_bc_item(p, layer, typ, bl, hd, qb, st, shm_raw);
#else
                            if (typ == 0) attn_b_item(p, layer, bl, hd, qb, st, st ? 0 : ((p.dupmask >> 8) & 3)); else if (st || ((p.dupmask >> 10) & 1) == 0) attn_c_item(p, layer, bl, hd, qb, st);
#endif
                        }
                    }
                }
#endif
                for (int it = bid; it < TG / 64; it += G) merge_a_item(p, it, st);
            }
            grid_barrier(barcnt, bartarget, (unsigned)G);
            if (DUPMASK & 32) grid_barrier(barcnt, bartarget, (unsigned)G);
            PHASE_END(3);
            LAUNDER();
            for (int rep = 0; rep <= ((DUPMASK >> 3) & 1); ++rep) {
                EpiBr epi{&p};
                gemm_phase<false>((const bf16_t*)(ws + OFF_WTBR) + (size_t)layer * 3 * DM * 512, 512, (size_t)DM * 512, DM, (const bf16_t*)(ws + OFF_SZ), 1536, 512, TG, 512, 3, epi, shm_g);
            }
            {
                const bool handoff = (DUPMASK == 0) && G == (DM / BM) * (TG / BM);
                if (handoff) {
                    int pm_, pn_; gemm_tile_of(bid, DM / BM, TG / BM, pm_, pn_);
                    unsigned* fl = (unsigned*)(ws + OFF_FLAG) + (layer * NGRP + grp) * 64 + pn_;
                    __syncthreads();
                    if (threadIdx.x == 0) {
                        __builtin_amdgcn_fence(__ATOMIC_RELEASE, "agent");
                        __hip_atomic_fetch_add(fl, 1u, __ATOMIC_RELAXED, __HIP_MEMORY_SCOPE_AGENT);
                        while (__hip_atomic_load(fl, __ATOMIC_RELAXED, __HIP_MEMORY_SCOPE_AGENT) < (unsigned)(DM / BM)) __builtin_amdgcn_s_sleep(1);
                        __builtin_amdgcn_fence(__ATOMIC_ACQUIRE, "agent");
                    }
                    __syncthreads();
                } else {
                    grid_barrier(barcnt, bartarget, (unsigned)G);
                    if (DUPMASK & 32) grid_barrier(barcnt, bartarget, (unsigned)G);
                }
            }
            PHASE_END(4);
            LAUNDER();
            for (int rep = ((DUPMASK >> 4) & 1); rep >= 0; --rep) {
                EpiOut epi{&p, layer, gtok0, rep == 0 || p.dupmask == 0x7fffffff};
                gemm_phase<false>((const bf16_t*)(ws + OFF_WTOUT) + (size_t)layer * DM * DM, DM, 0, DM, (const bf16_t*)(ws + OFF_MB), DM, 0, TG, DM, 1, epi, shm_g);
                if (rep == 0) {
                    const int nl = grp + 1 < NGRP ? layer : layer + 1, ng = grp + 1 < NGRP ? grp + 1 : 0;
                    if (nl < DEPTH) {
                        __syncthreads();
                        const float* xsrc = (nl == 0 ? p.x : (const float*)p.out) + (size_t)ng * TG * DM;
                        int per = (TG + G - 1) / G; int tb = bid * per, te = tb + per < TG ? tb + per : TG;
                        xprep_tokens(xsrc, (bf16_t*)(ws + OFF_XB), (float*)(ws + OFF_SS), tb, te);
                        if (nl != layer) for (int it = bid; it < 16 * 204; it += G) convert_win_tile(p, nl, it, (float*)shm_raw);
                    }
                }
            }
            grid_barrier(barcnt, bartarget, (unsigned)G);
            if (DUPMASK & 32) grid_barrier(barcnt, bartarget, (unsigned)G);
            PHASE_END(5);
        }
    }
    if (SPINSEL) { const unsigned long long t0_ = wall_clock64(); while (wall_clock64() - t0_ < tspan) __builtin_amdgcn_s_sleep(8); }
}

extern "C" void kernel_launch(void* const* d_in, const int* in_sizes, int n_in, void* d_out, int out_size, void* d_ws, size_t ws_size, hipStream_t stream) {
    static int grid_blocks = 0;
    if (!grid_blocks) {
        int dev = 0, cus = 0, per_cu = 0;
        hipGetDevice(&dev);
        hipDeviceGetAttribute(&cus, hipDeviceAttributeMultiprocessorCount, dev);
        hipOccupancyMaxActiveBlocksPerMultiprocessor(&per_cu, fwd_megakernel, NTHREADS, 0);
        if (per_cu > 1) per_cu = 1;
        grid_blocks = cus * per_cu;
    }
    if (ws_size < WS_NEED) { fprintf(stderr, "workspace too small: %zu < %zu\n", ws_size, (size_t)WS_NEED); return; }
    Params p{};
    p.dupmask = DUPMASK; p.pad_ = 0;
    p.x = (const float*)d_in[0]; p.pos = (const int*)d_in[1]; p.norm_g = (const float*)d_in[2]; p.w_in = (const float*)d_in[3];
    p.qk_g = (const float*)d_in[4]; p.w_br = (const float*)d_in[5]; p.w_out = (const float*)d_in[6];
    p.out = (float*)d_out; p.ws = (char*)d_ws;
    void* args[] = {&p};
    hipError_t e = hipLaunchCooperativeKernel((void*)fwd_megakernel, dim3(grid_blocks), dim3(NTHREADS), args, 0, stream);
    if (e != hipSuccess) fprintf(stderr, "cooperative launch failed: %s (grid %d)\n", hipGetErrorString(e), grid_blocks);
}
```
